# Optimizing an MI355X kernel written in HIP

```python
import math
import jax, jax.numpy as jnp
from jax import lax
import numpy as np

D_MODEL = 1024
BATCH = 16
SEQ = 2048
DEPTH = 2

CTX_LEN = 256
GRID_W = 64
Q_BLOCK = 128
ROPE_THETA = 10000.0
EPS = 1e-6
HEAD_DIM = 64
N_BRANCH = 4
BRANCH_WIDTH = 4 * HEAD_DIM
MLA_HEADS = 4
MLA_Q_LORA = 192
MLA_KV_LORA = 128
MLA_NOPE = 64
MLA_ROPE = 32
MLA_V = 64
MLA_QK = MLA_NOPE + MLA_ROPE
NA_HEADS = 4
NA_ROWS = 8
NA_COLS = 16
DIFF_HEADS = 4
DIFF_DIM = 32
GQA_HEADS = 4
GQA_KV_HEADS = 2
D_FF = 4 * D_MODEL
SPLIT_SIZES = (MLA_Q_LORA, MLA_KV_LORA, MLA_ROPE,
               3 * NA_HEADS * HEAD_DIM,
               3 * DIFF_HEADS * 2 * DIFF_DIM,
               (GQA_HEADS + 2 * GQA_KV_HEADS) * HEAD_DIM,
               N_BRANCH * D_MODEL)
IN_COLS = sum(SPLIT_SIZES)

kernel_name = 'hybrid_gated_branch_dit_block'


def rmsnorm(x, g):
    xf = x.astype(jnp.float32)
    y = xf * lax.rsqrt(jnp.mean(xf * xf, axis=-1, keepdims=True) + EPS)
    return (y * g.astype(jnp.float32)).astype(x.dtype)


def modulate(h, shift, scale):
    return h * (1.0 + scale) + shift


def split_last(z, sizes):
    parts, start = [], 0
    for n in sizes:
        parts.append(z[..., start:start + n])
        start += n
    return parts


def flat_heads(o):
    return o.reshape(*o.shape[:2], -1)


def rope_tables(rows, cols, rot_dim):
    n = rot_dim // 4
    inv_freq = jnp.power(ROPE_THETA, -jnp.arange(n, dtype=jnp.float32) / n)
    ang_r = rows.astype(jnp.float32)[:, None] * inv_freq
    ang_c = cols.astype(jnp.float32)[:, None] * inv_freq
    ang = jnp.concatenate([ang_r, ang_r, ang_c, ang_c], axis=-1)
    return jnp.cos(ang), jnp.sin(ang)


def apply_rope(t, cos, sin):
    shape = (cos.shape[0],) + (1,) * (t.ndim - 3) + (cos.shape[-1],)
    cos, sin = cos.reshape(shape), sin.reshape(shape)
    t1, t2, t3, t4 = jnp.split(t, 4, axis=-1)
    rot = jnp.concatenate([-t2, t1, -t4, t3], axis=-1)
    return (t * cos + rot * sin).astype(t.dtype)


def sweep_query_blocks(fn, q):
    B, S = q.shape[:2]
    nb = S // Q_BLOCK
    qb = jnp.moveaxis(q.reshape(B, nb, Q_BLOCK, *q.shape[2:]), 1, 0)
    out = lax.map(fn, qb)
    return jnp.moveaxis(out, 0, 1).reshape(B, S, *out.shape[3:])


def gqa_attention(q, k, v):
    B, _, H, d = q.shape
    n_kv = k.shape[2]
    G = H // n_kv
    scale = d ** -0.5

    def block(qb):
        qb = qb.reshape(B, Q_BLOCK, n_kv, G, d)
        s = jnp.einsum('bqngd,bknd->bngqk', qb, k).astype(jnp.float32) * scale
        p = jax.nn.softmax(s, axis=-1).astype(v.dtype)
        o = jnp.einsum('bngqk,bknd->bqngd', p, v)
        return o.reshape(B, Q_BLOCK, H, v.shape[-1])

    return sweep_query_blocks(block, q)


def mla_mixer(zl, zc, rope, g_qa, w_uq, g_kva, w_ukv, g_q, g_k, need_ctx):
    cos, sin = rope

    def queries(cq):
        q = (rmsnorm(cq, g_qa) @ w_uq).reshape(*cq.shape[:2], MLA_HEADS, MLA_QK)
        return rmsnorm(q, g_q)

    def keys_values(ckv, k_rope):
        kv = (rmsnorm(ckv, g_kva) @ w_ukv).reshape(*ckv.shape[:2], MLA_HEADS, MLA_NOPE + MLA_V)
        k_rope = jnp.broadcast_to(k_rope[:, :, None, :], (*k_rope.shape[:2], MLA_HEADS, MLA_ROPE))
        k = jnp.concatenate([kv[..., :MLA_NOPE], k_rope], axis=-1)
        return rmsnorm(k, g_k), kv[..., MLA_NOPE:]

    def rotate(t):
        return jnp.concatenate([t[..., :MLA_NOPE], apply_rope(t[..., MLA_NOPE:], cos, sin)], axis=-1)

    cq, ckv, kr = zl
    cq_c, ckv_c, kr_c = zc
    ql = rotate(queries(cq))
    kl, vl = keys_values(ckv, kr)
    kl = rotate(kl)
    k_ctx, v_ctx = keys_values(ckv_c, kr_c)
    o = gqa_attention(ql, jnp.concatenate([kl, k_ctx], axis=1), jnp.concatenate([vl, v_ctx], axis=1))
    o_c = flat_heads(gqa_attention(queries(cq_c), k_ctx, v_ctx)) if need_ctx else None
    return flat_heads(o), o_c


def na_mixer(zl, zc, g_q, g_k, rpb, need_ctx):
    def qkv(z):
        z = z.reshape(*z.shape[:2], 3, NA_HEADS, HEAD_DIM)
        return rmsnorm(z[:, :, 0], g_q), rmsnorm(z[:, :, 1], g_k), z[:, :, 2]

    ql, kl, vl = qkv(zl)
    qc, k_ctx, v_ctx = qkv(zc)
    B, S = ql.shape[:2]
    n_rows = S // GRID_W
    win_r = min(NA_ROWS, n_rows)
    win_c = NA_COLS
    n_nb = win_r * win_c
    scale = HEAD_DIM ** -0.5

    def to_grid(t):
        return t.reshape(B, n_rows, GRID_W, NA_HEADS, HEAD_DIM)

    k_grid, v_grid = to_grid(kl), to_grid(vl)
    row_start = jnp.clip(jnp.arange(n_rows) - win_r // 2, 0, n_rows - win_r)
    col = jnp.arange(GRID_W)
    col_idx = jnp.clip(col - win_c // 2, 0, GRID_W - win_c)[:, None] + jnp.arange(win_c)
    dc = col_idx - col[:, None] + (NA_COLS - 1)

    def row_block(args):
        q_row, r = args
        r0 = row_start[r]
        k_nb = jnp.take(lax.dynamic_slice_in_dim(k_grid, r0, win_r, axis=1), col_idx, axis=2)
        v_nb = jnp.take(lax.dynamic_slice_in_dim(v_grid, r0, win_r, axis=1), col_idx, axis=2)
        dr = r0 + jnp.arange(win_r) - r + (NA_ROWS - 1)
        bias = rpb[:, dr[:, None, None], dc[None, :, :]].transpose(0, 2, 1, 3)
        s_nb = jnp.einsum('bqhd,brqchd->bhqrc', q_row, k_nb).astype(jnp.float32) * scale + bias.astype(jnp.float32)
        s_ctx = jnp.einsum('bqhd,bkhd->bhqk', q_row, k_ctx).astype(jnp.float32) * scale
        p = jax.nn.softmax(jnp.concatenate([s_nb.reshape(B, NA_HEADS, GRID_W, n_nb), s_ctx], axis=-1), axis=-1)
        p = p.astype(v_nb.dtype)
        p_nb = p[..., :n_nb].reshape(B, NA_HEADS, GRID_W, win_r, win_c)
        return (jnp.einsum('bhqrc,brqchd->bqhd', p_nb, v_nb)
                + jnp.einsum('bhqk,bkhd->bqhd', p[..., n_nb:], v_ctx))

    out = lax.map(row_block, (jnp.moveaxis(to_grid(ql), 1, 0), jnp.arange(n_rows)))
    o = jnp.moveaxis(out, 0, 1).reshape(B, S, NA_HEADS * HEAD_DIM)
    o_c = flat_heads(gqa_attention(qc, k_ctx, v_ctx)) if need_ctx else None
    return o, o_c


def diff_mixer(zl, zc, rope, g_q, g_k, lq1, lk1, lq2, lk2, g_sub, lam_init, need_ctx):
    cos, sin = rope
    width = DIFF_HEADS * 2 * DIFF_DIM

    def qk(z, which, g):
        t = z[..., which * width:(which + 1) * width].reshape(*z.shape[:2], DIFF_HEADS, 2, DIFF_DIM)
        return rmsnorm(t, g)

    def vals(z):
        return z[..., 2 * width:].reshape(*z.shape[:2], DIFF_HEADS, 2 * DIFF_DIM)

    lam = (jnp.exp(jnp.sum(lq1.astype(jnp.float32) * lk1.astype(jnp.float32)))
           - jnp.exp(jnp.sum(lq2.astype(jnp.float32) * lk2.astype(jnp.float32))) + lam_init)
    scale = DIFF_DIM ** -0.5

    def attend(q, k, v):
        def block(qb):
            s = jnp.einsum('bqhmd,bkhmd->bhmqk', qb, k).astype(jnp.float32) * scale
            p = jax.nn.softmax(s, axis=-1)
            p_diff = (p[:, :, 0] - lam * p[:, :, 1]).astype(v.dtype)
            return jnp.einsum('bhqk,bkhd->bqhd', p_diff, v)
        o = rmsnorm(sweep_query_blocks(block, q), g_sub) * (1.0 - lam_init)
        return flat_heads(o)

    ql = apply_rope(qk(zl, 0, g_q), cos, sin)
    kl = apply_rope(qk(zl, 1, g_k), cos, sin)
    vl = vals(zl)
    k_ctx, v_ctx = qk(zc, 1, g_k), vals(zc)
    o = attend(ql, jnp.concatenate([kl, k_ctx], axis=1), jnp.concatenate([vl, v_ctx], axis=1))
    o_c = attend(qk(zc, 0, g_q), k_ctx, v_ctx) if need_ctx else None
    return o, o_c


def gqa_mixer(zl, zc, rope, g_q, g_k, need_ctx):
    cos, sin = rope
    nq, nkv = GQA_HEADS * HEAD_DIM, GQA_KV_HEADS * HEAD_DIM

    def qkv(z):
        q = rmsnorm(z[..., :nq].reshape(*z.shape[:2], GQA_HEADS, HEAD_DIM), g_q)
        k = rmsnorm(z[..., nq:nq + nkv].reshape(*z.shape[:2], GQA_KV_HEADS, HEAD_DIM), g_k)
        v = z[..., nq + nkv:].reshape(*z.shape[:2], GQA_KV_HEADS, HEAD_DIM)
        return q, k, v

    ql, kl, vl = qkv(zl)
    qc, k_ctx, v_ctx = qkv(zc)
    ql, kl = apply_rope(ql, cos, sin), apply_rope(kl, cos, sin)
    o = gqa_attention(ql, jnp.concatenate([kl, k_ctx], axis=1), jnp.concatenate([vl, v_ctx], axis=1))
    o_c = flat_heads(gqa_attention(qc, k_ctx, v_ctx)) if need_ctx else None
    return flat_heads(o), o_c


def merge_branches(branches, z_gate, w_branch, w_out):
    o = jnp.stack(branches, axis=2)
    proj = jnp.einsum('bsnw,nwd->bsnd', o, w_branch)
    gate = jax.nn.sigmoid(z_gate.reshape(*z_gate.shape[:2], N_BRANCH, D_MODEL))
    return jnp.sum(gate * proj, axis=2) @ w_out


def sq_relu_mlp(h, w_up, w_down):
    return jnp.square(jax.nn.relu(h @ w_up)) @ w_down


def setup_inputs(seed: int = 0) -> dict:
    key = jax.random.key(seed)
    k = jax.random.split(key, 31)
    L, D = DEPTH, D_MODEL

    def nrm(i, shape, scale):
        return scale * jax.random.normal(k[i], shape, jnp.float32)

    def gain(i, shape):
        return 1.0 + nrm(i, shape, 0.1)

    return {
        'x': nrm(0, (BATCH, SEQ, D), 1.0),
        'c': nrm(1, (BATCH, D), 1.0),
        'ctx': nrm(2, (BATCH, CTX_LEN, D), 1.0),
        'c_ctx': nrm(3, (D,), 1.0),
        'w_ada': nrm(4, (L, D, 6 * D), 0.5 * D ** -0.5),
        'b_ada': nrm(5, (L, 6 * D), 0.02),
        'g_norm1': gain(6, (L, D)),
        'g_norm2': gain(7, (L, D)),
        'w_in': nrm(8, (L, D, IN_COLS), D ** -0.5),
        'g_mla_qa': gain(9, (L, MLA_Q_LORA)),
        'w_mla_uq': nrm(10, (L, MLA_Q_LORA, MLA_HEADS * MLA_QK), MLA_Q_LORA ** -0.5),
        'g_mla_kva': gain(11, (L, MLA_KV_LORA)),
        'w_mla_ukv': nrm(12, (L, MLA_KV_LORA, MLA_HEADS * (MLA_NOPE + MLA_V)), MLA_KV_LORA ** -0.5),
        'g_mla_q': gain(13, (L, MLA_QK)),
        'g_mla_k': gain(14, (L, MLA_QK)),
        'g_na_q': gain(15, (L, HEAD_DIM)),
        'g_na_k': gain(16, (L, HEAD_DIM)),
        'na_rpb': nrm(17, (L, NA_HEADS, 2 * NA_ROWS - 1, 2 * NA_COLS - 1), 0.02),
        'g_diff_q': gain(18, (L, DIFF_DIM)),
        'g_diff_k': gain(19, (L, DIFF_DIM)),
        'diff_lq1': nrm(20, (L, DIFF_DIM), 0.1),
        'diff_lk1': nrm(21, (L, DIFF_DIM), 0.1),
        'diff_lq2': nrm(22, (L, DIFF_DIM), 0.1),
        'diff_lk2': nrm(23, (L, DIFF_DIM), 0.1),
        'g_diff_sub': gain(24, (L, 2 * DIFF_DIM)),
        'g_gqa_q': gain(25, (L, HEAD_DIM)),
        'g_gqa_k': gain(26, (L, HEAD_DIM)),
        'w_branch': nrm(27, (L, N_BRANCH, BRANCH_WIDTH, D), BRANCH_WIDTH ** -0.5),
        'w_out': nrm(28, (L, D, D), D ** -0.5),
        'w_up': nrm(29, (L, D, D_FF), D ** -0.5),
        'w_down': nrm(30, (L, D_FF, D), D_FF ** -0.5),
    }


def reference(x, c, ctx, c_ctx, w_ada, b_ada, g_norm1, g_norm2, w_in,
              g_mla_qa, w_mla_uq, g_mla_kva, w_mla_ukv, g_mla_q, g_mla_k,
              g_na_q, g_na_k, na_rpb,
              g_diff_q, g_diff_k, diff_lq1, diff_lk1, diff_lq2, diff_lk2, g_diff_sub,
              g_gqa_q, g_gqa_k, w_branch, w_out, w_up, w_down):
    S = x.shape[1]
    t = jnp.arange(S)
    rows, cols = t // GRID_W, t % GRID_W
    rope32 = rope_tables(rows, cols, MLA_ROPE)
    rope64 = rope_tables(rows, cols, HEAD_DIM)
    xc = ctx
    for l in range(DEPTH):
        need_ctx = l < DEPTH - 1
        lam_init = 0.8 - 0.6 * math.exp(-0.3 * l)
        mod = jax.nn.silu(c) @ w_ada[l] + b_ada[l]
        mod_c = jax.nn.silu(c_ctx) @ w_ada[l] + b_ada[l]
        sh1, sc1, gt1, sh2, sc2, gt2 = jnp.split(mod[:, None, :], 6, axis=-1)
        csh1, csc1, cgt1, csh2, csc2, cgt2 = jnp.split(mod_c, 6, axis=-1)

        z = split_last(modulate(rmsnorm(x, g_norm1[l]), sh1, sc1) @ w_in[l], SPLIT_SIZES)
        zc = split_last(modulate(rmsnorm(xc, g_norm1[l]), csh1, csc1) @ w_in[l], SPLIT_SIZES)

        oa, oa_c = mla_mixer(z[0:3], zc[0:3], rope32, g_mla_qa[l], w_mla_uq[l], g_mla_kva[l],
                             w_mla_ukv[l], g_mla_q[l], g_mla_k[l], need_ctx)
        ob, ob_c = na_mixer(z[3], zc[3], g_na_q[l], g_na_k[l], na_rpb[l], need_ctx)
        oc, oc_c = diff_mixer(z[4], zc[4], rope32, g_diff_q[l], g_diff_k[l], diff_lq1[l], diff_lk1[l],
                              diff_lq2[l], diff_lk2[l], g_diff_sub[l], lam_init, need_ctx)
        od, od_c = gqa_mixer(z[5], zc[5], rope64, g_gqa_q[l], g_gqa_k[l], need_ctx)

        x = x + gt1 * merge_branches([oa, ob, oc, od], z[6], w_branch[l], w_out[l])
        x = x + gt2 * sq_relu_mlp(modulate(rmsnorm(x, g_norm2[l]), sh2, sc2), w_up[l], w_down[l])
        if need_ctx:
            xc = xc + cgt1 * merge_branches([oa_c, ob_c, oc_c, od_c], zc[6], w_branch[l], w_out[l])
            xc = xc + cgt2 * sq_relu_mlp(modulate(rmsnorm(xc, g_norm2[l]), csh2, csc2), w_up[l], w_down[l])
    return x
```

```cpp
#include <hip/hip_runtime.h>
#include <hip/hip_cooperative_groups.h>
#include <cstdio>
namespace cg = cooperative_groups;

typedef _Float16 half_t;
typedef __attribute__((ext_vector_type(8))) _Float16 h8;
typedef __attribute__((ext_vector_type(4))) _Float16 h4;
typedef __attribute__((ext_vector_type(2))) _Float16 h2;
typedef __attribute__((ext_vector_type(4))) float f4;
typedef __attribute__((ext_vector_type(16))) float f16v;

#define DI __device__ __forceinline__

constexpr int NB = 16, SEQ = 2048, CTX = 256, TOK = 2304, NTOK = NB * TOK;
constexpr int NIN = 2400, NINP = 2432;
constexpr float LOG2E = 1.4426950408889634f;
constexpr float EPS = 1e-6f;

constexpr size_t W_IN = 0;
constexpr size_t W_GATE = W_IN + (size_t)NINP * 1024;
constexpr size_t W_BR = W_GATE + (size_t)4096 * 1024;
constexpr size_t W_OUT = W_BR + (size_t)4 * 1024 * 256;
constexpr size_t W_UP = W_OUT + (size_t)1024 * 1024;
constexpr size_t W_DOWN = W_UP + (size_t)4096 * 1024;
constexpr size_t W_UQ = W_DOWN + (size_t)1024 * 4096;
constexpr size_t W_UKV = W_UQ + (size_t)384 * 192;
constexpr size_t W_LAYER = W_UKV + (size_t)512 * 128;

constexpr size_t al256(size_t x) { return (x + 255) & ~(size_t)255; }
constexpr size_t OFF_W = 0;
constexpr size_t OFF_MOD = al256(OFF_W + 2 * W_LAYER * 2);
constexpr size_t OFF_XC = al256(OFF_MOD + (size_t)2 * 17 * 6144 * 4);
constexpr size_t OFF_H = al256(OFF_XC + (size_t)NB * CTX * 1024 * 4);
constexpr size_t OFF_BIG = al256(OFF_H + (size_t)NTOK * 1024 * 2);
constexpr size_t B_QM = 0;
constexpr size_t B_KM = B_QM + (size_t)NTOK * 384;
constexpr size_t B_VTM = B_KM + (size_t)NTOK * 384;
constexpr size_t B_QNA = B_VTM + (size_t)NTOK * 256;
constexpr size_t B_KNA = B_QNA + (size_t)NTOK * 256;
constexpr size_t B_VTNA = B_KNA + (size_t)NTOK * 256;
constexpr size_t B_QDF = B_VTNA + (size_t)NTOK * 256;
constexpr size_t B_KDF = B_QDF + (size_t)NTOK * 256;
constexpr size_t B_VTDF = B_KDF + (size_t)NTOK * 256;
constexpr size_t B_QG = B_VTDF + (size_t)NTOK * 256;
constexpr size_t B_KG = B_QG + (size_t)NTOK * 256;
constexpr size_t B_VTG = B_KG + (size_t)NTOK * 128;
constexpr size_t B_ZMLA = B_VTG + (size_t)NTOK * 128;
constexpr size_t B_O = B_ZMLA + (size_t)NTOK * 352;
constexpr size_t B_END = B_O + (size_t)NTOK * 1024;
constexpr size_t B_M = 0;
constexpr size_t B_U = 0;
constexpr size_t WS_NEED = OFF_BIG + B_END * 2;
static_assert(B_END >= (size_t)NTOK * 4096, "u must fit");

constexpr int SMEM_BYTES = 2 * 2 * 128 * 72 * 2;

struct Params {
  const float *x, *c, *ctx, *c_ctx, *w_ada, *b_ada, *g_norm1, *g_norm2, *w_in;
  const float *g_mla_qa, *w_mla_uq, *g_mla_kva, *w_mla_ukv, *g_mla_q, *g_mla_k;
  const float *g_na_q, *g_na_k, *na_rpb;
  const float *g_diff_q, *g_diff_k, *lq1, *lk1, *lq2, *lk2, *g_diff_sub;
  const float *g_gqa_q, *g_gqa_k, *w_branch, *w_out, *w_up, *w_down;
  float* out;
  char* ws;
};

DI int tid_opaque() {
  int t = threadIdx.x;
  asm volatile("" : "+v"(t));
  return t;
}

DI float wave_sum(float v) {
#pragma unroll
  for (int o = 32; o > 0; o >>= 1) v += __shfl_xor(v, o);
  return v;
}

DI void phase_mods(const Params& p, float* mods, char* smem) {
  float* sil = (float*)smem;
  const int tid = tid_opaque();
  for (int w = blockIdx.x; w < 192; w += gridDim.x) {
    const int l = w / 96, n0 = (w % 96) * 64;
    __syncthreads();
    for (int idx = tid; idx < 17 * 1024; idx += 256) {
      const int b = idx >> 10, k = idx & 1023;
      const float v = (b < 16) ? p.c[b * 1024 + k] : p.c_ctx[k];
      sil[idx] = v / (1.f + expf(-v));
    }
    __syncthreads();
    const int kq = tid >> 6, nn = tid & 63;
    float acc[17];
#pragma unroll
    for (int b = 0; b < 17; ++b) acc[b] = 0.f;
    const float* wp = p.w_ada + (size_t)l * 1024 * 6144 + (size_t)(kq * 256) * 6144 + n0 + nn;
    const float* sp = sil + kq * 256;
    for (int k = 0; k < 256; ++k) {
      const float wv = wp[(size_t)k * 6144];
#pragma unroll
      for (int b = 0; b < 17; ++b) acc[b] += sp[b * 1024 + k] * wv;
    }
    __syncthreads();
    float* red = (float*)smem;
#pragma unroll
    for (int b = 0; b < 17; ++b) red[(kq * 17 + b) * 64 + nn] = acc[b];
    __syncthreads();
    for (int idx = tid; idx < 17 * 64; idx += 256) {
      const int b = idx >> 6, n = idx & 63;
      const float s = red[b * 64 + n] + red[(17 + b) * 64 + n] + red[(34 + b) * 64 + n] + red[(51 + b) * 64 + n] +
                      p.b_ada[l * 6144 + n0 + n];
      mods[((size_t)l * 17 + b) * 6144 + n0 + n] = s;
    }
  }
  __syncthreads();
}

DI void tconv_job(const float* src, int ld, int c0, int K, int Nvalid, int Npad, half_t* dst, int& base,
                          float* tile) {
  const int nnt = Npad / 64, tot = (K / 64) * nnt;
  const int G = gridDim.x;
  const int start = (int)((blockIdx.x + G - (base % G)) % G);
  const int tid_ = tid_opaque();
  const int tx = tid_ & 63, ty = tid_ >> 6;
  for (int t = start; t < tot; t += G) {
    const int kt = t / nnt, nt = t % nnt;
    __syncthreads();
#pragma unroll 4
    for (int i = 0; i < 16; ++i) {
      const int k = i * 4 + ty, n = nt * 64 + tx;
      tile[k * 65 + tx] = (n < Nvalid) ? src[(size_t)(kt * 64 + k) * ld + c0 + n] : 0.f;
    }
    __syncthreads();
#pragma unroll 4
    for (int i = 0; i < 16; ++i) {
      const int n = i * 4 + ty;
      dst[(size_t)(nt * 64 + n) * K + kt * 64 + tx] = (half_t)tile[tx * 65 + n];
    }
  }
  base += tot;
}

DI void phase_norm(const float* xl, const float* xc, const float* gam, const float* mods_l, int sh_off,
                           int sc_off, half_t* h, bool skip_ctx) {
  const int tid_ = tid_opaque();
  const int wave = tid_ >> 6, lane = tid_ & 63;
  for (int g = blockIdx.x * 4 + wave; g < NTOK; g += gridDim.x * 4) {
    const int b = g / TOK, t = g - b * TOK;
    const bool isctx = t >= SEQ;
    if (isctx && skip_ctx) continue;
    const float* src = isctx ? xc + ((size_t)b * CTX + (t - SEQ)) * 1024 : xl + ((size_t)b * SEQ + t) * 1024;
    const float* mod = mods_l + (size_t)(isctx ? 16 : b) * 6144;
    float4 v[4];
    float ss = 0.f;
#pragma unroll
    for (int i = 0; i < 4; ++i) {
      v[i] = *(const float4*)(src + i * 256 + lane * 4);
      ss += v[i].x * v[i].x + v[i].y * v[i].y + v[i].z * v[i].z + v[i].w * v[i].w;
    }
    ss = wave_sum(ss);
    const float rstd = rsqrtf(ss * (1.f / 1024.f) + EPS);
#pragma unroll
    for (int i = 0; i < 4; ++i) {
      const int col = i * 256 + lane * 4;
      const float4 gg = *(const float4*)(gam + col);
      const float4 sc = *(const float4*)(mod + sc_off + col);
      const float4 sh = *(const float4*)(mod + sh_off + col);
      h4 o;
      o[0] = (half_t)(v[i].x * rstd * gg.x * (1.f + sc.x) + sh.x);
      o[1] = (half_t)(v[i].y * rstd * gg.y * (1.f + sc.y) + sh.y);
      o[2] = (half_t)(v[i].z * rstd * gg.z * (1.f + sc.z) + sh.z);
      o[3] = (half_t)(v[i].w * rstd * gg.w * (1.f + sc.w) + sh.w);
      *(h4*)(h + (size_t)g * 1024 + col) = o;
    }
  }
}

template <int NJ>
DI void gemm_tile(const half_t* A, int lda, const half_t* Bt, int ldb, int K, f4 (&acc)[4][NJ], half_t* sm) {
  constexpr int BQ = NJ;
  const int tid = tid_opaque(), lane = tid & 63, wave = tid >> 6;
  const int wm = wave >> 1, wn = wave & 1;
  const int lr = tid >> 3, lc = (tid & 7) * 8;
  const half_t* ap = A + (size_t)lr * lda + lc;
  const half_t* bp = Bt + (size_t)lr * ldb + lc;
  half_t* sa = sm;
  half_t* sb = sm + 2 * 128 * 72;
  uint4 ra[4], rb[BQ];
  const int nk = K >> 6;
#pragma unroll
  for (int q = 0; q < 4; ++q) ra[q] = *(const uint4*)(ap + (size_t)(q * 32) * lda);
#pragma unroll
  for (int q = 0; q < BQ; ++q) rb[q] = *(const uint4*)(bp + (size_t)(q * 32) * ldb);
#pragma unroll
  for (int q = 0; q < 4; ++q) *(uint4*)(sa + (lr + q * 32) * 72 + lc) = ra[q];
#pragma unroll
  for (int q = 0; q < BQ; ++q) *(uint4*)(sb + (lr + q * 32) * 72 + lc) = rb[q];
  __syncthreads();
  for (int kt = 0; kt < nk; ++kt) {
    const int cur = kt & 1;
    if (kt + 1 < nk) {
#pragma unroll
      for (int q = 0; q < 4; ++q) ra[q] = *(const uint4*)(ap + (size_t)(q * 32) * lda + (kt + 1) * 64);
#pragma unroll
      for (int q = 0; q < BQ; ++q) rb[q] = *(const uint4*)(bp + (size_t)(q * 32) * ldb + (kt + 1) * 64);
    }
    const half_t* ca = sa + cur * 128 * 72 + (wm * 64 + (lane & 15)) * 72 + (lane >> 4) * 8;
    const half_t* cb = sb + cur * 128 * 72 + (wn * (16 * NJ) + (lane & 15)) * 72 + (lane >> 4) * 8;
#pragma unroll
    for (int kk = 0; kk < 2; ++kk) {
      h8 af[4], bf[NJ];
#pragma unroll
      for (int i = 0; i < 4; ++i) af[i] = *(const h8*)(ca + i * 16 * 72 + kk * 32);
#pragma unroll
      for (int j = 0; j < NJ; ++j) bf[j] = *(const h8*)(cb + j * 16 * 72 + kk * 32);
#pragma unroll
      for (int i = 0; i < 4; ++i)
#pragma unroll
        for (int j = 0; j < NJ; ++j)
          acc[i][j] = __builtin_amdgcn_mfma_f32_16x16x32_f16(af[i], bf[j], acc[i][j], 0, 0, 0);
    }
    if (kt + 1 < nk) {
      const int nx = cur ^ 1;
#pragma unroll
      for (int q = 0; q < 4; ++q) *(uint4*)(sa + nx * 128 * 72 + (lr + q * 32) * 72 + lc) = ra[q];
#pragma unroll
      for (int q = 0; q < BQ; ++q) *(uint4*)(sb + nx * 128 * 72 + (lr + q * 32) * 72 + lc) = rb[q];
    }
    __syncthreads();
  }
}

template <int NJ>
DI void zero_acc(f4 (&acc)[4][NJ]) {
#pragma unroll
  for (int i = 0; i < 4; ++i)
#pragma unroll
    for (int j = 0; j < NJ; ++j) acc[i][j] = f4{0.f, 0.f, 0.f, 0.f};
}

DI int rt_row(int rt, bool skip_ctx) { return skip_ctx ? (rt >> 4) * TOK + (rt & 15) * 128 : rt * 128; }

DI half_t* z_dest(half_t* big, int b, int n, int& ts) {
  if (n < 352) { ts = 352; return big + B_ZMLA + (size_t)b * TOK * 352 + n; }
  if (n < 1120) {
    const int c = n - 352, part = c >> 8, hh = (c >> 6) & 3, dd = c & 63;
    if (part == 2) { ts = 1; return big + B_VTNA + ((size_t)(b * 4 + hh) * 64 + dd) * TOK; }
    ts = 64;
    return big + (part == 0 ? B_QNA : B_KNA) + (size_t)(b * 4 + hh) * TOK * 64 + dd;
  }
  if (n < 1888) {
    const int c = n - 1120, part = c >> 8;
    if (part == 2) { const int hh = (c >> 6) & 3, dd = c & 63; ts = 1; return big + B_VTDF + ((size_t)(b * 4 + hh) * 64 + dd) * TOK; }
    const int hm = (c >> 5) & 7, dd = c & 31;
    ts = 32;
    return big + (part == 0 ? B_QDF : B_KDF) + (size_t)(b * 8 + hm) * TOK * 32 + dd;
  }
  const int c = n - 1888, dd = c & 63;
  if (c < 256) { ts = 64; return big + B_QG + (size_t)(b * 4 + (c >> 6)) * TOK * 64 + dd; }
  if (c < 384) { ts = 64; return big + B_KG + (size_t)(b * 2 + ((c - 256) >> 6)) * TOK * 64 + dd; }
  ts = 1;
  return big + B_VTG + ((size_t)(b * 2 + ((c - 384) >> 6)) * 64 + dd) * TOK;
}

DI void store_tok4(half_t* ptr, int ts, int tb, const f4& v) {
  if (ts == 1) {
    h4 o; o[0] = (half_t)v[0]; o[1] = (half_t)v[1]; o[2] = (half_t)v[2]; o[3] = (half_t)v[3];
    *(h4*)(ptr + tb) = o;
  } else {
#pragma unroll
    for (int r = 0; r < 4; ++r) ptr[(size_t)(tb + r) * ts] = (half_t)v[r];
  }
}

DI void phase_inproj(const half_t* hbuf, const half_t* Wl, half_t* big, half_t* sm) {
  const int tid_ = tid_opaque();
  const int lane = tid_ & 63, wave = tid_ >> 6, wm = wave >> 1, wn = wave & 1;
  const int l15 = lane & 15, quad = lane >> 4;
  constexpr int NT = NINP / 128;
  for (int tile = blockIdx.x; tile < 288 * NT; tile += gridDim.x) {
    const int rt = tile / NT, nt = tile % NT;
    const int m0 = rt * 128, n0 = nt * 128;
    f4 acc[4][4];
    zero_acc<4>(acc);
    gemm_tile<4>(hbuf + (size_t)m0 * 1024, 1024, Wl + W_IN + (size_t)n0 * 1024, 1024, 1024, acc, sm);
    const int b = m0 / TOK, t0 = m0 - b * TOK;
#pragma unroll
    for (int j = 0; j < 4; ++j) {
      const int n = n0 + wn * 64 + j * 16 + l15;
      if (n < NIN) {
        int ts;
        half_t* ptr = z_dest(big, b, n, ts);
#pragma unroll
        for (int i = 0; i < 4; ++i) store_tok4(ptr, ts, t0 + wm * 64 + i * 16 + quad * 4, acc[i][j]);
      }
    }
  }
}

template <int DLEN, int LPR, int ROPE, bool KR>
DI void norm_rows(half_t* base, int stride, int nrows, const float* gain, float oscale, const half_t* zmla) {
  const int tid_ = tid_opaque();
  const int lane = tid_ & 63, wave = tid_ >> 6;
  constexpr int RPW = 64 / LPR;
  const int s = lane % LPR, sub = lane / LPR;
  const bool active = s * 8 < DLEN;
  float gn[8];
#pragma unroll
  for (int i = 0; i < 8; ++i) gn[i] = active ? gain[s * 8 + i] : 0.f;
  for (int r0 = (blockIdx.x * 4 + wave) * RPW; r0 < nrows; r0 += gridDim.x * 4 * RPW) {
    const int rho = r0 + sub;
    const int t = rho % TOK;
    half_t* ptr = base + (size_t)rho * stride + s * 8;
    const half_t* src = ptr;
    if (KR && s >= 8) {
      const int b = rho / (4 * TOK);
      src = zmla + ((size_t)b * TOK + t) * 352 + 320 + (s - 8) * 8;
    }
    float f[8];
    float ss = 0.f;
    if (active) {
      const h8 v = *(const h8*)src;
#pragma unroll
      for (int i = 0; i < 8; ++i) { f[i] = (float)v[i]; ss += f[i] * f[i]; }
    } else {
#pragma unroll
      for (int i = 0; i < 8; ++i) f[i] = 0.f;
    }
#pragma unroll
    for (int o = LPR / 2; o > 0; o >>= 1) ss += __shfl_xor(ss, o);
    const float rstd = rsqrtf(ss * (1.f / DLEN) + EPS);
#pragma unroll
    for (int i = 0; i < 8; ++i) f[i] = f[i] * rstd * gn[i];
    if (ROPE != 0) {
      constexpr int PX = (ROPE == 64) ? 2 : 1;
      float pf[8];
#pragma unroll
      for (int i = 0; i < 8; ++i) pf[i] = __shfl_xor(f[i], PX);
      constexpr int RB = (DLEN - ROPE) / 8;
      if (t < SEQ && s >= RB && active) {
        const int sr = s - RB;
        const int q = (ROPE == 64) ? (sr >> 1) : sr;
        const float pos = (float)((q < 2) ? (t >> 6) : (t & 63));
        const float sgn = (q & 1) ? 1.f : -1.f;
#pragma unroll
        for (int i = 0; i < 8; ++i) {
          const int idx = (ROPE == 64) ? ((sr & 1) * 8 + i) : i;
          constexpr float NF = (ROPE == 64) ? 16.f : 8.f;
          const float invf = exp2f(-(float)idx * (13.287712379549449f / NF));
          const float ang = pos * invf;
          float sn, cs;
          sincosf(ang, &sn, &cs);
          f[i] = f[i] * cs + sgn * pf[i] * sn;
        }
      }
    }
    if (active) {
      h8 o;
#pragma unroll
      for (int i = 0; i < 8; ++i) o[i] = (half_t)(f[i] * oscale);
      *(h8*)ptr = o;
    }
  }
}

DI void phase_mla_up(const half_t* Wl, half_t* big, half_t* sm) {
  const int tid_ = tid_opaque();
  const int lane = tid_ & 63, wave = tid_ >> 6, wm = wave >> 1, wn = wave & 1;
  const int l15 = lane & 15, quad = lane >> 4;
  const half_t* zmla = big + B_ZMLA;
  for (int tile = blockIdx.x; tile < 288 * 7; tile += gridDim.x) {
    const int rt = tile / 7, nt = tile % 7;
    const int m0 = rt * 128;
    const int b = m0 / TOK, t0 = m0 - b * TOK;
    f4 acc[4][4];
    zero_acc<4>(acc);
    if (nt < 3) {
      const int n0 = nt * 128;
      gemm_tile<4>(zmla + (size_t)m0 * 352, 352, Wl + W_UQ + (size_t)n0 * 192, 192, 192, acc, sm);
#pragma unroll
      for (int j = 0; j < 4; ++j) {
        const int n = n0 + wn * 64 + j * 16 + l15;
        const int hh = n / 96, dd = n - hh * 96;
        half_t* ptr = big + B_QM + (size_t)(b * 4 + hh) * TOK * 96 + dd;
#pragma unroll
        for (int i = 0; i < 4; ++i) store_tok4(ptr, 96, t0 + wm * 64 + i * 16 + quad * 4, acc[i][j]);
      }
    } else {
      const int n0 = (nt - 3) * 128;
      gemm_tile<4>(zmla + (size_t)m0 * 352 + 192, 352, Wl + W_UKV + (size_t)n0 * 128, 128, 128, acc, sm);
#pragma unroll
      for (int j = 0; j < 4; ++j) {
        const int n = n0 + wn * 64 + j * 16 + l15;
        const int hh = n >> 7, cc = n & 127;
        half_t* ptr;
        int ts;
        if (cc < 64) { ts = 96; ptr = big + B_KM + (size_t)(b * 4 + hh) * TOK * 96 + cc; }
        else { ts = 1; ptr = big + B_VTM + ((size_t)(b * 4 + hh) * 64 + (cc - 64)) * TOK; }
#pragma unroll
        for (int i = 0; i < 4; ++i) store_tok4(ptr, ts, t0 + wm * 64 + i * 16 + quad * 4, acc[i][j]);
      }
    }
  }
}

template <int DQ, bool NA, int NQG>
DI void attn_core(const half_t* Qp, const half_t* Kp, const half_t* Vp, int q0, int seg0_start, int seg0_tiles,
                  int seg1_start, int seg1_tiles, const float* rpb_h, int rq, f16v (&O)[2][NQG]) {
  constexpr int NKS = DQ / 16;
  const int lane = tid_opaque() & 63, r = lane & 31, h = lane >> 5;
  h8 qf[NQG][NKS];
#pragma unroll
  for (int qg = 0; qg < NQG; ++qg)
#pragma unroll
    for (int ks = 0; ks < NKS; ++ks) qf[qg][ks] = *(const h8*)(Qp + (size_t)(q0 + qg * 32 + r) * DQ + ks * 16 + h * 8);
  float mrun[NQG], lrun[NQG];
#pragma unroll
  for (int qg = 0; qg < NQG; ++qg) { mrun[qg] = -1e30f; lrun[qg] = 0.f; }
#pragma unroll
  for (int a = 0; a < 2; ++a)
#pragma unroll
    for (int c = 0; c < NQG; ++c)
#pragma unroll
      for (int i = 0; i < 16; ++i) O[a][c][i] = 0.f;
  const int ntiles = seg0_tiles + seg1_tiles;
  const half_t* kbase = Kp + (size_t)r * DQ + h * 8;
  const half_t* vbase = Vp + (size_t)r * TOK + h * 4;
  h8 kf[NKS];
  h4 vf[2][2][2];
  {
    const int k0 = (0 < seg0_tiles) ? seg0_start : seg1_start;
#pragma unroll
    for (int ks = 0; ks < NKS; ++ks) kf[ks] = *(const h8*)(kbase + (size_t)k0 * DQ + ks * 16);
#pragma unroll
    for (int dvt = 0; dvt < 2; ++dvt)
#pragma unroll
      for (int s = 0; s < 2; ++s)
#pragma unroll
        for (int hf = 0; hf < 2; ++hf) vf[dvt][s][hf] = *(const h4*)(vbase + (size_t)(dvt * 32) * TOK + k0 + s * 16 + hf * 8);
  }
  for (int it = 0; it < ntiles; ++it) {
    const int k0 = (it < seg0_tiles) ? seg0_start + it * 32 : seg1_start + (it - seg0_tiles) * 32;
    const int itn = (it + 1 < ntiles) ? it + 1 : it;
    const int k1 = (itn < seg0_tiles) ? seg0_start + itn * 32 : seg1_start + (itn - seg0_tiles) * 32;
    f16v S[NQG];
#pragma unroll
    for (int qg = 0; qg < NQG; ++qg) {
#pragma unroll
      for (int i = 0; i < 16; ++i) S[qg][i] = 0.f;
#pragma unroll
      for (int ks = 0; ks < NKS; ++ks) S[qg] = __builtin_amdgcn_mfma_f32_32x32x16_f16(kf[ks], qf[qg][ks], S[qg], 0, 0, 0);
    }
#pragma unroll
    for (int ks = 0; ks < NKS; ++ks) kf[ks] = *(const h8*)(kbase + (size_t)k1 * DQ + ks * 16);
    if (NA && it < seg0_tiles) {
      const int krow = k0 >> 6, cb = k0 & 63;
      const int dr = krow - rq + 7;
#pragma unroll
      for (int qg = 0; qg < NQG; ++qg) {
        const int qc = qg * 32 + r;
        const int cs = min(max(qc - 8, 0), 48);
#pragma unroll
        for (int i = 0; i < 16; ++i) {
          const int c = cb + (i & 3) + 8 * (i >> 2) + 4 * h;
          const bool valid = (c >= cs) && (c < cs + 16);
          float bias = 0.f;
          if (valid) bias = rpb_h[dr * 31 + (c - qc + 15)] * LOG2E;
          S[qg][i] = valid ? S[qg][i] + bias : -1e30f;
        }
      }
    }
#pragma unroll
    for (int qg = 0; qg < NQG; ++qg) {
      h8 P[2];
      float mx = S[qg][0];
#pragma unroll
      for (int i = 1; i < 16; ++i) mx = fmaxf(mx, S[qg][i]);
      mx = fmaxf(mx, __shfl_xor(mx, 32));
      const float mn = fmaxf(mrun[qg], mx);
      const float alpha = __builtin_amdgcn_exp2f(mrun[qg] - mn);
      mrun[qg] = mn;
      float rs = 0.f;
#pragma unroll
      for (int i = 0; i < 16; ++i) {
        float pv = __builtin_amdgcn_exp2f(S[qg][i] - mn);
        if (NA) pv = (S[qg][i] <= -1e29f) ? 0.f : pv;
        rs += pv;
        P[i >> 3][i & 7] = (half_t)pv;
      }
      lrun[qg] = lrun[qg] * alpha + rs;
#pragma unroll
      for (int dvt = 0; dvt < 2; ++dvt) {
#pragma unroll
        for (int i = 0; i < 16; ++i) O[dvt][qg][i] *= alpha;
#pragma unroll
        for (int s = 0; s < 2; ++s) {
          const h8 va = __builtin_shufflevector(vf[dvt][s][0], vf[dvt][s][1], 0, 1, 2, 3, 4, 5, 6, 7);
          O[dvt][qg] = __builtin_amdgcn_mfma_f32_32x32x16_f16(va, P[s], O[dvt][qg], 0, 0, 0);
        }
      }
    }
#pragma unroll
    for (int dvt = 0; dvt < 2; ++dvt)
#pragma unroll
      for (int s = 0; s < 2; ++s)
#pragma unroll
        for (int hf = 0; hf < 2; ++hf) vf[dvt][s][hf] = *(const h4*)(vbase + (size_t)(dvt * 32) * TOK + k1 + s * 16 + hf * 8);
  }
#pragma unroll
  for (int qg = 0; qg < NQG; ++qg) {
    const float lt = lrun[qg] + __shfl_xor(lrun[qg], 32);
    const float inv = 1.f / lt;
#pragma unroll
    for (int dvt = 0; dvt < 2; ++dvt)
#pragma unroll
      for (int i = 0; i < 16; ++i) O[dvt][qg][i] *= inv;
  }
}

template <int NQG>
DI void store_o(const f16v (&O)[2][NQG], half_t* orow0  ) {
  const int lane = tid_opaque() & 63, r = lane & 31, h = lane >> 5;
#pragma unroll
  for (int qg = 0; qg < NQG; ++qg)
#pragma unroll
    for (int dvt = 0; dvt < 2; ++dvt)
#pragma unroll
      for (int c = 0; c < 4; ++c) {
        h4 o;
#pragma unroll
        for (int j = 0; j < 4; ++j) o[j] = (half_t)O[dvt][qg][4 * c + j];
        *(h4*)(orow0 + (size_t)(qg * 32 + r) * 1024 + dvt * 32 + 8 * c + 4 * h) = o;
      }
}

DI void phase_attn(const Params& p, int l, half_t* big, bool need_ctx, char* smem) {
  const int tid_ = tid_opaque();
  const int lane = tid_ & 63, wave = tid_ >> 6, r = lane & 31, h = lane >> 5;
  const int NQB = need_ctx ? 9 : 8;
  const int nitems = 16 * 16 * NQB;
  half_t* obuf = big + B_O;
  const float lam_init = 0.8f - 0.6f * expf(-0.3f * (float)l);
  float lam;
  {
    float d1 = 0.f, d2 = 0.f;
#pragma unroll 1
    for (int i = 0; i < 32; ++i) {
      d1 += p.lq1[l * 32 + i] * p.lk1[l * 32 + i];
      d2 += p.lq2[l * 32 + i] * p.lk2[l * 32 + i];
    }
    lam = expf(d1) - expf(d2) + lam_init;
  }
  for (int item = blockIdx.x; item < nitems; item += gridDim.x) {
    const int hi = item / (16 * NQB);
    const int rem = item - hi * 16 * NQB;
    const int b = rem / NQB, qb = rem - b * NQB;
    const int q0 = qb * 256 + wave * 64;
    const bool qctx = qb == 8;
    const int mixer = hi >> 2, hh = hi & 3;
    const int s0 = qctx ? SEQ : 0, n0t = qctx ? 8 : 72;
    f16v O[2][2];
    half_t* orow = obuf + (size_t)(b * TOK + q0) * 1024 + hh * 64;
    if (mixer == 0) {
      float* stash = (float*)smem + wave * 4096;
      attn_core<32, false, 2>(big + B_QDF + (size_t)(b * 8 + hh * 2) * TOK * 32, big + B_KDF + (size_t)(b * 8 + hh * 2) * TOK * 32,
                           big + B_VTDF + (size_t)(b * 4 + hh) * 64 * TOK, q0, s0, n0t, 0, 0, nullptr, 0, O);
#pragma unroll
      for (int dvt = 0; dvt < 2; ++dvt)
#pragma unroll
        for (int qg = 0; qg < 2; ++qg)
#pragma unroll
          for (int i = 0; i < 16; ++i) stash[((dvt * 2 + qg) * 16 + i) * 64 + lane] = O[dvt][qg][i];
      attn_core<32, false, 2>(big + B_QDF + (size_t)(b * 8 + hh * 2 + 1) * TOK * 32, big + B_KDF + (size_t)(b * 8 + hh * 2 + 1) * TOK * 32,
                           big + B_VTDF + (size_t)(b * 4 + hh) * 64 * TOK, q0, s0, n0t, 0, 0, nullptr, 0, O);
#pragma unroll
      for (int qg = 0; qg < 2; ++qg) {
        float ss = 0.f;
#pragma unroll
        for (int dvt = 0; dvt < 2; ++dvt)
#pragma unroll
          for (int i = 0; i < 16; ++i) {
            const float v = stash[((dvt * 2 + qg) * 16 + i) * 64 + lane] - lam * O[dvt][qg][i];
            O[dvt][qg][i] = v;
            ss += v * v;
          }
        ss += __shfl_xor(ss, 32);
        const float rstd = rsqrtf(ss * (1.f / 64.f) + EPS) * (1.f - lam_init);
#pragma unroll
        for (int dvt = 0; dvt < 2; ++dvt)
#pragma unroll
          for (int i = 0; i < 16; ++i) {
            const int dv = dvt * 32 + (i & 3) + 8 * (i >> 2) + 4 * h;
            O[dvt][qg][i] *= rstd * p.g_diff_sub[l * 64 + dv];
          }
      }
      store_o<2>(O, orow + 2 * 256);
    } else if (mixer == 1) {
      for (int ps = 0; ps < 2; ++ps) {
        f16v O1[2][1];
        attn_core<96, false, 1>(big + B_QM + (size_t)(b * 4 + hh) * TOK * 96, big + B_KM + (size_t)(b * 4 + hh) * TOK * 96,
                                big + B_VTM + (size_t)(b * 4 + hh) * 64 * TOK, q0 + ps * 32, s0, n0t, 0, 0, nullptr, 0, O1);
        store_o<1>(O1, orow + (size_t)(ps * 32) * 1024 + 0 * 256);
      }
    } else if (mixer == 2) {
      const int kv = hh >> 1;
      attn_core<64, false, 2>(big + B_QG + (size_t)(b * 4 + hh) * TOK * 64, big + B_KG + (size_t)(b * 2 + kv) * TOK * 64,
                           big + B_VTG + (size_t)(b * 2 + kv) * 64 * TOK, q0, s0, n0t, 0, 0, nullptr, 0, O);
      store_o<2>(O, orow + 3 * 256);
    } else {
      const int rq = q0 >> 6;
      const int r0 = min(max(rq - 4, 0), 24);
      const int seg0s = r0 * 64, seg0n = qctx ? 0 : 16;
      attn_core<64, true, 2>(big + B_QNA + (size_t)(b * 4 + hh) * TOK * 64, big + B_KNA + (size_t)(b * 4 + hh) * TOK * 64,
                          big + B_VTNA + (size_t)(b * 4 + hh) * 64 * TOK, q0, seg0s, seg0n, SEQ, 8,
                          p.na_rpb + (size_t)(l * 4 + hh) * 15 * 31, rq, O);
      store_o<2>(O, orow + 1 * 256);
    }
  }
}

DI void phase_merge(const half_t* hbuf, const half_t* Wl, half_t* big, bool skip_ctx, half_t* sm) {
  const int tid_ = tid_opaque();
  const int lane = tid_ & 63, wave = tid_ >> 6, wm = wave >> 1, wn = wave & 1;
  const int l15 = lane & 15, quad = lane >> 4;
  const int nrt = skip_ctx ? 256 : 288;
  const half_t* obuf = big + B_O;
  half_t* mbuf = big + B_M;
  for (int tile = blockIdx.x; tile < nrt * 16; tile += gridDim.x) {
    const int rt = tile >> 4, nt = tile & 15;
    const int m0 = rt_row(rt, skip_ctx), n0 = nt * 64;
    f4 macc[4][2];
    zero_acc<2>(macc);
    for (int br = 0; br < 4; ++br) {
      f4 acc[4][2];
      zero_acc<2>(acc);
      gemm_tile<2>(hbuf + (size_t)m0 * 1024, 1024, Wl + W_GATE + (size_t)(br * 1024 + n0) * 1024, 1024, 1024, acc, sm);
      f4 sg[4][2];
#pragma unroll
      for (int i = 0; i < 4; ++i)
#pragma unroll
        for (int j = 0; j < 2; ++j)
#pragma unroll
          for (int r = 0; r < 4; ++r) sg[i][j][r] = 1.f / (1.f + __expf(-acc[i][j][r]));
      zero_acc<2>(acc);
      gemm_tile<2>(obuf + (size_t)m0 * 1024 + br * 256, 1024, Wl + W_BR + (size_t)(br * 1024 + n0) * 256, 256, 256, acc, sm);
#pragma unroll
      for (int i = 0; i < 4; ++i)
#pragma unroll
        for (int j = 0; j < 2; ++j)
#pragma unroll
          for (int r = 0; r < 4; ++r) macc[i][j][r] += sg[i][j][r] * acc[i][j][r];
    }
#pragma unroll
    for (int i = 0; i < 4; ++i)
#pragma unroll
      for (int j = 0; j < 2; ++j)
#pragma unroll
        for (int r = 0; r < 4; ++r)
          mbuf[(size_t)(m0 + wm * 64 + i * 16 + quad * 4 + r) * 1024 + n0 + wn * 32 + j * 16 + l15] = (half_t)macc[i][j][r];
  }
}

DI void phase_resid(const half_t* A, int K, const half_t* Wt, const float* xl_src, const float* xc_src, float* xl_dst,
                            float* xc_dst, const float* mods_l, int gt_off, bool skip_ctx, half_t* sm) {
  const int tid_ = tid_opaque();
  const int lane = tid_ & 63, wave = tid_ >> 6, wm = wave >> 1, wn = wave & 1;
  const int l15 = lane & 15, quad = lane >> 4;
  const int nrt = skip_ctx ? 256 : 288;
  for (int tile = blockIdx.x; tile < nrt * 8; tile += gridDim.x) {
    const int rt = tile >> 3, nt = tile & 7;
    const int m0 = rt_row(rt, skip_ctx), n0 = nt * 128;
    f4 acc[4][4];
    zero_acc<4>(acc);
    gemm_tile<4>(A + (size_t)m0 * K, K, Wt + (size_t)n0 * K, K, K, acc, sm);
    const int b = m0 / TOK, t0 = m0 - b * TOK;
    const bool isctx = t0 >= SEQ;
    const float* src = isctx ? xc_src + ((size_t)b * CTX + (t0 - SEQ)) * 1024 : xl_src + ((size_t)b * SEQ + t0) * 1024;
    float* dst = isctx ? xc_dst + ((size_t)b * CTX + (t0 - SEQ)) * 1024 : xl_dst + ((size_t)b * SEQ + t0) * 1024;
    const float* gt = mods_l + (size_t)(isctx ? 16 : b) * 6144 + gt_off;
#pragma unroll
    for (int j = 0; j < 4; ++j) {
      const int n = n0 + wn * 64 + j * 16 + l15;
      const float g = gt[n];
#pragma unroll
      for (int i = 0; i < 4; ++i)
#pragma unroll
        for (int r = 0; r < 4; ++r) {
          const size_t off = (size_t)(wm * 64 + i * 16 + quad * 4 + r) * 1024 + n;
          dst[off] = src[off] + g * acc[i][j][r];
        }
    }
  }
}

DI void phase_up(const half_t* hbuf, const half_t* Wl, half_t* ubuf, bool skip_ctx, half_t* sm) {
  const int tid_ = tid_opaque();
  const int lane = tid_ & 63, wave = tid_ >> 6, wm = wave >> 1, wn = wave & 1;
  const int l15 = lane & 15, quad = lane >> 4;
  const int nrt = skip_ctx ? 256 : 288;
  for (int tile = blockIdx.x; tile < nrt * 32; tile += gridDim.x) {
    const int rt = tile >> 5, nt = tile & 31;
    const int m0 = rt_row(rt, skip_ctx), n0 = nt * 128;
    f4 acc[4][4];
    zero_acc<4>(acc);
    gemm_tile<4>(hbuf + (size_t)m0 * 1024, 1024, Wl + W_UP + (size_t)n0 * 1024, 1024, 1024, acc, sm);
#pragma unroll
    for (int i = 0; i < 4; ++i)
#pragma unroll
      for (int j = 0; j < 4; ++j)
#pragma unroll
        for (int r = 0; r < 4; ++r) {
          const float v = fmaxf(acc[i][j][r], 0.f);
          ubuf[(size_t)(m0 + wm * 64 + i * 16 + quad * 4 + r) * 4096 + n0 + wn * 64 + j * 16 + l15] = (half_t)(v * v);
        }
  }
}

__global__ void __launch_bounds__(256, 2) hybrid_block_megakernel(Params p) {
  __shared__ __attribute__((aligned(16))) char smem[SMEM_BYTES];
  cg::grid_group grid = cg::this_grid();
  char* ws = p.ws;
  half_t* W = (half_t*)(ws + OFF_W);
  float* mods = (float*)(ws + OFF_MOD);
  float* xc = (float*)(ws + OFF_XC);
  half_t* hbuf = (half_t*)(ws + OFF_H);
  half_t* big = (half_t*)(ws + OFF_BIG);
  half_t* sm = (half_t*)smem;

  phase_mods(p, mods, smem);
  {
    int base = 0;
    float* tile = (float*)smem;
    for (int l = 0; l < 2; ++l) {
      half_t* Wl = W + (size_t)l * W_LAYER;
      tconv_job(p.w_in + (size_t)l * 1024 * 6496, 6496, 0, 1024, NIN, NINP, Wl + W_IN, base, tile);
      tconv_job(p.w_in + (size_t)l * 1024 * 6496, 6496, NIN, 1024, 4096, 4096, Wl + W_GATE, base, tile);
      for (int br = 0; br < 4; ++br)
        tconv_job(p.w_branch + ((size_t)l * 4 + br) * 256 * 1024, 1024, 0, 256, 1024, 1024, Wl + W_BR + (size_t)br * 1024 * 256, base, tile);
      tconv_job(p.w_out + (size_t)l * 1024 * 1024, 1024, 0, 1024, 1024, 1024, Wl + W_OUT, base, tile);
      tconv_job(p.w_up + (size_t)l * 1024 * 4096, 4096, 0, 1024, 4096, 4096, Wl + W_UP, base, tile);
      tconv_job(p.w_down + (size_t)l * 4096 * 1024, 1024, 0, 4096, 1024, 1024, Wl + W_DOWN, base, tile);
      tconv_job(p.w_mla_uq + (size_t)l * 192 * 384, 384, 0, 192, 384, 384, Wl + W_UQ, base, tile);
      tconv_job(p.w_mla_ukv + (size_t)l * 128 * 512, 512, 0, 128, 512, 512, Wl + W_UKV, base, tile);
    }
  }
  grid.sync();

  for (int l = 0; l < 2; ++l) {
    const bool need_ctx = (l == 0);
    const bool skip_ctx = !need_ctx;
    const half_t* Wl = W + (size_t)l * W_LAYER;
    const float* mods_l = mods + (size_t)l * 17 * 6144;
    const float* xl_src = (l == 0) ? p.x : p.out;
    const float* xc_src = (l == 0) ? p.ctx : xc;

    phase_norm(xl_src, xc_src, p.g_norm1 + l * 1024, mods_l, 0, 1024, hbuf, false);
    grid.sync();
    phase_inproj(hbuf, Wl, big, sm);
    grid.sync();
    {
      half_t* zmla = big + B_ZMLA;
      norm_rows<192, 32, 0, false>(zmla, 352, NTOK, p.g_mla_qa + l * 192, 1.f, nullptr);
      norm_rows<128, 16, 0, false>(zmla + 192, 352, NTOK, p.g_mla_kva + l * 128, 1.f, nullptr);
      norm_rows<64, 8, 0, false>(big + B_QNA, 64, NTOK * 4, p.g_na_q + l * 64, 0.125f * LOG2E, nullptr);
      norm_rows<64, 8, 0, false>(big + B_KNA, 64, NTOK * 4, p.g_na_k + l * 64, 1.f, nullptr);
      norm_rows<32, 4, 32, false>(big + B_QDF, 32, NTOK * 8, p.g_diff_q + l * 32, 0.17677669529663687f * LOG2E, nullptr);
      norm_rows<32, 4, 32, false>(big + B_KDF, 32, NTOK * 8, p.g_diff_k + l * 32, 1.f, nullptr);
      norm_rows<64, 8, 64, false>(big + B_QG, 64, NTOK * 4, p.g_gqa_q + l * 64, 0.125f * LOG2E, nullptr);
      norm_rows<64, 8, 64, false>(big + B_KG, 64, NTOK * 2, p.g_gqa_k + l * 64, 1.f, nullptr);
    }
    grid.sync();
    phase_mla_up(Wl, big, sm);
    grid.sync();
    norm_rows<96, 16, 32, false>(big + B_QM, 96, NTOK * 4, p.g_mla_q + l * 96, 0.10206207261596575f * LOG2E, nullptr);
    norm_rows<96, 16, 32, true>(big + B_KM, 96, NTOK * 4, p.g_mla_k + l * 96, 1.f, big + B_ZMLA);
    grid.sync();
    phase_attn(p, l, big, need_ctx, smem);
    grid.sync();
    phase_merge(hbuf, Wl, big, skip_ctx, sm);
    grid.sync();
    phase_resid(big + B_M, 1024, Wl + W_OUT, xl_src, xc_src, p.out, xc, mods_l, 2048, skip_ctx, sm);
    grid.sync();
    phase_norm(p.out, xc, p.g_norm2 + l * 1024, mods_l, 3072, 4096, hbuf, skip_ctx);
    grid.sync();
    phase_up(hbuf, Wl, big + B_U, skip_ctx, sm);
    grid.sync();
    phase_resid(big + B_U, 4096, Wl + W_DOWN, p.out, xc, p.out, xc, mods_l, 5120, skip_ctx, sm);
    if (l == 0) grid.sync();
  }
}

extern "C" void kernel_launch(void* const* d_in, const int* in_sizes, int n_in, void* d_out, int out_size, void* d_ws,
                              size_t ws_size, hipStream_t stream) {
  static int grid_blocks = 0;
  if (!grid_blocks) {
    int dev = 0, cus = 0, per_cu = 0;
    hipGetDevice(&dev);
    hipDeviceGetAttribute(&cus, hipDeviceAttributeMultiprocessorCount, dev);
    hipOccupancyMaxActiveBlocksPerMultiprocessor(&per_cu, hybrid_block_megakernel, 256, 0);
    if (per_cu < 1) per_cu = 1;
    if (per_cu > 2) per_cu = 2;
    grid_blocks = cus * per_cu;
  }
  if (ws_size < WS_NEED) fprintf(stderr, "workspace too small: %zu < %zu\n", ws_size, (size_t)WS_NEED);
  Params p{};
  const float** pf = (const float**)&p;
  for (int i = 0; i < 31; ++i) pf[i] = (const float*)d_in[i];
  p.out = (float*)d_out;
  p.ws = (char*)d_ws;
  void* args[] = {&p};
  hipError_t e = hipLaunchCooperativeKernel((void*)hybrid_block_megakernel, dim3(grid_blocks), dim3(256), args, 0, stream);
  if (e != hipSuccess) fprintf(stderr, "cooperative launch failed: %s (grid %d)\n", hipGetErrorString(e), grid_blocks);
}
```

```cpp
#include <hip/hip_runtime.h>
#include <hip/hip_cooperative_groups.h>
#include <cstdio>
namespace cg = cooperative_groups;

typedef _Float16 half_t;
typedef __attribute__((ext_vector_type(8))) _Float16 h8;
typedef __attribute__((ext_vector_type(4))) _Float16 h4;
typedef __attribute__((ext_vector_type(4))) float f4;
typedef __attribute__((ext_vector_type(16))) float f16v;

#define DI __device__ __forceinline__
#define LAS __attribute__((address_space(3)))

constexpr int NB = 16, SEQ = 2048, CTX = 256, TOK = 2304, NTOK = NB * TOK;
constexpr float LOG2E = 1.4426950408889634f;
constexpr float EPS = 1e-6f;

constexpr int NQK = 2048;
constexpr int NVT = 768;
constexpr int ZS = 576;
constexpr size_t W_QK = 0;
constexpr size_t W_V = W_QK + (size_t)NQK * 1024;
constexpr size_t W_GATE = W_V + (size_t)NVT * 1024;
constexpr size_t W_BR = W_GATE + (size_t)4096 * 1024;
constexpr size_t W_OUT = W_BR + (size_t)4 * 1024 * 256;
constexpr size_t W_UP = W_OUT + (size_t)1024 * 1024;
constexpr size_t W_DOWN = W_UP + (size_t)4096 * 1024;
constexpr size_t W_UQ = W_DOWN + (size_t)1024 * 4096;
constexpr size_t W_UK = W_UQ + (size_t)512 * 256;
constexpr size_t W_UV = W_UK + (size_t)256 * 256;
constexpr size_t W_LAYER = W_UV + (size_t)256 * 256;

constexpr size_t al256(size_t x) { return (x + 255) & ~(size_t)255; }
constexpr size_t OFF_BAR = 0;
constexpr size_t OFF_W = 16384;
constexpr size_t OFF_MOD = al256(OFF_W + 2 * W_LAYER * 2);
constexpr size_t OFF_XC = al256(OFF_MOD + (size_t)2 * 17 * 6144 * 4);
constexpr size_t OFF_H = al256(OFF_XC + (size_t)NB * CTX * 1024 * 4);
constexpr size_t OFF_BIG = al256(OFF_H + (size_t)NTOK * 1024 * 2);
constexpr size_t B_QM = 0;
constexpr size_t B_KM = B_QM + (size_t)NTOK * 384;
constexpr size_t B_VTM = B_KM + (size_t)NTOK * 384;
constexpr size_t B_QNA = B_VTM + (size_t)NTOK * 256;
constexpr size_t B_KNA = B_QNA + (size_t)NTOK * 256;
constexpr size_t B_VTNA = B_KNA + (size_t)NTOK * 256;
constexpr size_t B_QDF = B_VTNA + (size_t)NTOK * 256;
constexpr size_t B_KDF = B_QDF + (size_t)NTOK * 256;
constexpr size_t B_VTDF = B_KDF + (size_t)NTOK * 256;
constexpr size_t B_QG = B_VTDF + (size_t)NTOK * 256;
constexpr size_t B_KG = B_QG + (size_t)NTOK * 256;
constexpr size_t B_VTG = B_KG + (size_t)NTOK * 128;
constexpr size_t B_ZMLA = B_VTG + (size_t)NTOK * 128;
constexpr size_t B_O = B_ZMLA + (size_t)NTOK * ZS;
constexpr size_t B_END = B_O + (size_t)NTOK * 1024;
constexpr size_t B_M = 0;
constexpr size_t B_U = 0;
constexpr size_t WS_NEED = OFF_BIG + B_END * 2;
static_assert(B_END >= (size_t)NTOK * 4096, "u must fit");
static_assert(WS_NEED <= (size_t)536870912, "workspace budget");

constexpr int NTHR = 512, NWAVE = 8;
constexpr int GEMM_LDS = 131072;
constexpr int SMEM_BYTES = GEMM_LDS + 16;

struct Params {
  const float *x, *c, *ctx, *c_ctx, *w_ada, *b_ada, *g_norm1, *g_norm2, *w_in;
  const float *g_mla_qa, *w_mla_uq, *g_mla_kva, *w_mla_ukv, *g_mla_q, *g_mla_k;
  const float *g_na_q, *g_na_k, *na_rpb;
  const float *g_diff_q, *g_diff_k, *lq1, *lk1, *lq2, *lk2, *g_diff_sub;
  const float *g_gqa_q, *g_gqa_k, *w_branch, *w_out, *w_up, *w_down;
  float* out;
  char* ws;
};


DI int tid_opaque() {
  int t = threadIdx.x;
  asm volatile("" : "+v"(t));
  return t;
}

DI float wave_sum(float v) {
#pragma unroll
  for (int o = 32; o > 0; o >>= 1) v += __shfl_xor(v, o);
  return v;
}

#define XB_TMO      128
#define XB_XCNT(j)  (256  + 64 * (j))
#define XB_XSUB(j)  (1280 + 64 * (j))
#define XB_XGEN(j)  (2304 + 64 * (j))
#define XB_TOP      3328
#define XB_TOPGEN   3392
#define XCD_BAR_WORDS 3456
#define XB_SPIN_CAP (1u << 22)
DI unsigned xb_ld(unsigned* p) { return __hip_atomic_load(p, __ATOMIC_RELAXED, __HIP_MEMORY_SCOPE_AGENT); }
DI unsigned xb_add(unsigned* p, unsigned v) { return __hip_atomic_fetch_add(p, v, __ATOMIC_RELAXED, __HIP_MEMORY_SCOPE_AGENT); }
DI unsigned xb_xcc_id() { return (unsigned)__builtin_amdgcn_s_getreg((3 << 11) | 20) & 0xFu; }
#define XB_SPIN(cond, bar) do { unsigned _sp = 0; while (cond) { __builtin_amdgcn_s_sleep(1); \
    if ((++_sp & 255u) == 0u) { if (xb_ld(&(bar)[XB_TMO])) break; if (_sp > XB_SPIN_CAP) { atomicAdd(&(bar)[XB_TMO], 1u); break; } } } } while (0)
DI void xcd_barrier_post(unsigned* bar) {
  if (threadIdx.x == 0) (void)xb_add(&bar[XB_XCNT(xb_xcc_id())], 1u);
}
DI void xcd_barrier_complete(unsigned* bar, unsigned x, unsigned& nloc, unsigned& nx) {
  const unsigned G = gridDim.x * gridDim.y * gridDim.z;
  unsigned sum, cnt, mine, sp = 0u;
  for (;;) {
    sum = 0u; cnt = 0u; mine = 0u;
#pragma unroll
    for (unsigned j = 0; j < 16; ++j) { const unsigned c = xb_ld(&bar[XB_XCNT(j)]); sum += c; cnt += (c > 0u) ? 1u : 0u; mine = (j == x) ? c : mine; }
    if (sum == G) break;
    __builtin_amdgcn_s_sleep(1);
    if ((++sp & 255u) == 0u) { if (xb_ld(&bar[XB_TMO])) break; if (sp > XB_SPIN_CAP) { atomicAdd(&bar[XB_TMO], 1u); break; } }
  }
  nloc = mine > 0u ? mine : 1u; nx = cnt > 0u ? cnt : 1u;
}
DI void xcd_barrier(char* ws_, LAS unsigned char* lds_) {
  asm volatile("s_waitcnt vmcnt(0)" ::: "memory");
  __syncthreads();
  if (threadIdx.x == 0) {
    char* wsl = ws_;
    asm volatile("" : "+s"(wsl));
    unsigned* bar = (unsigned*)(wsl + OFF_BAR);
    volatile LAS unsigned* st = (volatile LAS unsigned*)(lds_ + GEMM_LDS);
    const unsigned x = xb_xcc_id();
    __builtin_amdgcn_s_waitcnt(0);
    unsigned nloc = st[0], nx = st[1];
    if (nloc == 0u) { xcd_barrier_complete(bar, x, nloc, nx); st[0] = nloc; st[1] = nx; }
    const unsigned old = xb_add(&bar[XB_XSUB(x)], 1u);
    const unsigned gen = old / nloc;
    if (old + 1u == (gen + 1u) * nloc) {
      __builtin_amdgcn_fence(__ATOMIC_RELEASE, "agent");
      asm volatile("s_waitcnt vmcnt(0)" ::: "memory");
      const unsigned og = xb_add(&bar[XB_TOP], 1u);
      const unsigned tg = og / nx;
      if (og + 1u == (tg + 1u) * nx) xb_add(&bar[XB_TOPGEN], 1u);
      else XB_SPIN(xb_ld(&bar[XB_TOPGEN]) == tg, bar);
      __builtin_amdgcn_fence(__ATOMIC_ACQUIRE, "agent");
      xb_add(&bar[XB_XGEN(x)], 1u);
      asm volatile("s_waitcnt vmcnt(0)" ::: "memory");
    } else {
      XB_SPIN(xb_ld(&bar[XB_XGEN(x)]) == gen, bar);
      __builtin_amdgcn_fence(__ATOMIC_ACQUIRE, "agent");
      asm volatile("s_waitcnt vmcnt(0)" ::: "memory");
    }
  }
  __syncthreads();
}

DI void phase_mods(const Params& p, float* mods, char* smem) {
  float* sil = (float*)smem;
  const int tid = tid_opaque();
  for (int w = blockIdx.x; w < 192; w += gridDim.x) {
    const int l = w / 96, n0 = (w % 96) * 64;
    __syncthreads();
    for (int idx = tid; idx < 17 * 1024; idx += NTHR) {
      const int b = idx >> 10, k = idx & 1023;
      const float v = (b < 16) ? p.c[b * 1024 + k] : p.c_ctx[k];
      sil[idx] = v / (1.f + expf(-v));
    }
    __syncthreads();
    const int kq = tid >> 6, nn = tid & 63;
    float acc[17];
#pragma unroll
    for (int b = 0; b < 17; ++b) acc[b] = 0.f;
    const float* wp = p.w_ada + (size_t)l * 1024 * 6144 + (size_t)(kq * 128) * 6144 + n0 + nn;
    const float* sp = sil + kq * 128;
#pragma unroll 4
    for (int k = 0; k < 128; ++k) {
      const float wv = wp[(size_t)k * 6144];
#pragma unroll
      for (int b = 0; b < 17; ++b) acc[b] += sp[b * 1024 + k] * wv;
    }
    __syncthreads();
    float* red = (float*)smem;
#pragma unroll
    for (int b = 0; b < 17; ++b) red[(kq * 17 + b) * 64 + nn] = acc[b];
    __syncthreads();
    for (int idx = tid; idx < 17 * 64; idx += NTHR) {
      float s = p.b_ada[l * 6144 + n0 + (idx & 63)];
#pragma unroll
      for (int q = 0; q < 8; ++q) s += red[q * 17 * 64 + idx];
      mods[((size_t)l * 17 + (idx >> 6)) * 6144 + n0 + (idx & 63)] = s;
    }
  }
  __syncthreads();
}

DI void tconv_job(const float* src, int ld, int c0, int K, int Kvalid, int Nvalid, int Npad, half_t* dst, int& base,
                  float* tile) {
  const int nnt = Npad / 64, tot = (K / 64) * nnt;
  const int G = gridDim.x;
  const int start = (int)((blockIdx.x + G - (base % G)) % G);
  const int tid_ = tid_opaque();
  const int tx = tid_ & 63, ty = tid_ >> 6;
  for (int t = start; t < tot; t += G) {
    const int kt = t / nnt, nt = t % nnt;
    __syncthreads();
#pragma unroll 4
    for (int i = 0; i < 8; ++i) {
      const int k = i * 8 + ty, n = nt * 64 + tx;
      tile[k * 65 + tx] = (n < Nvalid && kt * 64 + k < Kvalid) ? src[(size_t)(kt * 64 + k) * ld + c0 + n] : 0.f;
    }
    __syncthreads();
#pragma unroll 4
    for (int i = 0; i < 8; ++i) {
      const int n = i * 8 + ty;
      dst[(size_t)(nt * 64 + n) * K + kt * 64 + tx] = (half_t)tile[tx * 65 + n];
    }
  }
  base += tot;
}

DI void phase_norm(const float* xl, const float* xc, const float* gam, const float* mods_l, int sh_off,
                   int sc_off, half_t* h, bool skip_ctx) {
  const int tid_ = tid_opaque();
  const int wave = tid_ >> 6, lane = tid_ & 63;
  for (int g = blockIdx.x * NWAVE + wave; g < NTOK; g += gridDim.x * NWAVE) {
    const int b = g / TOK, t = g - b * TOK;
    const bool isctx = t >= SEQ;
    if (isctx && skip_ctx) continue;
    const float* src = isctx ? xc + ((size_t)b * CTX + (t - SEQ)) * 1024 : xl + ((size_t)b * SEQ + t) * 1024;
    const float* mod = mods_l + (size_t)(isctx ? 16 : b) * 6144;
    float4 v[4];
    float ss = 0.f;
#pragma unroll
    for (int i = 0; i < 4; ++i) {
      v[i] = *(const float4*)(src + i * 256 + lane * 4);
      ss += v[i].x * v[i].x + v[i].y * v[i].y + v[i].z * v[i].z + v[i].w * v[i].w;
    }
    ss = wave_sum(ss);
    const float rstd = rsqrtf(ss * (1.f / 1024.f) + EPS);
#pragma unroll
    for (int i = 0; i < 4; ++i) {
      const int col = i * 256 + lane * 4;
      const float4 gg = *(const float4*)(gam + col);
      const float4 sc = *(const float4*)(mod + sc_off + col);
      const float4 sh = *(const float4*)(mod + sh_off + col);
      h4 o;
      o[0] = (half_t)(v[i].x * rstd * gg.x * (1.f + sc.x) + sh.x);
      o[1] = (half_t)(v[i].y * rstd * gg.y * (1.f + sc.y) + sh.y);
      o[2] = (half_t)(v[i].z * rstd * gg.z * (1.f + sc.z) + sh.z);
      o[3] = (half_t)(v[i].w * rstd * gg.w * (1.f + sc.w) + sh.w);
      *(h4*)(h + (size_t)g * 1024 + col) = o;
    }
  }
}

template <int NJ>
DI void gemm_tile(const half_t* A, int lda, const half_t* Bt, int ldb, int K, f4 (&acc)[4][NJ], half_t* sm, int gtid) {
  constexpr int BQ = NJ;
  const int lane = gtid & 63, wave = gtid >> 6;
  const int wm = wave >> 1, wn = wave & 1;
  const int lr = gtid >> 3, lc = (gtid & 7) * 8;
  const half_t* ap = A + (size_t)lr * lda + lc;
  const half_t* bp = Bt + (size_t)lr * ldb + lc;
  half_t* sa = sm;
  half_t* sb = sm + 2 * 128 * 72;
  constexpr int BB = 32 * NJ * 72;
  uint4 ra[4], rb[BQ];
  const int nk = K >> 6;
#pragma unroll
  for (int q = 0; q < 4; ++q) ra[q] = *(const uint4*)(ap + (size_t)(q * 32) * lda);
#pragma unroll
  for (int q = 0; q < BQ; ++q) rb[q] = *(const uint4*)(bp + (size_t)(q * 32) * ldb);
#pragma unroll
  for (int q = 0; q < 4; ++q) *(uint4*)(sa + (lr + q * 32) * 72 + lc) = ra[q];
#pragma unroll
  for (int q = 0; q < BQ; ++q) *(uint4*)(sb + (lr + q * 32) * 72 + lc) = rb[q];
  __syncthreads();
  for (int kt = 0; kt < nk; ++kt) {
    const int cur = kt & 1;
    if (kt + 1 < nk) {
#pragma unroll
      for (int q = 0; q < 4; ++q) ra[q] = *(const uint4*)(ap + (size_t)(q * 32) * lda + (kt + 1) * 64);
#pragma unroll
      for (int q = 0; q < BQ; ++q) rb[q] = *(const uint4*)(bp + (size_t)(q * 32) * ldb + (kt + 1) * 64);
    }
    const half_t* ca = sa + cur * 128 * 72 + (wm * 64 + (lane & 15)) * 72 + (lane >> 4) * 8;
    const half_t* cb = sb + cur * BB + (wn * (16 * NJ) + (lane & 15)) * 72 + (lane >> 4) * 8;
#pragma unroll
    for (int kk = 0; kk < 2; ++kk) {
      h8 af[4], bf[NJ];
#pragma unroll
      for (int i = 0; i < 4; ++i) af[i] = *(const h8*)(ca + i * 16 * 72 + kk * 32);
#pragma unroll
      for (int j = 0; j < NJ; ++j) bf[j] = *(const h8*)(cb + j * 16 * 72 + kk * 32);
#pragma unroll
      for (int i = 0; i < 4; ++i)
#pragma unroll
        for (int j = 0; j < NJ; ++j)
          acc[i][j] = __builtin_amdgcn_mfma_f32_16x16x32_f16(af[i], bf[j], acc[i][j], 0, 0, 0);
    }
    if (kt + 1 < nk) {
      const int nx = cur ^ 1;
#pragma unroll
      for (int q = 0; q < 4; ++q) *(uint4*)(sa + nx * 128 * 72 + (lr + q * 32) * 72 + lc) = ra[q];
#pragma unroll
      for (int q = 0; q < BQ; ++q) *(uint4*)(sb + nx * BB + (lr + q * 32) * 72 + lc) = rb[q];
    }
    __syncthreads();
  }
}

template <int NJ>
DI void zero_acc(f4 (&acc)[4][NJ]) {
#pragma unroll
  for (int i = 0; i < 4; ++i)
#pragma unroll
    for (int j = 0; j < NJ; ++j) acc[i][j] = f4{0.f, 0.f, 0.f, 0.f};
}

constexpr int BK = 64, HALF = 128, HTB = HALF * BK * 2;
DI int lds_byte(int r, int c) { const int st = (r >> 4) * 2 + (c >> 5), rr = r & 15, cc = c & 31, ob = rr * 64 + cc * 2; return st * 1024 + (ob ^ (((ob >> 9) & 1) << 5)); }
DI void stage_rc(int b, int& R, int& C) { const int st = b / 1024, sb = b % 1024, swz = sb ^ (((sb >> 9) & 1) << 5); R = (st >> 1) * 16 + swz / 64; C = (st & 1) * 32 + (swz % 64) / 2; }
DI int perm32(int rho) { const int n = rho >> 4, i = rho & 15; return 8 * (i >> 2) + 4 * n + (i & 3); }

struct GUnit { const char* A; const char* B; int nt, pm, pn, aux; };

DI bool tile_map(int L, int nM, int nN, int& pm, int& pn) {
  const int nwg = nM * nN;
  if (L >= nwg) return false;
  int wgid = L;
  { const int q = nwg / 8, r = nwg % 8, xcd = wgid % 8, off = wgid / 8; wgid = (xcd < r ? xcd * (q + 1) : r * (q + 1) + (xcd - r) * q) + off; }
  const int nig = 8 * nN, gid = wgid / nig, fm = gid * 8, gsz = (nM - fm) < 8 ? (nM - fm) : 8;
  pm = fm + ((wgid % nig) % gsz); pn = (wgid % nig) / gsz;
  return true;
}

template <bool PERM, class Sched, class Epi>
DI void gemm256(LAS unsigned char* lds, const Sched& S, const Epi& E) {
  const int tid = tid_opaque(), wid = __builtin_amdgcn_readfirstlane(tid >> 6), lane = tid & 63, wr = wid >> 2, wc = wid & 3, fr = lane & 15, fq = lane >> 4;
  unsigned cvA0, cvA1, cvB0, cvB1;
  { int R, C;
    stage_rc(tid * 16, R, C); cvA0 = (unsigned)R * S.lda2 + C * 2; cvB0 = (unsigned)(PERM ? ((R & ~31) + perm32(R & 31)) : R) * S.ldb2 + C * 2;
    stage_rc(tid * 16 + 8192, R, C); cvA1 = (unsigned)R * S.lda2 + C * 2; cvB1 = (unsigned)(PERM ? ((R & ~31) + perm32(R & 31)) : R) * S.ldb2 + C * 2; }
  const size_t chA = (size_t)HALF * S.lda2, chB = (size_t)HALF * S.ldb2;
  const size_t kstep = (size_t)(BK * 2);
  const unsigned ldsw = (unsigned)wid * 1024u;
  const int aoff = lds_byte(wr * 64 + fr, fq * 8), boff = lds_byte(wc * 32 + fr, fq * 8);
#define G_SA(b, h) (((b) * 2 + (h)) * HTB)
#define G_SB(b, h) ((4 + (b) * 2 + (h)) * HTB)
#define G_STAGE(bufoff, gbase, v0, v1) do { \
    __builtin_amdgcn_global_load_lds((const unsigned*)((const char*)(gbase) + (v0)), (LAS unsigned*)(lds + (bufoff) + ldsw), 16, 0, 0); \
    __builtin_amdgcn_global_load_lds((const unsigned*)((const char*)(gbase) + (v1)), (LAS unsigned*)(lds + (bufoff) + ldsw + 8192), 16, 0, 0); } while (0)
#define G_LDA(dst, b, h) do { _Pragma("unroll") for (int m = 0; m < 4; ++m) _Pragma("unroll") for (int k = 0; k < 2; ++k) dst[m][k] = *(const LAS h8*)(lds + G_SA(b, h) + aoff + m * 2048 + k * 1024); } while (0)
#define G_LDB(dst, b, h) do { _Pragma("unroll") for (int n = 0; n < 2; ++n) _Pragma("unroll") for (int k = 0; k < 2; ++k) dst[n][k] = *(const LAS h8*)(lds + G_SB(b, h) + boff + n * 2048 + k * 1024); } while (0)
#define G_MMA(ai, bj, At, Bt) do { __builtin_amdgcn_s_setprio(1); _Pragma("unroll") for (int m = 0; m < 4; ++m) _Pragma("unroll") for (int n = 0; n < 2; ++n) _Pragma("unroll") for (int k = 0; k < 2; ++k) \
    acc[ai][bj][m][n] = __builtin_amdgcn_mfma_f32_16x16x32_f16(Bt[n][k], At[m][k], acc[ai][bj][m][n], 0, 0, 0); __builtin_amdgcn_s_setprio(0); } while (0)
#define G_WAIT_V(n) asm volatile("s_waitcnt vmcnt(" #n ")" ::: "memory")
#define G_WAIT_L(n) asm volatile("s_waitcnt lgkmcnt(" #n ")" ::: "memory")
#define G_BAR __builtin_amdgcn_s_barrier()
#define G_SCHED __builtin_amdgcn_sched_barrier(0)
  GUnit cur, nxt;
  int ui = 0;
  if (!S.next(0, cur)) return;
  f4 acc[2][2][4][2];
#pragma unroll
  for (int a = 0; a < 2; ++a)
#pragma unroll
    for (int b = 0; b < 2; ++b)
#pragma unroll
      for (int m = 0; m < 4; ++m)
#pragma unroll
        for (int n = 0; n < 2; ++n) acc[a][b][m][n] = f4{0.f, 0.f, 0.f, 0.f};
  h8 At[4][2], B0[2][2], B1[2][2];
  const char* cA = cur.A;
  const char* cB = cur.B;
  G_STAGE(G_SB(0, 0), cB, cvB0, cvB1); G_STAGE(G_SA(0, 0), cA, cvA0, cvA1); G_STAGE(G_SB(0, 1), cB + chB, cvB0, cvB1); G_STAGE(G_SA(0, 1), cA + chA, cvA0, cvA1);
  if (wr == 1) G_BAR;
  G_WAIT_V(4); G_BAR;
  G_STAGE(G_SB(1, 0), cB + kstep, cvB0, cvB1); G_STAGE(G_SA(1, 0), cA + kstep, cvA0, cvA1); G_STAGE(G_SB(1, 1), cB + chB + kstep, cvB0, cvB1);
  G_WAIT_V(6); G_BAR;
  for (;;) {
    const bool has_next = S.next(ui + 1, nxt);
    const char* nA = has_next ? nxt.A : cA;
    const char* nB = has_next ? nxt.B : cB;
    int nt = cur.nt;
    asm volatile("" : "+s"(nt));
    for (int t = 0; t < nt; t += 2) {
      const bool last = (t == nt - 2);
      const char* a1 = cA + (size_t)(t + 1) * kstep;
      const char* a2 = last ? nA : cA + (size_t)(t + 2) * kstep;
      const char* b2 = last ? nB : cB + (size_t)(t + 2) * kstep;
      const char* a3 = a2 + kstep;
      const char* b3 = b2 + kstep;
      G_LDB(B0, 0, 0); G_SCHED; G_LDA(At, 0, 0); G_STAGE(G_SA(1, 1), a1 + chA, cvA0, cvA1);
      G_WAIT_L(8); G_BAR; G_WAIT_L(0); G_MMA(0, 0, At, B0); G_BAR; G_SCHED;
      G_LDB(B1, 0, 1); G_STAGE(G_SB(0, 0), b2, cvB0, cvB1);
      G_BAR; G_WAIT_L(0); G_MMA(0, 1, At, B1); G_BAR;
      G_LDA(At, 0, 1); G_STAGE(G_SA(0, 0), a2, cvA0, cvA1);
      G_BAR; G_WAIT_L(0); G_MMA(1, 0, At, B0); G_BAR; G_SCHED;
      G_STAGE(G_SB(0, 1), b2 + chB, cvB0, cvB1);
      G_WAIT_V(6); G_BAR; G_MMA(1, 1, At, B1); G_BAR;
      G_LDB(B0, 1, 0); G_SCHED; G_LDA(At, 1, 0); G_STAGE(G_SA(0, 1), a2 + chA, cvA0, cvA1);
      G_WAIT_L(8); G_BAR; G_WAIT_L(0); G_MMA(0, 0, At, B0); G_BAR; G_SCHED;
      G_LDB(B1, 1, 1); G_STAGE(G_SB(1, 0), b3, cvB0, cvB1);
      G_BAR; G_WAIT_L(0); G_MMA(0, 1, At, B1); G_BAR;
      G_LDA(At, 1, 1); G_STAGE(G_SA(1, 0), a3, cvA0, cvA1);
      G_BAR; G_WAIT_L(0); G_MMA(1, 0, At, B0); G_BAR; G_SCHED;
      G_STAGE(G_SB(1, 1), b3 + chB, cvB0, cvB1);
      G_WAIT_V(6); G_BAR; G_MMA(1, 1, At, B1); G_BAR;
    }
    E(acc, cur, wr, wc, fr, fq);
    if (!has_next) break;
#pragma unroll
    for (int a = 0; a < 2; ++a)
#pragma unroll
      for (int b = 0; b < 2; ++b)
#pragma unroll
        for (int m = 0; m < 4; ++m)
#pragma unroll
          for (int n = 0; n < 2; ++n) acc[a][b][m][n] = f4{0.f, 0.f, 0.f, 0.f};
    cur = nxt; cA = nA; cB = nB; ++ui;
  }
  G_WAIT_V(0);
  if (wr == 0) G_BAR;
  G_BAR;
#undef G_SA
#undef G_SB
#undef G_STAGE
#undef G_LDA
#undef G_LDB
#undef G_MMA
#undef G_WAIT_V
#undef G_WAIT_L
#undef G_BAR
#undef G_SCHED
}

DI h8 pack8(const f4& a, const f4& b) {
  h8 o;
  o[0] = (half_t)a[0]; o[1] = (half_t)a[1]; o[2] = (half_t)a[2]; o[3] = (half_t)a[3];
  o[4] = (half_t)b[0]; o[5] = (half_t)b[1]; o[6] = (half_t)b[2]; o[7] = (half_t)b[3];
  return o;
}
DI int row0_of(int pm, bool skip_ctx) { return skip_ctx ? (pm >> 3) * TOK + (pm & 7) * 256 : pm * 256; }

struct SchedInproj {
  const half_t* hbuf; const half_t* Wl; int G, c;
  static constexpr unsigned lda2 = 2048, ldb2 = 2048;
  DI bool next(int i, GUnit& u) const {
    const int L = i * G + c;
    u.nt = 16;
    if (L < 144 * 8) {
      tile_map(L, 144, 8, u.pm, u.pn);
      u.A = (const char*)(hbuf + (size_t)u.pm * 256 * 1024); u.B = (const char*)(Wl + W_QK + (size_t)u.pn * 256 * 1024); u.aux = 0;
      return true;
    }
    if (!tile_map(L - 144 * 8, 3, 144, u.pm, u.pn)) return false;
    u.A = (const char*)(Wl + W_V + (size_t)u.pm * 256 * 1024); u.B = (const char*)(hbuf + (size_t)u.pn * 256 * 1024); u.aux = 1;
    return true;
  }
};
struct EpiInproj {
  half_t* big;
  DI void operator()(const f4 (&acc)[2][2][4][2], const GUnit& u, int wr, int wc, int fr, int fq) const {
    if (u.aux == 0) {
      const int g0 = u.pm * 256, b = g0 / TOK, t0 = g0 - b * TOK + wr * 64;
#pragma unroll
      for (int bj = 0; bj < 2; ++bj) {
        const int cb = u.pn * 256 + bj * 128 + wc * 32;
        half_t* ptr; int ts;
        if (cb < 576) { ptr = big + B_ZMLA + (size_t)b * TOK * ZS + cb; ts = ZS; }
        else if (cb < 1088) { const int c = cb - 576, part = c >> 8, hh = (c >> 6) & 3; ptr = big + (part ? B_KNA : B_QNA) + (size_t)(b * 4 + hh) * TOK * 64 + (c & 63); ts = 64; }
        else if (cb < 1600) { const int c = cb - 1088, part = c >> 8, hm = (c >> 5) & 7; ptr = big + (part ? B_KDF : B_QDF) + (size_t)(b * 8 + hm) * TOK * 32; ts = 32; }
        else if (cb < 1856) { const int c = cb - 1600; ptr = big + B_QG + (size_t)(b * 4 + (c >> 6)) * TOK * 64 + (c & 63); ts = 64; }
        else if (cb < 1984) { const int c = cb - 1856; ptr = big + B_KG + (size_t)(b * 2 + (c >> 6)) * TOK * 64 + (c & 63); ts = 64; }
        else continue;
        const unsigned lo = (unsigned)(fr * ts + 8 * fq) * 2u;
        char* rb = (char*)(ptr + (size_t)t0 * ts);
#pragma unroll
        for (int ai = 0; ai < 2; ++ai)
#pragma unroll
          for (int m = 0; m < 4; ++m)
            *(h8*)(rb + (size_t)((ai * 128 + m * 16) * ts) * 2 + lo) = pack8(acc[ai][bj][m][0], acc[ai][bj][m][1]);
      }
    } else {
      const int g0 = u.pn * 256, b = g0 / TOK, t0 = g0 - b * TOK;
      const int nh = (u.pm == 2) ? 2 : 4;
      char* vt = (char*)(big + (u.pm == 0 ? B_VTNA : (u.pm == 1 ? B_VTDF : B_VTG)) + (size_t)b * nh * 64 * TOK + (size_t)(wr * 64) * TOK + t0 + wc * 32);
      const unsigned lo = (unsigned)(fr * TOK + 8 * fq) * 2u;
#pragma unroll
      for (int ai = 0; ai < 2; ++ai) {
        if (u.pm == 2 && ai == 1) continue;
#pragma unroll
        for (int m = 0; m < 4; ++m)
#pragma unroll
          for (int bj = 0; bj < 2; ++bj)
            *(h8*)(vt + ((size_t)(ai * 128 + m * 16) * TOK + bj * 128) * 2 + lo) = pack8(acc[ai][bj][m][0], acc[ai][bj][m][1]);
      }
    }
  }
};

struct SchedMlaQK {
  const half_t* Wl; const half_t* zmla; int G, c;
  static constexpr unsigned lda2 = ZS * 2, ldb2 = 512;
  DI bool next(int i, GUnit& u) const {
    const int L = i * G + c;
    u.nt = 4;
    if (L < 288) {
      tile_map(L, 144, 2, u.pm, u.pn);
      u.A = (const char*)(zmla + (size_t)u.pm * 256 * ZS);
      u.B = (const char*)(Wl + W_UQ + (size_t)u.pn * 256 * 256); u.aux = 0;
      return true;
    }
    if (L < 432) {
      u.pm = L - 288; u.pn = 0;
      u.A = (const char*)(zmla + 256 + (size_t)u.pm * 256 * ZS);
      u.B = (const char*)(Wl + W_UK); u.aux = 1;
      return true;
    }
    return false;
  }
};
struct SchedMlaV {
  const half_t* Wl; const half_t* zmla; int G, c;
  static constexpr unsigned lda2 = 512, ldb2 = ZS * 2;
  DI bool next(int i, GUnit& u) const {
    const int L = i * G + c;
    if (L >= 144) return false;
    u.nt = 4; u.pm = 0; u.pn = L;
    u.A = (const char*)(Wl + W_UV);
    u.B = (const char*)(zmla + 256 + (size_t)u.pn * 256 * ZS); u.aux = 2;
    return true;
  }
};
struct EpiMla {
  half_t* big;
  DI void operator()(const f4 (&acc)[2][2][4][2], const GUnit& u, int wr, int wc, int fr, int fq) const {
    if (u.aux < 2) {
      const int g0 = u.pm * 256, b = g0 / TOK, t0 = g0 - b * TOK + wr * 64;
      const unsigned lo = (unsigned)(fr * 96 + 8 * fq) * 2u;
#pragma unroll
      for (int bj = 0; bj < 2; ++bj) {
        const int cb = u.pn * 256 + bj * 128 + wc * 32;
        half_t* ptr;
        if (u.aux == 0) {
          if (cb >= 384) continue;
          const int hh = cb / 96, dd = cb - hh * 96;
          ptr = big + B_QM + (size_t)(b * 4 + hh) * TOK * 96 + dd;
        } else {
          ptr = big + B_KM + (size_t)(b * 4 + (cb >> 6)) * TOK * 96 + (cb & 63);
        }
        char* rb = (char*)(ptr + (size_t)t0 * 96);
#pragma unroll
        for (int ai = 0; ai < 2; ++ai)
#pragma unroll
          for (int m = 0; m < 4; ++m)
            *(h8*)(rb + (size_t)((ai * 128 + m * 16) * 96) * 2 + lo) = pack8(acc[ai][bj][m][0], acc[ai][bj][m][1]);
      }
    } else {
      const int g0 = u.pn * 256, b = g0 / TOK, t0 = g0 - b * TOK;
      char* vt = (char*)(big + B_VTM + (size_t)b * 4 * 64 * TOK + (size_t)(wr * 64) * TOK + t0 + wc * 32);
      const unsigned lo = (unsigned)(fr * TOK + 8 * fq) * 2u;
#pragma unroll
      for (int ai = 0; ai < 2; ++ai)
#pragma unroll
        for (int m = 0; m < 4; ++m)
#pragma unroll
          for (int bj = 0; bj < 2; ++bj)
            *(h8*)(vt + ((size_t)(ai * 128 + m * 16) * TOK + bj * 128) * 2 + lo) = pack8(acc[ai][bj][m][0], acc[ai][bj][m][1]);
    }
  }
};

struct SchedRows {
  const half_t* A; const half_t* B; int K, nM, nN, G, c; bool skip_ctx; unsigned lda2, ldb2;
  DI bool next(int i, GUnit& u) const {
    if (!tile_map(i * G + c, nM, nN, u.pm, u.pn)) return false;
    u.A = (const char*)(A + (size_t)row0_of(u.pm, skip_ctx) * K); u.B = (const char*)(B + (size_t)u.pn * 256 * K);
    u.nt = K >> 6; u.aux = 0;
    return true;
  }
};
struct EpiResid {
  const float* xl_src; const float* xc_src; float* xl_dst; float* xc_dst; const float* mods_l; int gt_off; bool skip_ctx;
  DI void operator()(const f4 (&acc)[2][2][4][2], const GUnit& u, int wr, int wc, int fr, int fq) const {
    const int g0 = row0_of(u.pm, skip_ctx), b = g0 / TOK, t0 = g0 - b * TOK;
    const bool isctx = t0 >= SEQ;
    const int col0 = u.pn * 256 + wc * 32;
    const size_t rowoff = (size_t)(wr * 64) * 1024 + col0;
    const char* src = (const char*)((isctx ? xc_src + ((size_t)b * CTX + (t0 - SEQ)) * 1024 : xl_src + ((size_t)b * SEQ + t0) * 1024) + rowoff);
    char* dst = (char*)((isctx ? xc_dst + ((size_t)b * CTX + (t0 - SEQ)) * 1024 : xl_dst + ((size_t)b * SEQ + t0) * 1024) + rowoff);
    const char* gt = (const char*)(mods_l + (size_t)(isctx ? 16 : b) * 6144 + gt_off + col0);
    const unsigned lo = (unsigned)(fr * 1024 + 4 * fq) * 4u, glo = (unsigned)(4 * fq) * 4u;
    f4 gv[2][2];
#pragma unroll
    for (int bj = 0; bj < 2; ++bj)
#pragma unroll
      for (int n = 0; n < 2; ++n) gv[bj][n] = *(const f4*)(gt + (bj * 128 + n * 16) * 4 + glo);
#pragma unroll
    for (int ai = 0; ai < 2; ++ai)
#pragma unroll
      for (int m = 0; m < 4; ++m)
#pragma unroll
        for (int bj = 0; bj < 2; ++bj)
#pragma unroll
          for (int n = 0; n < 2; ++n) {
            const size_t uo = ((size_t)(ai * 128 + m * 16) * 1024 + bj * 128 + n * 16) * 4;
            const f4 xv = *(const f4*)(src + uo + lo);
            *(f4*)(dst + uo + lo) = xv + gv[bj][n] * acc[ai][bj][m][n];
          }
  }
};
struct EpiUp {
  half_t* ubuf; bool skip_ctx;
  DI void operator()(const f4 (&acc)[2][2][4][2], const GUnit& u, int wr, int wc, int fr, int fq) const {
    const int g0 = row0_of(u.pm, skip_ctx);
    char* rb = (char*)(ubuf + (size_t)(g0 + wr * 64) * 4096 + u.pn * 256 + wc * 32);
    const unsigned lo = (unsigned)(fr * 4096 + 8 * fq) * 2u;
#pragma unroll
    for (int ai = 0; ai < 2; ++ai)
#pragma unroll
      for (int m = 0; m < 4; ++m)
#pragma unroll
        for (int bj = 0; bj < 2; ++bj) {
          f4 a = acc[ai][bj][m][0], c = acc[ai][bj][m][1];
#pragma unroll
          for (int j = 0; j < 4; ++j) { a[j] = fmaxf(a[j], 0.f); a[j] *= a[j]; c[j] = fmaxf(c[j], 0.f); c[j] *= c[j]; }
          *(h8*)(rb + ((size_t)(ai * 128 + m * 16) * 4096 + bj * 128) * 2 + lo) = pack8(a, c);
        }
  }
};

template <int DLEN, int LPR, int ROPE, bool KR>
DI void norm_rows(half_t* base, int stride, int nrows, const float* gain, float oscale, const half_t* zmla) {
  const int tid_ = tid_opaque();
  const int lane = tid_ & 63, wave = tid_ >> 6;
  constexpr int RPW = 64 / LPR;
  const int s = lane % LPR, sub = lane / LPR;
  const bool active = s * 8 < DLEN;
  float gn[8];
#pragma unroll
  for (int i = 0; i < 8; ++i) gn[i] = active ? gain[s * 8 + i] : 0.f;
  for (int r0 = (blockIdx.x * NWAVE + wave) * RPW; r0 < nrows; r0 += gridDim.x * NWAVE * RPW) {
    const int rho = r0 + sub;
    const int t = rho % TOK;
    half_t* ptr = base + (size_t)rho * stride + s * 8;
    const half_t* src = ptr;
    if (KR && s >= 8) {
      const int b = rho / (4 * TOK);
      src = zmla + ((size_t)b * TOK + t) * ZS + 512 + (s - 8) * 8;
    }
    float f[8];
    float ss = 0.f;
    if (active) {
      const h8 v = *(const h8*)src;
#pragma unroll
      for (int i = 0; i < 8; ++i) { f[i] = (float)v[i]; ss += f[i] * f[i]; }
    } else {
#pragma unroll
      for (int i = 0; i < 8; ++i) f[i] = 0.f;
    }
#pragma unroll
    for (int o = LPR / 2; o > 0; o >>= 1) ss += __shfl_xor(ss, o);
    const float rstd = rsqrtf(ss * (1.f / DLEN) + EPS);
#pragma unroll
    for (int i = 0; i < 8; ++i) f[i] = f[i] * rstd * gn[i];
    if (ROPE != 0) {
      constexpr int PX = (ROPE == 64) ? 2 : 1;
      float pf[8];
#pragma unroll
      for (int i = 0; i < 8; ++i) pf[i] = __shfl_xor(f[i], PX);
      constexpr int RB = (DLEN - ROPE) / 8;
      if (t < SEQ && s >= RB && active) {
        const int sr = s - RB;
        const int q = (ROPE == 64) ? (sr >> 1) : sr;
        const float pos = (float)((q < 2) ? (t >> 6) : (t & 63));
        const float sgn = (q & 1) ? 1.f : -1.f;
#pragma unroll
        for (int i = 0; i < 8; ++i) {
          const int idx = (ROPE == 64) ? ((sr & 1) * 8 + i) : i;
          constexpr float NF = (ROPE == 64) ? 16.f : 8.f;
          const float invf = exp2f(-(float)idx * (13.287712379549449f / NF));
          const float ang = pos * invf;
          float sn, cs;
          sincosf(ang, &sn, &cs);
          f[i] = f[i] * cs + sgn * pf[i] * sn;
        }
      }
    }
    if (active) {
      h8 o;
#pragma unroll
      for (int i = 0; i < 8; ++i) o[i] = (half_t)(f[i] * oscale);
      *(h8*)ptr = o;
    }
  }
}

template <int DQ, bool NA, int NQG>
DI void attn_core(const half_t* Qp, const half_t* Kp, const half_t* Vp, int q0, int seg0_start, int seg0_tiles,
                  int seg1_start, int seg1_tiles, const float* rpb_h, int rq, f16v (&O)[2][NQG]) {
  constexpr int NKS = DQ / 16;
  const int lane = tid_opaque() & 63, r = lane & 31, h = lane >> 5;
  h8 qf[NQG][NKS];
#pragma unroll
  for (int qg = 0; qg < NQG; ++qg)
#pragma unroll
    for (int ks = 0; ks < NKS; ++ks) qf[qg][ks] = *(const h8*)(Qp + (size_t)(q0 + qg * 32 + r) * DQ + ks * 16 + h * 8);
  float mrun[NQG], lrun[NQG];
#pragma unroll
  for (int qg = 0; qg < NQG; ++qg) { mrun[qg] = -1e30f; lrun[qg] = 0.f; }
#pragma unroll
  for (int a = 0; a < 2; ++a)
#pragma unroll
    for (int c = 0; c < NQG; ++c)
#pragma unroll
      for (int i = 0; i < 16; ++i) O[a][c][i] = 0.f;
  const int ntiles = seg0_tiles + seg1_tiles;
  const half_t* kbase = Kp + (size_t)r * DQ + h * 8;
  const half_t* vbase = Vp + (size_t)r * TOK + h * 4;
  h8 kf[NKS];
  h4 vf[2][2][2];
  {
    const int k0 = (0 < seg0_tiles) ? seg0_start : seg1_start;
#pragma unroll
    for (int ks = 0; ks < NKS; ++ks) kf[ks] = *(const h8*)(kbase + (size_t)k0 * DQ + ks * 16);
#pragma unroll
    for (int dvt = 0; dvt < 2; ++dvt)
#pragma unroll
      for (int s = 0; s < 2; ++s)
#pragma unroll
        for (int hf = 0; hf < 2; ++hf) vf[dvt][s][hf] = *(const h4*)(vbase + (size_t)(dvt * 32) * TOK + k0 + s * 16 + hf * 8);
  }
  for (int it = 0; it < ntiles; ++it) {
    const int k0 = (it < seg0_tiles) ? seg0_start + it * 32 : seg1_start + (it - seg0_tiles) * 32;
    const int itn = (it + 1 < ntiles) ? it + 1 : it;
    const int k1 = (itn < seg0_tiles) ? seg0_start + itn * 32 : seg1_start + (itn - seg0_tiles) * 32;
    f16v S[NQG];
#pragma unroll
    for (int qg = 0; qg < NQG; ++qg) {
#pragma unroll
      for (int i = 0; i < 16; ++i) S[qg][i] = 0.f;
#pragma unroll
      for (int ks = 0; ks < NKS; ++ks) S[qg] = __builtin_amdgcn_mfma_f32_32x32x16_f16(kf[ks], qf[qg][ks], S[qg], 0, 0, 0);
    }
#pragma unroll
    for (int ks = 0; ks < NKS; ++ks) kf[ks] = *(const h8*)(kbase + (size_t)k1 * DQ + ks * 16);
    if (NA && it < seg0_tiles) {
      const int krow = k0 >> 6, cb = k0 & 63;
      const int dr = krow - rq + 7;
#pragma unroll
      for (int qg = 0; qg < NQG; ++qg) {
        const int qc = qg * 32 + r;
        const int cs = min(max(qc - 8, 0), 48);
#pragma unroll
        for (int i = 0; i < 16; ++i) {
          const int c = cb + (i & 3) + 8 * (i >> 2) + 4 * h;
          const bool valid = (c >= cs) && (c < cs + 16);
          float bias = 0.f;
          if (valid) bias = rpb_h[dr * 31 + (c - qc + 15)] * LOG2E;
          S[qg][i] = valid ? S[qg][i] + bias : -1e30f;
        }
      }
    }
#pragma unroll
    for (int qg = 0; qg < NQG; ++qg) {
      h8 P[2];
      float mx = S[qg][0];
#pragma unroll
      for (int i = 1; i < 16; ++i) mx = fmaxf(mx, S[qg][i]);
      mx = fmaxf(mx, __shfl_xor(mx, 32));
      const float mn = fmaxf(mrun[qg], mx);
      const float alpha = __builtin_amdgcn_exp2f(mrun[qg] - mn);
      mrun[qg] = mn;
      float rs = 0.f;
#pragma unroll
      for (int i = 0; i < 16; ++i) {
        float pv = __builtin_amdgcn_exp2f(S[qg][i] - mn);
        if (NA) pv = (S[qg][i] <= -1e29f) ? 0.f : pv;
        rs += pv;
        P[i >> 3][i & 7] = (half_t)pv;
      }
      lrun[qg] = lrun[qg] * alpha + rs;
#pragma unroll
      for (int dvt = 0; dvt < 2; ++dvt) {
#pragma unroll
        for (int i = 0; i < 16; ++i) O[dvt][qg][i] *= alpha;
#pragma unroll
        for (int s = 0; s < 2; ++s) {
          const h8 va = __builtin_shufflevector(vf[dvt][s][0], vf[dvt][s][1], 0, 1, 2, 3, 4, 5, 6, 7);
          O[dvt][qg] = __builtin_amdgcn_mfma_f32_32x32x16_f16(va, P[s], O[dvt][qg], 0, 0, 0);
        }
      }
    }
#pragma unroll
    for (int dvt = 0; dvt < 2; ++dvt)
#pragma unroll
      for (int s = 0; s < 2; ++s)
#pragma unroll
        for (int hf = 0; hf < 2; ++hf) vf[dvt][s][hf] = *(const h4*)(vbase + (size_t)(dvt * 32) * TOK + k1 + s * 16 + hf * 8);
  }
#pragma unroll
  for (int qg = 0; qg < NQG; ++qg) {
    const float lt = lrun[qg] + __shfl_xor(lrun[qg], 32);
    const float inv = 1.f / lt;
#pragma unroll
    for (int dvt = 0; dvt < 2; ++dvt)
#pragma unroll
      for (int i = 0; i < 16; ++i) O[dvt][qg][i] *= inv;
  }
}

template <int NQG>
DI void store_o(const f16v (&O)[2][NQG], half_t* orow0  ) {
  const int lane = tid_opaque() & 63, r = lane & 31, h = lane >> 5;
#pragma unroll
  for (int qg = 0; qg < NQG; ++qg)
#pragma unroll
    for (int dvt = 0; dvt < 2; ++dvt)
#pragma unroll
      for (int c = 0; c < 4; ++c) {
        h4 o;
#pragma unroll
        for (int j = 0; j < 4; ++j) o[j] = (half_t)O[dvt][qg][4 * c + j];
        *(h4*)(orow0 + (size_t)(qg * 32 + r) * 1024 + dvt * 32 + 8 * c + 4 * h) = o;
      }
}

DI void phase_attn(const Params& p, int l, half_t* big, bool need_ctx, char* smem) {
  const int tid_ = tid_opaque();
  const int lane = tid_ & 63, wave = __builtin_amdgcn_readfirstlane(tid_ >> 6), h = lane >> 5;
  const int grp = wave >> 2, wv = wave & 3;
  const int NQB = need_ctx ? 9 : 8;
  const int nitems = 16 * 16 * NQB;
  half_t* obuf = big + B_O;
  const float lam_init = 0.8f - 0.6f * expf(-0.3f * (float)l);
  float lam;
  {
    float d1 = 0.f, d2 = 0.f;
#pragma unroll 1
    for (int i = 0; i < 32; ++i) {
      d1 += p.lq1[l * 32 + i] * p.lk1[l * 32 + i];
      d2 += p.lq2[l * 32 + i] * p.lk2[l * 32 + i];
    }
    lam = expf(d1) - expf(d2) + lam_init;
    lam = __builtin_bit_cast(float, __builtin_amdgcn_readfirstlane(__builtin_bit_cast(int, lam)));
  }
  const float one_m_li = __builtin_bit_cast(float, __builtin_amdgcn_readfirstlane(__builtin_bit_cast(int, 1.f - lam_init)));
  for (int item = blockIdx.x * 2 + grp; item < nitems; item += gridDim.x * 2) {
    const int hi = item / (16 * NQB);
    const int rem = item - hi * 16 * NQB;
    const int b = rem / NQB, qb = rem - b * NQB;
    const int q0 = qb * 256 + wv * 64;
    const bool qctx = qb == 8;
    const int mixer = hi >> 2, hh = hi & 3;
    const int s0 = qctx ? SEQ : 0, n0t = qctx ? 8 : 72;
    f16v O[2][2];
    half_t* orow = obuf + (size_t)(b * TOK + q0) * 1024 + hh * 64;
    if (mixer == 0) {
      float* stash = (float*)smem + wave * 4096;
      attn_core<32, false, 2>(big + B_QDF + (size_t)(b * 8 + hh * 2) * TOK * 32, big + B_KDF + (size_t)(b * 8 + hh * 2) * TOK * 32,
                              big + B_VTDF + (size_t)(b * 4 + hh) * 64 * TOK, q0, s0, n0t, 0, 0, nullptr, 0, O);
#pragma unroll
      for (int dvt = 0; dvt < 2; ++dvt)
#pragma unroll
        for (int qg = 0; qg < 2; ++qg)
#pragma unroll
          for (int i = 0; i < 16; ++i) stash[((dvt * 2 + qg) * 16 + i) * 64 + lane] = O[dvt][qg][i];
      attn_core<32, false, 2>(big + B_QDF + (size_t)(b * 8 + hh * 2 + 1) * TOK * 32, big + B_KDF + (size_t)(b * 8 + hh * 2 + 1) * TOK * 32,
                              big + B_VTDF + (size_t)(b * 4 + hh) * 64 * TOK, q0, s0, n0t, 0, 0, nullptr, 0, O);
#pragma unroll
      for (int qg = 0; qg < 2; ++qg) {
        float ss = 0.f;
#pragma unroll
        for (int dvt = 0; dvt < 2; ++dvt)
#pragma unroll
          for (int i = 0; i < 16; ++i) {
            const float v = stash[((dvt * 2 + qg) * 16 + i) * 64 + lane] - lam * O[dvt][qg][i];
            O[dvt][qg][i] = v;
            ss += v * v;
          }
        ss += __shfl_xor(ss, 32);
        const float rstd = rsqrtf(ss * (1.f / 64.f) + EPS) * one_m_li;
#pragma unroll
        for (int dvt = 0; dvt < 2; ++dvt)
#pragma unroll
          for (int i = 0; i < 16; ++i) {
            const int dv = dvt * 32 + (i & 3) + 8 * (i >> 2) + 4 * h;
            O[dvt][qg][i] *= rstd * p.g_diff_sub[l * 64 + dv];
          }
      }
      store_o<2>(O, orow + 2 * 256);
    } else if (mixer == 1) {
      for (int ps = 0; ps < 2; ++ps) {
        f16v O1[2][1];
        attn_core<96, false, 1>(big + B_QM + (size_t)(b * 4 + hh) * TOK * 96, big + B_KM + (size_t)(b * 4 + hh) * TOK * 96,
                                big + B_VTM + (size_t)(b * 4 + hh) * 64 * TOK, q0 + ps * 32, s0, n0t, 0, 0, nullptr, 0, O1);
        store_o<1>(O1, orow + (size_t)(ps * 32) * 1024 + 0 * 256);
      }
    } else if (mixer == 2) {
      const int kv = hh >> 1;
      attn_core<64, false, 2>(big + B_QG + (size_t)(b * 4 + hh) * TOK * 64, big + B_KG + (size_t)(b * 2 + kv) * TOK * 64,
                              big + B_VTG + (size_t)(b * 2 + kv) * 64 * TOK, q0, s0, n0t, 0, 0, nullptr, 0, O);
      store_o<2>(O, orow + 3 * 256);
    } else {
      const int rq = q0 >> 6;
      const int r0 = min(max(rq - 4, 0), 24);
      const int seg0s = r0 * 64, seg0n = qctx ? 0 : 16;
      attn_core<64, true, 2>(big + B_QNA + (size_t)(b * 4 + hh) * TOK * 64, big + B_KNA + (size_t)(b * 4 + hh) * TOK * 64,
                             big + B_VTNA + (size_t)(b * 4 + hh) * 64 * TOK, q0, seg0s, seg0n, SEQ, 8,
                             p.na_rpb + (size_t)(l * 4 + hh) * 15 * 31, rq, O);
      store_o<2>(O, orow + 1 * 256);
    }
  }
}

DI void phase_merge(const half_t* hbuf, const half_t* Wl, half_t* big, bool skip_ctx, char* smem) {
  const int tid_ = tid_opaque();
  const int gtid = tid_ & 255, grp = tid_ >> 8;
  const int lane = gtid & 63, wave = gtid >> 6, wm = wave >> 1, wn = wave & 1;
  const int l15 = lane & 15, quad = lane >> 4;
  half_t* sm = (half_t*)(smem + grp * 55296);
  const int npairs = (skip_ctx ? 256 : 288) * 16 / 2;
  const half_t* obuf = big + B_O;
  half_t* mbuf = big + B_M;
  for (int pair = blockIdx.x; pair < npairs; pair += gridDim.x) {
    const int tile = pair * 2 + grp;
    const int rt = tile >> 4, nt = tile & 15;
    const int m0 = skip_ctx ? (rt >> 4) * TOK + (rt & 15) * 128 : rt * 128, n0 = nt * 64;
    f4 macc[4][2];
    zero_acc<2>(macc);
    for (int br = 0; br < 4; ++br) {
      f4 acc[4][2];
      zero_acc<2>(acc);
      gemm_tile<2>(hbuf + (size_t)m0 * 1024, 1024, Wl + W_GATE + (size_t)(br * 1024 + n0) * 1024, 1024, 1024, acc, sm, gtid);
      f4 sg[4][2];
#pragma unroll
      for (int i = 0; i < 4; ++i)
#pragma unroll
        for (int j = 0; j < 2; ++j)
#pragma unroll
          for (int r = 0; r < 4; ++r) sg[i][j][r] = 1.f / (1.f + __expf(-acc[i][j][r]));
      zero_acc<2>(acc);
      gemm_tile<2>(obuf + (size_t)m0 * 1024 + br * 256, 1024, Wl + W_BR + (size_t)(br * 1024 + n0) * 256, 256, 256, acc, sm, gtid);
#pragma unroll
      for (int i = 0; i < 4; ++i)
#pragma unroll
        for (int j = 0; j < 2; ++j)
#pragma unroll
          for (int r = 0; r < 4; ++r) macc[i][j][r] += sg[i][j][r] * acc[i][j][r];
    }
#pragma unroll
    for (int i = 0; i < 4; ++i)
#pragma unroll
      for (int j = 0; j < 2; ++j)
#pragma unroll
        for (int r = 0; r < 4; ++r)
          mbuf[(size_t)(m0 + wm * 64 + i * 16 + quad * 4 + r) * 1024 + n0 + wn * 32 + j * 16 + l15] = (half_t)macc[i][j][r];
  }
}

__global__ void __launch_bounds__(NTHR) hybrid_block_megakernel(Params p) {
  __shared__ __attribute__((aligned(16))) char smem[SMEM_BYTES];
  char* ws = p.ws;
  if (ws == nullptr) cg::this_grid().sync();
  half_t* W = (half_t*)(ws + OFF_W);
  float* mods = (float*)(ws + OFF_MOD);
  float* xc = (float*)(ws + OFF_XC);
  half_t* hbuf = (half_t*)(ws + OFF_H);
  half_t* big = (half_t*)(ws + OFF_BIG);
  LAS unsigned char* lds = (LAS unsigned char*)smem;
  const int G = gridDim.x, cblk = blockIdx.x;

  volatile LAS unsigned* st = (volatile LAS unsigned*)(lds + GEMM_LDS);
  if (threadIdx.x < 4) st[threadIdx.x] = 0u;
  __syncthreads();
  xcd_barrier_post((unsigned*)(ws + OFF_BAR));

  phase_mods(p, mods, smem);
  {
    int base = 0;
    float* tile = (float*)smem;
    for (int l = 0; l < 2; ++l) {
      half_t* Wl = W + (size_t)l * W_LAYER;
      const float* win = p.w_in + (size_t)l * 1024 * 6496;
      tconv_job(win, 6496, 0, 1024, 1024, 192, 256, Wl + W_QK, base, tile);
      tconv_job(win, 6496, 192, 1024, 1024, 128, 256, Wl + W_QK + (size_t)256 * 1024, base, tile);
      tconv_job(win, 6496, 320, 1024, 1024, 32, 64, Wl + W_QK + (size_t)512 * 1024, base, tile);
      tconv_job(win, 6496, 352, 1024, 1024, 256, 256, Wl + W_QK + (size_t)576 * 1024, base, tile);
      tconv_job(win, 6496, 608, 1024, 1024, 256, 256, Wl + W_QK + (size_t)832 * 1024, base, tile);
      tconv_job(win, 6496, 1120, 1024, 1024, 256, 256, Wl + W_QK + (size_t)1088 * 1024, base, tile);
      tconv_job(win, 6496, 1376, 1024, 1024, 256, 256, Wl + W_QK + (size_t)1344 * 1024, base, tile);
      tconv_job(win, 6496, 1888, 1024, 1024, 256, 256, Wl + W_QK + (size_t)1600 * 1024, base, tile);
      tconv_job(win, 6496, 2144, 1024, 1024, 128, 192, Wl + W_QK + (size_t)1856 * 1024, base, tile);
      tconv_job(win, 6496, 864, 1024, 1024, 256, 256, Wl + W_V, base, tile);
      tconv_job(win, 6496, 1632, 1024, 1024, 256, 256, Wl + W_V + (size_t)256 * 1024, base, tile);
      tconv_job(win, 6496, 2272, 1024, 1024, 128, 256, Wl + W_V + (size_t)512 * 1024, base, tile);
      tconv_job(win, 6496, 2400, 1024, 1024, 4096, 4096, Wl + W_GATE, base, tile);
      for (int br = 0; br < 4; ++br)
        tconv_job(p.w_branch + ((size_t)l * 4 + br) * 256 * 1024, 1024, 0, 256, 256, 1024, 1024, Wl + W_BR + (size_t)br * 1024 * 256, base, tile);
      tconv_job(p.w_out + (size_t)l * 1024 * 1024, 1024, 0, 1024, 1024, 1024, 1024, Wl + W_OUT, base, tile);
      tconv_job(p.w_up + (size_t)l * 1024 * 4096, 4096, 0, 1024, 1024, 4096, 4096, Wl + W_UP, base, tile);
      tconv_job(p.w_down + (size_t)l * 4096 * 1024, 1024, 0, 4096, 4096, 1024, 1024, Wl + W_DOWN, base, tile);
      tconv_job(p.w_mla_uq + (size_t)l * 192 * 384, 384, 0, 256, 192, 384, 512, Wl + W_UQ, base, tile);
      for (int hh = 0; hh < 4; ++hh) {
        tconv_job(p.w_mla_ukv + (size_t)l * 128 * 512, 512, hh * 128, 256, 128, 64, 64, Wl + W_UK + (size_t)hh * 64 * 256, base, tile);
        tconv_job(p.w_mla_ukv + (size_t)l * 128 * 512, 512, hh * 128 + 64, 256, 128, 64, 64, Wl + W_UV + (size_t)hh * 64 * 256, base, tile);
      }
    }
  }
  xcd_barrier(ws, lds);

  for (int l = 0; l < 2; ++l) {
    const bool need_ctx = (l == 0);
    const bool skip_ctx = !need_ctx;
    const half_t* Wl = W + (size_t)l * W_LAYER;
    const float* mods_l = mods + (size_t)l * 17 * 6144;
    const float* xl_src = (l == 0) ? p.x : p.out;
    const float* xc_src = (l == 0) ? p.ctx : xc;
    const int nrt = skip_ctx ? 128 : 144;

    phase_norm(xl_src, xc_src, p.g_norm1 + l * 1024, mods_l, 0, 1024, hbuf, false);
    xcd_barrier(ws, lds);
    {
      SchedInproj S{hbuf, Wl, G, cblk};
      EpiInproj E{big};
      gemm256<true>(lds, S, E);
    }
    xcd_barrier(ws, lds);
    {
      half_t* zmla = big + B_ZMLA;
      norm_rows<192, 32, 0, false>(zmla, ZS, NTOK, p.g_mla_qa + l * 192, 1.f, nullptr);
      norm_rows<128, 16, 0, false>(zmla + 256, ZS, NTOK, p.g_mla_kva + l * 128, 1.f, nullptr);
      norm_rows<64, 8, 0, false>(big + B_QNA, 64, NTOK * 4, p.g_na_q + l * 64, 0.125f * LOG2E, nullptr);
      norm_rows<64, 8, 0, false>(big + B_KNA, 64, NTOK * 4, p.g_na_k + l * 64, 1.f, nullptr);
      norm_rows<32, 4, 32, false>(big + B_QDF, 32, NTOK * 8, p.g_diff_q + l * 32, 0.17677669529663687f * LOG2E, nullptr);
      norm_rows<32, 4, 32, false>(big + B_KDF, 32, NTOK * 8, p.g_diff_k + l * 32, 1.f, nullptr);
      norm_rows<64, 8, 64, false>(big + B_QG, 64, NTOK * 4, p.g_gqa_q + l * 64, 0.125f * LOG2E, nullptr);
      norm_rows<64, 8, 64, false>(big + B_KG, 64, NTOK * 2, p.g_gqa_k + l * 64, 1.f, nullptr);
    }
    xcd_barrier(ws, lds);
    {
      SchedMlaQK S{Wl, big + B_ZMLA, G, cblk};
      EpiMla E{big};
      gemm256<true>(lds, S, E);
      SchedMlaV S2{Wl, big + B_ZMLA, G, cblk};
      gemm256<true>(lds, S2, E);
    }
    xcd_barrier(ws, lds);
    norm_rows<96, 16, 32, false>(big + B_QM, 96, NTOK * 4, p.g_mla_q + l * 96, 0.10206207261596575f * LOG2E, nullptr);
    norm_rows<96, 16, 32, true>(big + B_KM, 96, NTOK * 4, p.g_mla_k + l * 96, 1.f, big + B_ZMLA);
    xcd_barrier(ws, lds);
    phase_attn(p, l, big, need_ctx, smem);
    xcd_barrier(ws, lds);
    phase_merge(hbuf, Wl, big, skip_ctx, smem);
    xcd_barrier(ws, lds);
    {
      SchedRows S{big + B_M, Wl + W_OUT, 1024, nrt, 4, G, cblk, skip_ctx, 2048u, 2048u};
      EpiResid E{xl_src, xc_src, p.out, xc, mods_l, 2048, skip_ctx};
      gemm256<false>(lds, S, E);
    }
    xcd_barrier(ws, lds);
    phase_norm(p.out, xc, p.g_norm2 + l * 1024, mods_l, 3072, 4096, hbuf, skip_ctx);
    xcd_barrier(ws, lds);
    {
      SchedRows S{hbuf, Wl + W_UP, 1024, nrt, 16, G, cblk, skip_ctx, 2048u, 2048u};
      EpiUp E{big + B_U, skip_ctx};
      gemm256<true>(lds, S, E);
    }
    xcd_barrier(ws, lds);
    {
      SchedRows S{big + B_U, Wl + W_DOWN, 4096, nrt, 4, G, cblk, skip_ctx, 8192u, 8192u};
      EpiResid E{p.out, xc, p.out, xc, mods_l, 5120, skip_ctx};
      gemm256<false>(lds, S, E);
    }
    if (l == 0) xcd_barrier(ws, lds);
  }
}

extern "C" void kernel_launch(void* const* d_in, const int* in_sizes, int n_in, void* d_out, int out_size, void* d_ws,
                              size_t ws_size, hipStream_t stream) {
  static int grid_blocks = 0;
  if (!grid_blocks) {
    int dev = 0, cus = 0, per_cu = 0;
    (void)hipGetDevice(&dev);
    (void)hipDeviceGetAttribute(&cus, hipDeviceAttributeMultiprocessorCount, dev);
    (void)hipOccupancyMaxActiveBlocksPerMultiprocessor(&per_cu, hybrid_block_megakernel, NTHR, 0);
    if (per_cu < 1) fprintf(stderr, "occupancy query returned %d\n", per_cu);
    grid_blocks = cus;
  }
  if (ws_size < WS_NEED) fprintf(stderr, "workspace too small: %zu < %zu\n", ws_size, (size_t)WS_NEED);
  (void)hipMemsetAsync((char*)d_ws + OFF_BAR, 0, XCD_BAR_WORDS * 4, stream);
  Params p{};
  const float** pf = (const float**)&p;
  for (int i = 0; i < 31; ++i) pf[i] = (const float*)d_in[i];
  p.out = (float*)d_out;
  p.ws = (char*)d_ws;
  void* args[] = {&p};
  hipError_t e = hipLaunchCooperativeKernel((void*)hybrid_block_megakernel, dim3(grid_blocks), dim3(NTHR), args, 0, stream);
  if (e != hipSuccess) fprintf(stderr, "cooperative launch failed: %s (grid %d)\n", hipGetErrorString(e), grid_blocks);
}
```

```cpp
#include <hip/hip_runtime.h>
#include <hip/hip_cooperative_groups.h>
#include <cstdio>
namespace cg = cooperative_groups;

typedef _Float16 half_t;
typedef __attribute__((ext_vector_type(8))) _Float16 h8;
typedef __attribute__((ext_vector_type(4))) _Float16 h4;
typedef __attribute__((ext_vector_type(4))) float f4;
typedef __attribute__((ext_vector_type(16))) float f16v;

#define DI __device__ __forceinline__
#define LAS __attribute__((address_space(3)))

constexpr int NB = 16, SEQ = 2048, CTX = 256, TOK = 2304, NTOK = NB * TOK;
constexpr float LOG2E = 1.4426950408889634f;
constexpr float EPS = 1e-6f;

constexpr int NQK = 2048;
constexpr int NVT = 768;
constexpr int ZS = 576;
constexpr size_t W_QK = 0;
constexpr size_t W_V = W_QK + (size_t)NQK * 1024;
constexpr size_t W_GATE = W_V + (size_t)NVT * 1024;
constexpr size_t W_BR = W_GATE + (size_t)4096 * 1024;
constexpr size_t W_OUT = W_BR + (size_t)4 * 1024 * 256;
constexpr size_t W_UP = W_OUT + (size_t)1024 * 1024;
constexpr size_t W_DOWN = W_UP + (size_t)4096 * 1024;
constexpr size_t W_UQ = W_DOWN + (size_t)1024 * 4096;
constexpr size_t W_UK = W_UQ + (size_t)512 * 256;
constexpr size_t W_UV = W_UK + (size_t)256 * 256;
constexpr size_t W_LAYER = W_UV + (size_t)256 * 256;

constexpr size_t al256(size_t x) { return (x + 255) & ~(size_t)255; }
constexpr size_t OFF_BAR = 0;
constexpr size_t OFF_W = 16384;
constexpr size_t OFF_MOD = al256(OFF_W + 2 * W_LAYER * 2);
constexpr size_t OFF_XC = al256(OFF_MOD + (size_t)2 * 17 * 6144 * 4);
constexpr size_t OFF_H = al256(OFF_XC + (size_t)NB * CTX * 1024 * 4);
constexpr size_t OFF_BIG = al256(OFF_H + (size_t)NTOK * 1024 * 2);
constexpr size_t B_O = 0;
constexpr size_t B_QM = B_O + (size_t)NTOK * 1024;
constexpr size_t B_KM = B_QM + (size_t)NTOK * 384;
constexpr size_t B_VTM = B_KM + (size_t)NTOK * 384;
constexpr size_t B_QNA = B_VTM + (size_t)NTOK * 256;
constexpr size_t B_KNA = B_QNA + (size_t)NTOK * 256;
constexpr size_t B_VTNA = B_KNA + (size_t)NTOK * 256;
constexpr size_t B_QDF = B_VTNA + (size_t)NTOK * 256;
constexpr size_t B_KDF = B_QDF + (size_t)NTOK * 256;
constexpr size_t B_VTDF = B_KDF + (size_t)NTOK * 256;
constexpr size_t B_QG = B_VTDF + (size_t)NTOK * 256;
constexpr size_t B_KG = B_QG + (size_t)NTOK * 256;
constexpr size_t B_VTG = B_KG + (size_t)NTOK * 128;
constexpr size_t B_ZMLA = B_VTG + (size_t)NTOK * 128;
constexpr size_t B_END = B_ZMLA + (size_t)NTOK * ZS;
constexpr size_t B_M = B_O + (size_t)NTOK * 1024;
constexpr size_t GSLAB = (size_t)48 * 256 * 4096;
constexpr size_t B_G0 = B_M + (size_t)NTOK * 1024;
constexpr size_t B_G1 = B_G0 + GSLAB;
constexpr size_t B_P5END = B_G1 + GSLAB;
constexpr size_t B_U = 0;
constexpr size_t B_MAX = B_END > B_P5END ? B_END : B_P5END;
constexpr size_t WS_NEED = OFF_BIG + B_MAX * 2;
static_assert(B_MAX >= (size_t)NTOK * 4096, "u must fit");
static_assert(WS_NEED <= (size_t)536870912, "workspace budget");

constexpr int NTHR = 512, NWAVE = 8;
constexpr int GEMM_LDS = 131072;
constexpr int SMEM_BYTES = GEMM_LDS + 16;

struct Params {
  const float *x, *c, *ctx, *c_ctx, *w_ada, *b_ada, *g_norm1, *g_norm2, *w_in;
  const float *g_mla_qa, *w_mla_uq, *g_mla_kva, *w_mla_ukv, *g_mla_q, *g_mla_k;
  const float *g_na_q, *g_na_k, *na_rpb;
  const float *g_diff_q, *g_diff_k, *lq1, *lk1, *lq2, *lk2, *g_diff_sub;
  const float *g_gqa_q, *g_gqa_k, *w_branch, *w_out, *w_up, *w_down;
  float* out;
  char* ws;
};


DI int tid_opaque() {
  int t = threadIdx.x;
  asm volatile("" : "+v"(t));
  return t;
}

DI float wave_sum(float v) {
#pragma unroll
  for (int o = 32; o > 0; o >>= 1) v += __shfl_xor(v, o);
  return v;
}

#define XB_TMO      128
#define XB_XCNT(j)  (256  + 64 * (j))
#define XB_XSUB(j)  (1280 + 64 * (j))
#define XB_XGEN(j)  (2304 + 64 * (j))
#define XB_TOP      3328
#define XB_TOPGEN   3392
#define XCD_BAR_WORDS 3456
#define XB_SPIN_CAP (1u << 22)
DI unsigned xb_ld(unsigned* p) { return __hip_atomic_load(p, __ATOMIC_RELAXED, __HIP_MEMORY_SCOPE_AGENT); }
DI unsigned xb_add(unsigned* p, unsigned v) { return __hip_atomic_fetch_add(p, v, __ATOMIC_RELAXED, __HIP_MEMORY_SCOPE_AGENT); }
DI unsigned xb_xcc_id() { return (unsigned)__builtin_amdgcn_s_getreg((3 << 11) | 20) & 0xFu; }
#define XB_SPIN(cond, bar) do { unsigned _sp = 0; while (cond) { __builtin_amdgcn_s_sleep(1); \
    if ((++_sp & 255u) == 0u) { if (xb_ld(&(bar)[XB_TMO])) break; if (_sp > XB_SPIN_CAP) { atomicAdd(&(bar)[XB_TMO], 1u); break; } } } } while (0)
DI void xcd_barrier_post(unsigned* bar) {
  if (threadIdx.x == 0) (void)xb_add(&bar[XB_XCNT(xb_xcc_id())], 1u);
}
DI void xcd_barrier_complete(unsigned* bar, unsigned x, unsigned& nloc, unsigned& nx) {
  const unsigned G = gridDim.x * gridDim.y * gridDim.z;
  unsigned sum, cnt, mine, sp = 0u;
  for (;;) {
    sum = 0u; cnt = 0u; mine = 0u;
#pragma unroll
    for (unsigned j = 0; j < 16; ++j) { const unsigned c = xb_ld(&bar[XB_XCNT(j)]); sum += c; cnt += (c > 0u) ? 1u : 0u; mine = (j == x) ? c : mine; }
    if (sum == G) break;
    __builtin_amdgcn_s_sleep(1);
    if ((++sp & 255u) == 0u) { if (xb_ld(&bar[XB_TMO])) break; if (sp > XB_SPIN_CAP) { atomicAdd(&bar[XB_TMO], 1u); break; } }
  }
  nloc = mine > 0u ? mine : 1u; nx = cnt > 0u ? cnt : 1u;
}
DI void xcd_barrier(char* ws_, LAS unsigned char* lds_) {
  asm volatile("s_waitcnt vmcnt(0)" ::: "memory");
  __syncthreads();
  if (threadIdx.x == 0) {
    char* wsl = ws_;
    asm volatile("" : "+s"(wsl));
    unsigned* bar = (unsigned*)(wsl + OFF_BAR);
    volatile LAS unsigned* st = (volatile LAS unsigned*)(lds_ + GEMM_LDS);
    const unsigned x = xb_xcc_id();
    __builtin_amdgcn_s_waitcnt(0);
    unsigned nloc = st[0], nx = st[1];
    if (nloc == 0u) { xcd_barrier_complete(bar, x, nloc, nx); st[0] = nloc; st[1] = nx; }
    const unsigned old = xb_add(&bar[XB_XSUB(x)], 1u);
    const unsigned gen = old / nloc;
    if (old + 1u == (gen + 1u) * nloc) {
      __builtin_amdgcn_fence(__ATOMIC_RELEASE, "agent");
      asm volatile("s_waitcnt vmcnt(0)" ::: "memory");
      const unsigned og = xb_add(&bar[XB_TOP], 1u);
      const unsigned tg = og / nx;
      if (og + 1u == (tg + 1u) * nx) xb_add(&bar[XB_TOPGEN], 1u);
      else XB_SPIN(xb_ld(&bar[XB_TOPGEN]) == tg, bar);
      __builtin_amdgcn_fence(__ATOMIC_ACQUIRE, "agent");
      xb_add(&bar[XB_XGEN(x)], 1u);
      asm volatile("s_waitcnt vmcnt(0)" ::: "memory");
    } else {
      XB_SPIN(xb_ld(&bar[XB_XGEN(x)]) == gen, bar);
      __builtin_amdgcn_fence(__ATOMIC_ACQUIRE, "agent");
      asm volatile("s_waitcnt vmcnt(0)" ::: "memory");
    }
  }
  __syncthreads();
}

DI void phase_mods(const Params& p, float* mods, char* smem) {
  float* sil = (float*)smem;
  const int tid = tid_opaque();
  for (int w = blockIdx.x; w < 192; w += gridDim.x) {
    const int l = w / 96, n0 = (w % 96) * 64;
    __syncthreads();
    for (int idx = tid; idx < 17 * 1024; idx += NTHR) {
      const int b = idx >> 10, k = idx & 1023;
      const float v = (b < 16) ? p.c[b * 1024 + k] : p.c_ctx[k];
      sil[idx] = v / (1.f + expf(-v));
    }
    __syncthreads();
    const int kq = tid >> 6, nn = tid & 63;
    float acc[17];
#pragma unroll
    for (int b = 0; b < 17; ++b) acc[b] = 0.f;
    const float* wp = p.w_ada + (size_t)l * 1024 * 6144 + (size_t)(kq * 128) * 6144 + n0 + nn;
    const float* sp = sil + kq * 128;
#pragma unroll 4
    for (int k = 0; k < 128; ++k) {
      const float wv = wp[(size_t)k * 6144];
#pragma unroll
      for (int b = 0; b < 17; ++b) acc[b] += sp[b * 1024 + k] * wv;
    }
    __syncthreads();
    float* red = (float*)smem;
#pragma unroll
    for (int b = 0; b < 17; ++b) red[(kq * 17 + b) * 64 + nn] = acc[b];
    __syncthreads();
    for (int idx = tid; idx < 17 * 64; idx += NTHR) {
      float s = p.b_ada[l * 6144 + n0 + (idx & 63)];
#pragma unroll
      for (int q = 0; q < 8; ++q) s += red[q * 17 * 64 + idx];
      mods[((size_t)l * 17 + (idx >> 6)) * 6144 + n0 + (idx & 63)] = s;
    }
  }
  __syncthreads();
}

DI void tconv_job(const float* src, int ld, int c0, int K, int Kvalid, int Nvalid, int Npad, half_t* dst, int& base,
                  float* tile) {
  const int nnt = Npad / 64, tot = (K / 64) * nnt;
  const int G = gridDim.x;
  const int start = (int)((blockIdx.x + G - (base % G)) % G);
  const int tid_ = tid_opaque();
  const int tx = tid_ & 63, ty = tid_ >> 6;
  for (int t = start; t < tot; t += G) {
    const int kt = t / nnt, nt = t % nnt;
    __syncthreads();
#pragma unroll 4
    for (int i = 0; i < 8; ++i) {
      const int k = i * 8 + ty, n = nt * 64 + tx;
      tile[k * 65 + tx] = (n < Nvalid && kt * 64 + k < Kvalid) ? src[(size_t)(kt * 64 + k) * ld + c0 + n] : 0.f;
    }
    __syncthreads();
#pragma unroll 4
    for (int i = 0; i < 8; ++i) {
      const int n = i * 8 + ty;
      dst[(size_t)(nt * 64 + n) * K + kt * 64 + tx] = (half_t)tile[tx * 65 + n];
    }
  }
  base += tot;
}

DI void phase_norm(const float* xl, const float* xc, const float* gam, const float* mods_l, int sh_off,
                   int sc_off, half_t* h, bool skip_ctx) {
  const int tid_ = tid_opaque();
  const int wave = tid_ >> 6, lane = tid_ & 63;
  for (int g = blockIdx.x * NWAVE + wave; g < NTOK; g += gridDim.x * NWAVE) {
    const int b = g / TOK, t = g - b * TOK;
    const bool isctx = t >= SEQ;
    if (isctx && skip_ctx) continue;
    const float* src = isctx ? xc + ((size_t)b * CTX + (t - SEQ)) * 1024 : xl + ((size_t)b * SEQ + t) * 1024;
    const float* mod = mods_l + (size_t)(isctx ? 16 : b) * 6144;
    float4 v[4];
    float ss = 0.f;
#pragma unroll
    for (int i = 0; i < 4; ++i) {
      v[i] = *(const float4*)(src + i * 256 + lane * 4);
      ss += v[i].x * v[i].x + v[i].y * v[i].y + v[i].z * v[i].z + v[i].w * v[i].w;
    }
    ss = wave_sum(ss);
    const float rstd = rsqrtf(ss * (1.f / 1024.f) + EPS);
#pragma unroll
    for (int i = 0; i < 4; ++i) {
      const int col = i * 256 + lane * 4;
      const float4 gg = *(const float4*)(gam + col);
      const float4 sc = *(const float4*)(mod + sc_off + col);
      const float4 sh = *(const float4*)(mod + sh_off + col);
      h4 o;
      o[0] = (half_t)(v[i].x * rstd * gg.x * (1.f + sc.x) + sh.x);
      o[1] = (half_t)(v[i].y * rstd * gg.y * (1.f + sc.y) + sh.y);
      o[2] = (half_t)(v[i].z * rstd * gg.z * (1.f + sc.z) + sh.z);
      o[3] = (half_t)(v[i].w * rstd * gg.w * (1.f + sc.w) + sh.w);
      *(h4*)(h + (size_t)g * 1024 + col) = o;
    }
  }
}

constexpr int BK = 64, HALF = 128, HTB = HALF * BK * 2;
DI int lds_byte(int r, int c) { const int st = (r >> 4) * 2 + (c >> 5), rr = r & 15, cc = c & 31, ob = rr * 64 + cc * 2; return st * 1024 + (ob ^ (((ob >> 9) & 1) << 5)); }
DI void stage_rc(int b, int& R, int& C) { const int st = b / 1024, sb = b % 1024, swz = sb ^ (((sb >> 9) & 1) << 5); R = (st >> 1) * 16 + swz / 64; C = (st & 1) * 32 + (swz % 64) / 2; }
DI int perm32(int rho) { const int n = rho >> 4, i = rho & 15; return 8 * (i >> 2) + 4 * n + (i & 3); }

struct GUnit { const char* A; const char* B; int nt, pm, pn, aux; };

DI bool tile_map(int L, int nM, int nN, int& pm, int& pn) {
  const int nwg = nM * nN;
  if (L >= nwg) return false;
  int wgid = L;
  { const int q = nwg / 8, r = nwg % 8, xcd = wgid % 8, off = wgid / 8; wgid = (xcd < r ? xcd * (q + 1) : r * (q + 1) + (xcd - r) * q) + off; }
  const int nig = 8 * nN, gid = wgid / nig, fm = gid * 8, gsz = (nM - fm) < 8 ? (nM - fm) : 8;
  pm = fm + ((wgid % nig) % gsz); pn = (wgid % nig) / gsz;
  return true;
}

template <bool PERM, class Sched, class Epi>
DI void gemm256(LAS unsigned char* lds, const Sched& S, const Epi& E) {
  const int tid = tid_opaque(), wid = __builtin_amdgcn_readfirstlane(tid >> 6), lane = tid & 63, wr = wid >> 2, wc = wid & 3, fr = lane & 15, fq = lane >> 4;
  unsigned cvA0, cvA1, cvB0, cvB1;
  { int R, C;
    stage_rc(tid * 16, R, C); cvA0 = (unsigned)R * S.lda2 + C * 2; cvB0 = (unsigned)(PERM ? ((R & ~31) + perm32(R & 31)) : R) * S.ldb2 + C * 2;
    stage_rc(tid * 16 + 8192, R, C); cvA1 = (unsigned)R * S.lda2 + C * 2; cvB1 = (unsigned)(PERM ? ((R & ~31) + perm32(R & 31)) : R) * S.ldb2 + C * 2; }
  const size_t chA = (size_t)HALF * S.lda2, chB = (size_t)HALF * S.ldb2;
  const size_t kstep = (size_t)(BK * 2);
  const unsigned ldsw = (unsigned)wid * 1024u;
  const int aoff = lds_byte(wr * 64 + fr, fq * 8), boff = lds_byte(wc * 32 + fr, fq * 8);
#define G_SA(b, h) (((b) * 2 + (h)) * HTB)
#define G_SB(b, h) ((4 + (b) * 2 + (h)) * HTB)
#define G_STAGE(bufoff, gbase, v0, v1) do { \
    __builtin_amdgcn_global_load_lds((const unsigned*)((const char*)(gbase) + (v0)), (LAS unsigned*)(lds + (bufoff) + ldsw), 16, 0, 0); \
    __builtin_amdgcn_global_load_lds((const unsigned*)((const char*)(gbase) + (v1)), (LAS unsigned*)(lds + (bufoff) + ldsw + 8192), 16, 0, 0); } while (0)
#define G_LDA(dst, b, h) do { _Pragma("unroll") for (int m = 0; m < 4; ++m) _Pragma("unroll") for (int k = 0; k < 2; ++k) dst[m][k] = *(const LAS h8*)(lds + G_SA(b, h) + aoff + m * 2048 + k * 1024); } while (0)
#define G_LDB(dst, b, h) do { _Pragma("unroll") for (int n = 0; n < 2; ++n) _Pragma("unroll") for (int k = 0; k < 2; ++k) dst[n][k] = *(const LAS h8*)(lds + G_SB(b, h) + boff + n * 2048 + k * 1024); } while (0)
#define G_MMA(ai, bj, At, Bt) do { __builtin_amdgcn_s_setprio(1); _Pragma("unroll") for (int m = 0; m < 4; ++m) _Pragma("unroll") for (int n = 0; n < 2; ++n) _Pragma("unroll") for (int k = 0; k < 2; ++k) \
    acc[ai][bj][m][n] = __builtin_amdgcn_mfma_f32_16x16x32_f16(Bt[n][k], At[m][k], acc[ai][bj][m][n], 0, 0, 0); __builtin_amdgcn_s_setprio(0); } while (0)
#define G_WAIT_V(n) asm volatile("s_waitcnt vmcnt(" #n ")" ::: "memory")
#define G_WAIT_L(n) asm volatile("s_waitcnt lgkmcnt(" #n ")" ::: "memory")
#define G_BAR __builtin_amdgcn_s_barrier()
#define G_SCHED __builtin_amdgcn_sched_barrier(0)
  GUnit cur, nxt;
  int ui = 0;
  if (!S.next(0, cur)) return;
  f4 acc[2][2][4][2];
#pragma unroll
  for (int a = 0; a < 2; ++a)
#pragma unroll
    for (int b = 0; b < 2; ++b)
#pragma unroll
      for (int m = 0; m < 4; ++m)
#pragma unroll
        for (int n = 0; n < 2; ++n) acc[a][b][m][n] = f4{0.f, 0.f, 0.f, 0.f};
  h8 At[4][2], B0[2][2], B1[2][2];
  const char* cA = cur.A;
  const char* cB = cur.B;
  G_STAGE(G_SB(0, 0), cB, cvB0, cvB1); G_STAGE(G_SA(0, 0), cA, cvA0, cvA1); G_STAGE(G_SB(0, 1), cB + chB, cvB0, cvB1); G_STAGE(G_SA(0, 1), cA + chA, cvA0, cvA1);
  if (wr == 1) G_BAR;
  G_WAIT_V(4); G_BAR;
  G_STAGE(G_SB(1, 0), cB + kstep, cvB0, cvB1); G_STAGE(G_SA(1, 0), cA + kstep, cvA0, cvA1); G_STAGE(G_SB(1, 1), cB + chB + kstep, cvB0, cvB1);
  G_WAIT_V(6); G_BAR;
  for (;;) {
    const bool has_next = S.next(ui + 1, nxt);
    const char* nA = has_next ? nxt.A : cA;
    const char* nB = has_next ? nxt.B : cB;
    int nt = cur.nt;
    asm volatile("" : "+s"(nt));
    for (int t = 0; t < nt; t += 2) {
      const bool last = (t == nt - 2);
      const char* a1 = cA + (size_t)(t + 1) * kstep;
      const char* a2 = last ? nA : cA + (size_t)(t + 2) * kstep;
      const char* b2 = last ? nB : cB + (size_t)(t + 2) * kstep;
      const char* a3 = a2 + kstep;
      const char* b3 = b2 + kstep;
      G_LDB(B0, 0, 0); G_SCHED; G_LDA(At, 0, 0); G_STAGE(G_SA(1, 1), a1 + chA, cvA0, cvA1);
      G_WAIT_L(8); G_BAR; G_WAIT_L(0); G_MMA(0, 0, At, B0); G_BAR; G_SCHED;
      G_LDB(B1, 0, 1); G_STAGE(G_SB(0, 0), b2, cvB0, cvB1);
      G_BAR; G_WAIT_L(0); G_MMA(0, 1, At, B1); G_BAR;
      G_LDA(At, 0, 1); G_STAGE(G_SA(0, 0), a2, cvA0, cvA1);
      G_BAR; G_WAIT_L(0); G_MMA(1, 0, At, B0); G_BAR; G_SCHED;
      G_STAGE(G_SB(0, 1), b2 + chB, cvB0, cvB1);
      G_WAIT_V(6); G_BAR; G_MMA(1, 1, At, B1); G_BAR;
      G_LDB(B0, 1, 0); G_SCHED; G_LDA(At, 1, 0); G_STAGE(G_SA(0, 1), a2 + chA, cvA0, cvA1);
      G_WAIT_L(8); G_BAR; G_WAIT_L(0); G_MMA(0, 0, At, B0); G_BAR; G_SCHED;
      G_LDB(B1, 1, 1); G_STAGE(G_SB(1, 0), b3, cvB0, cvB1);
      G_BAR; G_WAIT_L(0); G_MMA(0, 1, At, B1); G_BAR;
      G_LDA(At, 1, 1); G_STAGE(G_SA(1, 0), a3, cvA0, cvA1);
      G_BAR; G_WAIT_L(0); G_MMA(1, 0, At, B0); G_BAR; G_SCHED;
      G_STAGE(G_SB(1, 1), b3 + chB, cvB0, cvB1);
      G_WAIT_V(6); G_BAR; G_MMA(1, 1, At, B1); G_BAR;
    }
    E(acc, cur, wr, wc, fr, fq);
    if (!has_next) break;
#pragma unroll
    for (int a = 0; a < 2; ++a)
#pragma unroll
      for (int b = 0; b < 2; ++b)
#pragma unroll
        for (int m = 0; m < 4; ++m)
#pragma unroll
          for (int n = 0; n < 2; ++n) acc[a][b][m][n] = f4{0.f, 0.f, 0.f, 0.f};
    cur = nxt; cA = nA; cB = nB; ++ui;
  }
  G_WAIT_V(0);
  if (wr == 0) G_BAR;
  G_BAR;
#undef G_SA
#undef G_SB
#undef G_STAGE
#undef G_LDA
#undef G_LDB
#undef G_MMA
#undef G_WAIT_V
#undef G_WAIT_L
#undef G_BAR
#undef G_SCHED
}

DI h8 pack8(const f4& a, const f4& b) {
  h8 o;
  o[0] = (half_t)a[0]; o[1] = (half_t)a[1]; o[2] = (half_t)a[2]; o[3] = (half_t)a[3];
  o[4] = (half_t)b[0]; o[5] = (half_t)b[1]; o[6] = (half_t)b[2]; o[7] = (half_t)b[3];
  return o;
}
DI int row0_of(int pm, bool skip_ctx) { return skip_ctx ? (pm >> 3) * TOK + (pm & 7) * 256 : pm * 256; }

struct SchedInproj {
  const half_t* hbuf; const half_t* Wl; int G, c;
  static constexpr unsigned lda2 = 2048, ldb2 = 2048;
  DI bool next(int i, GUnit& u) const {
    const int L = i * G + c;
    u.nt = 16;
    if (L < 144 * 8) {
      tile_map(L, 144, 8, u.pm, u.pn);
      u.A = (const char*)(hbuf + (size_t)u.pm * 256 * 1024); u.B = (const char*)(Wl + W_QK + (size_t)u.pn * 256 * 1024); u.aux = 0;
      return true;
    }
    if (!tile_map(L - 144 * 8, 3, 144, u.pm, u.pn)) return false;
    u.A = (const char*)(Wl + W_V + (size_t)u.pm * 256 * 1024); u.B = (const char*)(hbuf + (size_t)u.pn * 256 * 1024); u.aux = 1;
    return true;
  }
};
struct EpiInproj {
  half_t* big;
  DI void operator()(const f4 (&acc)[2][2][4][2], const GUnit& u, int wr, int wc, int fr, int fq) const {
    if (u.aux == 0) {
      const int g0 = u.pm * 256, b = g0 / TOK, t0 = g0 - b * TOK + wr * 64;
#pragma unroll
      for (int bj = 0; bj < 2; ++bj) {
        const int cb = u.pn * 256 + bj * 128 + wc * 32;
        half_t* ptr; int ts;
        if (cb < 576) { ptr = big + B_ZMLA + (size_t)b * TOK * ZS + cb; ts = ZS; }
        else if (cb < 1088) { const int c = cb - 576, part = c >> 8, hh = (c >> 6) & 3; ptr = big + (part ? B_KNA : B_QNA) + (size_t)(b * 4 + hh) * TOK * 64 + (c & 63); ts = 64; }
        else if (cb < 1600) { const int c = cb - 1088, part = c >> 8, hm = (c >> 5) & 7; ptr = big + (part ? B_KDF : B_QDF) + (size_t)(b * 8 + hm) * TOK * 32; ts = 32; }
        else if (cb < 1856) { const int c = cb - 1600; ptr = big + B_QG + (size_t)(b * 4 + (c >> 6)) * TOK * 64 + (c & 63); ts = 64; }
        else if (cb < 1984) { const int c = cb - 1856; ptr = big + B_KG + (size_t)(b * 2 + (c >> 6)) * TOK * 64 + (c & 63); ts = 64; }
        else continue;
        const unsigned lo = (unsigned)(fr * ts + 8 * fq) * 2u;
        char* rb = (char*)(ptr + (size_t)t0 * ts);
#pragma unroll
        for (int ai = 0; ai < 2; ++ai)
#pragma unroll
          for (int m = 0; m < 4; ++m)
            *(h8*)(rb + (size_t)((ai * 128 + m * 16) * ts) * 2 + lo) = pack8(acc[ai][bj][m][0], acc[ai][bj][m][1]);
      }
    } else {
      const int g0 = u.pn * 256, b = g0 / TOK, t0 = g0 - b * TOK;
      const int nh = (u.pm == 2) ? 2 : 4;
      char* vt = (char*)(big + (u.pm == 0 ? B_VTNA : (u.pm == 1 ? B_VTDF : B_VTG)) + (size_t)b * nh * 64 * TOK + (size_t)(wr * 64) * TOK + t0 + wc * 32);
      const unsigned lo = (unsigned)(fr * TOK + 8 * fq) * 2u;
#pragma unroll
      for (int ai = 0; ai < 2; ++ai) {
        if (u.pm == 2 && ai == 1) continue;
#pragma unroll
        for (int m = 0; m < 4; ++m)
#pragma unroll
          for (int bj = 0; bj < 2; ++bj)
            *(h8*)(vt + ((size_t)(ai * 128 + m * 16) * TOK + bj * 128) * 2 + lo) = pack8(acc[ai][bj][m][0], acc[ai][bj][m][1]);
      }
    }
  }
};

struct SchedMlaQK {
  const half_t* Wl; const half_t* zmla; int G, c;
  static constexpr unsigned lda2 = ZS * 2, ldb2 = 512;
  DI bool next(int i, GUnit& u) const {
    const int L = i * G + c;
    u.nt = 4;
    if (L < 288) {
      tile_map(L, 144, 2, u.pm, u.pn);
      u.A = (const char*)(zmla + (size_t)u.pm * 256 * ZS);
      u.B = (const char*)(Wl + W_UQ + (size_t)u.pn * 256 * 256); u.aux = 0;
      return true;
    }
    if (L < 432) {
      u.pm = L - 288; u.pn = 0;
      u.A = (const char*)(zmla + 256 + (size_t)u.pm * 256 * ZS);
      u.B = (const char*)(Wl + W_UK); u.aux = 1;
      return true;
    }
    return false;
  }
};
struct SchedMlaV {
  const half_t* Wl; const half_t* zmla; int G, c;
  static constexpr unsigned lda2 = 512, ldb2 = ZS * 2;
  DI bool next(int i, GUnit& u) const {
    const int L = i * G + c;
    if (L >= 144) return false;
    u.nt = 4; u.pm = 0; u.pn = L;
    u.A = (const char*)(Wl + W_UV);
    u.B = (const char*)(zmla + 256 + (size_t)u.pn * 256 * ZS); u.aux = 2;
    return true;
  }
};
struct EpiMla {
  half_t* big;
  DI void operator()(const f4 (&acc)[2][2][4][2], const GUnit& u, int wr, int wc, int fr, int fq) const {
    if (u.aux < 2) {
      const int g0 = u.pm * 256, b = g0 / TOK, t0 = g0 - b * TOK + wr * 64;
      const unsigned lo = (unsigned)(fr * 96 + 8 * fq) * 2u;
#pragma unroll
      for (int bj = 0; bj < 2; ++bj) {
        const int cb = u.pn * 256 + bj * 128 + wc * 32;
        half_t* ptr;
        if (u.aux == 0) {
          if (cb >= 384) continue;
          const int hh = cb / 96, dd = cb - hh * 96;
          ptr = big + B_QM + (size_t)(b * 4 + hh) * TOK * 96 + dd;
        } else {
          ptr = big + B_KM + (size_t)(b * 4 + (cb >> 6)) * TOK * 96 + (cb & 63);
        }
        char* rb = (char*)(ptr + (size_t)t0 * 96);
#pragma unroll
        for (int ai = 0; ai < 2; ++ai)
#pragma unroll
          for (int m = 0; m < 4; ++m)
            *(h8*)(rb + (size_t)((ai * 128 + m * 16) * 96) * 2 + lo) = pack8(acc[ai][bj][m][0], acc[ai][bj][m][1]);
      }
    } else {
      const int g0 = u.pn * 256, b = g0 / TOK, t0 = g0 - b * TOK;
      char* vt = (char*)(big + B_VTM + (size_t)b * 4 * 64 * TOK + (size_t)(wr * 64) * TOK + t0 + wc * 32);
      const unsigned lo = (unsigned)(fr * TOK + 8 * fq) * 2u;
#pragma unroll
      for (int ai = 0; ai < 2; ++ai)
#pragma unroll
        for (int m = 0; m < 4; ++m)
#pragma unroll
          for (int bj = 0; bj < 2; ++bj)
            *(h8*)(vt + ((size_t)(ai * 128 + m * 16) * TOK + bj * 128) * 2 + lo) = pack8(acc[ai][bj][m][0], acc[ai][bj][m][1]);
    }
  }
};

struct SchedRows {
  const half_t* A; const half_t* B; int K, nM, nN, G, c; bool skip_ctx; unsigned lda2, ldb2;
  DI bool next(int i, GUnit& u) const {
    if (!tile_map(i * G + c, nM, nN, u.pm, u.pn)) return false;
    u.A = (const char*)(A + (size_t)row0_of(u.pm, skip_ctx) * K); u.B = (const char*)(B + (size_t)u.pn * 256 * K);
    u.nt = K >> 6; u.aux = 0;
    return true;
  }
};
struct EpiResid {
  const float* xl_src; const float* xc_src; float* xl_dst; float* xc_dst; const float* mods_l; int gt_off; bool skip_ctx;
  DI void operator()(const f4 (&acc)[2][2][4][2], const GUnit& u, int wr, int wc, int fr, int fq) const {
    const int g0 = row0_of(u.pm, skip_ctx), b = g0 / TOK, t0 = g0 - b * TOK;
    const bool isctx = t0 >= SEQ;
    const int col0 = u.pn * 256 + wc * 32;
    const size_t rowoff = (size_t)(wr * 64) * 1024 + col0;
    const char* src = (const char*)((isctx ? xc_src + ((size_t)b * CTX + (t0 - SEQ)) * 1024 : xl_src + ((size_t)b * SEQ + t0) * 1024) + rowoff);
    char* dst = (char*)((isctx ? xc_dst + ((size_t)b * CTX + (t0 - SEQ)) * 1024 : xl_dst + ((size_t)b * SEQ + t0) * 1024) + rowoff);
    const char* gt = (const char*)(mods_l + (size_t)(isctx ? 16 : b) * 6144 + gt_off + col0);
    const unsigned lo = (unsigned)(fr * 1024 + 4 * fq) * 4u, glo = (unsigned)(4 * fq) * 4u;
    f4 gv[2][2];
#pragma unroll
    for (int bj = 0; bj < 2; ++bj)
#pragma unroll
      for (int n = 0; n < 2; ++n) gv[bj][n] = *(const f4*)(gt + (bj * 128 + n * 16) * 4 + glo);
#pragma unroll
    for (int ai = 0; ai < 2; ++ai)
#pragma unroll
      for (int m = 0; m < 4; ++m)
#pragma unroll
        for (int bj = 0; bj < 2; ++bj)
#pragma unroll
          for (int n = 0; n < 2; ++n) {
            const size_t uo = ((size_t)(ai * 128 + m * 16) * 1024 + bj * 128 + n * 16) * 4;
            const f4 xv = *(const f4*)(src + uo + lo);
            *(f4*)(dst + uo + lo) = xv + gv[bj][n] * acc[ai][bj][m][n];
          }
  }
};
struct EpiUp {
  half_t* ubuf; bool skip_ctx;
  DI void operator()(const f4 (&acc)[2][2][4][2], const GUnit& u, int wr, int wc, int fr, int fq) const {
    const int g0 = row0_of(u.pm, skip_ctx);
    char* rb = (char*)(ubuf + (size_t)(g0 + wr * 64) * 4096 + u.pn * 256 + wc * 32);
    const unsigned lo = (unsigned)(fr * 4096 + 8 * fq) * 2u;
#pragma unroll
    for (int ai = 0; ai < 2; ++ai)
#pragma unroll
      for (int m = 0; m < 4; ++m)
#pragma unroll
        for (int bj = 0; bj < 2; ++bj) {
          f4 a = acc[ai][bj][m][0], c = acc[ai][bj][m][1];
#pragma unroll
          for (int j = 0; j < 4; ++j) { a[j] = fmaxf(a[j], 0.f); a[j] *= a[j]; c[j] = fmaxf(c[j], 0.f); c[j] *= c[j]; }
          *(h8*)(rb + ((size_t)(ai * 128 + m * 16) * 4096 + bj * 128) * 2 + lo) = pack8(a, c);
        }
  }
};

template <int DLEN, int LPR, int ROPE, bool KR>
DI void norm_rows(half_t* base, int stride, int nrows, const float* gain, float oscale, const half_t* zmla) {
  const int tid_ = tid_opaque();
  const int lane = tid_ & 63, wave = tid_ >> 6;
  constexpr int RPW = 64 / LPR;
  const int s = lane % LPR, sub = lane / LPR;
  const bool active = s * 8 < DLEN;
  float gn[8];
#pragma unroll
  for (int i = 0; i < 8; ++i) gn[i] = active ? gain[s * 8 + i] : 0.f;
  for (int r0 = (blockIdx.x * NWAVE + wave) * RPW; r0 < nrows; r0 += gridDim.x * NWAVE * RPW) {
    const int rho = r0 + sub;
    const int t = rho % TOK;
    half_t* ptr = base + (size_t)rho * stride + s * 8;
    const half_t* src = ptr;
    if (KR && s >= 8) {
      const int b = rho / (4 * TOK);
      src = zmla + ((size_t)b * TOK + t) * ZS + 512 + (s - 8) * 8;
    }
    float f[8];
    float ss = 0.f;
    if (active) {
      const h8 v = *(const h8*)src;
#pragma unroll
      for (int i = 0; i < 8; ++i) { f[i] = (float)v[i]; ss += f[i] * f[i]; }
    } else {
#pragma unroll
      for (int i = 0; i < 8; ++i) f[i] = 0.f;
    }
#pragma unroll
    for (int o = LPR / 2; o > 0; o >>= 1) ss += __shfl_xor(ss, o);
    const float rstd = rsqrtf(ss * (1.f / DLEN) + EPS);
#pragma unroll
    for (int i = 0; i < 8; ++i) f[i] = f[i] * rstd * gn[i];
    if (ROPE != 0) {
      constexpr int PX = (ROPE == 64) ? 2 : 1;
      float pf[8];
#pragma unroll
      for (int i = 0; i < 8; ++i) pf[i] = __shfl_xor(f[i], PX);
      constexpr int RB = (DLEN - ROPE) / 8;
      if (t < SEQ && s >= RB && active) {
        const int sr = s - RB;
        const int q = (ROPE == 64) ? (sr >> 1) : sr;
        const float pos = (float)((q < 2) ? (t >> 6) : (t & 63));
        const float sgn = (q & 1) ? 1.f : -1.f;
#pragma unroll
        for (int i = 0; i < 8; ++i) {
          const int idx = (ROPE == 64) ? ((sr & 1) * 8 + i) : i;
          constexpr float NF = (ROPE == 64) ? 16.f : 8.f;
          const float invf = exp2f(-(float)idx * (13.287712379549449f / NF));
          const float ang = pos * invf;
          float sn, cs;
          sincosf(ang, &sn, &cs);
          f[i] = f[i] * cs + sgn * pf[i] * sn;
        }
      }
    }
    if (active) {
      h8 o;
#pragma unroll
      for (int i = 0; i < 8; ++i) o[i] = (half_t)(f[i] * oscale);
      *(h8*)ptr = o;
    }
  }
}

template <int DQ, bool NA, int NQG>
DI void attn_core(const half_t* Qp, const half_t* Kp, const half_t* Vp, int q0, int seg0_start, int seg0_tiles,
                  int seg1_start, int seg1_tiles, const float* rpb_h, int rq, f16v (&O)[2][NQG]) {
  constexpr int NKS = DQ / 16;
  const int lane = tid_opaque() & 63, r = lane & 31, h = lane >> 5;
  h8 qf[NQG][NKS];
#pragma unroll
  for (int qg = 0; qg < NQG; ++qg)
#pragma unroll
    for (int ks = 0; ks < NKS; ++ks) qf[qg][ks] = *(const h8*)(Qp + (size_t)(q0 + qg * 32 + r) * DQ + ks * 16 + h * 8);
  float mrun[NQG], lrun[NQG];
#pragma unroll
  for (int qg = 0; qg < NQG; ++qg) { mrun[qg] = -1e30f; lrun[qg] = 0.f; }
#pragma unroll
  for (int a = 0; a < 2; ++a)
#pragma unroll
    for (int c = 0; c < NQG; ++c)
#pragma unroll
      for (int i = 0; i < 16; ++i) O[a][c][i] = 0.f;
  const int ntiles = seg0_tiles + seg1_tiles;
  const half_t* kbase = Kp + (size_t)r * DQ + h * 8;
  const half_t* vbase = Vp + (size_t)r * TOK + h * 4;
  h8 kf[NKS];
  h4 vf[2][2][2];
  {
    const int k0 = (0 < seg0_tiles) ? seg0_start : seg1_start;
#pragma unroll
    for (int ks = 0; ks < NKS; ++ks) kf[ks] = *(const h8*)(kbase + (size_t)k0 * DQ + ks * 16);
#pragma unroll
    for (int dvt = 0; dvt < 2; ++dvt)
#pragma unroll
      for (int s = 0; s < 2; ++s)
#pragma unroll
        for (int hf = 0; hf < 2; ++hf) vf[dvt][s][hf] = *(const h4*)(vbase + (size_t)(dvt * 32) * TOK + k0 + s * 16 + hf * 8);
  }
  for (int it = 0; it < ntiles; ++it) {
    const int k0 = (it < seg0_tiles) ? seg0_start + it * 32 : seg1_start + (it - seg0_tiles) * 32;
    const int itn = (it + 1 < ntiles) ? it + 1 : it;
    const int k1 = (itn < seg0_tiles) ? seg0_start + itn * 32 : seg1_start + (itn - seg0_tiles) * 32;
    f16v S[NQG];
#pragma unroll
    for (int qg = 0; qg < NQG; ++qg) {
#pragma unroll
      for (int i = 0; i < 16; ++i) S[qg][i] = 0.f;
#pragma unroll
      for (int ks = 0; ks < NKS; ++ks) S[qg] = __builtin_amdgcn_mfma_f32_32x32x16_f16(kf[ks], qf[qg][ks], S[qg], 0, 0, 0);
    }
#pragma unroll
    for (int ks = 0; ks < NKS; ++ks) kf[ks] = *(const h8*)(kbase + (size_t)k1 * DQ + ks * 16);
    if (NA && it < seg0_tiles) {
      const int krow = k0 >> 6, cb = k0 & 63;
      const int dr = krow - rq + 7;
#pragma unroll
      for (int qg = 0; qg < NQG; ++qg) {
        const int qc = qg * 32 + r;
        const int cs = min(max(qc - 8, 0), 48);
#pragma unroll
        for (int i = 0; i < 16; ++i) {
          const int c = cb + (i & 3) + 8 * (i >> 2) + 4 * h;
          const bool valid = (c >= cs) && (c < cs + 16);
          float bias = 0.f;
          if (valid) bias = rpb_h[dr * 31 + (c - qc + 15)] * LOG2E;
          S[qg][i] = valid ? S[qg][i] + bias : -1e30f;
        }
      }
    }
#pragma unroll
    for (int qg = 0; qg < NQG; ++qg) {
      h8 P[2];
      float mx = S[qg][0];
#pragma unroll
      for (int i = 1; i < 16; ++i) mx = fmaxf(mx, S[qg][i]);
      mx = fmaxf(mx, __shfl_xor(mx, 32));
      const float mn = fmaxf(mrun[qg], mx);
      const float alpha = __builtin_amdgcn_exp2f(mrun[qg] - mn);
      mrun[qg] = mn;
      float rs = 0.f;
#pragma unroll
      for (int i = 0; i < 16; ++i) {
        float pv = __builtin_amdgcn_exp2f(S[qg][i] - mn);
        if (NA) pv = (S[qg][i] <= -1e29f) ? 0.f : pv;
        rs += pv;
        P[i >> 3][i & 7] = (half_t)pv;
      }
      lrun[qg] = lrun[qg] * alpha + rs;
#pragma unroll
      for (int dvt = 0; dvt < 2; ++dvt) {
#pragma unroll
        for (int i = 0; i < 16; ++i) O[dvt][qg][i] *= alpha;
#pragma unroll
        for (int s = 0; s < 2; ++s) {
          const h8 va = __builtin_shufflevector(vf[dvt][s][0], vf[dvt][s][1], 0, 1, 2, 3, 4, 5, 6, 7);
          O[dvt][qg] = __builtin_amdgcn_mfma_f32_32x32x16_f16(va, P[s], O[dvt][qg], 0, 0, 0);
        }
      }
    }
#pragma unroll
    for (int dvt = 0; dvt < 2; ++dvt)
#pragma unroll
      for (int s = 0; s < 2; ++s)
#pragma unroll
        for (int hf = 0; hf < 2; ++hf) vf[dvt][s][hf] = *(const h4*)(vbase + (size_t)(dvt * 32) * TOK + k1 + s * 16 + hf * 8);
  }
#pragma unroll
  for (int qg = 0; qg < NQG; ++qg) {
    const float lt = lrun[qg] + __shfl_xor(lrun[qg], 32);
    const float inv = 1.f / lt;
#pragma unroll
    for (int dvt = 0; dvt < 2; ++dvt)
#pragma unroll
      for (int i = 0; i < 16; ++i) O[dvt][qg][i] *= inv;
  }
}

template <int NQG>
DI void store_o(const f16v (&O)[2][NQG], half_t* orow0  ) {
  const int lane = tid_opaque() & 63, r = lane & 31, h = lane >> 5;
#pragma unroll
  for (int qg = 0; qg < NQG; ++qg)
#pragma unroll
    for (int dvt = 0; dvt < 2; ++dvt)
#pragma unroll
      for (int c = 0; c < 4; ++c) {
        h4 o;
#pragma unroll
        for (int j = 0; j < 4; ++j) o[j] = (half_t)O[dvt][qg][4 * c + j];
        *(h4*)(orow0 + (size_t)(qg * 32 + r) * 1024 + dvt * 32 + 8 * c + 4 * h) = o;
      }
}

DI void phase_attn(const Params& p, int l, half_t* big, bool need_ctx, char* smem) {
  const int tid_ = tid_opaque();
  const int lane = tid_ & 63, wave = __builtin_amdgcn_readfirstlane(tid_ >> 6), h = lane >> 5;
  const int grp = wave >> 2, wv = wave & 3;
  const int NQB = need_ctx ? 9 : 8;
  const int nitems = 16 * 16 * NQB;
  half_t* obuf = big + B_O;
  const float lam_init = 0.8f - 0.6f * expf(-0.3f * (float)l);
  float lam;
  {
    float d1 = 0.f, d2 = 0.f;
#pragma unroll 1
    for (int i = 0; i < 32; ++i) {
      d1 += p.lq1[l * 32 + i] * p.lk1[l * 32 + i];
      d2 += p.lq2[l * 32 + i] * p.lk2[l * 32 + i];
    }
    lam = expf(d1) - expf(d2) + lam_init;
    lam = __builtin_bit_cast(float, __builtin_amdgcn_readfirstlane(__builtin_bit_cast(int, lam)));
  }
  const float one_m_li = __builtin_bit_cast(float, __builtin_amdgcn_readfirstlane(__builtin_bit_cast(int, 1.f - lam_init)));
  for (int item = blockIdx.x * 2 + grp; item < nitems; item += gridDim.x * 2) {
    const int hi = item / (16 * NQB);
    const int rem = item - hi * 16 * NQB;
    const int b = rem / NQB, qb = rem - b * NQB;
    const int q0 = qb * 256 + wv * 64;
    const bool qctx = qb == 8;
    const int mixer = hi >> 2, hh = hi & 3;
    const int s0 = qctx ? SEQ : 0, n0t = qctx ? 8 : 72;
    f16v O[2][2];
    half_t* orow = obuf + (size_t)(b * TOK + q0) * 1024 + hh * 64;
    if (mixer == 0) {
      float* stash = (float*)smem + wave * 4096;
      attn_core<32, false, 2>(big + B_QDF + (size_t)(b * 8 + hh * 2) * TOK * 32, big + B_KDF + (size_t)(b * 8 + hh * 2) * TOK * 32,
                              big + B_VTDF + (size_t)(b * 4 + hh) * 64 * TOK, q0, s0, n0t, 0, 0, nullptr, 0, O);
#pragma unroll
      for (int dvt = 0; dvt < 2; ++dvt)
#pragma unroll
        for (int qg = 0; qg < 2; ++qg)
#pragma unroll
          for (int i = 0; i < 16; ++i) stash[((dvt * 2 + qg) * 16 + i) * 64 + lane] = O[dvt][qg][i];
      attn_core<32, false, 2>(big + B_QDF + (size_t)(b * 8 + hh * 2 + 1) * TOK * 32, big + B_KDF + (size_t)(b * 8 + hh * 2 + 1) * TOK * 32,
                              big + B_VTDF + (size_t)(b * 4 + hh) * 64 * TOK, q0, s0, n0t, 0, 0, nullptr, 0, O);
#pragma unroll
      for (int qg = 0; qg < 2; ++qg) {
        float ss = 0.f;
#pragma unroll
        for (int dvt = 0; dvt < 2; ++dvt)
#pragma unroll
          for (int i = 0; i < 16; ++i) {
            const float v = stash[((dvt * 2 + qg) * 16 + i) * 64 + lane] - lam * O[dvt][qg][i];
            O[dvt][qg][i] = v;
            ss += v * v;
          }
        ss += __shfl_xor(ss, 32);
        const float rstd = rsqrtf(ss * (1.f / 64.f) + EPS) * one_m_li;
#pragma unroll
        for (int dvt = 0; dvt < 2; ++dvt)
#pragma unroll
          for (int i = 0; i < 16; ++i) {
            const int dv = dvt * 32 + (i & 3) + 8 * (i >> 2) + 4 * h;
            O[dvt][qg][i] *= rstd * p.g_diff_sub[l * 64 + dv];
          }
      }
      store_o<2>(O, orow + 2 * 256);
    } else if (mixer == 1) {
      for (int ps = 0; ps < 2; ++ps) {
        f16v O1[2][1];
        attn_core<96, false, 1>(big + B_QM + (size_t)(b * 4 + hh) * TOK * 96, big + B_KM + (size_t)(b * 4 + hh) * TOK * 96,
                                big + B_VTM + (size_t)(b * 4 + hh) * 64 * TOK, q0 + ps * 32, s0, n0t, 0, 0, nullptr, 0, O1);
        store_o<1>(O1, orow + (size_t)(ps * 32) * 1024 + 0 * 256);
      }
    } else if (mixer == 2) {
      const int kv = hh >> 1;
      attn_core<64, false, 2>(big + B_QG + (size_t)(b * 4 + hh) * TOK * 64, big + B_KG + (size_t)(b * 2 + kv) * TOK * 64,
                              big + B_VTG + (size_t)(b * 2 + kv) * 64 * TOK, q0, s0, n0t, 0, 0, nullptr, 0, O);
      store_o<2>(O, orow + 3 * 256);
    } else {
      const int rq = q0 >> 6;
      const int r0 = min(max(rq - 4, 0), 24);
      const int seg0s = r0 * 64, seg0n = qctx ? 0 : 16;
      attn_core<64, true, 2>(big + B_QNA + (size_t)(b * 4 + hh) * TOK * 64, big + B_KNA + (size_t)(b * 4 + hh) * TOK * 64,
                             big + B_VTNA + (size_t)(b * 4 + hh) * 64 * TOK, q0, seg0s, seg0n, SEQ, 8,
                             p.na_rpb + (size_t)(l * 4 + hh) * 15 * 31, rq, O);
      store_o<2>(O, orow + 1 * 256);
    }
  }
}

struct SchedGate {
  const half_t* hbuf; const half_t* Wl; int pm0, cnt, G, c; bool skip_ctx;
  static constexpr unsigned lda2 = 2048, ldb2 = 2048;
  DI bool next(int i, GUnit& u) const {
    int pm, pn;
    if (!tile_map(i * G + c, cnt, 16, pm, pn)) return false;
    u.pm = pm0 + pm; u.pn = pn; u.nt = 16; u.aux = 0;
    u.A = (const char*)(hbuf + (size_t)row0_of(u.pm, skip_ctx) * 1024); u.B = (const char*)(Wl + W_GATE + (size_t)pn * 256 * 1024);
    return true;
  }
};
struct EpiGate {
  half_t* gb; int pm0;
  DI void operator()(const f4 (&acc)[2][2][4][2], const GUnit& u, int wr, int wc, int fr, int fq) const {
    char* rb = (char*)(gb + (size_t)((u.pm - pm0) * 256 + wr * 64) * 4096 + u.pn * 256 + wc * 32);
    const unsigned lo = (unsigned)(fr * 4096 + 8 * fq) * 2u;
#pragma unroll
    for (int ai = 0; ai < 2; ++ai)
#pragma unroll
      for (int m = 0; m < 4; ++m)
#pragma unroll
        for (int bj = 0; bj < 2; ++bj) {
          f4 a = acc[ai][bj][m][0], c = acc[ai][bj][m][1];
#pragma unroll
          for (int j = 0; j < 4; ++j) { a[j] = __builtin_amdgcn_rcpf(1.f + __expf(-a[j])); c[j] = __builtin_amdgcn_rcpf(1.f + __expf(-c[j])); }
          *(h8*)(rb + ((size_t)(ai * 128 + m * 16) * 4096 + bj * 128) * 2 + lo) = pack8(a, c);
        }
  }
};
struct SchedProj {
  const half_t* obuf; const half_t* Wl; int pm0, cnt, G, c; bool skip_ctx;
  static constexpr unsigned lda2 = 2048, ldb2 = 512;
  DI bool next(int i, GUnit& u) const {
    int pm, pn;
    if (!tile_map((i >> 2) * G + c, cnt, 4, pm, pn)) return false;
    const int br = i & 3;
    u.pm = pm0 + pm; u.pn = pn; u.nt = 4; u.aux = br;
    u.A = (const char*)(obuf + (size_t)row0_of(u.pm, skip_ctx) * 1024 + br * 256);
    u.B = (const char*)(Wl + W_BR + (size_t)(br * 1024 + pn * 256) * 256);
    return true;
  }
};
struct EpiProj {
  const half_t* gb; half_t* mbuf; int pm0; bool skip_ctx;
  DI void operator()(const f4 (&acc)[2][2][4][2], const GUnit& u, int wr, int wc, int fr, int fq) const {
    const int br = u.aux;
    const char* gp = (const char*)(gb + (size_t)((u.pm - pm0) * 256 + wr * 64) * 4096 + br * 1024 + u.pn * 256 + wc * 32);
    char* mp = (char*)(mbuf + (size_t)(row0_of(u.pm, skip_ctx) + wr * 64) * 1024 + u.pn * 256 + wc * 32);
    const unsigned glo = (unsigned)(fr * 4096 + 8 * fq) * 2u, mlo = (unsigned)(fr * 1024 + 8 * fq) * 2u;
#pragma unroll
    for (int ai = 0; ai < 2; ++ai)
#pragma unroll
      for (int m = 0; m < 4; ++m)
#pragma unroll
        for (int bj = 0; bj < 2; ++bj) {
          const h8 g = *(const h8*)(gp + ((size_t)(ai * 128 + m * 16) * 4096 + bj * 128) * 2 + glo);
          char* ma = mp + ((size_t)(ai * 128 + m * 16) * 1024 + bj * 128) * 2 + mlo;
          f4 a = acc[ai][bj][m][0], c = acc[ai][bj][m][1];
#pragma unroll
          for (int j = 0; j < 4; ++j) { a[j] *= (float)g[j]; c[j] *= (float)g[4 + j]; }
          if (br > 0) {
            const h8 pv = *(const h8*)ma;
#pragma unroll
            for (int j = 0; j < 4; ++j) { a[j] += (float)pv[j]; c[j] += (float)pv[4 + j]; }
          }
          *(h8*)ma = pack8(a, c);
        }
  }
};

__global__ void __launch_bounds__(NTHR) hybrid_block_megakernel(Params p) {
  __shared__ __attribute__((aligned(16))) char smem[SMEM_BYTES];
  char* ws = p.ws;
  if (ws == nullptr) cg::this_grid().sync();
  half_t* W = (half_t*)(ws + OFF_W);
  float* mods = (float*)(ws + OFF_MOD);
  float* xc = (float*)(ws + OFF_XC);
  half_t* hbuf = (half_t*)(ws + OFF_H);
  half_t* big = (half_t*)(ws + OFF_BIG);
  LAS unsigned char* lds = (LAS unsigned char*)smem;
  const int G = gridDim.x, cblk = blockIdx.x;

  volatile LAS unsigned* st = (volatile LAS unsigned*)(lds + GEMM_LDS);
  if (threadIdx.x < 4) st[threadIdx.x] = 0u;
  __syncthreads();
  xcd_barrier_post((unsigned*)(ws + OFF_BAR));

  phase_mods(p, mods, smem);
  {
    int base = 0;
    float* tile = (float*)smem;
    for (int l = 0; l < 2; ++l) {
      half_t* Wl = W + (size_t)l * W_LAYER;
      const float* win = p.w_in + (size_t)l * 1024 * 6496;
      tconv_job(win, 6496, 0, 1024, 1024, 192, 256, Wl + W_QK, base, tile);
      tconv_job(win, 6496, 192, 1024, 1024, 128, 256, Wl + W_QK + (size_t)256 * 1024, base, tile);
      tconv_job(win, 6496, 320, 1024, 1024, 32, 64, Wl + W_QK + (size_t)512 * 1024, base, tile);
      tconv_job(win, 6496, 352, 1024, 1024, 256, 256, Wl + W_QK + (size_t)576 * 1024, base, tile);
      tconv_job(win, 6496, 608, 1024, 1024, 256, 256, Wl + W_QK + (size_t)832 * 1024, base, tile);
      tconv_job(win, 6496, 1120, 1024, 1024, 256, 256, Wl + W_QK + (size_t)1088 * 1024, base, tile);
      tconv_job(win, 6496, 1376, 1024, 1024, 256, 256, Wl + W_QK + (size_t)1344 * 1024, base, tile);
      tconv_job(win, 6496, 1888, 1024, 1024, 256, 256, Wl + W_QK + (size_t)1600 * 1024, base, tile);
      tconv_job(win, 6496, 2144, 1024, 1024, 128, 192, Wl + W_QK + (size_t)1856 * 1024, base, tile);
      tconv_job(win, 6496, 864, 1024, 1024, 256, 256, Wl + W_V, base, tile);
      tconv_job(win, 6496, 1632, 1024, 1024, 256, 256, Wl + W_V + (size_t)256 * 1024, base, tile);
      tconv_job(win, 6496, 2272, 1024, 1024, 128, 256, Wl + W_V + (size_t)512 * 1024, base, tile);
      tconv_job(win, 6496, 2400, 1024, 1024, 4096, 4096, Wl + W_GATE, base, tile);
      for (int br = 0; br < 4; ++br)
        tconv_job(p.w_branch + ((size_t)l * 4 + br) * 256 * 1024, 1024, 0, 256, 256, 1024, 1024, Wl + W_BR + (size_t)br * 1024 * 256, base, tile);
      tconv_job(p.w_out + (size_t)l * 1024 * 1024, 1024, 0, 1024, 1024, 1024, 1024, Wl + W_OUT, base, tile);
      tconv_job(p.w_up + (size_t)l * 1024 * 4096, 4096, 0, 1024, 1024, 4096, 4096, Wl + W_UP, base, tile);
      tconv_job(p.w_down + (size_t)l * 4096 * 1024, 1024, 0, 4096, 4096, 1024, 1024, Wl + W_DOWN, base, tile);
      tconv_job(p.w_mla_uq + (size_t)l * 192 * 384, 384, 0, 256, 192, 384, 512, Wl + W_UQ, base, tile);
      for (int hh = 0; hh < 4; ++hh) {
        tconv_job(p.w_mla_ukv + (size_t)l * 128 * 512, 512, hh * 128, 256, 128, 64, 64, Wl + W_UK + (size_t)hh * 64 * 256, base, tile);
        tconv_job(p.w_mla_ukv + (size_t)l * 128 * 512, 512, hh * 128 + 64, 256, 128, 64, 64, Wl + W_UV + (size_t)hh * 64 * 256, base, tile);
      }
    }
  }
  xcd_barrier(ws, lds);

  for (int l = 0; l < 2; ++l) {
    const bool need_ctx = (l == 0);
    const bool skip_ctx = !need_ctx;
    const half_t* Wl = W + (size_t)l * W_LAYER;
    const float* mods_l = mods + (size_t)l * 17 * 6144;
    const float* xl_src = (l == 0) ? p.x : p.out;
    const float* xc_src = (l == 0) ? p.ctx : xc;
    const int nrt = skip_ctx ? 128 : 144;

    phase_norm(xl_src, xc_src, p.g_norm1 + l * 1024, mods_l, 0, 1024, hbuf, false);
    xcd_barrier(ws, lds);
    {
      SchedInproj S{hbuf, Wl, G, cblk};
      EpiInproj E{big};
      gemm256<true>(lds, S, E);
    }
    xcd_barrier(ws, lds);
    {
      half_t* zmla = big + B_ZMLA;
      norm_rows<192, 32, 0, false>(zmla, ZS, NTOK, p.g_mla_qa + l * 192, 1.f, nullptr);
      norm_rows<128, 16, 0, false>(zmla + 256, ZS, NTOK, p.g_mla_kva + l * 128, 1.f, nullptr);
      norm_rows<64, 8, 0, false>(big + B_QNA, 64, NTOK * 4, p.g_na_q + l * 64, 0.125f * LOG2E, nullptr);
      norm_rows<64, 8, 0, false>(big + B_KNA, 64, NTOK * 4, p.g_na_k + l * 64, 1.f, nullptr);
      norm_rows<32, 4, 32, false>(big + B_QDF, 32, NTOK * 8, p.g_diff_q + l * 32, 0.17677669529663687f * LOG2E, nullptr);
      norm_rows<32, 4, 32, false>(big + B_KDF, 32, NTOK * 8, p.g_diff_k + l * 32, 1.f, nullptr);
      norm_rows<64, 8, 64, false>(big + B_QG, 64, NTOK * 4, p.g_gqa_q + l * 64, 0.125f * LOG2E, nullptr);
      norm_rows<64, 8, 64, false>(big + B_KG, 64, NTOK * 2, p.g_gqa_k + l * 64, 1.f, nullptr);
    }
    xcd_barrier(ws, lds);
    {
      SchedMlaQK S{Wl, big + B_ZMLA, G, cblk};
      EpiMla E{big};
      gemm256<true>(lds, S, E);
      SchedMlaV S2{Wl, big + B_ZMLA, G, cblk};
      gemm256<true>(lds, S2, E);
    }
    xcd_barrier(ws, lds);
    norm_rows<96, 16, 32, false>(big + B_QM, 96, NTOK * 4, p.g_mla_q + l * 96, 0.10206207261596575f * LOG2E, nullptr);
    norm_rows<96, 16, 32, true>(big + B_KM, 96, NTOK * 4, p.g_mla_k + l * 96, 1.f, big + B_ZMLA);
    xcd_barrier(ws, lds);
    phase_attn(p, l, big, need_ctx, smem);
    xcd_barrier(ws, lds);
    {
      const int nsplit = need_ctx ? 3 : 4, cnt = nrt / nsplit;
      for (int j = 0; j <= nsplit; ++j) {
        if (j < nsplit) {
          SchedGate S{hbuf, Wl, j * cnt, cnt, G, cblk, skip_ctx};
          EpiGate E{big + ((j & 1) ? B_G1 : B_G0), j * cnt};
          gemm256<true>(lds, S, E);
        }
        if (j > 0) {
          SchedProj S{big + B_O, Wl, (j - 1) * cnt, cnt, G, cblk, skip_ctx};
          EpiProj E{big + (((j - 1) & 1) ? B_G1 : B_G0), big + B_M, (j - 1) * cnt, skip_ctx};
          gemm256<true>(lds, S, E);
        }
        xcd_barrier(ws, lds);
      }
    }
    {
      SchedRows S{big + B_M, Wl + W_OUT, 1024, nrt, 4, G, cblk, skip_ctx, 2048u, 2048u};
      EpiResid E{xl_src, xc_src, p.out, xc, mods_l, 2048, skip_ctx};
      gemm256<false>(lds, S, E);
    }
    xcd_barrier(ws, lds);
    phase_norm(p.out, xc, p.g_norm2 + l * 1024, mods_l, 3072, 4096, hbuf, skip_ctx);
    xcd_barrier(ws, lds);
    {
      SchedRows S{hbuf, Wl + W_UP, 1024, nrt, 16, G, cblk, skip_ctx, 2048u, 2048u};
      EpiUp E{big + B_U, skip_ctx};
      gemm256<true>(lds, S, E);
    }
    xcd_barrier(ws, lds);
    {
      SchedRows S{big + B_U, Wl + W_DOWN, 4096, nrt, 4, G, cblk, skip_ctx, 8192u, 8192u};
      EpiResid E{p.out, xc, p.out, xc, mods_l, 5120, skip_ctx};
      gemm256<false>(lds, S, E);
    }
    if (l == 0) xcd_barrier(ws, lds);
  }
}

extern "C" void kernel_launch(void* const* d_in, const int* in_sizes, int n_in, void* d_out, int out_size, void* d_ws,
                              size_t ws_size, hipStream_t stream) {
  static int grid_blocks = 0;
  if (!grid_blocks) {
    int dev = 0, cus = 0, per_cu = 0;
    (void)hipGetDevice(&dev);
    (void)hipDeviceGetAttribute(&cus, hipDeviceAttributeMultiprocessorCount, dev);
    (void)hipOccupancyMaxActiveBlocksPerMultiprocessor(&per_cu, hybrid_block_megakernel, NTHR, 0);
    if (per_cu < 1) fprintf(stderr, "occupancy query returned %d\n", per_cu);
    grid_blocks = cus;
  }
  if (ws_size < WS_NEED) fprintf(stderr, "workspace too small: %zu < %zu\n", ws_size, (size_t)WS_NEED);
  (void)hipMemsetAsync((char*)d_ws + OFF_BAR, 0, XCD_BAR_WORDS * 4, stream);
  Params p{};
  const float** pf = (const float**)&p;
  for (int i = 0; i < 31; ++i) pf[i] = (const float*)d_in[i];
  p.out = (float*)d_out;
  p.ws = (char*)d_ws;
  void* args[] = {&p};
  hipError_t e = hipLaunchCooperativeKernel((void*)hybrid_block_megakernel, dim3(grid_blocks), dim3(NTHR), args, 0, stream);
  if (e != hipSuccess) fprintf(stderr, "cooperative launch failed: %s (grid %d)\n", hipGetErrorString(e), grid_blocks);
}
```

```cpp
#include <hip/hip_runtime.h>
#include <hip/hip_cooperative_groups.h>
#include <cstdio>
namespace cg = cooperative_groups;

typedef _Float16 half_t;
typedef __attribute__((ext_vector_type(8))) _Float16 h8;
typedef __attribute__((ext_vector_type(4))) _Float16 h4;
typedef __attribute__((ext_vector_type(4))) float f4;
typedef __attribute__((ext_vector_type(16))) float f16v;

#define DI __device__ __forceinline__
#define LAS __attribute__((address_space(3)))

constexpr int NB = 16, SEQ = 2048, CTX = 256, TOK = 2304, NTOK = NB * TOK;
constexpr float LOG2E = 1.4426950408889634f;
constexpr float EPS = 1e-6f;

constexpr int NQK = 2048;
constexpr int NVT = 768;
constexpr int ZS = 576;
constexpr size_t W_QK = 0;
constexpr size_t W_V = W_QK + (size_t)NQK * 1024;
constexpr size_t W_GATE = W_V + (size_t)NVT * 1024;
constexpr size_t W_BR = W_GATE + (size_t)4096 * 1024;
constexpr size_t W_OUT = W_BR + (size_t)4 * 1024 * 256;
constexpr size_t W_UP = W_OUT + (size_t)1024 * 1024;
constexpr size_t W_DOWN = W_UP + (size_t)4096 * 1024;
constexpr size_t W_UQ = W_DOWN + (size_t)1024 * 4096;
constexpr size_t W_UK = W_UQ + (size_t)512 * 256;
constexpr size_t W_UV = W_UK + (size_t)256 * 256;
constexpr size_t W_LAYER = W_UV + (size_t)256 * 256;

constexpr size_t al256(size_t x) { return (x + 255) & ~(size_t)255; }
constexpr size_t OFF_BAR = 0;
constexpr size_t OFF_W = 16384;
constexpr size_t OFF_MOD = al256(OFF_W + 2 * W_LAYER * 2);
constexpr size_t OFF_XC = al256(OFF_MOD + (size_t)2 * 17 * 6144 * 4);
constexpr size_t OFF_H = al256(OFF_XC + (size_t)NB * CTX * 1024 * 4);
constexpr size_t OFF_BIG = al256(OFF_H + (size_t)NTOK * 1024 * 2);
constexpr size_t B_O = 0;
constexpr size_t B_QM = B_O + (size_t)NTOK * 1024;
constexpr size_t B_KM = B_QM + (size_t)NTOK * 384;
constexpr size_t B_VTM = B_KM + (size_t)NTOK * 384;
constexpr size_t B_QNA = B_VTM + (size_t)NTOK * 256;
constexpr size_t B_KNA = B_QNA + (size_t)NTOK * 256;
constexpr size_t B_VTNA = B_KNA + (size_t)NTOK * 256;
constexpr size_t B_QDF = B_VTNA + (size_t)NTOK * 256;
constexpr size_t B_KDF = B_QDF + (size_t)NTOK * 256;
constexpr size_t B_VTDF = B_KDF + (size_t)NTOK * 256;
constexpr size_t B_QG = B_VTDF + (size_t)NTOK * 256;
constexpr size_t B_KG = B_QG + (size_t)NTOK * 256;
constexpr size_t B_VTG = B_KG + (size_t)NTOK * 128;
constexpr size_t B_ZMLA = B_VTG + (size_t)NTOK * 128;
constexpr size_t B_END = B_ZMLA + (size_t)NTOK * ZS;
constexpr size_t B_M = B_O + (size_t)NTOK * 1024;
constexpr size_t GSLAB = (size_t)48 * 256 * 4096;
constexpr size_t B_G0 = B_M + (size_t)NTOK * 1024;
constexpr size_t B_G1 = B_G0 + GSLAB;
constexpr size_t B_P5END = B_G1 + GSLAB;
constexpr size_t B_U = 0;
constexpr size_t B_MAX = B_END > B_P5END ? B_END : B_P5END;
constexpr size_t WS_NEED = OFF_BIG + B_MAX * 2;
static_assert(B_MAX >= (size_t)NTOK * 4096, "u must fit");
static_assert(WS_NEED <= (size_t)536870912, "workspace budget");

constexpr int NTHR = 512, NWAVE = 8;
constexpr int GEMM_LDS = 131072;
constexpr int SMEM_BYTES = GEMM_LDS + 16;

struct Params {
  const float *x, *c, *ctx, *c_ctx, *w_ada, *b_ada, *g_norm1, *g_norm2, *w_in;
  const float *g_mla_qa, *w_mla_uq, *g_mla_kva, *w_mla_ukv, *g_mla_q, *g_mla_k;
  const float *g_na_q, *g_na_k, *na_rpb;
  const float *g_diff_q, *g_diff_k, *lq1, *lk1, *lq2, *lk2, *g_diff_sub;
  const float *g_gqa_q, *g_gqa_k, *w_branch, *w_out, *w_up, *w_down;
  float* out;
  char* ws;
};


typedef const Params __attribute__((address_space(4))) * KPtr;
DI KPtr kp() {
  KPtr q = (KPtr)__builtin_amdgcn_kernarg_segment_ptr();
  asm volatile("" : "+s"(q));
  return q;
}

DI int tid_opaque(int wv_) {
  unsigned z = 0u;
  asm volatile("" : "+v"(z));
  int t = (wv_ << 6) | (int)__builtin_amdgcn_mbcnt_hi(~0u, __builtin_amdgcn_mbcnt_lo(~0u, z));
  asm volatile("" : "+v"(t));
  return t;
}

DI float wave_sum(float v) {
#pragma unroll
  for (int o = 32; o > 0; o >>= 1) v += __shfl_xor(v, o);
  return v;
}

#define XB_TMO      128
#define XB_XCNT(j)  (256  + 64 * (j))
#define XB_XSUB(j)  (1280 + 64 * (j))
#define XB_XGEN(j)  (2304 + 64 * (j))
#define XB_TOP      3328
#define XB_TOPGEN   3392
#define XCD_BAR_WORDS 3456
#define XB_SPIN_CAP (1u << 22)
DI unsigned xb_ld(unsigned* p) { return __hip_atomic_load(p, __ATOMIC_RELAXED, __HIP_MEMORY_SCOPE_AGENT); }
DI unsigned xb_add(unsigned* p, unsigned v) { return __hip_atomic_fetch_add(p, v, __ATOMIC_RELAXED, __HIP_MEMORY_SCOPE_AGENT); }
DI unsigned xb_xcc_id() { return (unsigned)__builtin_amdgcn_s_getreg((3 << 11) | 20) & 0xFu; }
#define XB_SPIN(cond, bar) do { unsigned _sp = 0; while (cond) { __builtin_amdgcn_s_sleep(1); \
    if ((++_sp & 255u) == 0u) { if (xb_ld(&(bar)[XB_TMO])) break; if (_sp > XB_SPIN_CAP) { atomicAdd(&(bar)[XB_TMO], 1u); break; } } } } while (0)
DI void xcd_barrier_post(unsigned* bar, int wv_) {
  if (tid_opaque(wv_) == 0) (void)xb_add(&bar[XB_XCNT(xb_xcc_id())], 1u);
}
DI void xcd_barrier_complete(unsigned* bar, unsigned x, unsigned& nloc, unsigned& nx) {
  const unsigned G = gridDim.x * gridDim.y * gridDim.z;
  unsigned sum, cnt, mine, sp = 0u;
  for (;;) {
    sum = 0u; cnt = 0u; mine = 0u;
#pragma unroll
    for (unsigned j = 0; j < 16; ++j) { const unsigned c = xb_ld(&bar[XB_XCNT(j)]); sum += c; cnt += (c > 0u) ? 1u : 0u; mine = (j == x) ? c : mine; }
    if (sum == G) break;
    __builtin_amdgcn_s_sleep(1);
    if ((++sp & 255u) == 0u) { if (xb_ld(&bar[XB_TMO])) break; if (sp > XB_SPIN_CAP) { atomicAdd(&bar[XB_TMO], 1u); break; } }
  }
  nloc = mine > 0u ? mine : 1u; nx = cnt > 0u ? cnt : 1u;
}
DI void xcd_barrier(char* ws_, LAS unsigned char* lds_, int wv_) {
  asm volatile("s_waitcnt vmcnt(0)" ::: "memory");
  __syncthreads();
  if (tid_opaque(wv_) == 0) {
    char* wsl = ws_;
    asm volatile("" : "+s"(wsl));
    unsigned* bar = (unsigned*)(wsl + OFF_BAR);
    volatile LAS unsigned* st = (volatile LAS unsigned*)(lds_ + GEMM_LDS);
    const unsigned x = xb_xcc_id();
    __builtin_amdgcn_s_waitcnt(0);
    unsigned nloc = st[0], nx = st[1];
    if (nloc == 0u) { xcd_barrier_complete(bar, x, nloc, nx); st[0] = nloc; st[1] = nx; }
    const unsigned old = xb_add(&bar[XB_XSUB(x)], 1u);
    const unsigned gen = old / nloc;
    if (old + 1u == (gen + 1u) * nloc) {
      __builtin_amdgcn_fence(__ATOMIC_RELEASE, "agent");
      asm volatile("s_waitcnt vmcnt(0)" ::: "memory");
      const unsigned og = xb_add(&bar[XB_TOP], 1u);
      const unsigned tg = og / nx;
      if (og + 1u == (tg + 1u) * nx) xb_add(&bar[XB_TOPGEN], 1u);
      else XB_SPIN(xb_ld(&bar[XB_TOPGEN]) == tg, bar);
      __builtin_amdgcn_fence(__ATOMIC_ACQUIRE, "agent");
      xb_add(&bar[XB_XGEN(x)], 1u);
      asm volatile("s_waitcnt vmcnt(0)" ::: "memory");
    } else {
      XB_SPIN(xb_ld(&bar[XB_XGEN(x)]) == gen, bar);
      __builtin_amdgcn_fence(__ATOMIC_ACQUIRE, "agent");
      asm volatile("s_waitcnt vmcnt(0)" ::: "memory");
    }
  }
  __syncthreads();
}

DI void phase_mods(float* mods, char* smem, int wv_) {
  const KPtr p = kp();
  float* sil = (float*)smem;
  const int tid = tid_opaque(wv_);
  for (int w = blockIdx.x; w < 192; w += gridDim.x) {
    const int l = w / 96, n0 = (w % 96) * 64;
    __syncthreads();
    for (int idx = tid; idx < 17 * 1024; idx += NTHR) {
      const int b = idx >> 10, k = idx & 1023;
      const float v = (b < 16) ? p->c[b * 1024 + k] : p->c_ctx[k];
      sil[idx] = v / (1.f + expf(-v));
    }
    __syncthreads();
    const int kq = tid >> 6, nn = tid & 63;
    float acc[17];
#pragma unroll
    for (int b = 0; b < 17; ++b) acc[b] = 0.f;
    const float* wp = p->w_ada + (size_t)l * 1024 * 6144 + (size_t)(kq * 128) * 6144 + n0 + nn;
    const float* sp = sil + kq * 128;
#pragma unroll 4
    for (int k = 0; k < 128; ++k) {
      const float wv = wp[(size_t)k * 6144];
#pragma unroll
      for (int b = 0; b < 17; ++b) acc[b] += sp[b * 1024 + k] * wv;
    }
    __syncthreads();
    float* red = (float*)smem;
#pragma unroll
    for (int b = 0; b < 17; ++b) red[(kq * 17 + b) * 64 + nn] = acc[b];
    __syncthreads();
    for (int idx = tid; idx < 17 * 64; idx += NTHR) {
      float s = p->b_ada[l * 6144 + n0 + (idx & 63)];
#pragma unroll
      for (int q = 0; q < 8; ++q) s += red[q * 17 * 64 + idx];
      mods[((size_t)l * 17 + (idx >> 6)) * 6144 + n0 + (idx & 63)] = s;
    }
  }
  __syncthreads();
}

DI void tconv_job(const float* src, int ld, int c0, int K, int Kvalid, int Nvalid, int Npad, half_t* dst, int& base,
                  float* tile, int wv_) {
  const int nnt = Npad / 64, tot = (K / 64) * nnt;
  const int G = gridDim.x;
  const int start = (int)((blockIdx.x + G - (base % G)) % G);
  const int tid_ = tid_opaque(wv_);
  const int tx = tid_ & 63, ty = tid_ >> 6;
  for (int t = start; t < tot; t += G) {
    const int kt = t / nnt, nt = t % nnt;
    __syncthreads();
#pragma unroll 4
    for (int i = 0; i < 8; ++i) {
      const int k = i * 8 + ty, n = nt * 64 + tx;
      tile[k * 65 + tx] = (n < Nvalid && kt * 64 + k < Kvalid) ? src[(size_t)(kt * 64 + k) * ld + c0 + n] : 0.f;
    }
    __syncthreads();
#pragma unroll 4
    for (int i = 0; i < 8; ++i) {
      const int n = i * 8 + ty;
      dst[(size_t)(nt * 64 + n) * K + kt * 64 + tx] = (half_t)tile[tx * 65 + n];
    }
  }
  base += tot;
}

DI void phase_norm(const float* xl, const float* xc, const float* gam, const float* mods_l, int sh_off,
                   int sc_off, half_t* h, bool skip_ctx, int wv_) {
  const int tid_ = tid_opaque(wv_);
  const int wave = tid_ >> 6, lane = tid_ & 63;
  for (int g = blockIdx.x * NWAVE + wave; g < NTOK; g += gridDim.x * NWAVE) {
    const int b = g / TOK, t = g - b * TOK;
    const bool isctx = t >= SEQ;
    if (isctx && skip_ctx) continue;
    const float* src = isctx ? xc + ((size_t)b * CTX + (t - SEQ)) * 1024 : xl + ((size_t)b * SEQ + t) * 1024;
    const float* mod = mods_l + (size_t)(isctx ? 16 : b) * 6144;
    float4 v[4];
    float ss = 0.f;
#pragma unroll
    for (int i = 0; i < 4; ++i) {
      v[i] = *(const float4*)(src + i * 256 + lane * 4);
      ss += v[i].x * v[i].x + v[i].y * v[i].y + v[i].z * v[i].z + v[i].w * v[i].w;
    }
    ss = wave_sum(ss);
    const float rstd = rsqrtf(ss * (1.f / 1024.f) + EPS);
#pragma unroll
    for (int i = 0; i < 4; ++i) {
      const int col = i * 256 + lane * 4;
      const float4 gg = *(const float4*)(gam + col);
      const float4 sc = *(const float4*)(mod + sc_off + col);
      const float4 sh = *(const float4*)(mod + sh_off + col);
      h4 o;
      o[0] = (half_t)(v[i].x * rstd * gg.x * (1.f + sc.x) + sh.x);
      o[1] = (half_t)(v[i].y * rstd * gg.y * (1.f + sc.y) + sh.y);
      o[2] = (half_t)(v[i].z * rstd * gg.z * (1.f + sc.z) + sh.z);
      o[3] = (half_t)(v[i].w * rstd * gg.w * (1.f + sc.w) + sh.w);
      *(h4*)(h + (size_t)g * 1024 + col) = o;
    }
  }
}

constexpr int BK = 64, HALF = 128, HTB = HALF * BK * 2;
DI int lds_byte(int r, int c) { const int st = (r >> 4) * 2 + (c >> 5), rr = r & 15, cc = c & 31, ob = rr * 64 + cc * 2; return st * 1024 + (ob ^ (((ob >> 9) & 1) << 5)); }
DI void stage_rc(int b, int& R, int& C) { const int st = b / 1024, sb = b % 1024, swz = sb ^ (((sb >> 9) & 1) << 5); R = (st >> 1) * 16 + swz / 64; C = (st & 1) * 32 + (swz % 64) / 2; }
DI int perm32(int rho) { const int n = rho >> 4, i = rho & 15; return 8 * (i >> 2) + 4 * n + (i & 3); }

struct GUnit { const char* A; const char* B; int nt, pm, pn, aux; };

DI bool tile_map(int L, int nM, int nN, int& pm, int& pn) {
  const int nwg = nM * nN;
  if (L >= nwg) return false;
  int wgid = L;
  { const int q = nwg / 8, r = nwg % 8, xcd = wgid % 8, off = wgid / 8; wgid = (xcd < r ? xcd * (q + 1) : r * (q + 1) + (xcd - r) * q) + off; }
  const int nig = 8 * nN, gid = wgid / nig, fm = gid * 8, gsz = (nM - fm) < 8 ? (nM - fm) : 8;
  pm = fm + ((wgid % nig) % gsz); pn = (wgid % nig) / gsz;
  return true;
}

template <bool PERM, class Sched, class Epi>
DI void gemm256(LAS unsigned char* lds, const Sched& S, const Epi& E, int wv_) {
  const int tid = tid_opaque(wv_), wid = __builtin_amdgcn_readfirstlane(tid >> 6), lane = tid & 63, wr = wid >> 2, wc = wid & 3, fr = lane & 15, fq = lane >> 4;
  unsigned cvA0, cvA1, cvB0, cvB1;
  { int R, C;
    stage_rc(tid * 16, R, C); cvA0 = (unsigned)R * S.lda2 + C * 2; cvB0 = (unsigned)(PERM ? ((R & ~31) + perm32(R & 31)) : R) * S.ldb2 + C * 2;
    stage_rc(tid * 16 + 8192, R, C); cvA1 = (unsigned)R * S.lda2 + C * 2; cvB1 = (unsigned)(PERM ? ((R & ~31) + perm32(R & 31)) : R) * S.ldb2 + C * 2; }
  const size_t chA = (size_t)HALF * S.lda2, chB = (size_t)HALF * S.ldb2;
  const size_t kstep = (size_t)(BK * 2);
  const unsigned ldsw = (unsigned)wid * 1024u;
  const int aoff = lds_byte(wr * 64 + fr, fq * 8), boff = lds_byte(wc * 32 + fr, fq * 8);
#define G_SA(b, h) (((b) * 2 + (h)) * HTB)
#define G_SB(b, h) ((4 + (b) * 2 + (h)) * HTB)
#define G_STAGE(bufoff, gbase, v0, v1) do { \
    __builtin_amdgcn_global_load_lds((const unsigned*)((const char*)(gbase) + (v0)), (LAS unsigned*)(lds + (bufoff) + ldsw), 16, 0, 0); \
    __builtin_amdgcn_global_load_lds((const unsigned*)((const char*)(gbase) + (v1)), (LAS unsigned*)(lds + (bufoff) + ldsw + 8192), 16, 0, 0); } while (0)
#define G_LDA(dst, b, h) do { _Pragma("unroll") for (int m = 0; m < 4; ++m) _Pragma("unroll") for (int k = 0; k < 2; ++k) dst[m][k] = *(const LAS h8*)(lds + G_SA(b, h) + aoff + m * 2048 + k * 1024); } while (0)
#define G_LDB(dst, b, h) do { _Pragma("unroll") for (int n = 0; n < 2; ++n) _Pragma("unroll") for (int k = 0; k < 2; ++k) dst[n][k] = *(const LAS h8*)(lds + G_SB(b, h) + boff + n * 2048 + k * 1024); } while (0)
#define G_MMA(ai, bj, At, Bt) do { __builtin_amdgcn_s_setprio(1); _Pragma("unroll") for (int m = 0; m < 4; ++m) _Pragma("unroll") for (int n = 0; n < 2; ++n) _Pragma("unroll") for (int k = 0; k < 2; ++k) \
    acc[ai][bj][m][n] = __builtin_amdgcn_mfma_f32_16x16x32_f16(Bt[n][k], At[m][k], acc[ai][bj][m][n], 0, 0, 0); __builtin_amdgcn_s_setprio(0); } while (0)
#define G_WAIT_V(n) asm volatile("s_waitcnt vmcnt(" #n ")" ::: "memory")
#define G_WAIT_L(n) asm volatile("s_waitcnt lgkmcnt(" #n ")" ::: "memory")
#define G_BAR __builtin_amdgcn_s_barrier()
#define G_SCHED __builtin_amdgcn_sched_barrier(0)
  GUnit cur, nxt;
  int ui = 0;
  if (!S.next(0, cur)) return;
  f4 acc[2][2][4][2];
#pragma unroll
  for (int a = 0; a < 2; ++a)
#pragma unroll
    for (int b = 0; b < 2; ++b)
#pragma unroll
      for (int m = 0; m < 4; ++m)
#pragma unroll
        for (int n = 0; n < 2; ++n) acc[a][b][m][n] = f4{0.f, 0.f, 0.f, 0.f};
  h8 At[4][2], B0[2][2], B1[2][2];
  const char* cA = cur.A;
  const char* cB = cur.B;
  G_STAGE(G_SB(0, 0), cB, cvB0, cvB1); G_STAGE(G_SA(0, 0), cA, cvA0, cvA1); G_STAGE(G_SB(0, 1), cB + chB, cvB0, cvB1); G_STAGE(G_SA(0, 1), cA + chA, cvA0, cvA1);
  if (wr == 1) G_BAR;
  G_WAIT_V(4); G_BAR;
  G_STAGE(G_SB(1, 0), cB + kstep, cvB0, cvB1); G_STAGE(G_SA(1, 0), cA + kstep, cvA0, cvA1); G_STAGE(G_SB(1, 1), cB + chB + kstep, cvB0, cvB1);
  G_WAIT_V(6); G_BAR;
  for (;;) {
    const bool has_next = S.next(ui + 1, nxt);
    const char* nA = has_next ? nxt.A : cA;
    const char* nB = has_next ? nxt.B : cB;
    int nt = cur.nt;
    asm volatile("" : "+s"(nt));
    for (int t = 0; t < nt; t += 2) {
      const bool last = (t == nt - 2);
      const char* a1 = cA + (size_t)(t + 1) * kstep;
      const char* a2 = last ? nA : cA + (size_t)(t + 2) * kstep;
      const char* b2 = last ? nB : cB + (size_t)(t + 2) * kstep;
      const char* a3 = a2 + kstep;
      const char* b3 = b2 + kstep;
      G_LDB(B0, 0, 0); G_SCHED; G_LDA(At, 0, 0); G_STAGE(G_SA(1, 1), a1 + chA, cvA0, cvA1);
      G_WAIT_L(8); G_BAR; G_WAIT_L(0); G_MMA(0, 0, At, B0); G_BAR; G_SCHED;
      G_LDB(B1, 0, 1); G_STAGE(G_SB(0, 0), b2, cvB0, cvB1);
      G_BAR; G_WAIT_L(0); G_MMA(0, 1, At, B1); G_BAR;
      G_LDA(At, 0, 1); G_STAGE(G_SA(0, 0), a2, cvA0, cvA1);
      G_BAR; G_WAIT_L(0); G_MMA(1, 0, At, B0); G_BAR; G_SCHED;
      G_STAGE(G_SB(0, 1), b2 + chB, cvB0, cvB1);
      G_WAIT_V(6); G_BAR; G_MMA(1, 1, At, B1); G_BAR;
      G_LDB(B0, 1, 0); G_SCHED; G_LDA(At, 1, 0); G_STAGE(G_SA(0, 1), a2 + chA, cvA0, cvA1);
      G_WAIT_L(8); G_BAR; G_WAIT_L(0); G_MMA(0, 0, At, B0); G_BAR; G_SCHED;
      G_LDB(B1, 1, 1); G_STAGE(G_SB(1, 0), b3, cvB0, cvB1);
      G_BAR; G_WAIT_L(0); G_MMA(0, 1, At, B1); G_BAR;
      G_LDA(At, 1, 1); G_STAGE(G_SA(1, 0), a3, cvA0, cvA1);
      G_BAR; G_WAIT_L(0); G_MMA(1, 0, At, B0); G_BAR; G_SCHED;
      G_STAGE(G_SB(1, 1), b3 + chB, cvB0, cvB1);
      G_WAIT_V(6); G_BAR; G_MMA(1, 1, At, B1); G_BAR;
    }
    E(acc, cur, wr, wc, fr, fq);
    if (!has_next) break;
#pragma unroll
    for (int a = 0; a < 2; ++a)
#pragma unroll
      for (int b = 0; b < 2; ++b)
#pragma unroll
        for (int m = 0; m < 4; ++m)
#pragma unroll
          for (int n = 0; n < 2; ++n) acc[a][b][m][n] = f4{0.f, 0.f, 0.f, 0.f};
    cur = nxt; cA = nA; cB = nB; ++ui;
  }
  G_WAIT_V(0);
  if (wr == 0) G_BAR;
  G_BAR;
#undef G_SA
#undef G_SB
#undef G_STAGE
#undef G_LDA
#undef G_LDB
#undef G_MMA
#undef G_WAIT_V
#undef G_WAIT_L
#undef G_BAR
#undef G_SCHED
}

DI h8 pack8(const f4& a, const f4& b) {
  h8 o;
  o[0] = (half_t)a[0]; o[1] = (half_t)a[1]; o[2] = (half_t)a[2]; o[3] = (half_t)a[3];
  o[4] = (half_t)b[0]; o[5] = (half_t)b[1]; o[6] = (half_t)b[2]; o[7] = (half_t)b[3];
  return o;
}
DI int row0_of(int pm, bool skip_ctx) { return skip_ctx ? (pm >> 3) * TOK + (pm & 7) * 256 : pm * 256; }

struct SchedInproj {
  const half_t* hbuf; const half_t* Wl; int G, c;
  static constexpr unsigned lda2 = 2048, ldb2 = 2048;
  DI bool next(int i, GUnit& u) const {
    const int L = i * G + c;
    u.nt = 16;
    if (L < 144 * 8) {
      tile_map(L, 144, 8, u.pm, u.pn);
      u.A = (const char*)(hbuf + (size_t)u.pm * 256 * 1024); u.B = (const char*)(Wl + W_QK + (size_t)u.pn * 256 * 1024); u.aux = 0;
      return true;
    }
    if (!tile_map(L - 144 * 8, 3, 144, u.pm, u.pn)) return false;
    u.A = (const char*)(Wl + W_V + (size_t)u.pm * 256 * 1024); u.B = (const char*)(hbuf + (size_t)u.pn * 256 * 1024); u.aux = 1;
    return true;
  }
};
struct EpiInproj {
  half_t* big;
  DI void operator()(const f4 (&acc)[2][2][4][2], const GUnit& u, int wr, int wc, int fr, int fq) const {
    if (u.aux == 0) {
      const int g0 = u.pm * 256, b = g0 / TOK, t0 = g0 - b * TOK + wr * 64;
#pragma unroll
      for (int bj = 0; bj < 2; ++bj) {
        const int cb = u.pn * 256 + bj * 128 + wc * 32;
        half_t* ptr; int ts;
        if (cb < 576) { ptr = big + B_ZMLA + (size_t)b * TOK * ZS + cb; ts = ZS; }
        else if (cb < 1088) { const int c = cb - 576, part = c >> 8, hh = (c >> 6) & 3; ptr = big + (part ? B_KNA : B_QNA) + (size_t)(b * 4 + hh) * TOK * 64 + (c & 63); ts = 64; }
        else if (cb < 1600) { const int c = cb - 1088, part = c >> 8, hm = (c >> 5) & 7; ptr = big + (part ? B_KDF : B_QDF) + (size_t)(b * 8 + hm) * TOK * 32; ts = 32; }
        else if (cb < 1856) { const int c = cb - 1600; ptr = big + B_QG + (size_t)(b * 4 + (c >> 6)) * TOK * 64 + (c & 63); ts = 64; }
        else if (cb < 1984) { const int c = cb - 1856; ptr = big + B_KG + (size_t)(b * 2 + (c >> 6)) * TOK * 64 + (c & 63); ts = 64; }
        else continue;
        const unsigned lo = (unsigned)(fr * ts + 8 * fq) * 2u;
        char* rb = (char*)(ptr + (size_t)t0 * ts);
#pragma unroll
        for (int ai = 0; ai < 2; ++ai)
#pragma unroll
          for (int m = 0; m < 4; ++m)
            *(h8*)(rb + (size_t)((ai * 128 + m * 16) * ts) * 2 + lo) = pack8(acc[ai][bj][m][0], acc[ai][bj][m][1]);
      }
    } else {
      const int g0 = u.pn * 256, b = g0 / TOK, t0 = g0 - b * TOK;
      const int nh = (u.pm == 2) ? 2 : 4;
      char* vt = (char*)(big + (u.pm == 0 ? B_VTNA : (u.pm == 1 ? B_VTDF : B_VTG)) + (size_t)b * nh * 64 * TOK + (size_t)(wr * 64) * TOK + t0 + wc * 32);
      const unsigned lo = (unsigned)(fr * TOK + 8 * fq) * 2u;
#pragma unroll
      for (int ai = 0; ai < 2; ++ai) {
        if (u.pm == 2 && ai == 1) continue;
#pragma unroll
        for (int m = 0; m < 4; ++m)
#pragma unroll
          for (int bj = 0; bj < 2; ++bj)
            *(h8*)(vt + ((size_t)(ai * 128 + m * 16) * TOK + bj * 128) * 2 + lo) = pack8(acc[ai][bj][m][0], acc[ai][bj][m][1]);
      }
    }
  }
};

struct SchedMlaQK {
  const half_t* Wl; const half_t* zmla; int G, c;
  static constexpr unsigned lda2 = ZS * 2, ldb2 = 512;
  DI bool next(int i, GUnit& u) const {
    const int L = i * G + c;
    u.nt = 4;
    if (L < 288) {
      tile_map(L, 144, 2, u.pm, u.pn);
      u.A = (const char*)(zmla + (size_t)u.pm * 256 * ZS);
      u.B = (const char*)(Wl + W_UQ + (size_t)u.pn * 256 * 256); u.aux = 0;
      return true;
    }
    if (L < 432) {
      u.pm = L - 288; u.pn = 0;
      u.A = (const char*)(zmla + 256 + (size_t)u.pm * 256 * ZS);
      u.B = (const char*)(Wl + W_UK); u.aux = 1;
      return true;
    }
    return false;
  }
};
struct SchedMlaV {
  const half_t* Wl; const half_t* zmla; int G, c;
  static constexpr unsigned lda2 = 512, ldb2 = ZS * 2;
  DI bool next(int i, GUnit& u) const {
    const int L = i * G + c;
    if (L >= 144) return false;
    u.nt = 4; u.pm = 0; u.pn = L;
    u.A = (const char*)(Wl + W_UV);
    u.B = (const char*)(zmla + 256 + (size_t)u.pn * 256 * ZS); u.aux = 2;
    return true;
  }
};
struct EpiMla {
  half_t* big;
  DI void operator()(const f4 (&acc)[2][2][4][2], const GUnit& u, int wr, int wc, int fr, int fq) const {
    if (u.aux < 2) {
      const int g0 = u.pm * 256, b = g0 / TOK, t0 = g0 - b * TOK + wr * 64;
      const unsigned lo = (unsigned)(fr * 96 + 8 * fq) * 2u;
#pragma unroll
      for (int bj = 0; bj < 2; ++bj) {
        const int cb = u.pn * 256 + bj * 128 + wc * 32;
        half_t* ptr;
        if (u.aux == 0) {
          if (cb >= 384) continue;
          const int hh = cb / 96, dd = cb - hh * 96;
          ptr = big + B_QM + (size_t)(b * 4 + hh) * TOK * 96 + dd;
        } else {
          ptr = big + B_KM + (size_t)(b * 4 + (cb >> 6)) * TOK * 96 + (cb & 63);
        }
        char* rb = (char*)(ptr + (size_t)t0 * 96);
#pragma unroll
        for (int ai = 0; ai < 2; ++ai)
#pragma unroll
          for (int m = 0; m < 4; ++m)
            *(h8*)(rb + (size_t)((ai * 128 + m * 16) * 96) * 2 + lo) = pack8(acc[ai][bj][m][0], acc[ai][bj][m][1]);
      }
    } else {
      const int g0 = u.pn * 256, b = g0 / TOK, t0 = g0 - b * TOK;
      char* vt = (char*)(big + B_VTM + (size_t)b * 4 * 64 * TOK + (size_t)(wr * 64) * TOK + t0 + wc * 32);
      const unsigned lo = (unsigned)(fr * TOK + 8 * fq) * 2u;
#pragma unroll
      for (int ai = 0; ai < 2; ++ai)
#pragma unroll
        for (int m = 0; m < 4; ++m)
#pragma unroll
          for (int bj = 0; bj < 2; ++bj)
            *(h8*)(vt + ((size_t)(ai * 128 + m * 16) * TOK + bj * 128) * 2 + lo) = pack8(acc[ai][bj][m][0], acc[ai][bj][m][1]);
    }
  }
};

struct SchedRows {
  const half_t* A; const half_t* B; int K, nM, nN, G, c; bool skip_ctx; unsigned lda2, ldb2;
  DI bool next(int i, GUnit& u) const {
    if (!tile_map(i * G + c, nM, nN, u.pm, u.pn)) return false;
    u.A = (const char*)(A + (size_t)row0_of(u.pm, skip_ctx) * K); u.B = (const char*)(B + (size_t)u.pn * 256 * K);
    u.nt = K >> 6; u.aux = 0;
    return true;
  }
};
struct EpiResid {
  const float* xl_src; const float* xc_src; float* xl_dst; float* xc_dst; const float* mods_l; int gt_off; bool skip_ctx;
  DI void operator()(const f4 (&acc)[2][2][4][2], const GUnit& u, int wr, int wc, int fr, int fq) const {
    const int g0 = row0_of(u.pm, skip_ctx), b = g0 / TOK, t0 = g0 - b * TOK;
    const bool isctx = t0 >= SEQ;
    const int col0 = u.pn * 256 + wc * 32;
    const size_t rowoff = (size_t)(wr * 64) * 1024 + col0;
    const char* src = (const char*)((isctx ? xc_src + ((size_t)b * CTX + (t0 - SEQ)) * 1024 : xl_src + ((size_t)b * SEQ + t0) * 1024) + rowoff);
    char* dst = (char*)((isctx ? xc_dst + ((size_t)b * CTX + (t0 - SEQ)) * 1024 : xl_dst + ((size_t)b * SEQ + t0) * 1024) + rowoff);
    const char* gt = (const char*)(mods_l + (size_t)(isctx ? 16 : b) * 6144 + gt_off + col0);
    const unsigned lo = (unsigned)(fr * 1024 + 4 * fq) * 4u, glo = (unsigned)(4 * fq) * 4u;
    f4 gv[2][2];
#pragma unroll
    for (int bj = 0; bj < 2; ++bj)
#pragma unroll
      for (int n = 0; n < 2; ++n) gv[bj][n] = *(const f4*)(gt + (bj * 128 + n * 16) * 4 + glo);
#pragma unroll
    for (int ai = 0; ai < 2; ++ai)
#pragma unroll
      for (int m = 0; m < 4; ++m)
#pragma unroll
        for (int bj = 0; bj < 2; ++bj)
#pragma unroll
          for (int n = 0; n < 2; ++n) {
            const size_t uo = ((size_t)(ai * 128 + m * 16) * 1024 + bj * 128 + n * 16) * 4;
            const f4 xv = *(const f4*)(src + uo + lo);
            *(f4*)(dst + uo + lo) = xv + gv[bj][n] * acc[ai][bj][m][n];
          }
  }
};
struct EpiUp {
  half_t* ubuf; bool skip_ctx;
  DI void operator()(const f4 (&acc)[2][2][4][2], const GUnit& u, int wr, int wc, int fr, int fq) const {
    const int g0 = row0_of(u.pm, skip_ctx);
    char* rb = (char*)(ubuf + (size_t)(g0 + wr * 64) * 4096 + u.pn * 256 + wc * 32);
    const unsigned lo = (unsigned)(fr * 4096 + 8 * fq) * 2u;
#pragma unroll
    for (int ai = 0; ai < 2; ++ai)
#pragma unroll
      for (int m = 0; m < 4; ++m)
#pragma unroll
        for (int bj = 0; bj < 2; ++bj) {
          f4 a = acc[ai][bj][m][0], c = acc[ai][bj][m][1];
#pragma unroll
          for (int j = 0; j < 4; ++j) { a[j] = fmaxf(a[j], 0.f); a[j] *= a[j]; c[j] = fmaxf(c[j], 0.f); c[j] *= c[j]; }
          *(h8*)(rb + ((size_t)(ai * 128 + m * 16) * 4096 + bj * 128) * 2 + lo) = pack8(a, c);
        }
  }
};

template <int DLEN, int LPR, int ROPE, bool KR>
DI void norm_rows(half_t* base, int stride, int nrows, const float* gain, float oscale, const half_t* zmla, int wv_) {
  const int tid_ = tid_opaque(wv_);
  const int lane = tid_ & 63, wave = tid_ >> 6;
  constexpr int RPW = 64 / LPR;
  const int s = lane % LPR, sub = lane / LPR;
  const bool active = s * 8 < DLEN;
  float gn[8];
#pragma unroll
  for (int i = 0; i < 8; ++i) gn[i] = active ? gain[s * 8 + i] : 0.f;
  for (int r0 = (blockIdx.x * NWAVE + wave) * RPW; r0 < nrows; r0 += gridDim.x * NWAVE * RPW) {
    const int rho = r0 + sub;
    const int t = rho % TOK;
    half_t* ptr = base + (size_t)rho * stride + s * 8;
    const half_t* src = ptr;
    if (KR && s >= 8) {
      const int b = rho / (4 * TOK);
      src = zmla + ((size_t)b * TOK + t) * ZS + 512 + (s - 8) * 8;
    }
    float f[8];
    float ss = 0.f;
    if (active) {
      const h8 v = *(const h8*)src;
#pragma unroll
      for (int i = 0; i < 8; ++i) { f[i] = (float)v[i]; ss += f[i] * f[i]; }
    } else {
#pragma unroll
      for (int i = 0; i < 8; ++i) f[i] = 0.f;
    }
#pragma unroll
    for (int o = LPR / 2; o > 0; o >>= 1) ss += __shfl_xor(ss, o);
    const float rstd = rsqrtf(ss * (1.f / DLEN) + EPS);
#pragma unroll
    for (int i = 0; i < 8; ++i) f[i] = f[i] * rstd * gn[i];
    if (ROPE != 0) {
      constexpr int PX = (ROPE == 64) ? 2 : 1;
      float pf[8];
#pragma unroll
      for (int i = 0; i < 8; ++i) pf[i] = __shfl_xor(f[i], PX);
      constexpr int RB = (DLEN - ROPE) / 8;
      if (t < SEQ && s >= RB && active) {
        const int sr = s - RB;
        const int q = (ROPE == 64) ? (sr >> 1) : sr;
        const float pos = (float)((q < 2) ? (t >> 6) : (t & 63));
        const float sgn = (q & 1) ? 1.f : -1.f;
#pragma unroll
        for (int i = 0; i < 8; ++i) {
          const int idx = (ROPE == 64) ? ((sr & 1) * 8 + i) : i;
          constexpr float NF = (ROPE == 64) ? 16.f : 8.f;
          const float invf = exp2f(-(float)idx * (13.287712379549449f / NF));
          const float ang = pos * invf;
          float sn, cs;
          sincosf(ang, &sn, &cs);
          f[i] = f[i] * cs + sgn * pf[i] * sn;
        }
      }
    }
    if (active) {
      h8 o;
#pragma unroll
      for (int i = 0; i < 8; ++i) o[i] = (half_t)(f[i] * oscale);
      *(h8*)ptr = o;
    }
  }
}

constexpr int ATT_STAGE = 22528, ATT_VOFF = 13312, ATT_STASH = 49152;
template <int DQ, bool NA, int NQG>
DI void attn_wg(const half_t* Qp, const half_t* Kp, const half_t* Vp, int q0, bool active, int seg0_start, int seg0_tiles,
                int seg1_start, int seg1_tiles, const float* rpb_h, int rq, char* smem, int tid, f16v (&O)[2][NQG]) {
  constexpr int NKS = DQ / 16, KSTR = DQ + 8, VSTR = 72, CPK = DQ / 8, KCH = 64 * CPK;
  const int lane = tid & 63, r = lane & 31, h = lane >> 5;
  h8 qf[NQG][NKS];
#pragma unroll
  for (int qg = 0; qg < NQG; ++qg)
#pragma unroll
    for (int ks = 0; ks < NKS; ++ks) qf[qg][ks] = *(const h8*)(Qp + (size_t)(q0 + qg * 32 + r) * DQ + ks * 16 + h * 8);
  float mrun[NQG], lrun[NQG];
#pragma unroll
  for (int qg = 0; qg < NQG; ++qg) { mrun[qg] = -1e30f; lrun[qg] = 0.f; }
#pragma unroll
  for (int a = 0; a < 2; ++a)
#pragma unroll
    for (int c = 0; c < NQG; ++c)
#pragma unroll
      for (int i = 0; i < 16; ++i) O[a][c][i] = 0.f;
  const int ntiles = seg0_tiles + seg1_tiles;
  const int kc0 = tid, kc1 = tid + 512;
  const half_t* kg0 = Kp + kc0 * 8;
  const half_t* kg1 = Kp + kc1 * 8;
  const half_t* vg = Vp + (size_t)(tid >> 3) * TOK + (tid & 7) * 8;
  const int ks0 = (kc0 / CPK) * KSTR + (kc0 % CPK) * 8, ks1 = (kc1 / CPK) * KSTR + (kc1 % CPK) * 8, vs0 = (tid >> 3) * VSTR + (tid & 7) * 8;
  uint4 kreg0 = {0, 0, 0, 0}, kreg1 = {0, 0, 0, 0}, vreg;
  const int r0w = min(max(rq - 4, 0), 24);
  {
    const int k0 = (0 < seg0_tiles) ? seg0_start : seg1_start;
    if (kc0 < KCH) kreg0 = *(const uint4*)(kg0 + (size_t)k0 * DQ);
    if (DQ == 96 && kc1 < KCH) kreg1 = *(const uint4*)(kg1 + (size_t)k0 * DQ);
    vreg = *(const uint4*)(vg + k0);
    if (kc0 < KCH) *(uint4*)((half_t*)smem + ks0) = kreg0;
    if (DQ == 96 && kc1 < KCH) *(uint4*)((half_t*)smem + ks1) = kreg1;
    *(uint4*)((half_t*)(smem + ATT_VOFF) + vs0) = vreg;
  }
  __syncthreads();
  for (int it = 0; it < ntiles; ++it) {
    const int k0 = (it < seg0_tiles) ? seg0_start + it * 64 : seg1_start + (it - seg0_tiles) * 64;
    const bool more = it + 1 < ntiles;
    if (more) {
      const int itn = it + 1;
      const int k1 = (itn < seg0_tiles) ? seg0_start + itn * 64 : seg1_start + (itn - seg0_tiles) * 64;
      if (kc0 < KCH) kreg0 = *(const uint4*)(kg0 + (size_t)k1 * DQ);
      if (DQ == 96 && kc1 < KCH) kreg1 = *(const uint4*)(kg1 + (size_t)k1 * DQ);
      vreg = *(const uint4*)(vg + k1);
    }
    const half_t* ksm = (const half_t*)(smem + (it & 1) * ATT_STAGE) + r * KSTR + h * 8;
    const half_t* vsm = (const half_t*)(smem + (it & 1) * ATT_STAGE + ATT_VOFF) + r * VSTR + h * 4;
    const bool masked = NA && it < seg0_tiles;
    const int krow = k0 >> 6;
    const bool need = active && (!masked || (krow >= r0w && krow < r0w + 8));
    if (need) {
#pragma unroll 1
      for (int st = 0; st < 2; ++st) {
        f16v S[NQG];
#pragma unroll
        for (int qg = 0; qg < NQG; ++qg)
#pragma unroll
          for (int i = 0; i < 16; ++i) S[qg][i] = 0.f;
#pragma unroll
        for (int ks = 0; ks < NKS; ++ks) {
          const h8 kf = *(const h8*)(ksm + (st * 32) * KSTR + ks * 16);
#pragma unroll
          for (int qg = 0; qg < NQG; ++qg) S[qg] = __builtin_amdgcn_mfma_f32_32x32x16_f16(kf, qf[qg][ks], S[qg], 0, 0, 0);
        }
        if (masked) {
          const int cb = st * 32;
          const int dr = krow - rq + 7;
#pragma unroll
          for (int qg = 0; qg < NQG; ++qg) {
            const int qc = qg * 32 + r;
            const int cs = min(max(qc - 8, 0), 48);
#pragma unroll
            for (int i = 0; i < 16; ++i) {
              const int c = cb + (i & 3) + 8 * (i >> 2) + 4 * h;
              const bool valid = (c >= cs) && (c < cs + 16);
              float bias = 0.f;
              if (valid) bias = rpb_h[dr * 31 + (c - qc + 15)] * LOG2E;
              S[qg][i] = valid ? S[qg][i] + bias : -1e30f;
            }
          }
        }
        h4 vf[2][2][2];
#pragma unroll
        for (int dvt = 0; dvt < 2; ++dvt)
#pragma unroll
          for (int sx = 0; sx < 2; ++sx)
#pragma unroll
            for (int hf = 0; hf < 2; ++hf) vf[dvt][sx][hf] = *(const h4*)(vsm + (dvt * 32) * VSTR + st * 32 + sx * 16 + hf * 8);
#pragma unroll
        for (int qg = 0; qg < NQG; ++qg) {
          h8 P[2];
          float mx = S[qg][0];
#pragma unroll
          for (int i = 1; i < 16; ++i) mx = fmaxf(mx, S[qg][i]);
          mx = fmaxf(mx, __shfl_xor(mx, 32));
          const float mn = fmaxf(mrun[qg], mx);
          const float alpha = __builtin_amdgcn_exp2f(mrun[qg] - mn);
          mrun[qg] = mn;
          float rs = 0.f;
#pragma unroll
          for (int i = 0; i < 16; ++i) {
            float pv = __builtin_amdgcn_exp2f(S[qg][i] - mn);
            if (NA) pv = (S[qg][i] <= -1e29f) ? 0.f : pv;
            rs += pv;
            P[i >> 3][i & 7] = (half_t)pv;
          }
          lrun[qg] = lrun[qg] * alpha + rs;
#pragma unroll
          for (int dvt = 0; dvt < 2; ++dvt) {
#pragma unroll
            for (int i = 0; i < 16; ++i) O[dvt][qg][i] *= alpha;
#pragma unroll
            for (int sx = 0; sx < 2; ++sx) {
              const h8 va = __builtin_shufflevector(vf[dvt][sx][0], vf[dvt][sx][1], 0, 1, 2, 3, 4, 5, 6, 7);
              O[dvt][qg] = __builtin_amdgcn_mfma_f32_32x32x16_f16(va, P[sx], O[dvt][qg], 0, 0, 0);
            }
          }
        }
      }
    }
    if (more) {
      char* nb = smem + ((it + 1) & 1) * ATT_STAGE;
      if (kc0 < KCH) *(uint4*)((half_t*)nb + ks0) = kreg0;
      if (DQ == 96 && kc1 < KCH) *(uint4*)((half_t*)nb + ks1) = kreg1;
      *(uint4*)((half_t*)(nb + ATT_VOFF) + vs0) = vreg;
    }
    __syncthreads();
  }
#pragma unroll
  for (int qg = 0; qg < NQG; ++qg) {
    const float lt = lrun[qg] + __shfl_xor(lrun[qg], 32);
    const float inv = 1.f / lt;
#pragma unroll
    for (int dvt = 0; dvt < 2; ++dvt)
#pragma unroll
      for (int i = 0; i < 16; ++i) O[dvt][qg][i] *= inv;
  }
}

template <int NQG>
DI void store_o(const f16v (&O)[2][NQG], half_t* orow0  , int lane) {
  const int r = lane & 31, h = lane >> 5;
#pragma unroll
  for (int qg = 0; qg < NQG; ++qg)
#pragma unroll
    for (int dvt = 0; dvt < 2; ++dvt)
#pragma unroll
      for (int c = 0; c < 4; ++c) {
        h4 o;
#pragma unroll
        for (int j = 0; j < 4; ++j) o[j] = (half_t)O[dvt][qg][4 * c + j];
        *(h4*)(orow0 + (size_t)(qg * 32 + r) * 1024 + dvt * 32 + 8 * c + 4 * h) = o;
      }
}

DI void phase_attn(int l, half_t* big, bool need_ctx, char* smem, int wv_) {
  const KPtr p = kp();
  const int wave = wv_;
  const int NQB = need_ctx ? 5 : 4;
  half_t* obuf = big + B_O;
  const float lam_init = 0.8f - 0.6f * expf(-0.3f * (float)l);
  float lam;
  {
    float d1 = 0.f, d2 = 0.f;
#pragma unroll 1
    for (int i = 0; i < 32; ++i) {
      d1 += p->lq1[l * 32 + i] * p->lk1[l * 32 + i];
      d2 += p->lq2[l * 32 + i] * p->lk2[l * 32 + i];
    }
    lam = expf(d1) - expf(d2) + lam_init;
    lam = __builtin_bit_cast(float, __builtin_amdgcn_readfirstlane(__builtin_bit_cast(int, lam)));
  }
  const float one_m_li = __builtin_bit_cast(float, __builtin_amdgcn_readfirstlane(__builtin_bit_cast(int, 1.f - lam_init)));
  const int per = 4 * 16 * NQB;
#pragma unroll
  for (int mixer = 0; mixer < 4; ++mixer) {
    const int lo = mixer * per;
    const int first = lo + (int)((blockIdx.x + gridDim.x - (lo % gridDim.x)) % gridDim.x);
    const int tid_m = tid_opaque(wv_);
    const int lane = tid_m & 63, h = lane >> 5;
#pragma unroll 1
    for (int item = first; item < lo + per; item += gridDim.x) {
      const int hi = item / (16 * NQB);
      const int rem = item - hi * 16 * NQB;
      const int b = rem / NQB, qb = rem - b * NQB;
      const bool qctx = qb == 4;
      const bool active = !qctx || wave < 4;
      const int q0 = active ? qb * 512 + wave * 64 : SEQ;
      const int hh = hi & 3;
      const int s0 = qctx ? SEQ : 0, n0t = qctx ? 4 : 36;
      f16v O[2][2];
      half_t* orow = obuf + (size_t)(b * TOK + q0) * 1024 + hh * 64;
      if (mixer == 0) {
        half_t* stash = (half_t*)(smem + ATT_STASH) + wave * 4096;
        attn_wg<32, false, 2>(big + B_QDF + (size_t)(b * 8 + hh * 2) * TOK * 32, big + B_KDF + (size_t)(b * 8 + hh * 2) * TOK * 32,
                              big + B_VTDF + (size_t)(b * 4 + hh) * 64 * TOK, q0, active, s0, n0t, 0, 0, nullptr, 0, smem, tid_m, O);
#pragma unroll
        for (int dvt = 0; dvt < 2; ++dvt)
#pragma unroll
          for (int qg = 0; qg < 2; ++qg)
#pragma unroll
            for (int i = 0; i < 16; ++i) stash[((dvt * 2 + qg) * 16 + i) * 64 + lane] = (half_t)O[dvt][qg][i];
        attn_wg<32, false, 2>(big + B_QDF + (size_t)(b * 8 + hh * 2 + 1) * TOK * 32, big + B_KDF + (size_t)(b * 8 + hh * 2 + 1) * TOK * 32,
                              big + B_VTDF + (size_t)(b * 4 + hh) * 64 * TOK, q0, active, s0, n0t, 0, 0, nullptr, 0, smem, tid_m, O);
#pragma unroll
        for (int qg = 0; qg < 2; ++qg) {
          float ss = 0.f;
#pragma unroll
          for (int dvt = 0; dvt < 2; ++dvt)
#pragma unroll
            for (int i = 0; i < 16; ++i) {
              const float v = (float)stash[((dvt * 2 + qg) * 16 + i) * 64 + lane] - lam * O[dvt][qg][i];
              O[dvt][qg][i] = v;
              ss += v * v;
            }
          ss += __shfl_xor(ss, 32);
          const float rstd = rsqrtf(ss * (1.f / 64.f) + EPS) * one_m_li;
#pragma unroll
          for (int dvt = 0; dvt < 2; ++dvt)
#pragma unroll
            for (int i = 0; i < 16; ++i) {
              const int dv = dvt * 32 + (i & 3) + 8 * (i >> 2) + 4 * h;
              O[dvt][qg][i] *= rstd * p->g_diff_sub[l * 64 + dv];
            }
        }
        if (active) store_o<2>(O, orow + 2 * 256, lane);
      } else if (mixer == 1) {
        attn_wg<96, false, 2>(big + B_QM + (size_t)(b * 4 + hh) * TOK * 96, big + B_KM + (size_t)(b * 4 + hh) * TOK * 96,
                              big + B_VTM + (size_t)(b * 4 + hh) * 64 * TOK, q0, active, s0, n0t, 0, 0, nullptr, 0, smem, tid_m, O);
        if (active) store_o<2>(O, orow + 0 * 256, lane);
      } else if (mixer == 2) {
        const int kv = hh >> 1;
        attn_wg<64, false, 2>(big + B_QG + (size_t)(b * 4 + hh) * TOK * 64, big + B_KG + (size_t)(b * 2 + kv) * TOK * 64,
                              big + B_VTG + (size_t)(b * 2 + kv) * 64 * TOK, q0, active, s0, n0t, 0, 0, nullptr, 0, smem, tid_m, O);
        if (active) store_o<2>(O, orow + 3 * 256, lane);
      } else {
        const int rq = q0 >> 6;
        const int rq0 = qb * 8;
        const int rlo = min(max(rq0 - 4, 0), 24), rhi = min(max(rq0 + 7 - 4, 0), 24) + 8;
        const int seg0s = rlo * 64, seg0n = qctx ? 0 : (rhi - rlo);
        attn_wg<64, true, 2>(big + B_QNA + (size_t)(b * 4 + hh) * TOK * 64, big + B_KNA + (size_t)(b * 4 + hh) * TOK * 64,
                             big + B_VTNA + (size_t)(b * 4 + hh) * 64 * TOK, q0, active, seg0s, seg0n, SEQ, 4,
                             p->na_rpb + (size_t)(l * 4 + hh) * 15 * 31, rq, smem, tid_m, O);
        if (active) store_o<2>(O, orow + 1 * 256, lane);
      }
    }
  }
}

struct SchedGate {
  const half_t* hbuf; const half_t* Wl; int pm0, cnt, G, c; bool skip_ctx;
  static constexpr unsigned lda2 = 2048, ldb2 = 2048;
  DI bool next(int i, GUnit& u) const {
    int pm, pn;
    if (!tile_map(i * G + c, cnt, 16, pm, pn)) return false;
    u.pm = pm0 + pm; u.pn = pn; u.nt = 16; u.aux = 0;
    u.A = (const char*)(hbuf + (size_t)row0_of(u.pm, skip_ctx) * 1024); u.B = (const char*)(Wl + W_GATE + (size_t)pn * 256 * 1024);
    return true;
  }
};
struct EpiGate {
  half_t* gb; int pm0;
  DI void operator()(const f4 (&acc)[2][2][4][2], const GUnit& u, int wr, int wc, int fr, int fq) const {
    char* rb = (char*)(gb + (size_t)((u.pm - pm0) * 256 + wr * 64) * 4096 + u.pn * 256 + wc * 32);
    const unsigned lo = (unsigned)(fr * 4096 + 8 * fq) * 2u;
#pragma unroll
    for (int ai = 0; ai < 2; ++ai)
#pragma unroll
      for (int m = 0; m < 4; ++m)
#pragma unroll
        for (int bj = 0; bj < 2; ++bj) {
          f4 a = acc[ai][bj][m][0], c = acc[ai][bj][m][1];
#pragma unroll
          for (int j = 0; j < 4; ++j) { a[j] = __builtin_amdgcn_rcpf(1.f + __expf(-a[j])); c[j] = __builtin_amdgcn_rcpf(1.f + __expf(-c[j])); }
          *(h8*)(rb + ((size_t)(ai * 128 + m * 16) * 4096 + bj * 128) * 2 + lo) = pack8(a, c);
        }
  }
};
struct SchedProj {
  const half_t* obuf; const half_t* Wl; int pm0, cnt, G, c; bool skip_ctx;
  static constexpr unsigned lda2 = 2048, ldb2 = 512;
  DI bool next(int i, GUnit& u) const {
    int pm, pn;
    if (!tile_map((i >> 2) * G + c, cnt, 4, pm, pn)) return false;
    const int br = i & 3;
    u.pm = pm0 + pm; u.pn = pn; u.nt = 4; u.aux = br;
    u.A = (const char*)(obuf + (size_t)row0_of(u.pm, skip_ctx) * 1024 + br * 256);
    u.B = (const char*)(Wl + W_BR + (size_t)(br * 1024 + pn * 256) * 256);
    return true;
  }
};
struct EpiProj {
  const half_t* gb; half_t* mbuf; int pm0; bool skip_ctx;
  DI void operator()(const f4 (&acc)[2][2][4][2], const GUnit& u, int wr, int wc, int fr, int fq) const {
    const int br = u.aux;
    const char* gp = (const char*)(gb + (size_t)((u.pm - pm0) * 256 + wr * 64) * 4096 + br * 1024 + u.pn * 256 + wc * 32);
    char* mp = (char*)(mbuf + (size_t)(row0_of(u.pm, skip_ctx) + wr * 64) * 1024 + u.pn * 256 + wc * 32);
    const unsigned glo = (unsigned)(fr * 4096 + 8 * fq) * 2u, mlo = (unsigned)(fr * 1024 + 8 * fq) * 2u;
#pragma unroll
    for (int ai = 0; ai < 2; ++ai)
#pragma unroll
      for (int m = 0; m < 4; ++m)
#pragma unroll
        for (int bj = 0; bj < 2; ++bj) {
          const h8 g = *(const h8*)(gp + ((size_t)(ai * 128 + m * 16) * 4096 + bj * 128) * 2 + glo);
          char* ma = mp + ((size_t)(ai * 128 + m * 16) * 1024 + bj * 128) * 2 + mlo;
          f4 a = acc[ai][bj][m][0], c = acc[ai][bj][m][1];
#pragma unroll
          for (int j = 0; j < 4; ++j) { a[j] *= (float)g[j]; c[j] *= (float)g[4 + j]; }
          if (br > 0) {
            const h8 pv = *(const h8*)ma;
#pragma unroll
            for (int j = 0; j < 4; ++j) { a[j] += (float)pv[j]; c[j] += (float)pv[4 + j]; }
          }
          *(h8*)ma = pack8(a, c);
        }
  }
};

__global__ void __launch_bounds__(NTHR) hybrid_block_megakernel(Params p) {
  __shared__ __attribute__((aligned(16))) char smem[SMEM_BYTES];
  char* ws = kp()->ws;
  if (ws == nullptr) cg::this_grid().sync();
  half_t* W = (half_t*)(ws + OFF_W);
  float* mods = (float*)(ws + OFF_MOD);
  float* xc = (float*)(ws + OFF_XC);
  half_t* hbuf = (half_t*)(ws + OFF_H);
  half_t* big = (half_t*)(ws + OFF_BIG);
  LAS unsigned char* lds = (LAS unsigned char*)smem;
  const int G = gridDim.x, cblk = blockIdx.x;

  const int wv_ = __builtin_amdgcn_readfirstlane((int)threadIdx.x >> 6);
  volatile LAS unsigned* st = (volatile LAS unsigned*)(lds + GEMM_LDS);
  if (threadIdx.x < 4) st[threadIdx.x] = 0u;
  __syncthreads();
  xcd_barrier_post((unsigned*)(ws + OFF_BAR), wv_);

  phase_mods(mods, smem, wv_);
  {
    int base = 0;
    float* tile = (float*)smem;
    for (int l = 0; l < 2; ++l) {
      half_t* Wl = W + (size_t)l * W_LAYER;
      const float* win = kp()->w_in + (size_t)l * 1024 * 6496;
      tconv_job(win, 6496, 0, 1024, 1024, 192, 256, Wl + W_QK, base, tile, wv_);
      tconv_job(win, 6496, 192, 1024, 1024, 128, 256, Wl + W_QK + (size_t)256 * 1024, base, tile, wv_);
      tconv_job(win, 6496, 320, 1024, 1024, 32, 64, Wl + W_QK + (size_t)512 * 1024, base, tile, wv_);
      tconv_job(win, 6496, 352, 1024, 1024, 256, 256, Wl + W_QK + (size_t)576 * 1024, base, tile, wv_);
      tconv_job(win, 6496, 608, 1024, 1024, 256, 256, Wl + W_QK + (size_t)832 * 1024, base, tile, wv_);
      tconv_job(win, 6496, 1120, 1024, 1024, 256, 256, Wl + W_QK + (size_t)1088 * 1024, base, tile, wv_);
      tconv_job(win, 6496, 1376, 1024, 1024, 256, 256, Wl + W_QK + (size_t)1344 * 1024, base, tile, wv_);
      tconv_job(win, 6496, 1888, 1024, 1024, 256, 256, Wl + W_QK + (size_t)1600 * 1024, base, tile, wv_);
      tconv_job(win, 6496, 2144, 1024, 1024, 128, 192, Wl + W_QK + (size_t)1856 * 1024, base, tile, wv_);
      tconv_job(win, 6496, 864, 1024, 1024, 256, 256, Wl + W_V, base, tile, wv_);
      tconv_job(win, 6496, 1632, 1024, 1024, 256, 256, Wl + W_V + (size_t)256 * 1024, base, tile, wv_);
      tconv_job(win, 6496, 2272, 1024, 1024, 128, 256, Wl + W_V + (size_t)512 * 1024, base, tile, wv_);
      tconv_job(win, 6496, 2400, 1024, 1024, 4096, 4096, Wl + W_GATE, base, tile, wv_);
      for (int br = 0; br < 4; ++br)
        tconv_job(kp()->w_branch + ((size_t)l * 4 + br) * 256 * 1024, 1024, 0, 256, 256, 1024, 1024, Wl + W_BR + (size_t)br * 1024 * 256, base, tile, wv_);
      tconv_job(kp()->w_out + (size_t)l * 1024 * 1024, 1024, 0, 1024, 1024, 1024, 1024, Wl + W_OUT, base, tile, wv_);
      tconv_job(kp()->w_up + (size_t)l * 1024 * 4096, 4096, 0, 1024, 1024, 4096, 4096, Wl + W_UP, base, tile, wv_);
      tconv_job(kp()->w_down + (size_t)l * 4096 * 1024, 1024, 0, 4096, 4096, 1024, 1024, Wl + W_DOWN, base, tile, wv_);
      tconv_job(kp()->w_mla_uq + (size_t)l * 192 * 384, 384, 0, 256, 192, 384, 512, Wl + W_UQ, base, tile, wv_);
      for (int hh = 0; hh < 4; ++hh) {
        tconv_job(kp()->w_mla_ukv + (size_t)l * 128 * 512, 512, hh * 128, 256, 128, 64, 64, Wl + W_UK + (size_t)hh * 64 * 256, base, tile, wv_);
        tconv_job(kp()->w_mla_ukv + (size_t)l * 128 * 512, 512, hh * 128 + 64, 256, 128, 64, 64, Wl + W_UV + (size_t)hh * 64 * 256, base, tile, wv_);
      }
    }
  }
  xcd_barrier(ws, lds, wv_);

  for (int l = 0; l < 2; ++l) {
    const bool need_ctx = (l == 0);
    const bool skip_ctx = !need_ctx;
    const half_t* Wl = W + (size_t)l * W_LAYER;
    const float* mods_l = mods + (size_t)l * 17 * 6144;
    const float* xl_src = (l == 0) ? kp()->x : kp()->out;
    const float* xc_src = (l == 0) ? kp()->ctx : xc;
    const int nrt = skip_ctx ? 128 : 144;

    phase_norm(xl_src, xc_src, kp()->g_norm1 + l * 1024, mods_l, 0, 1024, hbuf, false, wv_);
    xcd_barrier(ws, lds, wv_);
    {
      SchedInproj S{hbuf, Wl, G, cblk};
      EpiInproj E{big};
      gemm256<true>(lds, S, E, wv_);
    }
    xcd_barrier(ws, lds, wv_);
    {
      half_t* zmla = big + B_ZMLA;
      norm_rows<192, 32, 0, false>(zmla, ZS, NTOK, kp()->g_mla_qa + l * 192, 1.f, nullptr, wv_);
      norm_rows<128, 16, 0, false>(zmla + 256, ZS, NTOK, kp()->g_mla_kva + l * 128, 1.f, nullptr, wv_);
      norm_rows<64, 8, 0, false>(big + B_QNA, 64, NTOK * 4, kp()->g_na_q + l * 64, 0.125f * LOG2E, nullptr, wv_);
      norm_rows<64, 8, 0, false>(big + B_KNA, 64, NTOK * 4, kp()->g_na_k + l * 64, 1.f, nullptr, wv_);
      norm_rows<32, 4, 32, false>(big + B_QDF, 32, NTOK * 8, kp()->g_diff_q + l * 32, 0.17677669529663687f * LOG2E, nullptr, wv_);
      norm_rows<32, 4, 32, false>(big + B_KDF, 32, NTOK * 8, kp()->g_diff_k + l * 32, 1.f, nullptr, wv_);
      norm_rows<64, 8, 64, false>(big + B_QG, 64, NTOK * 4, kp()->g_gqa_q + l * 64, 0.125f * LOG2E, nullptr, wv_);
      norm_rows<64, 8, 64, false>(big + B_KG, 64, NTOK * 2, kp()->g_gqa_k + l * 64, 1.f, nullptr, wv_);
    }
    xcd_barrier(ws, lds, wv_);
    {
      SchedMlaQK S{Wl, big + B_ZMLA, G, cblk};
      EpiMla E{big};
      gemm256<true>(lds, S, E, wv_);
      SchedMlaV S2{Wl, big + B_ZMLA, G, cblk};
      gemm256<true>(lds, S2, E, wv_);
    }
    xcd_barrier(ws, lds, wv_);
    norm_rows<96, 16, 32, false>(big + B_QM, 96, NTOK * 4, kp()->g_mla_q + l * 96, 0.10206207261596575f * LOG2E, nullptr, wv_);
    norm_rows<96, 16, 32, true>(big + B_KM, 96, NTOK * 4, kp()->g_mla_k + l * 96, 1.f, big + B_ZMLA, wv_);
    xcd_barrier(ws, lds, wv_);
    phase_attn(l, big, need_ctx, smem, wv_);
    xcd_barrier(ws, lds, wv_);
    {
      const int nsplit = need_ctx ? 3 : 4, cnt = nrt / nsplit;
      for (int j = 0; j <= nsplit; ++j) {
        if (j < nsplit) {
          SchedGate S{hbuf, Wl, j * cnt, cnt, G, cblk, skip_ctx};
          EpiGate E{big + ((j & 1) ? B_G1 : B_G0), j * cnt};
          gemm256<true>(lds, S, E, wv_);
        }
        if (j > 0) {
          SchedProj S{big + B_O, Wl, (j - 1) * cnt, cnt, G, cblk, skip_ctx};
          EpiProj E{big + (((j - 1) & 1) ? B_G1 : B_G0), big + B_M, (j - 1) * cnt, skip_ctx};
          gemm256<true>(lds, S, E, wv_);
        }
        xcd_barrier(ws, lds, wv_);
      }
    }
    {
      SchedRows S{big + B_M, Wl + W_OUT, 1024, nrt, 4, G, cblk, skip_ctx, 2048u, 2048u};
      EpiResid E{xl_src, xc_src, kp()->out, xc, mods_l, 2048, skip_ctx};
      gemm256<false>(lds, S, E, wv_);
    }
    xcd_barrier(ws, lds, wv_);
    phase_norm(kp()->out, xc, kp()->g_norm2 + l * 1024, mods_l, 3072, 4096, hbuf, skip_ctx, wv_);
    xcd_barrier(ws, lds, wv_);
    {
      SchedRows S{hbuf, Wl + W_UP, 1024, nrt, 16, G, cblk, skip_ctx, 2048u, 2048u};
      EpiUp E{big + B_U, skip_ctx};
      gemm256<true>(lds, S, E, wv_);
    }
    xcd_barrier(ws, lds, wv_);
    {
      SchedRows S{big + B_U, Wl + W_DOWN, 4096, nrt, 4, G, cblk, skip_ctx, 8192u, 8192u};
      EpiResid E{kp()->out, xc, kp()->out, xc, mods_l, 5120, skip_ctx};
      gemm256<false>(lds, S, E, wv_);
    }
    if (l == 0) xcd_barrier(ws, lds, wv_);
  }
}

extern "C" void kernel_launch(void* const* d_in, const int* in_sizes, int n_in, void* d_out, int out_size, void* d_ws,
                              size_t ws_size, hipStream_t stream) {
  static int grid_blocks = 0;
  if (!grid_blocks) {
    int dev = 0, cus = 0, per_cu = 0;
    (void)hipGetDevice(&dev);
    (void)hipDeviceGetAttribute(&cus, hipDeviceAttributeMultiprocessorCount, dev);
    (void)hipOccupancyMaxActiveBlocksPerMultiprocessor(&per_cu, hybrid_block_megakernel, NTHR, 0);
    if (per_cu < 1) fprintf(stderr, "occupancy query returned %d\n", per_cu);
    grid_blocks = cus;
  }
  if (ws_size < WS_NEED) fprintf(stderr, "workspace too small: %zu < %zu\n", ws_size, (size_t)WS_NEED);
  (void)hipMemsetAsync((char*)d_ws + OFF_BAR, 0, XCD_BAR_WORDS * 4, stream);
  Params p{};
  const float** pf = (const float**)&p;
  for (int i = 0; i < 31; ++i) pf[i] = (const float*)d_in[i];
  p.out = (float*)d_out;
  p.ws = (char*)d_ws;
  void* args[] = {&p};
  hipError_t e = hipLaunchCooperativeKernel((void*)hybrid_block_megakernel, dim3(grid_blocks), dim3(NTHR), args, 0, stream);
  if (e != hipSuccess) fprintf(stderr, "cooperative launch failed: %s (grid %d)\n", hipGetErrorString(e), grid_blocks);
}
```

```cpp
#include <hip/hip_runtime.h>
#include <hip/hip_cooperative_groups.h>
#include <cstdio>
namespace cg = cooperative_groups;

typedef _Float16 half_t;
typedef __attribute__((ext_vector_type(8))) _Float16 h8;
typedef __attribute__((ext_vector_type(4))) _Float16 h4;
typedef __attribute__((ext_vector_type(4))) float f4;
typedef __attribute__((ext_vector_type(16))) float f16v;

#define DI __device__ __forceinline__
#define LAS __attribute__((address_space(3)))

constexpr int NB = 16, SEQ = 2048, CTX = 256, TOK = 2304, NTOK = NB * TOK;
constexpr float LOG2E = 1.4426950408889634f;
constexpr float EPS = 1e-6f;

constexpr int NQK = 2048;
constexpr int NVT = 768;
constexpr int ZS = 576;
constexpr size_t W_QK = 0;
constexpr size_t W_V = W_QK + (size_t)NQK * 1024;
constexpr size_t W_GATE = W_V + (size_t)NVT * 1024;
constexpr size_t W_BR = W_GATE + (size_t)4096 * 1024;
constexpr size_t W_OUT = W_BR + (size_t)4 * 1024 * 256;
constexpr size_t W_UP = W_OUT + (size_t)1024 * 1024;
constexpr size_t W_DOWN = W_UP + (size_t)4096 * 1024;
constexpr size_t W_UQ = W_DOWN + (size_t)1024 * 4096;
constexpr size_t W_UK = W_UQ + (size_t)512 * 256;
constexpr size_t W_UV = W_UK + (size_t)256 * 256;
constexpr size_t W_LAYER = W_UV + (size_t)256 * 256;

constexpr size_t al256(size_t x) { return (x + 255) & ~(size_t)255; }
constexpr size_t OFF_BAR = 0;
constexpr size_t OFF_W = 16384;
constexpr size_t OFF_MOD = al256(OFF_W + 2 * W_LAYER * 2);
constexpr size_t OFF_XC = al256(OFF_MOD + (size_t)2 * 17 * 6144 * 4);
constexpr size_t OFF_H = al256(OFF_XC + (size_t)NB * CTX * 1024 * 4);
constexpr size_t OFF_BIG = al256(OFF_H + (size_t)NTOK * 1024 * 2);
constexpr size_t B_O = 0;
constexpr size_t B_QM = B_O + (size_t)NTOK * 1024;
constexpr size_t B_KM = B_QM + (size_t)NTOK * 384;
constexpr size_t B_VTM = B_KM + (size_t)NTOK * 384;
constexpr size_t B_QNA = B_VTM + (size_t)NTOK * 256;
constexpr size_t B_KNA = B_QNA + (size_t)NTOK * 256;
constexpr size_t B_VTNA = B_KNA + (size_t)NTOK * 256;
constexpr size_t B_QDF = B_VTNA + (size_t)NTOK * 256;
constexpr size_t B_KDF = B_QDF + (size_t)NTOK * 256;
constexpr size_t B_VTDF = B_KDF + (size_t)NTOK * 256;
constexpr size_t B_QG = B_VTDF + (size_t)NTOK * 256;
constexpr size_t B_KG = B_QG + (size_t)NTOK * 256;
constexpr size_t B_VTG = B_KG + (size_t)NTOK * 128;
constexpr size_t B_ZMLA = B_VTG + (size_t)NTOK * 128;
constexpr size_t B_END = B_ZMLA + (size_t)NTOK * ZS;
constexpr size_t B_M = B_O + (size_t)NTOK * 1024;
constexpr size_t GSLAB = (size_t)64 * 256 * 4096;
constexpr size_t B_G0 = B_M + (size_t)NTOK * 1024;
constexpr size_t B_P5END = B_G0 + GSLAB;
constexpr size_t B_U = 0;
constexpr size_t B_MAX = B_END > B_P5END ? B_END : B_P5END;
constexpr size_t WS_NEED = OFF_BIG + B_MAX * 2;
static_assert(B_MAX >= (size_t)NTOK * 4096, "u must fit");
static_assert(WS_NEED <= (size_t)536870912, "workspace budget");

constexpr int NTHR = 512, NWAVE = 8;
constexpr int GEMM_LDS = 131072;
constexpr int SMEM_BYTES = GEMM_LDS + 16;

struct Params {
  const float *x, *c, *ctx, *c_ctx, *w_ada, *b_ada, *g_norm1, *g_norm2, *w_in;
  const float *g_mla_qa, *w_mla_uq, *g_mla_kva, *w_mla_ukv, *g_mla_q, *g_mla_k;
  const float *g_na_q, *g_na_k, *na_rpb;
  const float *g_diff_q, *g_diff_k, *lq1, *lk1, *lq2, *lk2, *g_diff_sub;
  const float *g_gqa_q, *g_gqa_k, *w_branch, *w_out, *w_up, *w_down;
  float* out;
  char* ws;
};


typedef const Params __attribute__((address_space(4))) * KPtr;
DI KPtr kp() {
  KPtr q = (KPtr)__builtin_amdgcn_kernarg_segment_ptr();
  asm volatile("" : "+s"(q));
  return q;
}

DI int tid_opaque(int wv_) {
  unsigned z = 0u;
  asm volatile("" : "+v"(z));
  int t = (wv_ << 6) | (int)__builtin_amdgcn_mbcnt_hi(~0u, __builtin_amdgcn_mbcnt_lo(~0u, z));
  asm volatile("" : "+v"(t));
  return t;
}

DI float wave_sum(float v) {
#pragma unroll
  for (int o = 32; o > 0; o >>= 1) v += __shfl_xor(v, o);
  return v;
}

#define XB_TMO      128
#define XB_XCNT(j)  (256  + 64 * (j))
#define XB_XSUB(j)  (1280 + 64 * (j))
#define XB_XGEN(j)  (2304 + 64 * (j))
#define XB_TOP      3328
#define XB_TOPGEN   3392
#define XCD_BAR_WORDS 3456
#define XB_SPIN_CAP (1u << 22)
DI unsigned xb_ld(unsigned* p) { return __hip_atomic_load(p, __ATOMIC_RELAXED, __HIP_MEMORY_SCOPE_AGENT); }
DI unsigned xb_add(unsigned* p, unsigned v) { return __hip_atomic_fetch_add(p, v, __ATOMIC_RELAXED, __HIP_MEMORY_SCOPE_AGENT); }
DI unsigned xb_xcc_id() { return (unsigned)__builtin_amdgcn_s_getreg((3 << 11) | 20) & 0xFu; }
#define XB_SPIN(cond, bar) do { unsigned _sp = 0; while (cond) { __builtin_amdgcn_s_sleep(1); \
    if ((++_sp & 255u) == 0u) { if (xb_ld(&(bar)[XB_TMO])) break; if (_sp > XB_SPIN_CAP) { atomicAdd(&(bar)[XB_TMO], 1u); break; } } } } while (0)
DI void xcd_barrier_post(unsigned* bar, int wv_) {
  if (tid_opaque(wv_) == 0) (void)xb_add(&bar[XB_XCNT(xb_xcc_id())], 1u);
}
DI void xcd_barrier_complete(unsigned* bar, unsigned x, unsigned& nloc, unsigned& nx) {
  const unsigned G = gridDim.x * gridDim.y * gridDim.z;
  unsigned sum, cnt, mine, sp = 0u;
  for (;;) {
    sum = 0u; cnt = 0u; mine = 0u;
#pragma unroll
    for (unsigned j = 0; j < 16; ++j) { const unsigned c = xb_ld(&bar[XB_XCNT(j)]); sum += c; cnt += (c > 0u) ? 1u : 0u; mine = (j == x) ? c : mine; }
    if (sum == G) break;
    __builtin_amdgcn_s_sleep(1);
    if ((++sp & 255u) == 0u) { if (xb_ld(&bar[XB_TMO])) break; if (sp > XB_SPIN_CAP) { atomicAdd(&bar[XB_TMO], 1u); break; } }
  }
  nloc = mine > 0u ? mine : 1u; nx = cnt > 0u ? cnt : 1u;
}
DI void xcd_barrier(char* ws_, LAS unsigned char* lds_, int wv_) {
  asm volatile("s_waitcnt vmcnt(0)" ::: "memory");
  __syncthreads();
  if (tid_opaque(wv_) == 0) {
    char* wsl = ws_;
    asm volatile("" : "+s"(wsl));
    unsigned* bar = (unsigned*)(wsl + OFF_BAR);
    volatile LAS unsigned* st = (volatile LAS unsigned*)(lds_ + GEMM_LDS);
    const unsigned x = xb_xcc_id();
    __builtin_amdgcn_s_waitcnt(0);
    unsigned nloc = st[0], nx = st[1];
    if (nloc == 0u) { xcd_barrier_complete(bar, x, nloc, nx); st[0] = nloc; st[1] = nx; }
    const unsigned old = xb_add(&bar[XB_XSUB(x)], 1u);
    const unsigned gen = old / nloc;
    if (old + 1u == (gen + 1u) * nloc) {
      __builtin_amdgcn_fence(__ATOMIC_RELEASE, "agent");
      asm volatile("s_waitcnt vmcnt(0)" ::: "memory");
      const unsigned og = xb_add(&bar[XB_TOP], 1u);
      const unsigned tg = og / nx;
      if (og + 1u == (tg + 1u) * nx) xb_add(&bar[XB_TOPGEN], 1u);
      else XB_SPIN(xb_ld(&bar[XB_TOPGEN]) == tg, bar);
      __builtin_amdgcn_fence(__ATOMIC_ACQUIRE, "agent");
      xb_add(&bar[XB_XGEN(x)], 1u);
      asm volatile("s_waitcnt vmcnt(0)" ::: "memory");
    } else {
      XB_SPIN(xb_ld(&bar[XB_XGEN(x)]) == gen, bar);
      __builtin_amdgcn_fence(__ATOMIC_ACQUIRE, "agent");
      asm volatile("s_waitcnt vmcnt(0)" ::: "memory");
    }
  }
  __syncthreads();
}

DI void phase_mods(float* mods, char* smem, int wv_) {
  const KPtr p = kp();
  float* sil = (float*)smem;
  const int tid = tid_opaque(wv_);
  for (int w = blockIdx.x; w < 192; w += gridDim.x) {
    const int l = w / 96, n0 = (w % 96) * 64;
    __syncthreads();
    for (int idx = tid; idx < 17 * 1024; idx += NTHR) {
      const int b = idx >> 10, k = idx & 1023;
      const float v = (b < 16) ? p->c[b * 1024 + k] : p->c_ctx[k];
      sil[idx] = v / (1.f + expf(-v));
    }
    __syncthreads();
    const int kq = tid >> 6, nn = tid & 63;
    float acc[17];
#pragma unroll
    for (int b = 0; b < 17; ++b) acc[b] = 0.f;
    const float* wp = p->w_ada + (size_t)l * 1024 * 6144 + (size_t)(kq * 128) * 6144 + n0 + nn;
    const float* sp = sil + kq * 128;
#pragma unroll 4
    for (int k = 0; k < 128; ++k) {
      const float wv = wp[(size_t)k * 6144];
#pragma unroll
      for (int b = 0; b < 17; ++b) acc[b] += sp[b * 1024 + k] * wv;
    }
    __syncthreads();
    float* red = (float*)smem;
#pragma unroll
    for (int b = 0; b < 17; ++b) red[(kq * 17 + b) * 64 + nn] = acc[b];
    __syncthreads();
    for (int idx = tid; idx < 17 * 64; idx += NTHR) {
      float s = p->b_ada[l * 6144 + n0 + (idx & 63)];
#pragma unroll
      for (int q = 0; q < 8; ++q) s += red[q * 17 * 64 + idx];
      mods[((size_t)l * 17 + (idx >> 6)) * 6144 + n0 + (idx & 63)] = s;
    }
  }
  __syncthreads();
}

DI void tconv_job(const float* src, int ld, int c0, int K, int Kvalid, int Nvalid, int Npad, half_t* dst, int& base,
                  float* tile, int wv_) {
  const int nnt = Npad / 64, tot = (K / 64) * nnt;
  const int G = gridDim.x;
  const int start = (int)((blockIdx.x + G - (base % G)) % G);
  const int tid_ = tid_opaque(wv_);
  const int tx = tid_ & 63, ty = tid_ >> 6;
  for (int t = start; t < tot; t += G) {
    const int kt = t / nnt, nt = t % nnt;
    __syncthreads();
#pragma unroll 4
    for (int i = 0; i < 8; ++i) {
      const int k = i * 8 + ty, n = nt * 64 + tx;
      tile[k * 65 + tx] = (n < Nvalid && kt * 64 + k < Kvalid) ? src[(size_t)(kt * 64 + k) * ld + c0 + n] : 0.f;
    }
    __syncthreads();
#pragma unroll 4
    for (int i = 0; i < 8; ++i) {
      const int n = i * 8 + ty;
      dst[(size_t)(nt * 64 + n) * K + kt * 64 + tx] = (half_t)tile[tx * 65 + n];
    }
  }
  base += tot;
}

DI void phase_norm(const float* xl, const float* xc, const float* gam, const float* mods_l, int sh_off,
                   int sc_off, half_t* h, bool skip_ctx, int wv_) {
  const int tid_ = tid_opaque(wv_);
  const int wave = tid_ >> 6, lane = tid_ & 63;
  for (int g = blockIdx.x * NWAVE + wave; g < NTOK; g += gridDim.x * NWAVE) {
    const int b = g / TOK, t = g - b * TOK;
    const bool isctx = t >= SEQ;
    if (isctx && skip_ctx) continue;
    const float* src = isctx ? xc + ((size_t)b * CTX + (t - SEQ)) * 1024 : xl + ((size_t)b * SEQ + t) * 1024;
    const float* mod = mods_l + (size_t)(isctx ? 16 : b) * 6144;
    float4 v[4];
    float ss = 0.f;
#pragma unroll
    for (int i = 0; i < 4; ++i) {
      v[i] = *(const float4*)(src + i * 256 + lane * 4);
      ss += v[i].x * v[i].x + v[i].y * v[i].y + v[i].z * v[i].z + v[i].w * v[i].w;
    }
    ss = wave_sum(ss);
    const float rstd = rsqrtf(ss * (1.f / 1024.f) + EPS);
#pragma unroll
    for (int i = 0; i < 4; ++i) {
      const int col = i * 256 + lane * 4;
      const float4 gg = *(const float4*)(gam + col);
      const float4 sc = *(const float4*)(mod + sc_off + col);
      const float4 sh = *(const float4*)(mod + sh_off + col);
      h4 o;
      o[0] = (half_t)(v[i].x * rstd * gg.x * (1.f + sc.x) + sh.x);
      o[1] = (half_t)(v[i].y * rstd * gg.y * (1.f + sc.y) + sh.y);
      o[2] = (half_t)(v[i].z * rstd * gg.z * (1.f + sc.z) + sh.z);
      o[3] = (half_t)(v[i].w * rstd * gg.w * (1.f + sc.w) + sh.w);
      *(h4*)(h + (size_t)g * 1024 + col) = o;
    }
  }
}

constexpr int BK = 64, HALF = 128, HTB = HALF * BK * 2;
DI int lds_byte(int r, int c) { const int st = (r >> 4) * 2 + (c >> 5), rr = r & 15, cc = c & 31, ob = rr * 64 + cc * 2; return st * 1024 + (ob ^ (((ob >> 9) & 1) << 5)); }
DI void stage_rc(int b, int& R, int& C) { const int st = b / 1024, sb = b % 1024, swz = sb ^ (((sb >> 9) & 1) << 5); R = (st >> 1) * 16 + swz / 64; C = (st & 1) * 32 + (swz % 64) / 2; }
DI int perm32(int rho) { const int n = rho >> 4, i = rho & 15; return 8 * (i >> 2) + 4 * n + (i & 3); }

struct GUnit { const char* A; const char* B; int nt, pm, pn, aux; };

DI bool tile_map(int L, int nM, int nN, int& pm, int& pn) {
  const int nwg = nM * nN;
  if (L >= nwg) return false;
  int wgid = L;
  { const int q = nwg / 8, r = nwg % 8, xcd = wgid % 8, off = wgid / 8; wgid = (xcd < r ? xcd * (q + 1) : r * (q + 1) + (xcd - r) * q) + off; }
  const int nig = 8 * nN, gid = wgid / nig, fm = gid * 8, gsz = (nM - fm) < 8 ? (nM - fm) : 8;
  pm = fm + ((wgid % nig) % gsz); pn = (wgid % nig) / gsz;
  return true;
}

template <bool PERM, class Sched, class Epi>
DI void gemm256(LAS unsigned char* lds, const Sched& S, const Epi& E, int wv_) {
  const int tid = tid_opaque(wv_), wid = __builtin_amdgcn_readfirstlane(tid >> 6), lane = tid & 63, wr = wid >> 2, wc = wid & 3, fr = lane & 15, fq = lane >> 4;
  unsigned cvA0, cvA1, cvB0, cvB1;
  { int R, C;
    stage_rc(tid * 16, R, C); cvA0 = (unsigned)R * S.lda2 + C * 2; cvB0 = (unsigned)(PERM ? ((R & ~31) + perm32(R & 31)) : R) * S.ldb2 + C * 2;
    stage_rc(tid * 16 + 8192, R, C); cvA1 = (unsigned)R * S.lda2 + C * 2; cvB1 = (unsigned)(PERM ? ((R & ~31) + perm32(R & 31)) : R) * S.ldb2 + C * 2; }
  const size_t chA = (size_t)HALF * S.lda2, chB = (size_t)HALF * S.ldb2;
  const size_t kstep = (size_t)(BK * 2);
  const unsigned ldsw = (unsigned)wid * 1024u;
  const int aoff = lds_byte(wr * 64 + fr, fq * 8), boff = lds_byte(wc * 32 + fr, fq * 8);
#define G_SA(b, h) (((b) * 2 + (h)) * HTB)
#define G_SB(b, h) ((4 + (b) * 2 + (h)) * HTB)
#define G_STAGE(bufoff, gbase, v0, v1) do { \
    __builtin_amdgcn_global_load_lds((const unsigned*)((const char*)(gbase) + (v0)), (LAS unsigned*)(lds + (bufoff) + ldsw), 16, 0, 0); \
    __builtin_amdgcn_global_load_lds((const unsigned*)((const char*)(gbase) + (v1)), (LAS unsigned*)(lds + (bufoff) + ldsw + 8192), 16, 0, 0); } while (0)
#define G_LDA(dst, b, h) do { _Pragma("unroll") for (int m = 0; m < 4; ++m) _Pragma("unroll") for (int k = 0; k < 2; ++k) dst[m][k] = *(const LAS h8*)(lds + G_SA(b, h) + aoff + m * 2048 + k * 1024); } while (0)
#define G_LDB(dst, b, h) do { _Pragma("unroll") for (int n = 0; n < 2; ++n) _Pragma("unroll") for (int k = 0; k < 2; ++k) dst[n][k] = *(const LAS h8*)(lds + G_SB(b, h) + boff + n * 2048 + k * 1024); } while (0)
#define G_MMA(ai, bj, At, Bt) do { __builtin_amdgcn_s_setprio(1); _Pragma("unroll") for (int m = 0; m < 4; ++m) _Pragma("unroll") for (int n = 0; n < 2; ++n) _Pragma("unroll") for (int k = 0; k < 2; ++k) \
    acc[ai][bj][m][n] = __builtin_amdgcn_mfma_f32_16x16x32_f16(Bt[n][k], At[m][k], acc[ai][bj][m][n], 0, 0, 0); __builtin_amdgcn_s_setprio(0); } while (0)
#define G_WAIT_V(n) asm volatile("s_waitcnt vmcnt(" #n ")" ::: "memory")
#define G_WAIT_L(n) asm volatile("s_waitcnt lgkmcnt(" #n ")" ::: "memory")
#define G_BAR __builtin_amdgcn_s_barrier()
#define G_SCHED __builtin_amdgcn_sched_barrier(0)
  GUnit cur, nxt;
  int ui = 0;
  if (!S.next(0, cur)) return;
  f4 acc[2][2][4][2];
#pragma unroll
  for (int a = 0; a < 2; ++a)
#pragma unroll
    for (int b = 0; b < 2; ++b)
#pragma unroll
      for (int m = 0; m < 4; ++m)
#pragma unroll
        for (int n = 0; n < 2; ++n) acc[a][b][m][n] = f4{0.f, 0.f, 0.f, 0.f};
  h8 At[4][2], B0[2][2], B1[2][2];
  const char* cA = cur.A;
  const char* cB = cur.B;
  G_STAGE(G_SB(0, 0), cB, cvB0, cvB1); G_STAGE(G_SA(0, 0), cA, cvA0, cvA1); G_STAGE(G_SB(0, 1), cB + chB, cvB0, cvB1); G_STAGE(G_SA(0, 1), cA + chA, cvA0, cvA1);
  if (wr == 1) G_BAR;
  G_WAIT_V(4); G_BAR;
  G_STAGE(G_SB(1, 0), cB + kstep, cvB0, cvB1); G_STAGE(G_SA(1, 0), cA + kstep, cvA0, cvA1); G_STAGE(G_SB(1, 1), cB + chB + kstep, cvB0, cvB1);
  G_WAIT_V(6); G_BAR;
  for (;;) {
    const bool has_next = S.next(ui + 1, nxt);
    const char* nA = has_next ? nxt.A : cA;
    const char* nB = has_next ? nxt.B : cB;
    int nt = cur.nt;
    asm volatile("" : "+s"(nt));
    for (int t = 0; t < nt; t += 2) {
      const bool last = (t == nt - 2);
      const char* a1 = cA + (size_t)(t + 1) * kstep;
      const char* a2 = last ? nA : cA + (size_t)(t + 2) * kstep;
      const char* b2 = last ? nB : cB + (size_t)(t + 2) * kstep;
      const char* a3 = a2 + kstep;
      const char* b3 = b2 + kstep;
      G_LDB(B0, 0, 0); G_SCHED; G_LDA(At, 0, 0); G_STAGE(G_SA(1, 1), a1 + chA, cvA0, cvA1);
      G_WAIT_L(8); G_BAR; G_WAIT_L(0); G_MMA(0, 0, At, B0); G_BAR; G_SCHED;
      G_LDB(B1, 0, 1); G_STAGE(G_SB(0, 0), b2, cvB0, cvB1);
      G_BAR; G_WAIT_L(0); G_MMA(0, 1, At, B1); G_BAR;
      G_LDA(At, 0, 1); G_STAGE(G_SA(0, 0), a2, cvA0, cvA1);
      G_BAR; G_WAIT_L(0); G_MMA(1, 0, At, B0); G_BAR; G_SCHED;
      G_STAGE(G_SB(0, 1), b2 + chB, cvB0, cvB1);
      G_WAIT_V(6); G_BAR; G_MMA(1, 1, At, B1); G_BAR;
      G_LDB(B0, 1, 0); G_SCHED; G_LDA(At, 1, 0); G_STAGE(G_SA(0, 1), a2 + chA, cvA0, cvA1);
      G_WAIT_L(8); G_BAR; G_WAIT_L(0); G_MMA(0, 0, At, B0); G_BAR; G_SCHED;
      G_LDB(B1, 1, 1); G_STAGE(G_SB(1, 0), b3, cvB0, cvB1);
      G_BAR; G_WAIT_L(0); G_MMA(0, 1, At, B1); G_BAR;
      G_LDA(At, 1, 1); G_STAGE(G_SA(1, 0), a3, cvA0, cvA1);
      G_BAR; G_WAIT_L(0); G_MMA(1, 0, At, B0); G_BAR; G_SCHED;
      G_STAGE(G_SB(1, 1), b3 + chB, cvB0, cvB1);
      G_WAIT_V(6); G_BAR; G_MMA(1, 1, At, B1); G_BAR;
    }
    E(acc, cur, wr, wc, fr, fq);
    if (!has_next) break;
#pragma unroll
    for (int a = 0; a < 2; ++a)
#pragma unroll
      for (int b = 0; b < 2; ++b)
#pragma unroll
        for (int m = 0; m < 4; ++m)
#pragma unroll
          for (int n = 0; n < 2; ++n) acc[a][b][m][n] = f4{0.f, 0.f, 0.f, 0.f};
    cur = nxt; cA = nA; cB = nB; ++ui;
  }
  G_WAIT_V(0);
  if (wr == 0) G_BAR;
  G_BAR;
#undef G_SA
#undef G_SB
#undef G_STAGE
#undef G_LDA
#undef G_LDB
#undef G_MMA
#undef G_WAIT_V
#undef G_WAIT_L
#undef G_BAR
#undef G_SCHED
}

DI h8 pack8(const f4& a, const f4& b) {
  h8 o;
  o[0] = (half_t)a[0]; o[1] = (half_t)a[1]; o[2] = (half_t)a[2]; o[3] = (half_t)a[3];
  o[4] = (half_t)b[0]; o[5] = (half_t)b[1]; o[6] = (half_t)b[2]; o[7] = (half_t)b[3];
  return o;
}
DI int row0_of(int pm, int mode) { return mode == 0 ? pm * 256 : (mode == 1 ? (pm >> 3) * TOK + (pm & 7) * 256 : pm * TOK + SEQ); }

struct SchedInproj {
  const half_t* hbuf; const half_t* Wl; int G, c;
  static constexpr unsigned lda2 = 2048, ldb2 = 2048;
  DI bool next(int i, GUnit& u) const {
    const int L = i * G + c;
    u.nt = 16;
    if (L < 144 * 8) {
      tile_map(L, 144, 8, u.pm, u.pn);
      u.A = (const char*)(hbuf + (size_t)u.pm * 256 * 1024); u.B = (const char*)(Wl + W_QK + (size_t)u.pn * 256 * 1024); u.aux = 0;
      return true;
    }
    if (!tile_map(L - 144 * 8, 3, 144, u.pm, u.pn)) return false;
    u.A = (const char*)(Wl + W_V + (size_t)u.pm * 256 * 1024); u.B = (const char*)(hbuf + (size_t)u.pn * 256 * 1024); u.aux = 1;
    return true;
  }
};
struct EpiInproj {
  half_t* big;
  DI void operator()(const f4 (&acc)[2][2][4][2], const GUnit& u, int wr, int wc, int fr, int fq) const {
    if (u.aux == 0) {
      const int g0 = u.pm * 256, b = g0 / TOK, t0 = g0 - b * TOK + wr * 64;
#pragma unroll
      for (int bj = 0; bj < 2; ++bj) {
        const int cb = u.pn * 256 + bj * 128 + wc * 32;
        half_t* ptr; int ts;
        if (cb < 576) { ptr = big + B_ZMLA + (size_t)b * TOK * ZS + cb; ts = ZS; }
        else if (cb < 1088) { const int c = cb - 576, part = c >> 8, hh = (c >> 6) & 3; ptr = big + (part ? B_KNA : B_QNA) + (size_t)(b * 4 + hh) * TOK * 64 + (c & 63); ts = 64; }
        else if (cb < 1600) { const int c = cb - 1088, part = c >> 8, hm = (c >> 5) & 7; ptr = big + (part ? B_KDF : B_QDF) + (size_t)(b * 8 + hm) * TOK * 32; ts = 32; }
        else if (cb < 1856) { const int c = cb - 1600; ptr = big + B_QG + (size_t)(b * 4 + (c >> 6)) * TOK * 64 + (c & 63); ts = 64; }
        else if (cb < 1984) { const int c = cb - 1856; ptr = big + B_KG + (size_t)(b * 2 + (c >> 6)) * TOK * 64 + (c & 63); ts = 64; }
        else continue;
        const unsigned lo = (unsigned)(fr * ts + 8 * fq) * 2u;
        char* rb = (char*)(ptr + (size_t)t0 * ts);
#pragma unroll
        for (int ai = 0; ai < 2; ++ai)
#pragma unroll
          for (int m = 0; m < 4; ++m)
            *(h8*)(rb + (size_t)((ai * 128 + m * 16) * ts) * 2 + lo) = pack8(acc[ai][bj][m][0], acc[ai][bj][m][1]);
      }
    } else {
      const int g0 = u.pn * 256, b = g0 / TOK, t0 = g0 - b * TOK;
      const int nh = (u.pm == 2) ? 2 : 4;
      char* vt = (char*)(big + (u.pm == 0 ? B_VTNA : (u.pm == 1 ? B_VTDF : B_VTG)) + (size_t)b * nh * 64 * TOK + (size_t)(wr * 64) * TOK + t0 + wc * 32);
      const unsigned lo = (unsigned)(fr * TOK + 8 * fq) * 2u;
#pragma unroll
      for (int ai = 0; ai < 2; ++ai) {
        if (u.pm == 2 && ai == 1) continue;
#pragma unroll
        for (int m = 0; m < 4; ++m)
#pragma unroll
          for (int bj = 0; bj < 2; ++bj)
            *(h8*)(vt + ((size_t)(ai * 128 + m * 16) * TOK + bj * 128) * 2 + lo) = pack8(acc[ai][bj][m][0], acc[ai][bj][m][1]);
      }
    }
  }
};

struct SchedMlaQK {
  const half_t* Wl; const half_t* zmla; int G, c;
  static constexpr unsigned lda2 = ZS * 2, ldb2 = 512;
  DI bool next(int i, GUnit& u) const {
    const int L = i * G + c;
    u.nt = 4;
    if (L < 288) {
      tile_map(L, 144, 2, u.pm, u.pn);
      u.A = (const char*)(zmla + (size_t)u.pm * 256 * ZS);
      u.B = (const char*)(Wl + W_UQ + (size_t)u.pn * 256 * 256); u.aux = 0;
      return true;
    }
    if (L < 432) {
      u.pm = L - 288; u.pn = 0;
      u.A = (const char*)(zmla + 256 + (size_t)u.pm * 256 * ZS);
      u.B = (const char*)(Wl + W_UK); u.aux = 1;
      return true;
    }
    return false;
  }
};
struct SchedMlaV {
  const half_t* Wl; const half_t* zmla; int G, c;
  static constexpr unsigned lda2 = 512, ldb2 = ZS * 2;
  DI bool next(int i, GUnit& u) const {
    const int L = i * G + c;
    if (L >= 144) return false;
    u.nt = 4; u.pm = 0; u.pn = L;
    u.A = (const char*)(Wl + W_UV);
    u.B = (const char*)(zmla + 256 + (size_t)u.pn * 256 * ZS); u.aux = 2;
    return true;
  }
};
struct EpiMla {
  half_t* big;
  DI void operator()(const f4 (&acc)[2][2][4][2], const GUnit& u, int wr, int wc, int fr, int fq) const {
    if (u.aux < 2) {
      const int g0 = u.pm * 256, b = g0 / TOK, t0 = g0 - b * TOK + wr * 64;
      const unsigned lo = (unsigned)(fr * 96 + 8 * fq) * 2u;
#pragma unroll
      for (int bj = 0; bj < 2; ++bj) {
        const int cb = u.pn * 256 + bj * 128 + wc * 32;
        half_t* ptr;
        if (u.aux == 0) {
          if (cb >= 384) continue;
          const int hh = cb / 96, dd = cb - hh * 96;
          ptr = big + B_QM + (size_t)(b * 4 + hh) * TOK * 96 + dd;
        } else {
          ptr = big + B_KM + (size_t)(b * 4 + (cb >> 6)) * TOK * 96 + (cb & 63);
        }
        char* rb = (char*)(ptr + (size_t)t0 * 96);
#pragma unroll
        for (int ai = 0; ai < 2; ++ai)
#pragma unroll
          for (int m = 0; m < 4; ++m)
            *(h8*)(rb + (size_t)((ai * 128 + m * 16) * 96) * 2 + lo) = pack8(acc[ai][bj][m][0], acc[ai][bj][m][1]);
      }
    } else {
      const int g0 = u.pn * 256, b = g0 / TOK, t0 = g0 - b * TOK;
      char* vt = (char*)(big + B_VTM + (size_t)b * 4 * 64 * TOK + (size_t)(wr * 64) * TOK + t0 + wc * 32);
      const unsigned lo = (unsigned)(fr * TOK + 8 * fq) * 2u;
#pragma unroll
      for (int ai = 0; ai < 2; ++ai)
#pragma unroll
        for (int m = 0; m < 4; ++m)
#pragma unroll
          for (int bj = 0; bj < 2; ++bj)
            *(h8*)(vt + ((size_t)(ai * 128 + m * 16) * TOK + bj * 128) * 2 + lo) = pack8(acc[ai][bj][m][0], acc[ai][bj][m][1]);
    }
  }
};

struct SchedRows {
  const half_t* A; const half_t* B; int K, nM, nN, G, c; bool skip_ctx; unsigned lda2, ldb2;
  DI bool next(int i, GUnit& u) const {
    if (!tile_map(i * G + c, nM, nN, u.pm, u.pn)) return false;
    u.A = (const char*)(A + (size_t)row0_of(u.pm, skip_ctx) * K); u.B = (const char*)(B + (size_t)u.pn * 256 * K);
    u.nt = K >> 6; u.aux = 0;
    return true;
  }
};
struct EpiResid {
  const float* xl_src; const float* xc_src; float* xl_dst; float* xc_dst; const float* mods_l; int gt_off; bool skip_ctx;
  DI void operator()(const f4 (&acc)[2][2][4][2], const GUnit& u, int wr, int wc, int fr, int fq) const {
    const int g0 = row0_of(u.pm, skip_ctx), b = g0 / TOK, t0 = g0 - b * TOK;
    const bool isctx = t0 >= SEQ;
    const int col0 = u.pn * 256 + wc * 32;
    const size_t rowoff = (size_t)(wr * 64) * 1024 + col0;
    const char* src = (const char*)((isctx ? xc_src + ((size_t)b * CTX + (t0 - SEQ)) * 1024 : xl_src + ((size_t)b * SEQ + t0) * 1024) + rowoff);
    char* dst = (char*)((isctx ? xc_dst + ((size_t)b * CTX + (t0 - SEQ)) * 1024 : xl_dst + ((size_t)b * SEQ + t0) * 1024) + rowoff);
    const char* gt = (const char*)(mods_l + (size_t)(isctx ? 16 : b) * 6144 + gt_off + col0);
    const unsigned lo = (unsigned)(fr * 1024 + 4 * fq) * 4u, glo = (unsigned)(4 * fq) * 4u;
    f4 gv[2][2];
#pragma unroll
    for (int bj = 0; bj < 2; ++bj)
#pragma unroll
      for (int n = 0; n < 2; ++n) gv[bj][n] = *(const f4*)(gt + (bj * 128 + n * 16) * 4 + glo);
#pragma unroll
    for (int ai = 0; ai < 2; ++ai)
#pragma unroll
      for (int m = 0; m < 4; ++m)
#pragma unroll
        for (int bj = 0; bj < 2; ++bj)
#pragma unroll
          for (int n = 0; n < 2; ++n) {
            const size_t uo = ((size_t)(ai * 128 + m * 16) * 1024 + bj * 128 + n * 16) * 4;
            const f4 xv = *(const f4*)(src + uo + lo);
            *(f4*)(dst + uo + lo) = xv + gv[bj][n] * acc[ai][bj][m][n];
          }
  }
};
struct EpiUp {
  half_t* ubuf; bool skip_ctx;
  DI void operator()(const f4 (&acc)[2][2][4][2], const GUnit& u, int wr, int wc, int fr, int fq) const {
    const int g0 = row0_of(u.pm, skip_ctx);
    char* rb = (char*)(ubuf + (size_t)(g0 + wr * 64) * 4096 + u.pn * 256 + wc * 32);
    const unsigned lo = (unsigned)(fr * 4096 + 8 * fq) * 2u;
#pragma unroll
    for (int ai = 0; ai < 2; ++ai)
#pragma unroll
      for (int m = 0; m < 4; ++m)
#pragma unroll
        for (int bj = 0; bj < 2; ++bj) {
          f4 a = acc[ai][bj][m][0], c = acc[ai][bj][m][1];
#pragma unroll
          for (int j = 0; j < 4; ++j) { a[j] = fmaxf(a[j], 0.f); a[j] *= a[j]; c[j] = fmaxf(c[j], 0.f); c[j] *= c[j]; }
          *(h8*)(rb + ((size_t)(ai * 128 + m * 16) * 4096 + bj * 128) * 2 + lo) = pack8(a, c);
        }
  }
};

template <int DLEN, int LPR, int ROPE, bool KR>
DI void norm_rows(half_t* base, int stride, int nrows, const float* gain, float oscale, const half_t* zmla, int wv_) {
  const int tid_ = tid_opaque(wv_);
  const int lane = tid_ & 63, wave = tid_ >> 6;
  constexpr int RPW = 64 / LPR;
  const int s = lane % LPR, sub = lane / LPR;
  const bool active = s * 8 < DLEN;
  float gn[8];
#pragma unroll
  for (int i = 0; i < 8; ++i) gn[i] = active ? gain[s * 8 + i] : 0.f;
  for (int r0 = (blockIdx.x * NWAVE + wave) * RPW; r0 < nrows; r0 += gridDim.x * NWAVE * RPW) {
    const int rho = r0 + sub;
    const int t = rho % TOK;
    half_t* ptr = base + (size_t)rho * stride + s * 8;
    const half_t* src = ptr;
    if (KR && s >= 8) {
      const int b = rho / (4 * TOK);
      src = zmla + ((size_t)b * TOK + t) * ZS + 512 + (s - 8) * 8;
    }
    float f[8];
    float ss = 0.f;
    if (active) {
      const h8 v = *(const h8*)src;
#pragma unroll
      for (int i = 0; i < 8; ++i) { f[i] = (float)v[i]; ss += f[i] * f[i]; }
    } else {
#pragma unroll
      for (int i = 0; i < 8; ++i) f[i] = 0.f;
    }
#pragma unroll
    for (int o = LPR / 2; o > 0; o >>= 1) ss += __shfl_xor(ss, o);
    const float rstd = rsqrtf(ss * (1.f / DLEN) + EPS);
#pragma unroll
    for (int i = 0; i < 8; ++i) f[i] = f[i] * rstd * gn[i];
    if (ROPE != 0) {
      constexpr int PX = (ROPE == 64) ? 2 : 1;
      float pf[8];
#pragma unroll
      for (int i = 0; i < 8; ++i) pf[i] = __shfl_xor(f[i], PX);
      constexpr int RB = (DLEN - ROPE) / 8;
      if (t < SEQ && s >= RB && active) {
        const int sr = s - RB;
        const int q = (ROPE == 64) ? (sr >> 1) : sr;
        const float pos = (float)((q < 2) ? (t >> 6) : (t & 63));
        const float sgn = (q & 1) ? 1.f : -1.f;
#pragma unroll
        for (int i = 0; i < 8; ++i) {
          const int idx = (ROPE == 64) ? ((sr & 1) * 8 + i) : i;
          constexpr float NF = (ROPE == 64) ? 16.f : 8.f;
          const float invf = exp2f(-(float)idx * (13.287712379549449f / NF));
          const float ang = pos * invf;
          float sn, cs;
          sincosf(ang, &sn, &cs);
          f[i] = f[i] * cs + sgn * pf[i] * sn;
        }
      }
    }
    if (active) {
      h8 o;
#pragma unroll
      for (int i = 0; i < 8; ++i) o[i] = (half_t)(f[i] * oscale);
      *(h8*)ptr = o;
    }
  }
}

constexpr int ATT_STAGE = 22528, ATT_VOFF = 13312, ATT_STASH = 49152;
template <int DQ, bool NA, int NQG>
DI void attn_wg(const half_t* Qp, const half_t* Kp, const half_t* Vp, int q0, bool active, int seg0_start, int seg0_tiles,
                int seg1_start, int seg1_tiles, const float* rpb_h, int rq, char* smem, int tid, f16v (&O)[2][NQG]) {
  constexpr int NKS = DQ / 16, KSTR = DQ + 8, VSTR = 72, CPK = DQ / 8, KCH = 64 * CPK;
  const int lane = tid & 63, r = lane & 31, h = lane >> 5;
  h8 qf[NQG][NKS];
#pragma unroll
  for (int qg = 0; qg < NQG; ++qg)
#pragma unroll
    for (int ks = 0; ks < NKS; ++ks) qf[qg][ks] = *(const h8*)(Qp + (size_t)(q0 + qg * 32 + r) * DQ + ks * 16 + h * 8);
  float mrun[NQG], lrun[NQG];
#pragma unroll
  for (int qg = 0; qg < NQG; ++qg) { mrun[qg] = -1e30f; lrun[qg] = 0.f; }
#pragma unroll
  for (int a = 0; a < 2; ++a)
#pragma unroll
    for (int c = 0; c < NQG; ++c)
#pragma unroll
      for (int i = 0; i < 16; ++i) O[a][c][i] = 0.f;
  const int ntiles = seg0_tiles + seg1_tiles;
  const int kc0 = tid, kc1 = tid + 512;
  const half_t* kg0 = Kp + kc0 * 8;
  const half_t* kg1 = Kp + kc1 * 8;
  const half_t* vg = Vp + (size_t)(tid >> 3) * TOK + (tid & 7) * 8;
  const int ks0 = (kc0 / CPK) * KSTR + (kc0 % CPK) * 8, ks1 = (kc1 / CPK) * KSTR + (kc1 % CPK) * 8, vs0 = (tid >> 3) * VSTR + (tid & 7) * 8;
  uint4 kreg0 = {0, 0, 0, 0}, kreg1 = {0, 0, 0, 0}, vreg;
  const int r0w = min(max(rq - 4, 0), 24);
  {
    const int k0 = (0 < seg0_tiles) ? seg0_start : seg1_start;
    if (kc0 < KCH) kreg0 = *(const uint4*)(kg0 + (size_t)k0 * DQ);
    if (DQ == 96 && kc1 < KCH) kreg1 = *(const uint4*)(kg1 + (size_t)k0 * DQ);
    vreg = *(const uint4*)(vg + k0);
    if (kc0 < KCH) *(uint4*)((half_t*)smem + ks0) = kreg0;
    if (DQ == 96 && kc1 < KCH) *(uint4*)((half_t*)smem + ks1) = kreg1;
    *(uint4*)((half_t*)(smem + ATT_VOFF) + vs0) = vreg;
  }
  __syncthreads();
  for (int it = 0; it < ntiles; ++it) {
    const int k0 = (it < seg0_tiles) ? seg0_start + it * 64 : seg1_start + (it - seg0_tiles) * 64;
    const bool more = it + 1 < ntiles;
    if (more) {
      const int itn = it + 1;
      const int k1 = (itn < seg0_tiles) ? seg0_start + itn * 64 : seg1_start + (itn - seg0_tiles) * 64;
      if (kc0 < KCH) kreg0 = *(const uint4*)(kg0 + (size_t)k1 * DQ);
      if (DQ == 96 && kc1 < KCH) kreg1 = *(const uint4*)(kg1 + (size_t)k1 * DQ);
      vreg = *(const uint4*)(vg + k1);
    }
    const half_t* ksm = (const half_t*)(smem + (it & 1) * ATT_STAGE) + r * KSTR + h * 8;
    const half_t* vsm = (const half_t*)(smem + (it & 1) * ATT_STAGE + ATT_VOFF) + r * VSTR + h * 4;
    const bool masked = NA && it < seg0_tiles;
    const int krow = k0 >> 6;
    const bool need = active && (!masked || (krow >= r0w && krow < r0w + 8));
    if (need) {
#pragma unroll 1
      for (int st = 0; st < 2; ++st) {
        f16v S[NQG];
#pragma unroll
        for (int qg = 0; qg < NQG; ++qg)
#pragma unroll
          for (int i = 0; i < 16; ++i) S[qg][i] = 0.f;
#pragma unroll
        for (int ks = 0; ks < NKS; ++ks) {
          const h8 kf = *(const h8*)(ksm + (st * 32) * KSTR + ks * 16);
#pragma unroll
          for (int qg = 0; qg < NQG; ++qg) S[qg] = __builtin_amdgcn_mfma_f32_32x32x16_f16(kf, qf[qg][ks], S[qg], 0, 0, 0);
        }
        if (masked) {
          const int cb = st * 32;
          const int dr = krow - rq + 7;
#pragma unroll
          for (int qg = 0; qg < NQG; ++qg) {
            const int qc = qg * 32 + r;
            const int cs = min(max(qc - 8, 0), 48);
#pragma unroll
            for (int i = 0; i < 16; ++i) {
              const int c = cb + (i & 3) + 8 * (i >> 2) + 4 * h;
              const bool valid = (c >= cs) && (c < cs + 16);
              float bias = 0.f;
              if (valid) bias = rpb_h[dr * 31 + (c - qc + 15)] * LOG2E;
              S[qg][i] = valid ? S[qg][i] + bias : -1e30f;
            }
          }
        }
        h4 vf[2][2][2];
#pragma unroll
        for (int dvt = 0; dvt < 2; ++dvt)
#pragma unroll
          for (int sx = 0; sx < 2; ++sx)
#pragma unroll
            for (int hf = 0; hf < 2; ++hf) vf[dvt][sx][hf] = *(const h4*)(vsm + (dvt * 32) * VSTR + st * 32 + sx * 16 + hf * 8);
#pragma unroll
        for (int qg = 0; qg < NQG; ++qg) {
          h8 P[2];
          float mx = S[qg][0];
#pragma unroll
          for (int i = 1; i < 16; ++i) mx = fmaxf(mx, S[qg][i]);
          mx = fmaxf(mx, __shfl_xor(mx, 32));
          const float mn = fmaxf(mrun[qg], mx);
          const float alpha = __builtin_amdgcn_exp2f(mrun[qg] - mn);
          mrun[qg] = mn;
          float rs = 0.f;
#pragma unroll
          for (int i = 0; i < 16; ++i) {
            float pv = __builtin_amdgcn_exp2f(S[qg][i] - mn);
            if (NA) pv = (S[qg][i] <= -1e29f) ? 0.f : pv;
            rs += pv;
            P[i >> 3][i & 7] = (half_t)pv;
          }
          lrun[qg] = lrun[qg] * alpha + rs;
#pragma unroll
          for (int dvt = 0; dvt < 2; ++dvt) {
#pragma unroll
            for (int i = 0; i < 16; ++i) O[dvt][qg][i] *= alpha;
#pragma unroll
            for (int sx = 0; sx < 2; ++sx) {
              const h8 va = __builtin_shufflevector(vf[dvt][sx][0], vf[dvt][sx][1], 0, 1, 2, 3, 4, 5, 6, 7);
              O[dvt][qg] = __builtin_amdgcn_mfma_f32_32x32x16_f16(va, P[sx], O[dvt][qg], 0, 0, 0);
            }
          }
        }
      }
    }
    if (more) {
      char* nb = smem + ((it + 1) & 1) * ATT_STAGE;
      if (kc0 < KCH) *(uint4*)((half_t*)nb + ks0) = kreg0;
      if (DQ == 96 && kc1 < KCH) *(uint4*)((half_t*)nb + ks1) = kreg1;
      *(uint4*)((half_t*)(nb + ATT_VOFF) + vs0) = vreg;
    }
    __syncthreads();
  }
#pragma unroll
  for (int qg = 0; qg < NQG; ++qg) {
    const float lt = lrun[qg] + __shfl_xor(lrun[qg], 32);
    const float inv = 1.f / lt;
#pragma unroll
    for (int dvt = 0; dvt < 2; ++dvt)
#pragma unroll
      for (int i = 0; i < 16; ++i) O[dvt][qg][i] *= inv;
  }
}

template <int NQG>
DI void store_o(const f16v (&O)[2][NQG], half_t* orow0  , int lane) {
  const int r = lane & 31, h = lane >> 5;
#pragma unroll
  for (int qg = 0; qg < NQG; ++qg)
#pragma unroll
    for (int dvt = 0; dvt < 2; ++dvt)
#pragma unroll
      for (int c = 0; c < 4; ++c) {
        h4 o;
#pragma unroll
        for (int j = 0; j < 4; ++j) o[j] = (half_t)O[dvt][qg][4 * c + j];
        *(h4*)(orow0 + (size_t)(qg * 32 + r) * 1024 + dvt * 32 + 8 * c + 4 * h) = o;
      }
}

DI void phase_attn(int l, half_t* big, bool need_ctx, char* smem, int wv_) {
  const KPtr p = kp();
  const int wave = wv_;
  const int NQB = need_ctx ? 5 : 4;
  half_t* obuf = big + B_O;
  const float lam_init = 0.8f - 0.6f * expf(-0.3f * (float)l);
  float lam;
  {
    float d1 = 0.f, d2 = 0.f;
#pragma unroll 1
    for (int i = 0; i < 32; ++i) {
      d1 += p->lq1[l * 32 + i] * p->lk1[l * 32 + i];
      d2 += p->lq2[l * 32 + i] * p->lk2[l * 32 + i];
    }
    lam = expf(d1) - expf(d2) + lam_init;
    lam = __builtin_bit_cast(float, __builtin_amdgcn_readfirstlane(__builtin_bit_cast(int, lam)));
  }
  const float one_m_li = __builtin_bit_cast(float, __builtin_amdgcn_readfirstlane(__builtin_bit_cast(int, 1.f - lam_init)));
  const int per = 4 * 16 * NQB;
#pragma unroll
  for (int mixer = 0; mixer < 4; ++mixer) {
    const int lo = mixer * per;
    const int first = lo + (int)((blockIdx.x + gridDim.x - (lo % gridDim.x)) % gridDim.x);
    const int tid_m = tid_opaque(wv_);
    const int lane = tid_m & 63, h = lane >> 5;
#pragma unroll 1
    for (int item = first; item < lo + per; item += gridDim.x) {
      const int hi = item / (16 * NQB);
      const int rem = item - hi * 16 * NQB;
      const int b = rem / NQB, qb = rem - b * NQB;
      const bool qctx = qb == 4;
      const bool active = !qctx || wave < 4;
      const int q0 = active ? qb * 512 + wave * 64 : SEQ;
      const int hh = hi & 3;
      const int s0 = qctx ? SEQ : 0, n0t = qctx ? 4 : 36;
      f16v O[2][2];
      half_t* orow = obuf + (size_t)(b * TOK + q0) * 1024 + hh * 64;
      if (mixer == 0) {
        half_t* stash = (half_t*)(smem + ATT_STASH) + wave * 4096;
        attn_wg<32, false, 2>(big + B_QDF + (size_t)(b * 8 + hh * 2) * TOK * 32, big + B_KDF + (size_t)(b * 8 + hh * 2) * TOK * 32,
                              big + B_VTDF + (size_t)(b * 4 + hh) * 64 * TOK, q0, active, s0, n0t, 0, 0, nullptr, 0, smem, tid_m, O);
#pragma unroll
        for (int dvt = 0; dvt < 2; ++dvt)
#pragma unroll
          for (int qg = 0; qg < 2; ++qg)
#pragma unroll
            for (int i = 0; i < 16; ++i) stash[((dvt * 2 + qg) * 16 + i) * 64 + lane] = (half_t)O[dvt][qg][i];
        attn_wg<32, false, 2>(big + B_QDF + (size_t)(b * 8 + hh * 2 + 1) * TOK * 32, big + B_KDF + (size_t)(b * 8 + hh * 2 + 1) * TOK * 32,
                              big + B_VTDF + (size_t)(b * 4 + hh) * 64 * TOK, q0, active, s0, n0t, 0, 0, nullptr, 0, smem, tid_m, O);
#pragma unroll
        for (int qg = 0; qg < 2; ++qg) {
          float ss = 0.f;
#pragma unroll
          for (int dvt = 0; dvt < 2; ++dvt)
#pragma unroll
            for (int i = 0; i < 16; ++i) {
              const float v = (float)stash[((dvt * 2 + qg) * 16 + i) * 64 + lane] - lam * O[dvt][qg][i];
              O[dvt][qg][i] = v;
              ss += v * v;
            }
          ss += __shfl_xor(ss, 32);
          const float rstd = rsqrtf(ss * (1.f / 64.f) + EPS) * one_m_li;
#pragma unroll
          for (int dvt = 0; dvt < 2; ++dvt)
#pragma unroll
            for (int i = 0; i < 16; ++i) {
              const int dv = dvt * 32 + (i & 3) + 8 * (i >> 2) + 4 * h;
              O[dvt][qg][i] *= rstd * p->g_diff_sub[l * 64 + dv];
            }
        }
        if (active) store_o<2>(O, orow + 2 * 256, lane);
      } else if (mixer == 1) {
        attn_wg<96, false, 2>(big + B_QM + (size_t)(b * 4 + hh) * TOK * 96, big + B_KM + (size_t)(b * 4 + hh) * TOK * 96,
                              big + B_VTM + (size_t)(b * 4 + hh) * 64 * TOK, q0, active, s0, n0t, 0, 0, nullptr, 0, smem, tid_m, O);
        if (active) store_o<2>(O, orow + 0 * 256, lane);
      } else if (mixer == 2) {
        const int kv = hh >> 1;
        attn_wg<64, false, 2>(big + B_QG + (size_t)(b * 4 + hh) * TOK * 64, big + B_KG + (size_t)(b * 2 + kv) * TOK * 64,
                              big + B_VTG + (size_t)(b * 2 + kv) * 64 * TOK, q0, active, s0, n0t, 0, 0, nullptr, 0, smem, tid_m, O);
        if (active) store_o<2>(O, orow + 3 * 256, lane);
      } else {
        const int rq = q0 >> 6;
        const int rq0 = qb * 8;
        const int rlo = min(max(rq0 - 4, 0), 24), rhi = min(max(rq0 + 7 - 4, 0), 24) + 8;
        const int seg0s = rlo * 64, seg0n = qctx ? 0 : (rhi - rlo);
        attn_wg<64, true, 2>(big + B_QNA + (size_t)(b * 4 + hh) * TOK * 64, big + B_KNA + (size_t)(b * 4 + hh) * TOK * 64,
                             big + B_VTNA + (size_t)(b * 4 + hh) * 64 * TOK, q0, active, seg0s, seg0n, SEQ, 4,
                             p->na_rpb + (size_t)(l * 4 + hh) * 15 * 31, rq, smem, tid_m, O);
        if (active) store_o<2>(O, orow + 1 * 256, lane);
      }
    }
  }
}

struct SchedGate {
  const half_t* hbuf; const half_t* Wl; int pm0, cnt, G, c, mode;
  static constexpr unsigned lda2 = 2048, ldb2 = 2048;
  DI bool next(int i, GUnit& u) const {
    int pm, pn;
    if (!tile_map(i * G + c, cnt, 16, pm, pn)) return false;
    u.pm = pm0 + pm; u.pn = pn; u.nt = 16; u.aux = 0;
    u.A = (const char*)(hbuf + (size_t)row0_of(u.pm, mode) * 1024); u.B = (const char*)(Wl + W_GATE + (size_t)pn * 256 * 1024);
    return true;
  }
};
struct EpiGate {
  half_t* gb; int pm0;
  DI void operator()(const f4 (&acc)[2][2][4][2], const GUnit& u, int wr, int wc, int fr, int fq) const {
    char* rb = (char*)(gb + (size_t)((u.pm - pm0) * 256 + wr * 64) * 4096 + u.pn * 256 + wc * 32);
    const unsigned lo = (unsigned)(fr * 4096 + 8 * fq) * 2u;
#pragma unroll
    for (int ai = 0; ai < 2; ++ai)
#pragma unroll
      for (int m = 0; m < 4; ++m)
#pragma unroll
        for (int bj = 0; bj < 2; ++bj) {
          f4 a = acc[ai][bj][m][0], c = acc[ai][bj][m][1];
#pragma unroll
          for (int j = 0; j < 4; ++j) { a[j] = __builtin_amdgcn_rcpf(1.f + __expf(-a[j])); c[j] = __builtin_amdgcn_rcpf(1.f + __expf(-c[j])); }
          *(h8*)(rb + ((size_t)(ai * 128 + m * 16) * 4096 + bj * 128) * 2 + lo) = pack8(a, c);
        }
  }
};
struct SchedProj {
  const half_t* obuf; const half_t* Wl; int pm0, cnt, G, c, mode;
  static constexpr unsigned lda2 = 2048, ldb2 = 512;
  DI bool next(int i, GUnit& u) const {
    int pm, pn;
    if (!tile_map((i >> 2) * G + c, cnt, 4, pm, pn)) return false;
    const int br = i & 3;
    u.pm = pm0 + pm; u.pn = pn; u.nt = 4; u.aux = br;
    u.A = (const char*)(obuf + (size_t)row0_of(u.pm, mode) * 1024 + br * 256);
    u.B = (const char*)(Wl + W_BR + (size_t)(br * 1024 + pn * 256) * 256);
    return true;
  }
};
struct EpiProj {
  const half_t* gb; half_t* mbuf; int pm0, mode;
  DI void operator()(const f4 (&acc)[2][2][4][2], const GUnit& u, int wr, int wc, int fr, int fq) const {
    const int br = u.aux;
    const char* gp = (const char*)(gb + (size_t)((u.pm - pm0) * 256 + wr * 64) * 4096 + br * 1024 + u.pn * 256 + wc * 32);
    char* mp = (char*)(mbuf + (size_t)(row0_of(u.pm, mode) + wr * 64) * 1024 + u.pn * 256 + wc * 32);
    const unsigned glo = (unsigned)(fr * 4096 + 8 * fq) * 2u, mlo = (unsigned)(fr * 1024 + 8 * fq) * 2u;
#pragma unroll
    for (int ai = 0; ai < 2; ++ai)
#pragma unroll
      for (int m = 0; m < 4; ++m)
#pragma unroll
        for (int bj = 0; bj < 2; ++bj) {
          const h8 g = *(const h8*)(gp + ((size_t)(ai * 128 + m * 16) * 4096 + bj * 128) * 2 + glo);
          char* ma = mp + ((size_t)(ai * 128 + m * 16) * 1024 + bj * 128) * 2 + mlo;
          f4 a = acc[ai][bj][m][0], c = acc[ai][bj][m][1];
#pragma unroll
          for (int j = 0; j < 4; ++j) { a[j] *= (float)g[j]; c[j] *= (float)g[4 + j]; }
          if (br > 0) {
            const h8 pv = *(const h8*)ma;
#pragma unroll
            for (int j = 0; j < 4; ++j) { a[j] += (float)pv[j]; c[j] += (float)pv[4 + j]; }
          }
          *(h8*)ma = pack8(a, c);
        }
  }
};

__global__ void __launch_bounds__(NTHR) hybrid_block_megakernel(Params p) {
  __shared__ __attribute__((aligned(16))) char smem[SMEM_BYTES];
  char* ws = kp()->ws;
  if (ws == nullptr) cg::this_grid().sync();
  half_t* W = (half_t*)(ws + OFF_W);
  float* mods = (float*)(ws + OFF_MOD);
  float* xc = (float*)(ws + OFF_XC);
  half_t* hbuf = (half_t*)(ws + OFF_H);
  half_t* big = (half_t*)(ws + OFF_BIG);
  LAS unsigned char* lds = (LAS unsigned char*)smem;
  const int G = gridDim.x, cblk = blockIdx.x;

  const int wv_ = __builtin_amdgcn_readfirstlane((int)threadIdx.x >> 6);
  volatile LAS unsigned* st = (volatile LAS unsigned*)(lds + GEMM_LDS);
  if (threadIdx.x < 4) st[threadIdx.x] = 0u;
  __syncthreads();
  xcd_barrier_post((unsigned*)(ws + OFF_BAR), wv_);

  phase_mods(mods, smem, wv_);
  {
    int base = 0;
    float* tile = (float*)smem;
    for (int l = 0; l < 2; ++l) {
      half_t* Wl = W + (size_t)l * W_LAYER;
      const float* win = kp()->w_in + (size_t)l * 1024 * 6496;
      tconv_job(win, 6496, 0, 1024, 1024, 192, 256, Wl + W_QK, base, tile, wv_);
      tconv_job(win, 6496, 192, 1024, 1024, 128, 256, Wl + W_QK + (size_t)256 * 1024, base, tile, wv_);
      tconv_job(win, 6496, 320, 1024, 1024, 32, 64, Wl + W_QK + (size_t)512 * 1024, base, tile, wv_);
      tconv_job(win, 6496, 352, 1024, 1024, 256, 256, Wl + W_QK + (size_t)576 * 1024, base, tile, wv_);
      tconv_job(win, 6496, 608, 1024, 1024, 256, 256, Wl + W_QK + (size_t)832 * 1024, base, tile, wv_);
      tconv_job(win, 6496, 1120, 1024, 1024, 256, 256, Wl + W_QK + (size_t)1088 * 1024, base, tile, wv_);
      tconv_job(win, 6496, 1376, 1024, 1024, 256, 256, Wl + W_QK + (size_t)1344 * 1024, base, tile, wv_);
      tconv_job(win, 6496, 1888, 1024, 1024, 256, 256, Wl + W_QK + (size_t)1600 * 1024, base, tile, wv_);
      tconv_job(win, 6496, 2144, 1024, 1024, 128, 192, Wl + W_QK + (size_t)1856 * 1024, base, tile, wv_);
      tconv_job(win, 6496, 864, 1024, 1024, 256, 256, Wl + W_V, base, tile, wv_);
      tconv_job(win, 6496, 1632, 1024, 1024, 256, 256, Wl + W_V + (size_t)256 * 1024, base, tile, wv_);
      tconv_job(win, 6496, 2272, 1024, 1024, 128, 256, Wl + W_V + (size_t)512 * 1024, base, tile, wv_);
      tconv_job(win, 6496, 2400, 1024, 1024, 4096, 4096, Wl + W_GATE, base, tile, wv_);
      for (int br = 0; br < 4; ++br)
        tconv_job(kp()->w_branch + ((size_t)l * 4 + br) * 256 * 1024, 1024, 0, 256, 256, 1024, 1024, Wl + W_BR + (size_t)br * 1024 * 256, base, tile, wv_);
      tconv_job(kp()->w_out + (size_t)l * 1024 * 1024, 1024, 0, 1024, 1024, 1024, 1024, Wl + W_OUT, base, tile, wv_);
      tconv_job(kp()->w_up + (size_t)l * 1024 * 4096, 4096, 0, 1024, 1024, 4096, 4096, Wl + W_UP, base, tile, wv_);
      tconv_job(kp()->w_down + (size_t)l * 4096 * 1024, 1024, 0, 4096, 4096, 1024, 1024, Wl + W_DOWN, base, tile, wv_);
      tconv_job(kp()->w_mla_uq + (size_t)l * 192 * 384, 384, 0, 256, 192, 384, 512, Wl + W_UQ, base, tile, wv_);
      for (int hh = 0; hh < 4; ++hh) {
        tconv_job(kp()->w_mla_ukv + (size_t)l * 128 * 512, 512, hh * 128, 256, 128, 64, 64, Wl + W_UK + (size_t)hh * 64 * 256, base, tile, wv_);
        tconv_job(kp()->w_mla_ukv + (size_t)l * 128 * 512, 512, hh * 128 + 64, 256, 128, 64, 64, Wl + W_UV + (size_t)hh * 64 * 256, base, tile, wv_);
      }
    }
  }
  xcd_barrier(ws, lds, wv_);

  for (int l = 0; l < 2; ++l) {
    const bool need_ctx = (l == 0);
    const bool skip_ctx = !need_ctx;
    const half_t* Wl = W + (size_t)l * W_LAYER;
    const float* mods_l = mods + (size_t)l * 17 * 6144;
    const float* xl_src = (l == 0) ? kp()->x : kp()->out;
    const float* xc_src = (l == 0) ? kp()->ctx : xc;
    const int nrt = skip_ctx ? 128 : 144;

    phase_norm(xl_src, xc_src, kp()->g_norm1 + l * 1024, mods_l, 0, 1024, hbuf, false, wv_);
    xcd_barrier(ws, lds, wv_);
    {
      SchedInproj S{hbuf, Wl, G, cblk};
      EpiInproj E{big};
      gemm256<true>(lds, S, E, wv_);
    }
    xcd_barrier(ws, lds, wv_);
    {
      half_t* zmla = big + B_ZMLA;
      norm_rows<192, 32, 0, false>(zmla, ZS, NTOK, kp()->g_mla_qa + l * 192, 1.f, nullptr, wv_);
      norm_rows<128, 16, 0, false>(zmla + 256, ZS, NTOK, kp()->g_mla_kva + l * 128, 1.f, nullptr, wv_);
      norm_rows<64, 8, 0, false>(big + B_QNA, 64, NTOK * 4, kp()->g_na_q + l * 64, 0.125f * LOG2E, nullptr, wv_);
      norm_rows<64, 8, 0, false>(big + B_KNA, 64, NTOK * 4, kp()->g_na_k + l * 64, 1.f, nullptr, wv_);
      norm_rows<32, 4, 32, false>(big + B_QDF, 32, NTOK * 8, kp()->g_diff_q + l * 32, 0.17677669529663687f * LOG2E, nullptr, wv_);
      norm_rows<32, 4, 32, false>(big + B_KDF, 32, NTOK * 8, kp()->g_diff_k + l * 32, 1.f, nullptr, wv_);
      norm_rows<64, 8, 64, false>(big + B_QG, 64, NTOK * 4, kp()->g_gqa_q + l * 64, 0.125f * LOG2E, nullptr, wv_);
      norm_rows<64, 8, 64, false>(big + B_KG, 64, NTOK * 2, kp()->g_gqa_k + l * 64, 1.f, nullptr, wv_);
    }
    xcd_barrier(ws, lds, wv_);
    {
      SchedMlaQK S{Wl, big + B_ZMLA, G, cblk};
      EpiMla E{big};
      gemm256<true>(lds, S, E, wv_);
      SchedMlaV S2{Wl, big + B_ZMLA, G, cblk};
      gemm256<true>(lds, S2, E, wv_);
    }
    xcd_barrier(ws, lds, wv_);
    norm_rows<96, 16, 32, false>(big + B_QM, 96, NTOK * 4, kp()->g_mla_q + l * 96, 0.10206207261596575f * LOG2E, nullptr, wv_);
    norm_rows<96, 16, 32, true>(big + B_KM, 96, NTOK * 4, kp()->g_mla_k + l * 96, 1.f, big + B_ZMLA, wv_);
    xcd_barrier(ws, lds, wv_);
    phase_attn(l, big, need_ctx, smem, wv_);
    xcd_barrier(ws, lds, wv_);
    {
      const int nsp = need_ctx ? 3 : 2;
      for (int j = 0; j < nsp; ++j) {
        const int mode = (j < 2) ? 1 : 2, pm0 = (j < 2) ? j * 64 : 0, cnt = (j < 2) ? 64 : 16;
        {
          SchedGate S{hbuf, Wl, pm0, cnt, G, cblk, mode};
          EpiGate E{big + B_G0, pm0};
          gemm256<true>(lds, S, E, wv_);
        }
        xcd_barrier(ws, lds, wv_);
        {
          SchedProj S{big + B_O, Wl, pm0, cnt, G, cblk, mode};
          EpiProj E{big + B_G0, big + B_M, pm0, mode};
          gemm256<true>(lds, S, E, wv_);
        }
        xcd_barrier(ws, lds, wv_);
      }
    }
    {
      SchedRows S{big + B_M, Wl + W_OUT, 1024, nrt, 4, G, cblk, skip_ctx, 2048u, 2048u};
      EpiResid E{xl_src, xc_src, kp()->out, xc, mods_l, 2048, skip_ctx};
      gemm256<false>(lds, S, E, wv_);
    }
    xcd_barrier(ws, lds, wv_);
    phase_norm(kp()->out, xc, kp()->g_norm2 + l * 1024, mods_l, 3072, 4096, hbuf, skip_ctx, wv_);
    xcd_barrier(ws, lds, wv_);
    {
      SchedRows S{hbuf, Wl + W_UP, 1024, nrt, 16, G, cblk, skip_ctx, 2048u, 2048u};
      EpiUp E{big + B_U, skip_ctx};
      gemm256<true>(lds, S, E, wv_);
    }
    xcd_barrier(ws, lds, wv_);
    {
      SchedRows S{big + B_U, Wl + W_DOWN, 4096, nrt, 4, G, cblk, skip_ctx, 8192u, 8192u};
      EpiResid E{kp()->out, xc, kp()->out, xc, mods_l, 5120, skip_ctx};
      gemm256<false>(lds, S, E, wv_);
    }
    if (l == 0) xcd_barrier(ws, lds, wv_);
  }
}

extern "C" void kernel_launch(void* const* d_in, const int* in_sizes, int n_in, void* d_out, int out_size, void* d_ws,
                              size_t ws_size, hipStream_t stream) {
  static int grid_blocks = 0;
  if (!grid_blocks) {
    int dev = 0, cus = 0, per_cu = 0;
    (void)hipGetDevice(&dev);
    (void)hipDeviceGetAttribute(&cus, hipDeviceAttributeMultiprocessorCount, dev);
    (void)hipOccupancyMaxActiveBlocksPerMultiprocessor(&per_cu, hybrid_block_megakernel, NTHR, 0);
    if (per_cu < 1) fprintf(stderr, "occupancy query returned %d\n", per_cu);
    grid_blocks = cus;
  }
  if (ws_size < WS_NEED) fprintf(stderr, "workspace too small: %zu < %zu\n", ws_size, (size_t)WS_NEED);
  (void)hipMemsetAsync((char*)d_ws + OFF_BAR, 0, XCD_BAR_WORDS * 4, stream);
  Params p{};
  const float** pf = (const float**)&p;
  for (int i = 0; i < 31; ++i) pf[i] = (const float*)d_in[i];
  p.out = (float*)d_out;
  p.ws = (char*)d_ws;
  void* args[] = {&p};
  hipError_t e = hipLaunchCooperativeKernel((void*)hybrid_block_megakernel, dim3(grid_blocks), dim3(NTHR), args, 0, stream);
  if (e != hipSuccess) fprintf(stderr, "cooperative launch failed: %s (grid %d)\n", hipGetErrorString(e), grid_blocks);
}
```

```cpp
#include <hip/hip_runtime.h>
#include <hip/hip_cooperative_groups.h>
#include <cstdio>
namespace cg = cooperative_groups;

typedef _Float16 half_t;
typedef __attribute__((ext_vector_type(8))) _Float16 h8;
typedef __attribute__((ext_vector_type(4))) _Float16 h4;
typedef __attribute__((ext_vector_type(4))) float f4;
typedef __attribute__((ext_vector_type(16))) float f16v;

#define DI __device__ __forceinline__
#define LAS __attribute__((address_space(3)))

constexpr int NB = 16, SEQ = 2048, CTX = 256, TOK = 2304, NTOK = NB * TOK;
constexpr float LOG2E = 1.4426950408889634f;
constexpr float EPS = 1e-6f;

constexpr int NQK = 2048;
constexpr int NVT = 768;
constexpr int ZS = 576;
constexpr size_t W_QK = 0;
constexpr size_t W_V = W_QK + (size_t)NQK * 1024;
constexpr size_t W_GATE = W_V + (size_t)NVT * 1024;
constexpr size_t W_BR = W_GATE + (size_t)4096 * 1024;
constexpr size_t W_OUT = W_BR + (size_t)4 * 1024 * 256;
constexpr size_t W_UP = W_OUT + (size_t)1024 * 1024;
constexpr size_t W_DOWN = W_UP + (size_t)4096 * 1024;
constexpr size_t W_UQ = W_DOWN + (size_t)1024 * 4096;
constexpr size_t W_UK = W_UQ + (size_t)512 * 256;
constexpr size_t W_UV = W_UK + (size_t)256 * 256;
constexpr size_t W_LAYER = W_UV + (size_t)256 * 256;

constexpr size_t al256(size_t x) { return (x + 255) & ~(size_t)255; }
constexpr size_t OFF_BAR = 0;
constexpr size_t OFF_W = 16384;
constexpr size_t OFF_MOD = al256(OFF_W + 2 * W_LAYER * 2);
constexpr size_t OFF_XC = al256(OFF_MOD + (size_t)2 * 17 * 6144 * 4);
constexpr size_t OFF_H = al256(OFF_XC + (size_t)NB * CTX * 1024 * 4);
constexpr size_t OFF_BIG = al256(OFF_H + (size_t)NTOK * 1024 * 2);
constexpr size_t B_O = 0;
constexpr size_t B_QM = B_O + (size_t)NTOK * 1024;
constexpr size_t B_KM = B_QM + (size_t)NTOK * 384;
constexpr size_t B_VTM = B_KM + (size_t)NTOK * 384;
constexpr size_t B_QNA = B_VTM + (size_t)NTOK * 256;
constexpr size_t B_KNA = B_QNA + (size_t)NTOK * 256;
constexpr size_t B_VTNA = B_KNA + (size_t)NTOK * 256;
constexpr size_t B_QDF = B_VTNA + (size_t)NTOK * 256;
constexpr size_t B_KDF = B_QDF + (size_t)NTOK * 256;
constexpr size_t B_VTDF = B_KDF + (size_t)NTOK * 256;
constexpr size_t B_QG = B_VTDF + (size_t)NTOK * 256;
constexpr size_t B_KG = B_QG + (size_t)NTOK * 256;
constexpr size_t B_VTG = B_KG + (size_t)NTOK * 128;
constexpr size_t B_ZMLA = B_VTG + (size_t)NTOK * 128;
constexpr size_t B_END = B_ZMLA + (size_t)NTOK * ZS;
constexpr size_t B_M = B_O + (size_t)NTOK * 1024;
constexpr size_t GSLAB = (size_t)64 * 256 * 4096;
constexpr size_t B_G0 = B_M + (size_t)NTOK * 1024;
constexpr size_t B_P5END = B_G0 + GSLAB;
constexpr size_t B_U = 0;
constexpr size_t B_MAX = B_END > B_P5END ? B_END : B_P5END;
constexpr size_t OFF_PART = OFF_BIG + (size_t)NTOK * 4096 * 2;
constexpr size_t WS_NEED = (OFF_BIG + B_MAX * 2) > (OFF_PART + (size_t)4 * NB * CTX * 1024 * 4) ? (OFF_BIG + B_MAX * 2) : (OFF_PART + (size_t)4 * NB * CTX * 1024 * 4);
static_assert(B_P5END * 2 <= (size_t)NTOK * 4096 * 2, "merge buffers must end before the partial buffer");
static_assert(B_MAX >= (size_t)NTOK * 4096, "u must fit");
static_assert(WS_NEED <= (size_t)536870912, "workspace budget");

constexpr int NTHR = 512, NWAVE = 8;
constexpr int GEMM_LDS = 131072;
constexpr int SMEM_BYTES = GEMM_LDS + 16;

struct Params {
  const float *x, *c, *ctx, *c_ctx, *w_ada, *b_ada, *g_norm1, *g_norm2, *w_in;
  const float *g_mla_qa, *w_mla_uq, *g_mla_kva, *w_mla_ukv, *g_mla_q, *g_mla_k;
  const float *g_na_q, *g_na_k, *na_rpb;
  const float *g_diff_q, *g_diff_k, *lq1, *lk1, *lq2, *lk2, *g_diff_sub;
  const float *g_gqa_q, *g_gqa_k, *w_branch, *w_out, *w_up, *w_down;
  float* out;
  char* ws;
};


typedef const Params __attribute__((address_space(4))) * KPtr;
DI KPtr kp() {
  KPtr q = (KPtr)__builtin_amdgcn_kernarg_segment_ptr();
  asm volatile("" : "+s"(q));
  return q;
}

DI int tid_opaque(int wv_) {
  unsigned z = 0u;
  asm volatile("" : "+v"(z));
  int t = (wv_ << 6) | (int)__builtin_amdgcn_mbcnt_hi(~0u, __builtin_amdgcn_mbcnt_lo(~0u, z));
  asm volatile("" : "+v"(t));
  return t;
}

DI float wave_sum(float v) {
#pragma unroll
  for (int o = 32; o > 0; o >>= 1) v += __shfl_xor(v, o);
  return v;
}

#define XB_TMO      128
#define XB_XCNT(j)  (256  + 64 * (j))
#define XB_XSUB(j)  (1280 + 64 * (j))
#define XB_XGEN(j)  (2304 + 64 * (j))
#define XB_TOP      3328
#define XB_TOPGEN   3392
#define XCD_BAR_WORDS 3456
#define XB_SPIN_CAP (1u << 22)
DI unsigned xb_ld(unsigned* p) { return __hip_atomic_load(p, __ATOMIC_RELAXED, __HIP_MEMORY_SCOPE_AGENT); }
DI unsigned xb_add(unsigned* p, unsigned v) { return __hip_atomic_fetch_add(p, v, __ATOMIC_RELAXED, __HIP_MEMORY_SCOPE_AGENT); }
DI unsigned xb_xcc_id() { return (unsigned)__builtin_amdgcn_s_getreg((3 << 11) | 20) & 0xFu; }
#define XB_SPIN(cond, bar) do { unsigned _sp = 0; while (cond) { __builtin_amdgcn_s_sleep(1); \
    if ((++_sp & 255u) == 0u) { if (xb_ld(&(bar)[XB_TMO])) break; if (_sp > XB_SPIN_CAP) { atomicAdd(&(bar)[XB_TMO], 1u); break; } } } } while (0)
DI void xcd_barrier_post(unsigned* bar, int wv_) {
  if (tid_opaque(wv_) == 0) (void)xb_add(&bar[XB_XCNT(xb_xcc_id())], 1u);
}
DI void xcd_barrier_complete(unsigned* bar, unsigned x, unsigned& nloc, unsigned& nx) {
  const unsigned G = gridDim.x * gridDim.y * gridDim.z;
  unsigned sum, cnt, mine, sp = 0u;
  for (;;) {
    sum = 0u; cnt = 0u; mine = 0u;
#pragma unroll
    for (unsigned j = 0; j < 16; ++j) { const unsigned c = xb_ld(&bar[XB_XCNT(j)]); sum += c; cnt += (c > 0u) ? 1u : 0u; mine = (j == x) ? c : mine; }
    if (sum == G) break;
    __builtin_amdgcn_s_sleep(1);
    if ((++sp & 255u) == 0u) { if (xb_ld(&bar[XB_TMO])) break; if (sp > XB_SPIN_CAP) { atomicAdd(&bar[XB_TMO], 1u); break; } }
  }
  nloc = mine > 0u ? mine : 1u; nx = cnt > 0u ? cnt : 1u;
}
DI void xcd_barrier(char* ws_, LAS unsigned char* lds_, int wv_) {
  asm volatile("s_waitcnt vmcnt(0)" ::: "memory");
  __syncthreads();
  if (tid_opaque(wv_) == 0) {
    char* wsl = ws_;
    asm volatile("" : "+s"(wsl));
    unsigned* bar = (unsigned*)(wsl + OFF_BAR);
    volatile LAS unsigned* st = (volatile LAS unsigned*)(lds_ + GEMM_LDS);
    const unsigned x = xb_xcc_id();
    __builtin_amdgcn_s_waitcnt(0);
    unsigned nloc = st[0], nx = st[1];
    if (nloc == 0u) { xcd_barrier_complete(bar, x, nloc, nx); st[0] = nloc; st[1] = nx; }
    const unsigned old = xb_add(&bar[XB_XSUB(x)], 1u);
    const unsigned gen = old / nloc;
    if (old + 1u == (gen + 1u) * nloc) {
      __builtin_amdgcn_fence(__ATOMIC_RELEASE, "agent");
      asm volatile("s_waitcnt vmcnt(0)" ::: "memory");
      const unsigned og = xb_add(&bar[XB_TOP], 1u);
      const unsigned tg = og / nx;
      if (og + 1u == (tg + 1u) * nx) xb_add(&bar[XB_TOPGEN], 1u);
      else XB_SPIN(xb_ld(&bar[XB_TOPGEN]) == tg, bar);
      __builtin_amdgcn_fence(__ATOMIC_ACQUIRE, "agent");
      xb_add(&bar[XB_XGEN(x)], 1u);
      asm volatile("s_waitcnt vmcnt(0)" ::: "memory");
    } else {
      XB_SPIN(xb_ld(&bar[XB_XGEN(x)]) == gen, bar);
      __builtin_amdgcn_fence(__ATOMIC_ACQUIRE, "agent");
      asm volatile("s_waitcnt vmcnt(0)" ::: "memory");
    }
  }
  __syncthreads();
}

DI void phase_mods(float* mods, char* smem, int wv_) {
  const KPtr p = kp();
  float* sil = (float*)smem;
  const int tid = tid_opaque(wv_);
  for (int w = blockIdx.x; w < 192; w += gridDim.x) {
    const int l = w / 96, n0 = (w % 96) * 64;
    __syncthreads();
    for (int idx = tid; idx < 17 * 1024; idx += NTHR) {
      const int b = idx >> 10, k = idx & 1023;
      const float v = (b < 16) ? p->c[b * 1024 + k] : p->c_ctx[k];
      sil[idx] = v / (1.f + expf(-v));
    }
    __syncthreads();
    const int kq = tid >> 6, nn = tid & 63;
    float acc[17];
#pragma unroll
    for (int b = 0; b < 17; ++b) acc[b] = 0.f;
    const float* wp = p->w_ada + (size_t)l * 1024 * 6144 + (size_t)(kq * 128) * 6144 + n0 + nn;
    const float* sp = sil + kq * 128;
#pragma unroll 4
    for (int k = 0; k < 128; ++k) {
      const float wv = wp[(size_t)k * 6144];
#pragma unroll
      for (int b = 0; b < 17; ++b) acc[b] += sp[b * 1024 + k] * wv;
    }
    __syncthreads();
    float* red = (float*)smem;
#pragma unroll
    for (int b = 0; b < 17; ++b) red[(kq * 17 + b) * 64 + nn] = acc[b];
    __syncthreads();
    for (int idx = tid; idx < 17 * 64; idx += NTHR) {
      float s = p->b_ada[l * 6144 + n0 + (idx & 63)];
#pragma unroll
      for (int q = 0; q < 8; ++q) s += red[q * 17 * 64 + idx];
      mods[((size_t)l * 17 + (idx >> 6)) * 6144 + n0 + (idx & 63)] = s;
    }
  }
  __syncthreads();
}

DI void tconv_job(const float* src, int ld, int c0, int K, int Kvalid, int Nvalid, int Npad, half_t* dst, int& base,
                  float* tile, int wv_) {
  const int nnt = Npad / 64, tot = (K / 64) * nnt;
  const int G = gridDim.x;
  const int start = (int)((blockIdx.x + G - (base % G)) % G);
  const int tid_ = tid_opaque(wv_);
  const int tx = tid_ & 63, ty = tid_ >> 6;
  for (int t = start; t < tot; t += G) {
    const int kt = t / nnt, nt = t % nnt;
    __syncthreads();
#pragma unroll 4
    for (int i = 0; i < 8; ++i) {
      const int k = i * 8 + ty, n = nt * 64 + tx;
      tile[k * 65 + tx] = (n < Nvalid && kt * 64 + k < Kvalid) ? src[(size_t)(kt * 64 + k) * ld + c0 + n] : 0.f;
    }
    __syncthreads();
#pragma unroll 4
    for (int i = 0; i < 8; ++i) {
      const int n = i * 8 + ty;
      dst[(size_t)(nt * 64 + n) * K + kt * 64 + tx] = (half_t)tile[tx * 65 + n];
    }
  }
  base += tot;
}

DI void phase_norm(const float* xl, const float* xc, const float* gam, const float* mods_l, int sh_off,
                   int sc_off, half_t* h, bool skip_ctx, const float* part, float* xc_store, int wv_) {
  const int tid_ = tid_opaque(wv_);
  const int wave = tid_ >> 6, lane = tid_ & 63;
  for (int g = blockIdx.x * NWAVE + wave; g < NTOK; g += gridDim.x * NWAVE) {
    const int b = g / TOK, t = g - b * TOK;
    const bool isctx = t >= SEQ;
    if (isctx && skip_ctx) continue;
    const float* src = isctx ? xc + ((size_t)b * CTX + (t - SEQ)) * 1024 : xl + ((size_t)b * SEQ + t) * 1024;
    const float* mod = mods_l + (size_t)(isctx ? 16 : b) * 6144;
    float4 v[4];
    float ss = 0.f;
#pragma unroll
    for (int i = 0; i < 4; ++i) {
      v[i] = *(const float4*)(src + i * 256 + lane * 4);
      ss += v[i].x * v[i].x + v[i].y * v[i].y + v[i].z * v[i].z + v[i].w * v[i].w;
    }
    if (isctx && part != nullptr) {
      const size_t ro = ((size_t)b * CTX + (t - SEQ)) * 1024;
      ss = 0.f;
#pragma unroll
      for (int i = 0; i < 4; ++i) {
#pragma unroll
        for (int ks = 0; ks < 4; ++ks) {
          const float4 pv = *(const float4*)(part + (size_t)ks * NB * CTX * 1024 + ro + i * 256 + lane * 4);
          v[i].x += pv.x; v[i].y += pv.y; v[i].z += pv.z; v[i].w += pv.w;
        }
        ss += v[i].x * v[i].x + v[i].y * v[i].y + v[i].z * v[i].z + v[i].w * v[i].w;
        if (xc_store != nullptr) *(float4*)(xc_store + ro + i * 256 + lane * 4) = v[i];
      }
    }
    ss = wave_sum(ss);
    const float rstd = rsqrtf(ss * (1.f / 1024.f) + EPS);
#pragma unroll
    for (int i = 0; i < 4; ++i) {
      const int col = i * 256 + lane * 4;
      const float4 gg = *(const float4*)(gam + col);
      const float4 sc = *(const float4*)(mod + sc_off + col);
      const float4 sh = *(const float4*)(mod + sh_off + col);
      h4 o;
      o[0] = (half_t)(v[i].x * rstd * gg.x * (1.f + sc.x) + sh.x);
      o[1] = (half_t)(v[i].y * rstd * gg.y * (1.f + sc.y) + sh.y);
      o[2] = (half_t)(v[i].z * rstd * gg.z * (1.f + sc.z) + sh.z);
      o[3] = (half_t)(v[i].w * rstd * gg.w * (1.f + sc.w) + sh.w);
      *(h4*)(h + (size_t)g * 1024 + col) = o;
    }
  }
}

constexpr int BK = 64, HALF = 128, HTB = HALF * BK * 2;
DI int lds_byte(int r, int c) { const int st = (r >> 4) * 2 + (c >> 5), rr = r & 15, cc = c & 31, ob = rr * 64 + cc * 2; return st * 1024 + (ob ^ (((ob >> 9) & 1) << 5)); }
DI void stage_rc(int b, int& R, int& C) { const int st = b / 1024, sb = b % 1024, swz = sb ^ (((sb >> 9) & 1) << 5); R = (st >> 1) * 16 + swz / 64; C = (st & 1) * 32 + (swz % 64) / 2; }
DI int perm32(int rho) { const int n = rho >> 4, i = rho & 15; return 8 * (i >> 2) + 4 * n + (i & 3); }

struct GUnit { const char* A; const char* B; int nt, pm, pn, aux, ks; };

DI bool tile_map(int L, int nM, int nN, int& pm, int& pn) {
  const int nwg = nM * nN;
  if (L >= nwg) return false;
  int wgid = L;
  { const int q = nwg / 8, r = nwg % 8, xcd = wgid % 8, off = wgid / 8; wgid = (xcd < r ? xcd * (q + 1) : r * (q + 1) + (xcd - r) * q) + off; }
  const int nig = 8 * nN, gid = wgid / nig, fm = gid * 8, gsz = (nM - fm) < 8 ? (nM - fm) : 8;
  pm = fm + ((wgid % nig) % gsz); pn = (wgid % nig) / gsz;
  return true;
}

template <bool PERM, class Sched, class Epi>
DI void gemm256(LAS unsigned char* lds, const Sched& S, const Epi& E, int wv_) {
  const int tid = tid_opaque(wv_), wid = __builtin_amdgcn_readfirstlane(tid >> 6), lane = tid & 63, wr = wid >> 2, wc = wid & 3, fr = lane & 15, fq = lane >> 4;
  unsigned cvA0, cvA1, cvB0, cvB1;
  { int R, C;
    stage_rc(tid * 16, R, C); cvA0 = (unsigned)R * S.lda2 + C * 2; cvB0 = (unsigned)(PERM ? ((R & ~31) + perm32(R & 31)) : R) * S.ldb2 + C * 2;
    stage_rc(tid * 16 + 8192, R, C); cvA1 = (unsigned)R * S.lda2 + C * 2; cvB1 = (unsigned)(PERM ? ((R & ~31) + perm32(R & 31)) : R) * S.ldb2 + C * 2; }
  const size_t chA = (size_t)HALF * S.lda2, chB = (size_t)HALF * S.ldb2;
  const size_t kstep = (size_t)(BK * 2);
  const unsigned ldsw = (unsigned)wid * 1024u;
  const int aoff = lds_byte(wr * 64 + fr, fq * 8), boff = lds_byte(wc * 32 + fr, fq * 8);
#define G_SA(b, h) (((b) * 2 + (h)) * HTB)
#define G_SB(b, h) ((4 + (b) * 2 + (h)) * HTB)
#define G_STAGE(bufoff, gbase, v0, v1) do { \
    __builtin_amdgcn_global_load_lds((const unsigned*)((const char*)(gbase) + (v0)), (LAS unsigned*)(lds + (bufoff) + ldsw), 16, 0, 0); \
    __builtin_amdgcn_global_load_lds((const unsigned*)((const char*)(gbase) + (v1)), (LAS unsigned*)(lds + (bufoff) + ldsw + 8192), 16, 0, 0); } while (0)
#define G_LDA(dst, b, h) do { _Pragma("unroll") for (int m = 0; m < 4; ++m) _Pragma("unroll") for (int k = 0; k < 2; ++k) dst[m][k] = *(const LAS h8*)(lds + G_SA(b, h) + aoff + m * 2048 + k * 1024); } while (0)
#define G_LDB(dst, b, h) do { _Pragma("unroll") for (int n = 0; n < 2; ++n) _Pragma("unroll") for (int k = 0; k < 2; ++k) dst[n][k] = *(const LAS h8*)(lds + G_SB(b, h) + boff + n * 2048 + k * 1024); } while (0)
#define G_MMA(ai, bj, At, Bt) do { __builtin_amdgcn_s_setprio(1); _Pragma("unroll") for (int m = 0; m < 4; ++m) _Pragma("unroll") for (int n = 0; n < 2; ++n) _Pragma("unroll") for (int k = 0; k < 2; ++k) \
    acc[ai][bj][m][n] = __builtin_amdgcn_mfma_f32_16x16x32_f16(Bt[n][k], At[m][k], acc[ai][bj][m][n], 0, 0, 0); __builtin_amdgcn_s_setprio(0); } while (0)
#define G_WAIT_V(n) asm volatile("s_waitcnt vmcnt(" #n ")" ::: "memory")
#define G_WAIT_L(n) asm volatile("s_waitcnt lgkmcnt(" #n ")" ::: "memory")
#define G_BAR __builtin_amdgcn_s_barrier()
#define G_SCHED __builtin_amdgcn_sched_barrier(0)
  GUnit cur, nxt;
  int ui = 0;
  if (!S.next(0, cur)) return;
  f4 acc[2][2][4][2];
#pragma unroll
  for (int a = 0; a < 2; ++a)
#pragma unroll
    for (int b = 0; b < 2; ++b)
#pragma unroll
      for (int m = 0; m < 4; ++m)
#pragma unroll
        for (int n = 0; n < 2; ++n) acc[a][b][m][n] = f4{0.f, 0.f, 0.f, 0.f};
  h8 At[4][2], B0[2][2], B1[2][2];
  const char* cA = cur.A;
  const char* cB = cur.B;
  G_STAGE(G_SB(0, 0), cB, cvB0, cvB1); G_STAGE(G_SA(0, 0), cA, cvA0, cvA1); G_STAGE(G_SB(0, 1), cB + chB, cvB0, cvB1); G_STAGE(G_SA(0, 1), cA + chA, cvA0, cvA1);
  if (wr == 1) G_BAR;
  G_WAIT_V(4); G_BAR;
  G_STAGE(G_SB(1, 0), cB + kstep, cvB0, cvB1); G_STAGE(G_SA(1, 0), cA + kstep, cvA0, cvA1); G_STAGE(G_SB(1, 1), cB + chB + kstep, cvB0, cvB1);
  G_WAIT_V(6); G_BAR;
  for (;;) {
    const bool has_next = S.next(ui + 1, nxt);
    const char* nA = has_next ? nxt.A : cA;
    const char* nB = has_next ? nxt.B : cB;
    int nt = cur.nt;
    asm volatile("" : "+s"(nt));
    for (int t = 0; t < nt; t += 2) {
      const bool last = (t == nt - 2);
      const char* a1 = cA + (size_t)(t + 1) * kstep;
      const char* a2 = last ? nA : cA + (size_t)(t + 2) * kstep;
      const char* b2 = last ? nB : cB + (size_t)(t + 2) * kstep;
      const char* a3 = a2 + kstep;
      const char* b3 = b2 + kstep;
      G_LDB(B0, 0, 0); G_SCHED; G_LDA(At, 0, 0); G_STAGE(G_SA(1, 1), a1 + chA, cvA0, cvA1);
      G_WAIT_L(8); G_BAR; G_WAIT_L(0); G_MMA(0, 0, At, B0); G_BAR; G_SCHED;
      G_LDB(B1, 0, 1); G_STAGE(G_SB(0, 0), b2, cvB0, cvB1);
      G_BAR; G_WAIT_L(0); G_MMA(0, 1, At, B1); G_BAR;
      G_LDA(At, 0, 1); G_STAGE(G_SA(0, 0), a2, cvA0, cvA1);
      G_BAR; G_WAIT_L(0); G_MMA(1, 0, At, B0); G_BAR; G_SCHED;
      G_STAGE(G_SB(0, 1), b2 + chB, cvB0, cvB1);
      G_WAIT_V(6); G_BAR; G_MMA(1, 1, At, B1); G_BAR;
      G_LDB(B0, 1, 0); G_SCHED; G_LDA(At, 1, 0); G_STAGE(G_SA(0, 1), a2 + chA, cvA0, cvA1);
      G_WAIT_L(8); G_BAR; G_WAIT_L(0); G_MMA(0, 0, At, B0); G_BAR; G_SCHED;
      G_LDB(B1, 1, 1); G_STAGE(G_SB(1, 0), b3, cvB0, cvB1);
      G_BAR; G_WAIT_L(0); G_MMA(0, 1, At, B1); G_BAR;
      G_LDA(At, 1, 1); G_STAGE(G_SA(1, 0), a3, cvA0, cvA1);
      G_BAR; G_WAIT_L(0); G_MMA(1, 0, At, B0); G_BAR; G_SCHED;
      G_STAGE(G_SB(1, 1), b3 + chB, cvB0, cvB1);
      G_WAIT_V(6); G_BAR; G_MMA(1, 1, At, B1); G_BAR;
    }
    E(acc, cur, wr, wc, fr, fq);
    if (!has_next) break;
#pragma unroll
    for (int a = 0; a < 2; ++a)
#pragma unroll
      for (int b = 0; b < 2; ++b)
#pragma unroll
        for (int m = 0; m < 4; ++m)
#pragma unroll
          for (int n = 0; n < 2; ++n) acc[a][b][m][n] = f4{0.f, 0.f, 0.f, 0.f};
    cur = nxt; cA = nA; cB = nB; ++ui;
  }
  G_WAIT_V(0);
  if (wr == 0) G_BAR;
  G_BAR;
#undef G_SA
#undef G_SB
#undef G_STAGE
#undef G_LDA
#undef G_LDB
#undef G_MMA
#undef G_WAIT_V
#undef G_WAIT_L
#undef G_BAR
#undef G_SCHED
}

DI h8 pack8(const f4& a, const f4& b) {
  h8 o;
  o[0] = (half_t)a[0]; o[1] = (half_t)a[1]; o[2] = (half_t)a[2]; o[3] = (half_t)a[3];
  o[4] = (half_t)b[0]; o[5] = (half_t)b[1]; o[6] = (half_t)b[2]; o[7] = (half_t)b[3];
  return o;
}
DI int row0_of(int pm, int mode) { return mode == 0 ? pm * 256 : (mode == 1 ? (pm >> 3) * TOK + (pm & 7) * 256 : pm * TOK + SEQ); }

struct SchedInproj {
  const half_t* hbuf; const half_t* Wl; int G, c;
  static constexpr unsigned lda2 = 2048, ldb2 = 2048;
  DI bool next(int i, GUnit& u) const {
    const int L = i * G + c;
    u.nt = 16;
    if (L < 144 * 8) {
      tile_map(L, 144, 8, u.pm, u.pn);
      u.A = (const char*)(hbuf + (size_t)u.pm * 256 * 1024); u.B = (const char*)(Wl + W_QK + (size_t)u.pn * 256 * 1024); u.aux = 0;
      return true;
    }
    if (!tile_map(L - 144 * 8, 3, 144, u.pm, u.pn)) return false;
    u.A = (const char*)(Wl + W_V + (size_t)u.pm * 256 * 1024); u.B = (const char*)(hbuf + (size_t)u.pn * 256 * 1024); u.aux = 1;
    return true;
  }
};
struct EpiInproj {
  half_t* big;
  DI void operator()(const f4 (&acc)[2][2][4][2], const GUnit& u, int wr, int wc, int fr, int fq) const {
    if (u.aux == 0) {
      const int g0 = u.pm * 256, b = g0 / TOK, t0 = g0 - b * TOK + wr * 64;
#pragma unroll
      for (int bj = 0; bj < 2; ++bj) {
        const int cb = u.pn * 256 + bj * 128 + wc * 32;
        half_t* ptr; int ts;
        if (cb < 576) { ptr = big + B_ZMLA + (size_t)b * TOK * ZS + cb; ts = ZS; }
        else if (cb < 1088) { const int c = cb - 576, part = c >> 8, hh = (c >> 6) & 3; ptr = big + (part ? B_KNA : B_QNA) + (size_t)(b * 4 + hh) * TOK * 64 + (c & 63); ts = 64; }
        else if (cb < 1600) { const int c = cb - 1088, part = c >> 8, hm = (c >> 5) & 7; ptr = big + (part ? B_KDF : B_QDF) + (size_t)(b * 8 + hm) * TOK * 32; ts = 32; }
        else if (cb < 1856) { const int c = cb - 1600; ptr = big + B_QG + (size_t)(b * 4 + (c >> 6)) * TOK * 64 + (c & 63); ts = 64; }
        else if (cb < 1984) { const int c = cb - 1856; ptr = big + B_KG + (size_t)(b * 2 + (c >> 6)) * TOK * 64 + (c & 63); ts = 64; }
        else continue;
        const unsigned lo = (unsigned)(fr * ts + 8 * fq) * 2u;
        char* rb = (char*)(ptr + (size_t)t0 * ts);
#pragma unroll
        for (int ai = 0; ai < 2; ++ai)
#pragma unroll
          for (int m = 0; m < 4; ++m)
            *(h8*)(rb + (size_t)((ai * 128 + m * 16) * ts) * 2 + lo) = pack8(acc[ai][bj][m][0], acc[ai][bj][m][1]);
      }
    } else {
      const int g0 = u.pn * 256, b = g0 / TOK, t0 = g0 - b * TOK;
      const int nh = (u.pm == 2) ? 2 : 4;
      char* vt = (char*)(big + (u.pm == 0 ? B_VTNA : (u.pm == 1 ? B_VTDF : B_VTG)) + (size_t)b * nh * 64 * TOK + (size_t)(wr * 64) * TOK + t0 + wc * 32);
      const unsigned lo = (unsigned)(fr * TOK + 8 * fq) * 2u;
#pragma unroll
      for (int ai = 0; ai < 2; ++ai) {
        if (u.pm == 2 && ai == 1) continue;
#pragma unroll
        for (int m = 0; m < 4; ++m)
#pragma unroll
          for (int bj = 0; bj < 2; ++bj)
            *(h8*)(vt + ((size_t)(ai * 128 + m * 16) * TOK + bj * 128) * 2 + lo) = pack8(acc[ai][bj][m][0], acc[ai][bj][m][1]);
      }
    }
  }
};

struct SchedMlaQK {
  const half_t* Wl; const half_t* zmla; int G, c;
  static constexpr unsigned lda2 = ZS * 2, ldb2 = 512;
  DI bool next(int i, GUnit& u) const {
    const int L = i * G + c;
    u.nt = 4;
    if (L < 288) {
      tile_map(L, 144, 2, u.pm, u.pn);
      u.A = (const char*)(zmla + (size_t)u.pm * 256 * ZS);
      u.B = (const char*)(Wl + W_UQ + (size_t)u.pn * 256 * 256); u.aux = 0;
      return true;
    }
    if (L < 432) {
      u.pm = L - 288; u.pn = 0;
      u.A = (const char*)(zmla + 256 + (size_t)u.pm * 256 * ZS);
      u.B = (const char*)(Wl + W_UK); u.aux = 1;
      return true;
    }
    return false;
  }
};
struct SchedMlaV {
  const half_t* Wl; const half_t* zmla; int G, c;
  static constexpr unsigned lda2 = 512, ldb2 = ZS * 2;
  DI bool next(int i, GUnit& u) const {
    const int L = i * G + c;
    if (L >= 144) return false;
    u.nt = 4; u.pm = 0; u.pn = L;
    u.A = (const char*)(Wl + W_UV);
    u.B = (const char*)(zmla + 256 + (size_t)u.pn * 256 * ZS); u.aux = 2;
    return true;
  }
};
struct EpiMla {
  half_t* big;
  DI void operator()(const f4 (&acc)[2][2][4][2], const GUnit& u, int wr, int wc, int fr, int fq) const {
    if (u.aux < 2) {
      const int g0 = u.pm * 256, b = g0 / TOK, t0 = g0 - b * TOK + wr * 64;
      const unsigned lo = (unsigned)(fr * 96 + 8 * fq) * 2u;
#pragma unroll
      for (int bj = 0; bj < 2; ++bj) {
        const int cb = u.pn * 256 + bj * 128 + wc * 32;
        half_t* ptr;
        if (u.aux == 0) {
          if (cb >= 384) continue;
          const int hh = cb / 96, dd = cb - hh * 96;
          ptr = big + B_QM + (size_t)(b * 4 + hh) * TOK * 96 + dd;
        } else {
          ptr = big + B_KM + (size_t)(b * 4 + (cb >> 6)) * TOK * 96 + (cb & 63);
        }
        char* rb = (char*)(ptr + (size_t)t0 * 96);
#pragma unroll
        for (int ai = 0; ai < 2; ++ai)
#pragma unroll
          for (int m = 0; m < 4; ++m)
            *(h8*)(rb + (size_t)((ai * 128 + m * 16) * 96) * 2 + lo) = pack8(acc[ai][bj][m][0], acc[ai][bj][m][1]);
      }
    } else {
      const int g0 = u.pn * 256, b = g0 / TOK, t0 = g0 - b * TOK;
      char* vt = (char*)(big + B_VTM + (size_t)b * 4 * 64 * TOK + (size_t)(wr * 64) * TOK + t0 + wc * 32);
      const unsigned lo = (unsigned)(fr * TOK + 8 * fq) * 2u;
#pragma unroll
      for (int ai = 0; ai < 2; ++ai)
#pragma unroll
        for (int m = 0; m < 4; ++m)
#pragma unroll
          for (int bj = 0; bj < 2; ++bj)
            *(h8*)(vt + ((size_t)(ai * 128 + m * 16) * TOK + bj * 128) * 2 + lo) = pack8(acc[ai][bj][m][0], acc[ai][bj][m][1]);
    }
  }
};

struct SchedRows {
  const half_t* A; const half_t* B; int K, nM, nN, G, c; int mode; unsigned lda2, ldb2;
  DI bool next(int i, GUnit& u) const {
    if (!tile_map(i * G + c, nM, nN, u.pm, u.pn)) return false;
    u.A = (const char*)(A + (size_t)row0_of(u.pm, mode) * K); u.B = (const char*)(B + (size_t)u.pn * 256 * K);
    u.nt = K >> 6; u.aux = 0;
    return true;
  }
};
struct SchedResid {
  const half_t* A; const half_t* B; int K, nN, nctx, G, c; unsigned lda2, ldb2;
  DI bool next(int i, GUnit& u) const {
    const int L = i * G + c, nfull = 128 * nN;
    if (L < nfull) {
      tile_map(L, 128, nN, u.pm, u.pn);
      u.A = (const char*)(A + (size_t)row0_of(u.pm, 1) * K); u.B = (const char*)(B + (size_t)u.pn * 256 * K);
      u.nt = K >> 6; u.aux = 0;
      return true;
    }
    const int L2 = L - nfull;
    if (L2 >= nctx * nN * 4) return false;
    const int ks = L2 & 3, t = L2 >> 2;
    u.pm = t / nN; u.pn = t - u.pm * nN;
    const int kq = K >> 2;
    u.A = (const char*)(A + (size_t)row0_of(u.pm, 2) * K + ks * kq); u.B = (const char*)(B + (size_t)u.pn * 256 * K + ks * kq);
    u.nt = kq >> 6; u.aux = 1; u.ks = ks;
    return true;
  }
};
struct EpiResid {
  const float* xl_src; float* xl_dst; float* part; const float* mods_l; int gt_off;
  DI void operator()(const f4 (&acc)[2][2][4][2], const GUnit& u, int wr, int wc, int fr, int fq) const {
    const bool isctx = u.aux == 1;
    const int g0 = row0_of(u.pm, isctx ? 2 : 1), b = g0 / TOK, t0 = g0 - b * TOK;
    const int col0 = u.pn * 256 + wc * 32;
    const size_t rowoff = (size_t)(wr * 64) * 1024 + col0;
    const char* src = (const char*)(xl_src + ((size_t)b * SEQ + (isctx ? 0 : t0)) * 1024 + rowoff);
    char* dst = (char*)(xl_dst + ((size_t)b * SEQ + (isctx ? 0 : t0)) * 1024 + rowoff);
    const char* gt = (const char*)(mods_l + (size_t)(isctx ? 16 : b) * 6144 + gt_off + col0);
    const unsigned lo = (unsigned)(fr * 1024 + 4 * fq) * 4u, glo = (unsigned)(4 * fq) * 4u;
    f4 gv[2][2];
#pragma unroll
    for (int bj = 0; bj < 2; ++bj)
#pragma unroll
      for (int n = 0; n < 2; ++n) gv[bj][n] = *(const f4*)(gt + (bj * 128 + n * 16) * 4 + glo);
    if (!isctx) {
#pragma unroll
      for (int ai = 0; ai < 2; ++ai)
#pragma unroll
        for (int m = 0; m < 4; ++m)
#pragma unroll
          for (int bj = 0; bj < 2; ++bj)
#pragma unroll
            for (int n = 0; n < 2; ++n) {
              const size_t uo = ((size_t)(ai * 128 + m * 16) * 1024 + bj * 128 + n * 16) * 4;
              const f4 xv = *(const f4*)(src + uo + lo);
              *(f4*)(dst + uo + lo) = xv + gv[bj][n] * acc[ai][bj][m][n];
            }
    } else {
      char* pp = (char*)(part + ((size_t)u.ks * NB * CTX + (size_t)b * CTX + (t0 - SEQ) + wr * 64) * 1024 + col0);
#pragma unroll
      for (int ai = 0; ai < 2; ++ai)
#pragma unroll
        for (int m = 0; m < 4; ++m)
#pragma unroll
          for (int bj = 0; bj < 2; ++bj)
#pragma unroll
            for (int n = 0; n < 2; ++n)
              *(f4*)(pp + ((size_t)(ai * 128 + m * 16) * 1024 + bj * 128 + n * 16) * 4 + lo) = gv[bj][n] * acc[ai][bj][m][n];
    }
  }
};
struct EpiUp {
  half_t* ubuf; int skip_ctx;
  DI void operator()(const f4 (&acc)[2][2][4][2], const GUnit& u, int wr, int wc, int fr, int fq) const {
    const int g0 = row0_of(u.pm, skip_ctx);
    char* rb = (char*)(ubuf + (size_t)(g0 + wr * 64) * 4096 + u.pn * 256 + wc * 32);
    const unsigned lo = (unsigned)(fr * 4096 + 8 * fq) * 2u;
#pragma unroll
    for (int ai = 0; ai < 2; ++ai)
#pragma unroll
      for (int m = 0; m < 4; ++m)
#pragma unroll
        for (int bj = 0; bj < 2; ++bj) {
          f4 a = acc[ai][bj][m][0], c = acc[ai][bj][m][1];
#pragma unroll
          for (int j = 0; j < 4; ++j) { a[j] = fmaxf(a[j], 0.f); a[j] *= a[j]; c[j] = fmaxf(c[j], 0.f); c[j] *= c[j]; }
          *(h8*)(rb + ((size_t)(ai * 128 + m * 16) * 4096 + bj * 128) * 2 + lo) = pack8(a, c);
        }
  }
};

template <int DLEN, int LPR, int ROPE, bool KR>
DI void norm_rows(half_t* base, int stride, int nrows, const float* gain, float oscale, const half_t* zmla, int wv_) {
  const int tid_ = tid_opaque(wv_);
  const int lane = tid_ & 63, wave = tid_ >> 6;
  constexpr int RPW = 64 / LPR;
  const int s = lane % LPR, sub = lane / LPR;
  const bool active = s * 8 < DLEN;
  float gn[8];
#pragma unroll
  for (int i = 0; i < 8; ++i) gn[i] = active ? gain[s * 8 + i] : 0.f;
  for (int r0 = (blockIdx.x * NWAVE + wave) * RPW; r0 < nrows; r0 += gridDim.x * NWAVE * RPW) {
    const int rho = r0 + sub;
    const int t = rho % TOK;
    half_t* ptr = base + (size_t)rho * stride + s * 8;
    const half_t* src = ptr;
    if (KR && s >= 8) {
      const int b = rho / (4 * TOK);
      src = zmla + ((size_t)b * TOK + t) * ZS + 512 + (s - 8) * 8;
    }
    float f[8];
    float ss = 0.f;
    if (active) {
      const h8 v = *(const h8*)src;
#pragma unroll
      for (int i = 0; i < 8; ++i) { f[i] = (float)v[i]; ss += f[i] * f[i]; }
    } else {
#pragma unroll
      for (int i = 0; i < 8; ++i) f[i] = 0.f;
    }
#pragma unroll
    for (int o = LPR / 2; o > 0; o >>= 1) ss += __shfl_xor(ss, o);
    const float rstd = rsqrtf(ss * (1.f / DLEN) + EPS);
#pragma unroll
    for (int i = 0; i < 8; ++i) f[i] = f[i] * rstd * gn[i];
    if (ROPE != 0) {
      constexpr int PX = (ROPE == 64) ? 2 : 1;
      float pf[8];
#pragma unroll
      for (int i = 0; i < 8; ++i) pf[i] = __shfl_xor(f[i], PX);
      constexpr int RB = (DLEN - ROPE) / 8;
      if (t < SEQ && s >= RB && active) {
        const int sr = s - RB;
        const int q = (ROPE == 64) ? (sr >> 1) : sr;
        const float pos = (float)((q < 2) ? (t >> 6) : (t & 63));
        const float sgn = (q & 1) ? 1.f : -1.f;
#pragma unroll
        for (int i = 0; i < 8; ++i) {
          const int idx = (ROPE == 64) ? ((sr & 1) * 8 + i) : i;
          constexpr float NF = (ROPE == 64) ? 16.f : 8.f;
          const float invf = exp2f(-(float)idx * (13.287712379549449f / NF));
          const float ang = pos * invf;
          float sn, cs;
          sincosf(ang, &sn, &cs);
          f[i] = f[i] * cs + sgn * pf[i] * sn;
        }
      }
    }
    if (active) {
      h8 o;
#pragma unroll
      for (int i = 0; i < 8; ++i) o[i] = (half_t)(f[i] * oscale);
      *(h8*)ptr = o;
    }
  }
}

constexpr int ATT_STAGE = 22528, ATT_VOFF = 13312, ATT_STASH = 49152;
template <int DQ, bool NA, int NQG>
DI void attn_wg(const half_t* Qp, const half_t* Kp, const half_t* Vp, int q0, bool active, int seg0_start, int seg0_tiles,
                int seg1_start, int seg1_tiles, const float* rpb_h, int rq, char* smem, int tid, f16v (&O)[2][NQG]) {
  constexpr int NKS = DQ / 16, KSTR = DQ + 8, VSTR = 72, CPK = DQ / 8, KCH = 64 * CPK;
  const int lane = tid & 63, r = lane & 31, h = lane >> 5;
  h8 qf[NQG][NKS];
#pragma unroll
  for (int qg = 0; qg < NQG; ++qg)
#pragma unroll
    for (int ks = 0; ks < NKS; ++ks) qf[qg][ks] = *(const h8*)(Qp + (size_t)(q0 + qg * 32 + r) * DQ + ks * 16 + h * 8);
  float mrun[NQG], lrun[NQG];
#pragma unroll
  for (int qg = 0; qg < NQG; ++qg) { mrun[qg] = -1e30f; lrun[qg] = 0.f; }
#pragma unroll
  for (int a = 0; a < 2; ++a)
#pragma unroll
    for (int c = 0; c < NQG; ++c)
#pragma unroll
      for (int i = 0; i < 16; ++i) O[a][c][i] = 0.f;
  const int ntiles = seg0_tiles + seg1_tiles;
  const int kc0 = tid, kc1 = tid + 512;
  const half_t* kg0 = Kp + kc0 * 8;
  const half_t* kg1 = Kp + kc1 * 8;
  const half_t* vg = Vp + (size_t)(tid >> 3) * TOK + (tid & 7) * 8;
  const int ks0 = (kc0 / CPK) * KSTR + (kc0 % CPK) * 8, ks1 = (kc1 / CPK) * KSTR + (kc1 % CPK) * 8, vs0 = (tid >> 3) * VSTR + (tid & 7) * 8;
  uint4 kreg0 = {0, 0, 0, 0}, kreg1 = {0, 0, 0, 0}, vreg;
  const int r0w = min(max(rq - 4, 0), 24);
  {
    const int k0 = (0 < seg0_tiles) ? seg0_start : seg1_start;
    if (kc0 < KCH) kreg0 = *(const uint4*)(kg0 + (size_t)k0 * DQ);
    if (DQ == 96 && kc1 < KCH) kreg1 = *(const uint4*)(kg1 + (size_t)k0 * DQ);
    vreg = *(const uint4*)(vg + k0);
    if (kc0 < KCH) *(uint4*)((half_t*)smem + ks0) = kreg0;
    if (DQ == 96 && kc1 < KCH) *(uint4*)((half_t*)smem + ks1) = kreg1;
    *(uint4*)((half_t*)(smem + ATT_VOFF) + vs0) = vreg;
  }
  __syncthreads();
  for (int it = 0; it < ntiles; ++it) {
    const int k0 = (it < seg0_tiles) ? seg0_start + it * 64 : seg1_start + (it - seg0_tiles) * 64;
    const bool more = it + 1 < ntiles;
    if (more) {
      const int itn = it + 1;
      const int k1 = (itn < seg0_tiles) ? seg0_start + itn * 64 : seg1_start + (itn - seg0_tiles) * 64;
      if (kc0 < KCH) kreg0 = *(const uint4*)(kg0 + (size_t)k1 * DQ);
      if (DQ == 96 && kc1 < KCH) kreg1 = *(const uint4*)(kg1 + (size_t)k1 * DQ);
      vreg = *(const uint4*)(vg + k1);
    }
    const half_t* ksm = (const half_t*)(smem + (it & 1) * ATT_STAGE) + r * KSTR + h * 8;
    const half_t* vsm = (const half_t*)(smem + (it & 1) * ATT_STAGE + ATT_VOFF) + r * VSTR + h * 4;
    const bool masked = NA && it < seg0_tiles;
    const int krow = k0 >> 6;
    const bool need = active && (!masked || (krow >= r0w && krow < r0w + 8));
    if (need) {
#pragma unroll 1
      for (int st = 0; st < 2; ++st) {
        f16v S[NQG];
#pragma unroll
        for (int qg = 0; qg < NQG; ++qg)
#pragma unroll
          for (int i = 0; i < 16; ++i) S[qg][i] = 0.f;
#pragma unroll
        for (int ks = 0; ks < NKS; ++ks) {
          const h8 kf = *(const h8*)(ksm + (st * 32) * KSTR + ks * 16);
#pragma unroll
          for (int qg = 0; qg < NQG; ++qg) S[qg] = __builtin_amdgcn_mfma_f32_32x32x16_f16(kf, qf[qg][ks], S[qg], 0, 0, 0);
        }
        if (masked) {
          const int cb = st * 32;
          const int dr = krow - rq + 7;
#pragma unroll
          for (int qg = 0; qg < NQG; ++qg) {
            const int qc = qg * 32 + r;
            const int cs = min(max(qc - 8, 0), 48);
#pragma unroll
            for (int i = 0; i < 16; ++i) {
              const int c = cb + (i & 3) + 8 * (i >> 2) + 4 * h;
              const bool valid = (c >= cs) && (c < cs + 16);
              float bias = 0.f;
              if (valid) bias = rpb_h[dr * 31 + (c - qc + 15)] * LOG2E;
              S[qg][i] = valid ? S[qg][i] + bias : -1e30f;
            }
          }
        }
        h4 vf[2][2][2];
#pragma unroll
        for (int dvt = 0; dvt < 2; ++dvt)
#pragma unroll
          for (int sx = 0; sx < 2; ++sx)
#pragma unroll
            for (int hf = 0; hf < 2; ++hf) vf[dvt][sx][hf] = *(const h4*)(vsm + (dvt * 32) * VSTR + st * 32 + sx * 16 + hf * 8);
#pragma unroll
        for (int qg = 0; qg < NQG; ++qg) {
          h8 P[2];
          float mx = S[qg][0];
#pragma unroll
          for (int i = 1; i < 16; ++i) mx = fmaxf(mx, S[qg][i]);
          mx = fmaxf(mx, __shfl_xor(mx, 32));
          const float mn = fmaxf(mrun[qg], mx);
          if (__builtin_amdgcn_ballot_w64(mn > mrun[qg]) != 0ull) {
            const float alpha = __builtin_amdgcn_exp2f(mrun[qg] - mn);
            lrun[qg] *= alpha;
#pragma unroll
            for (int dvt = 0; dvt < 2; ++dvt)
#pragma unroll
              for (int i = 0; i < 16; ++i) O[dvt][qg][i] *= alpha;
            mrun[qg] = mn;
          }
          float rs = 0.f;
#pragma unroll
          for (int i = 0; i < 16; ++i) {
            float pv = __builtin_amdgcn_exp2f(S[qg][i] - mn);
            if (NA) pv = (S[qg][i] <= -1e29f) ? 0.f : pv;
            rs += pv;
            P[i >> 3][i & 7] = (half_t)pv;
          }
          lrun[qg] += rs;
#pragma unroll
          for (int dvt = 0; dvt < 2; ++dvt) {
#pragma unroll
            for (int sx = 0; sx < 2; ++sx) {
              const h8 va = __builtin_shufflevector(vf[dvt][sx][0], vf[dvt][sx][1], 0, 1, 2, 3, 4, 5, 6, 7);
              O[dvt][qg] = __builtin_amdgcn_mfma_f32_32x32x16_f16(va, P[sx], O[dvt][qg], 0, 0, 0);
            }
          }
        }
      }
    }
    if (more) {
      char* nb = smem + ((it + 1) & 1) * ATT_STAGE;
      if (kc0 < KCH) *(uint4*)((half_t*)nb + ks0) = kreg0;
      if (DQ == 96 && kc1 < KCH) *(uint4*)((half_t*)nb + ks1) = kreg1;
      *(uint4*)((half_t*)(nb + ATT_VOFF) + vs0) = vreg;
    }
    __syncthreads();
  }
#pragma unroll
  for (int qg = 0; qg < NQG; ++qg) {
    const float lt = lrun[qg] + __shfl_xor(lrun[qg], 32);
    const float inv = 1.f / lt;
#pragma unroll
    for (int dvt = 0; dvt < 2; ++dvt)
#pragma unroll
      for (int i = 0; i < 16; ++i) O[dvt][qg][i] *= inv;
  }
}

template <int NQG>
DI void store_o(const f16v (&O)[2][NQG], half_t* orow0  , int lane) {
  const int r = lane & 31, h = lane >> 5;
#pragma unroll
  for (int qg = 0; qg < NQG; ++qg)
#pragma unroll
    for (int dvt = 0; dvt < 2; ++dvt)
#pragma unroll
      for (int c = 0; c < 4; ++c) {
        h4 o;
#pragma unroll
        for (int j = 0; j < 4; ++j) o[j] = (half_t)O[dvt][qg][4 * c + j];
        *(h4*)(orow0 + (size_t)(qg * 32 + r) * 1024 + dvt * 32 + 8 * c + 4 * h) = o;
      }
}

DI void phase_attn(int l, half_t* big, bool need_ctx, char* smem, int wv_) {
  const KPtr p = kp();
  const int wave = wv_;
  const int NQB = need_ctx ? 5 : 4;
  half_t* obuf = big + B_O;
  const float lam_init = 0.8f - 0.6f * expf(-0.3f * (float)l);
  float lam;
  {
    float d1 = 0.f, d2 = 0.f;
#pragma unroll 1
    for (int i = 0; i < 32; ++i) {
      d1 += p->lq1[l * 32 + i] * p->lk1[l * 32 + i];
      d2 += p->lq2[l * 32 + i] * p->lk2[l * 32 + i];
    }
    lam = expf(d1) - expf(d2) + lam_init;
    lam = __builtin_bit_cast(float, __builtin_amdgcn_readfirstlane(__builtin_bit_cast(int, lam)));
  }
  const float one_m_li = __builtin_bit_cast(float, __builtin_amdgcn_readfirstlane(__builtin_bit_cast(int, 1.f - lam_init)));
  const int per = 4 * 16 * NQB;
#pragma unroll
  for (int mixer = 0; mixer < 4; ++mixer) {
    const int lo = mixer * per;
    const int first = lo + (int)((blockIdx.x + gridDim.x - (lo % gridDim.x)) % gridDim.x);
    const int tid_m = tid_opaque(wv_);
    const int lane = tid_m & 63, h = lane >> 5;
#pragma unroll 1
    for (int item = first; item < lo + per; item += gridDim.x) {
      const int hi = item / (16 * NQB);
      const int rem = item - hi * 16 * NQB;
      const int b = rem / NQB, qb = rem - b * NQB;
      const bool qctx = qb == 4;
      const bool active = !qctx || wave < 4;
      const int q0 = active ? qb * 512 + wave * 64 : SEQ;
      const int hh = hi & 3;
      const int s0 = qctx ? SEQ : 0, n0t = qctx ? 4 : 36;
      f16v O[2][2];
      half_t* orow = obuf + (size_t)(b * TOK + q0) * 1024 + hh * 64;
      if (mixer == 0) {
        half_t* stash = (half_t*)(smem + ATT_STASH) + wave * 4096;
        attn_wg<32, false, 2>(big + B_QDF + (size_t)(b * 8 + hh * 2) * TOK * 32, big + B_KDF + (size_t)(b * 8 + hh * 2) * TOK * 32,
                              big + B_VTDF + (size_t)(b * 4 + hh) * 64 * TOK, q0, active, s0, n0t, 0, 0, nullptr, 0, smem, tid_m, O);
#pragma unroll
        for (int dvt = 0; dvt < 2; ++dvt)
#pragma unroll
          for (int qg = 0; qg < 2; ++qg)
#pragma unroll
            for (int i = 0; i < 16; ++i) stash[((dvt * 2 + qg) * 16 + i) * 64 + lane] = (half_t)O[dvt][qg][i];
        attn_wg<32, false, 2>(big + B_QDF + (size_t)(b * 8 + hh * 2 + 1) * TOK * 32, big + B_KDF + (size_t)(b * 8 + hh * 2 + 1) * TOK * 32,
                              big + B_VTDF + (size_t)(b * 4 + hh) * 64 * TOK, q0, active, s0, n0t, 0, 0, nullptr, 0, smem, tid_m, O);
#pragma unroll
        for (int qg = 0; qg < 2; ++qg) {
          float ss = 0.f;
#pragma unroll
          for (int dvt = 0; dvt < 2; ++dvt)
#pragma unroll
            for (int i = 0; i < 16; ++i) {
              const float v = (float)stash[((dvt * 2 + qg) * 16 + i) * 64 + lane] - lam * O[dvt][qg][i];
              O[dvt][qg][i] = v;
              ss += v * v;
            }
          ss += __shfl_xor(ss, 32);
          const float rstd = rsqrtf(ss * (1.f / 64.f) + EPS) * one_m_li;
#pragma unroll
          for (int dvt = 0; dvt < 2; ++dvt)
#pragma unroll
            for (int i = 0; i < 16; ++i) {
              const int dv = dvt * 32 + (i & 3) + 8 * (i >> 2) + 4 * h;
              O[dvt][qg][i] *= rstd * p->g_diff_sub[l * 64 + dv];
            }
        }
        if (active) store_o<2>(O, orow + 2 * 256, lane);
      } else if (mixer == 1) {
        attn_wg<96, false, 2>(big + B_QM + (size_t)(b * 4 + hh) * TOK * 96, big + B_KM + (size_t)(b * 4 + hh) * TOK * 96,
                              big + B_VTM + (size_t)(b * 4 + hh) * 64 * TOK, q0, active, s0, n0t, 0, 0, nullptr, 0, smem, tid_m, O);
        if (active) store_o<2>(O, orow + 0 * 256, lane);
      } else if (mixer == 2) {
        const int kv = hh >> 1;
        attn_wg<64, false, 2>(big + B_QG + (size_t)(b * 4 + hh) * TOK * 64, big + B_KG + (size_t)(b * 2 + kv) * TOK * 64,
                              big + B_VTG + (size_t)(b * 2 + kv) * 64 * TOK, q0, active, s0, n0t, 0, 0, nullptr, 0, smem, tid_m, O);
        if (active) store_o<2>(O, orow + 3 * 256, lane);
      } else {
        const int rq = q0 >> 6;
        const int rq0 = qb * 8;
        const int rlo = min(max(rq0 - 4, 0), 24), rhi = min(max(rq0 + 7 - 4, 0), 24) + 8;
        const int seg0s = rlo * 64, seg0n = qctx ? 0 : (rhi - rlo);
        attn_wg<64, true, 2>(big + B_QNA + (size_t)(b * 4 + hh) * TOK * 64, big + B_KNA + (size_t)(b * 4 + hh) * TOK * 64,
                             big + B_VTNA + (size_t)(b * 4 + hh) * 64 * TOK, q0, active, seg0s, seg0n, SEQ, 4,
                             p->na_rpb + (size_t)(l * 4 + hh) * 15 * 31, rq, smem, tid_m, O);
        if (active) store_o<2>(O, orow + 1 * 256, lane);
      }
    }
  }
}

struct SchedGate {
  const half_t* hbuf; const half_t* Wl; int pm0, cnt, G, c, mode;
  static constexpr unsigned lda2 = 2048, ldb2 = 2048;
  DI bool next(int i, GUnit& u) const {
    int pm, pn;
    if (!tile_map(i * G + c, cnt, 16, pm, pn)) return false;
    u.pm = pm0 + pm; u.pn = pn; u.nt = 16; u.aux = 0;
    u.A = (const char*)(hbuf + (size_t)row0_of(u.pm, mode) * 1024); u.B = (const char*)(Wl + W_GATE + (size_t)pn * 256 * 1024);
    return true;
  }
};
struct EpiGate {
  half_t* gb; int pm0;
  DI void operator()(const f4 (&acc)[2][2][4][2], const GUnit& u, int wr, int wc, int fr, int fq) const {
    char* rb = (char*)(gb + (size_t)((u.pm - pm0) * 256 + wr * 64) * 4096 + u.pn * 256 + wc * 32);
    const unsigned lo = (unsigned)(fr * 4096 + 8 * fq) * 2u;
#pragma unroll
    for (int ai = 0; ai < 2; ++ai)
#pragma unroll
      for (int m = 0; m < 4; ++m)
#pragma unroll
        for (int bj = 0; bj < 2; ++bj) {
          f4 a = acc[ai][bj][m][0], c = acc[ai][bj][m][1];
#pragma unroll
          for (int j = 0; j < 4; ++j) { a[j] = __builtin_amdgcn_rcpf(1.f + __expf(-a[j])); c[j] = __builtin_amdgcn_rcpf(1.f + __expf(-c[j])); }
          *(h8*)(rb + ((size_t)(ai * 128 + m * 16) * 4096 + bj * 128) * 2 + lo) = pack8(a, c);
        }
  }
};
struct SchedProj {
  const half_t* obuf; const half_t* Wl; int pm0, cnt, G, c, mode;
  static constexpr unsigned lda2 = 2048, ldb2 = 512;
  DI bool next(int i, GUnit& u) const {
    int pm, pn;
    if (!tile_map((i >> 2) * G + c, cnt, 4, pm, pn)) return false;
    const int br = i & 3;
    u.pm = pm0 + pm; u.pn = pn; u.nt = 4; u.aux = br;
    u.A = (const char*)(obuf + (size_t)row0_of(u.pm, mode) * 1024 + br * 256);
    u.B = (const char*)(Wl + W_BR + (size_t)(br * 1024 + pn * 256) * 256);
    return true;
  }
};
struct EpiProj {
  const half_t* gb; half_t* mbuf; int pm0, mode;
  DI void operator()(const f4 (&acc)[2][2][4][2], const GUnit& u, int wr, int wc, int fr, int fq) const {
    const int br = u.aux;
    const char* gp = (const char*)(gb + (size_t)((u.pm - pm0) * 256 + wr * 64) * 4096 + br * 1024 + u.pn * 256 + wc * 32);
    char* mp = (char*)(mbuf + (size_t)(row0_of(u.pm, mode) + wr * 64) * 1024 + u.pn * 256 + wc * 32);
    const unsigned glo = (unsigned)(fr * 4096 + 8 * fq) * 2u, mlo = (unsigned)(fr * 1024 + 8 * fq) * 2u;
#pragma unroll
    for (int ai = 0; ai < 2; ++ai)
#pragma unroll
      for (int m = 0; m < 4; ++m)
#pragma unroll
        for (int bj = 0; bj < 2; ++bj) {
          const h8 g = *(const h8*)(gp + ((size_t)(ai * 128 + m * 16) * 4096 + bj * 128) * 2 + glo);
          char* ma = mp + ((size_t)(ai * 128 + m * 16) * 1024 + bj * 128) * 2 + mlo;
          f4 a = acc[ai][bj][m][0], c = acc[ai][bj][m][1];
#pragma unroll
          for (int j = 0; j < 4; ++j) { a[j] *= (float)g[j]; c[j] *= (float)g[4 + j]; }
          if (br > 0) {
            const h8 pv = *(const h8*)ma;
#pragma unroll
            for (int j = 0; j < 4; ++j) { a[j] += (float)pv[j]; c[j] += (float)pv[4 + j]; }
          }
          *(h8*)ma = pack8(a, c);
        }
  }
};

__global__ void __launch_bounds__(NTHR) hybrid_block_megakernel(Params p) {
  __shared__ __attribute__((aligned(16))) char smem[SMEM_BYTES];
  char* ws = kp()->ws;
  if (ws == nullptr) cg::this_grid().sync();
  half_t* W = (half_t*)(ws + OFF_W);
  float* mods = (float*)(ws + OFF_MOD);
  float* xc = (float*)(ws + OFF_XC);
  half_t* hbuf = (half_t*)(ws + OFF_H);
  half_t* big = (half_t*)(ws + OFF_BIG);
  float* part = (float*)(ws + OFF_PART);
  LAS unsigned char* lds = (LAS unsigned char*)smem;
  const int G = gridDim.x, cblk = blockIdx.x;

  const int wv_ = __builtin_amdgcn_readfirstlane((int)threadIdx.x >> 6);
  volatile LAS unsigned* st = (volatile LAS unsigned*)(lds + GEMM_LDS);
  if (threadIdx.x < 4) st[threadIdx.x] = 0u;
  __syncthreads();
  xcd_barrier_post((unsigned*)(ws + OFF_BAR), wv_);

  phase_mods(mods, smem, wv_);
  {
    int base = 0;
    float* tile = (float*)smem;
    for (int l = 0; l < 2; ++l) {
      half_t* Wl = W + (size_t)l * W_LAYER;
      const float* win = kp()->w_in + (size_t)l * 1024 * 6496;
      tconv_job(win, 6496, 0, 1024, 1024, 192, 256, Wl + W_QK, base, tile, wv_);
      tconv_job(win, 6496, 192, 1024, 1024, 128, 256, Wl + W_QK + (size_t)256 * 1024, base, tile, wv_);
      tconv_job(win, 6496, 320, 1024, 1024, 32, 64, Wl + W_QK + (size_t)512 * 1024, base, tile, wv_);
      tconv_job(win, 6496, 352, 1024, 1024, 256, 256, Wl + W_QK + (size_t)576 * 1024, base, tile, wv_);
      tconv_job(win, 6496, 608, 1024, 1024, 256, 256, Wl + W_QK + (size_t)832 * 1024, base, tile, wv_);
      tconv_job(win, 6496, 1120, 1024, 1024, 256, 256, Wl + W_QK + (size_t)1088 * 1024, base, tile, wv_);
      tconv_job(win, 6496, 1376, 1024, 1024, 256, 256, Wl + W_QK + (size_t)1344 * 1024, base, tile, wv_);
      tconv_job(win, 6496, 1888, 1024, 1024, 256, 256, Wl + W_QK + (size_t)1600 * 1024, base, tile, wv_);
      tconv_job(win, 6496, 2144, 1024, 1024, 128, 192, Wl + W_QK + (size_t)1856 * 1024, base, tile, wv_);
      tconv_job(win, 6496, 864, 1024, 1024, 256, 256, Wl + W_V, base, tile, wv_);
      tconv_job(win, 6496, 1632, 1024, 1024, 256, 256, Wl + W_V + (size_t)256 * 1024, base, tile, wv_);
      tconv_job(win, 6496, 2272, 1024, 1024, 128, 256, Wl + W_V + (size_t)512 * 1024, base, tile, wv_);
      tconv_job(win, 6496, 2400, 1024, 1024, 4096, 4096, Wl + W_GATE, base, tile, wv_);
      for (int br = 0; br < 4; ++br)
        tconv_job(kp()->w_branch + ((size_t)l * 4 + br) * 256 * 1024, 1024, 0, 256, 256, 1024, 1024, Wl + W_BR + (size_t)br * 1024 * 256, base, tile, wv_);
      tconv_job(kp()->w_out + (size_t)l * 1024 * 1024, 1024, 0, 1024, 1024, 1024, 1024, Wl + W_OUT, base, tile, wv_);
      tconv_job(kp()->w_up + (size_t)l * 1024 * 4096, 4096, 0, 1024, 1024, 4096, 4096, Wl + W_UP, base, tile, wv_);
      tconv_job(kp()->w_down + (size_t)l * 4096 * 1024, 1024, 0, 4096, 4096, 1024, 1024, Wl + W_DOWN, base, tile, wv_);
      tconv_job(kp()->w_mla_uq + (size_t)l * 192 * 384, 384, 0, 256, 192, 384, 512, Wl + W_UQ, base, tile, wv_);
      for (int hh = 0; hh < 4; ++hh) {
        tconv_job(kp()->w_mla_ukv + (size_t)l * 128 * 512, 512, hh * 128, 256, 128, 64, 64, Wl + W_UK + (size_t)hh * 64 * 256, base, tile, wv_);
        tconv_job(kp()->w_mla_ukv + (size_t)l * 128 * 512, 512, hh * 128 + 64, 256, 128, 64, 64, Wl + W_UV + (size_t)hh * 64 * 256, base, tile, wv_);
      }
    }
  }
  xcd_barrier(ws, lds, wv_);

  for (int l = 0; l < 2; ++l) {
    const bool need_ctx = (l == 0);
    const bool skip_ctx = !need_ctx;
    const half_t* Wl = W + (size_t)l * W_LAYER;
    const float* mods_l = mods + (size_t)l * 17 * 6144;
    const float* xl_src = (l == 0) ? kp()->x : kp()->out;
    const float* xc_src = (l == 0) ? kp()->ctx : xc;
    const int nrt = skip_ctx ? 128 : 144;

    phase_norm(xl_src, xc_src, kp()->g_norm1 + l * 1024, mods_l, 0, 1024, hbuf, false, (l == 1) ? part : nullptr, nullptr, wv_);
    xcd_barrier(ws, lds, wv_);
    {
      SchedInproj S{hbuf, Wl, G, cblk};
      EpiInproj E{big};
      gemm256<true>(lds, S, E, wv_);
    }
    xcd_barrier(ws, lds, wv_);
    {
      half_t* zmla = big + B_ZMLA;
      norm_rows<192, 32, 0, false>(zmla, ZS, NTOK, kp()->g_mla_qa + l * 192, 1.f, nullptr, wv_);
      norm_rows<128, 16, 0, false>(zmla + 256, ZS, NTOK, kp()->g_mla_kva + l * 128, 1.f, nullptr, wv_);
      norm_rows<64, 8, 0, false>(big + B_QNA, 64, NTOK * 4, kp()->g_na_q + l * 64, 0.125f * LOG2E, nullptr, wv_);
      norm_rows<64, 8, 0, false>(big + B_KNA, 64, NTOK * 4, kp()->g_na_k + l * 64, 1.f, nullptr, wv_);
      norm_rows<32, 4, 32, false>(big + B_QDF, 32, NTOK * 8, kp()->g_diff_q + l * 32, 0.17677669529663687f * LOG2E, nullptr, wv_);
      norm_rows<32, 4, 32, false>(big + B_KDF, 32, NTOK * 8, kp()->g_diff_k + l * 32, 1.f, nullptr, wv_);
      norm_rows<64, 8, 64, false>(big + B_QG, 64, NTOK * 4, kp()->g_gqa_q + l * 64, 0.125f * LOG2E, nullptr, wv_);
      norm_rows<64, 8, 64, false>(big + B_KG, 64, NTOK * 2, kp()->g_gqa_k + l * 64, 1.f, nullptr, wv_);
    }
    xcd_barrier(ws, lds, wv_);
    {
      SchedMlaQK S{Wl, big + B_ZMLA, G, cblk};
      EpiMla E{big};
      gemm256<true>(lds, S, E, wv_);
      SchedMlaV S2{Wl, big + B_ZMLA, G, cblk};
      gemm256<true>(lds, S2, E, wv_);
    }
    xcd_barrier(ws, lds, wv_);
    norm_rows<96, 16, 32, false>(big + B_QM, 96, NTOK * 4, kp()->g_mla_q + l * 96, 0.10206207261596575f * LOG2E, nullptr, wv_);
    norm_rows<96, 16, 32, true>(big + B_KM, 96, NTOK * 4, kp()->g_mla_k + l * 96, 1.f, big + B_ZMLA, wv_);
    xcd_barrier(ws, lds, wv_);
    phase_attn(l, big, need_ctx, smem, wv_);
    xcd_barrier(ws, lds, wv_);
    {
      const int nsp = need_ctx ? 3 : 2;
      for (int j = 0; j < nsp; ++j) {
        const int mode = (j < 2) ? 1 : 2, pm0 = (j < 2) ? j * 64 : 0, cnt = (j < 2) ? 64 : 16;
        {
          SchedGate S{hbuf, Wl, pm0, cnt, G, cblk, mode};
          EpiGate E{big + B_G0, pm0};
          gemm256<true>(lds, S, E, wv_);
        }
        xcd_barrier(ws, lds, wv_);
        {
          SchedProj S{big + B_O, Wl, pm0, cnt, G, cblk, mode};
          EpiProj E{big + B_G0, big + B_M, pm0, mode};
          gemm256<true>(lds, S, E, wv_);
        }
        xcd_barrier(ws, lds, wv_);
      }
    }
    {
      SchedResid S{big + B_M, Wl + W_OUT, 1024, 4, need_ctx ? 16 : 0, G, cblk, 2048u, 2048u};
      EpiResid E{xl_src, kp()->out, part, mods_l, 2048};
      gemm256<false>(lds, S, E, wv_);
    }
    xcd_barrier(ws, lds, wv_);
    phase_norm(kp()->out, xc_src, kp()->g_norm2 + l * 1024, mods_l, 3072, 4096, hbuf, skip_ctx, need_ctx ? part : nullptr, need_ctx ? xc : nullptr, wv_);
    xcd_barrier(ws, lds, wv_);
    {
      SchedRows S{hbuf, Wl + W_UP, 1024, nrt, 16, G, cblk, skip_ctx ? 1 : 0, 2048u, 2048u};
      EpiUp E{big + B_U, skip_ctx ? 1 : 0};
      gemm256<true>(lds, S, E, wv_);
    }
    xcd_barrier(ws, lds, wv_);
    {
      SchedResid S{big + B_U, Wl + W_DOWN, 4096, 4, need_ctx ? 16 : 0, G, cblk, 8192u, 8192u};
      EpiResid E{kp()->out, kp()->out, part, mods_l, 5120};
      gemm256<false>(lds, S, E, wv_);
    }
    if (l == 0) xcd_barrier(ws, lds, wv_);
  }
}

extern "C" void kernel_launch(void* const* d_in, const int* in_sizes, int n_in, void* d_out, int out_size, void* d_ws,
                              size_t ws_size, hipStream_t stream) {
  static int grid_blocks = 0;
  if (!grid_blocks) {
    int dev = 0, cus = 0, per_cu = 0;
    (void)hipGetDevice(&dev);
    (void)hipDeviceGetAttribute(&cus, hipDeviceAttributeMultiprocessorCount, dev);
    (void)hipOccupancyMaxActiveBlocksPerMultiprocessor(&per_cu, hybrid_block_megakernel, NTHR, 0);
    if (per_cu < 1) fprintf(stderr, "occupancy query returned %d\n", per_cu);
    grid_blocks = cus;
  }
  if (ws_size < WS_NEED) fprintf(stderr, "workspace too small: %zu < %zu\n", ws_size, (size_t)WS_NEED);
  (void)hipMemsetAsync((char*)d_ws + OFF_BAR, 0, XCD_BAR_WORDS * 4, stream);
  Params p{};
  const float** pf = (const float**)&p;
  for (int i = 0; i < 31; ++i) pf[i] = (const float*)d_in[i];
  p.out = (float*)d_out;
  p.ws = (char*)d_ws;
  void* args[] = {&p};
  hipError_t e = hipLaunchCooperativeKernel((void*)hybrid_block_megakernel, dim3(grid_blocks), dim3(NTHR), args, 0, stream);
  if (e != hipSuccess) fprintf(stderr, "cooperative launch failed: %s (grid %d)\n", hipGetErrorString(e), grid_blocks);
}
```

```cpp
#include <hip/hip_runtime.h>
#include <hip/hip_cooperative_groups.h>
#include <cstdio>
namespace cg = cooperative_groups;

typedef _Float16 half_t;
typedef __attribute__((ext_vector_type(8))) _Float16 h8;
typedef __attribute__((ext_vector_type(4))) _Float16 h4;
typedef __attribute__((ext_vector_type(4))) float f4;
typedef __attribute__((ext_vector_type(16))) float f16v;

#define DI __device__ __forceinline__
#define LAS __attribute__((address_space(3)))

constexpr int NB = 16, SEQ = 2048, CTX = 256, TOK = 2304, NTOK = NB * TOK;
constexpr float LOG2E = 1.4426950408889634f;
constexpr float EPS = 1e-6f;

constexpr int NQK = 2048;
constexpr int NVT = 768;
constexpr int ZS = 576;
constexpr size_t W_QK = 0;
constexpr size_t W_V = W_QK + (size_t)NQK * 1024;
constexpr size_t W_GATE = W_V + (size_t)NVT * 1024;
constexpr size_t W_BR = W_GATE + (size_t)4096 * 1024;
constexpr size_t W_OUT = W_BR + (size_t)4 * 1024 * 256;
constexpr size_t W_UP = W_OUT + (size_t)1024 * 1024;
constexpr size_t W_DOWN = W_UP + (size_t)4096 * 1024;
constexpr size_t W_UQ = W_DOWN + (size_t)1024 * 4096;
constexpr size_t W_UK = W_UQ + (size_t)512 * 256;
constexpr size_t W_UV = W_UK + (size_t)256 * 256;
constexpr size_t W_LAYER = W_UV + (size_t)256 * 256;

constexpr size_t al256(size_t x) { return (x + 255) & ~(size_t)255; }
constexpr size_t OFF_BAR = 0;
constexpr size_t OFF_W = 16384;
constexpr size_t OFF_MOD = al256(OFF_W + 2 * W_LAYER * 2);
constexpr size_t OFF_XC = al256(OFF_MOD + (size_t)2 * 17 * 6144 * 4);
constexpr size_t OFF_H = al256(OFF_XC + (size_t)NB * CTX * 1024 * 4);
constexpr size_t OFF_BIG = al256(OFF_H + (size_t)NTOK * 1024 * 2);
constexpr size_t B_O = 0;
constexpr size_t B_QM = B_O + (size_t)NTOK * 1024;
constexpr size_t B_KM = B_QM + (size_t)NTOK * 384;
constexpr size_t B_VTM = B_KM + (size_t)NTOK * 384;
constexpr size_t B_QNA = B_VTM + (size_t)NTOK * 256;
constexpr size_t B_KNA = B_QNA + (size_t)NTOK * 256;
constexpr size_t B_VTNA = B_KNA + (size_t)NTOK * 256;
constexpr size_t B_QDF = B_VTNA + (size_t)NTOK * 256;
constexpr size_t B_KDF = B_QDF + (size_t)NTOK * 256;
constexpr size_t B_VTDF = B_KDF + (size_t)NTOK * 256;
constexpr size_t B_QG = B_VTDF + (size_t)NTOK * 256;
constexpr size_t B_KG = B_QG + (size_t)NTOK * 256;
constexpr size_t B_VTG = B_KG + (size_t)NTOK * 128;
constexpr size_t B_ZMLA = B_VTG + (size_t)NTOK * 128;
constexpr size_t B_END = B_ZMLA + (size_t)NTOK * ZS;
constexpr size_t B_M = B_O + (size_t)NTOK * 1024;
constexpr size_t GSLAB = (size_t)64 * 256 * 4096;
constexpr size_t B_G0 = B_M + (size_t)NTOK * 1024;
constexpr size_t B_P5END = B_G0 + GSLAB;
constexpr size_t B_U = 0;
constexpr size_t B_MAX = B_END > B_P5END ? B_END : B_P5END;
constexpr size_t OFF_PART = OFF_BIG + (size_t)NTOK * 4096 * 2;
constexpr size_t WS_NEED = (OFF_BIG + B_MAX * 2) > (OFF_PART + (size_t)4 * NB * CTX * 1024 * 4) ? (OFF_BIG + B_MAX * 2) : (OFF_PART + (size_t)4 * NB * CTX * 1024 * 4);
static_assert(B_P5END * 2 <= (size_t)NTOK * 4096 * 2, "merge buffers must end before the partial buffer");
static_assert(B_MAX >= (size_t)NTOK * 4096, "u must fit");
static_assert(WS_NEED <= (size_t)536870912, "workspace budget");

constexpr int NTHR = 512, NWAVE = 8;
constexpr int GEMM_LDS = 131072;
constexpr int SMEM_BYTES = GEMM_LDS + 16;

struct Params {
  const float *x, *c, *ctx, *c_ctx, *w_ada, *b_ada, *g_norm1, *g_norm2, *w_in;
  const float *g_mla_qa, *w_mla_uq, *g_mla_kva, *w_mla_ukv, *g_mla_q, *g_mla_k;
  const float *g_na_q, *g_na_k, *na_rpb;
  const float *g_diff_q, *g_diff_k, *lq1, *lk1, *lq2, *lk2, *g_diff_sub;
  const float *g_gqa_q, *g_gqa_k, *w_branch, *w_out, *w_up, *w_down;
  float* out;
  char* ws;
};


typedef const Params __attribute__((address_space(4))) * KPtr;
DI KPtr kp() {
  KPtr q = (KPtr)__builtin_amdgcn_kernarg_segment_ptr();
  asm volatile("" : "+s"(q));
  return q;
}

DI int tid_opaque(int wv_) {
  unsigned z = 0u;
  asm volatile("" : "+v"(z));
  int t = (wv_ << 6) | (int)__builtin_amdgcn_mbcnt_hi(~0u, __builtin_amdgcn_mbcnt_lo(~0u, z));
  asm volatile("" : "+v"(t));
  return t;
}

DI float wave_sum(float v) {
#pragma unroll
  for (int o = 32; o > 0; o >>= 1) v += __shfl_xor(v, o);
  return v;
}

#define XB_TMO      128
#define XB_XCNT(j)  (256  + 64 * (j))
#define XB_XSUB(j)  (1280 + 64 * (j))
#define XB_XGEN(j)  (2304 + 64 * (j))
#define XB_TOP      3328
#define XB_TOPGEN   3392
#define XCD_BAR_WORDS 3456
#define XB_SPIN_CAP (1u << 22)
DI unsigned xb_ld(unsigned* p) { return __hip_atomic_load(p, __ATOMIC_RELAXED, __HIP_MEMORY_SCOPE_AGENT); }
DI unsigned xb_add(unsigned* p, unsigned v) { return __hip_atomic_fetch_add(p, v, __ATOMIC_RELAXED, __HIP_MEMORY_SCOPE_AGENT); }
DI unsigned xb_xcc_id() { return (unsigned)__builtin_amdgcn_s_getreg((3 << 11) | 20) & 0xFu; }
#define XB_SPIN(cond, bar) do { unsigned _sp = 0; while (cond) { __builtin_amdgcn_s_sleep(1); \
    if ((++_sp & 255u) == 0u) { if (xb_ld(&(bar)[XB_TMO])) break; if (_sp > XB_SPIN_CAP) { atomicAdd(&(bar)[XB_TMO], 1u); break; } } } } while (0)
DI void xcd_barrier_post(unsigned* bar, int wv_) {
  if (tid_opaque(wv_) == 0) (void)xb_add(&bar[XB_XCNT(xb_xcc_id())], 1u);
}
DI void xcd_barrier_complete(unsigned* bar, unsigned x, unsigned& nloc, unsigned& nx) {
  const unsigned G = gridDim.x * gridDim.y * gridDim.z;
  unsigned sum, cnt, mine, sp = 0u;
  for (;;) {
    sum = 0u; cnt = 0u; mine = 0u;
#pragma unroll
    for (unsigned j = 0; j < 16; ++j) { const unsigned c = xb_ld(&bar[XB_XCNT(j)]); sum += c; cnt += (c > 0u) ? 1u : 0u; mine = (j == x) ? c : mine; }
    if (sum == G) break;
    __builtin_amdgcn_s_sleep(1);
    if ((++sp & 255u) == 0u) { if (xb_ld(&bar[XB_TMO])) break; if (sp > XB_SPIN_CAP) { atomicAdd(&bar[XB_TMO], 1u); break; } }
  }
  nloc = mine > 0u ? mine : 1u; nx = cnt > 0u ? cnt : 1u;
}
DI void xcd_barrier(char* ws_, LAS unsigned char* lds_, int wv_) {
  asm volatile("s_waitcnt vmcnt(0)" ::: "memory");
  __syncthreads();
  if (tid_opaque(wv_) == 0) {
    char* wsl = ws_;
    asm volatile("" : "+s"(wsl));
    unsigned* bar = (unsigned*)(wsl + OFF_BAR);
    volatile LAS unsigned* st = (volatile LAS unsigned*)(lds_ + GEMM_LDS);
    const unsigned x = xb_xcc_id();
    __builtin_amdgcn_s_waitcnt(0);
    unsigned nloc = st[0], nx = st[1];
    if (nloc == 0u) { xcd_barrier_complete(bar, x, nloc, nx); st[0] = nloc; st[1] = nx; }
    const unsigned old = xb_add(&bar[XB_XSUB(x)], 1u);
    const unsigned gen = old / nloc;
    if (old + 1u == (gen + 1u) * nloc) {
      __builtin_amdgcn_fence(__ATOMIC_RELEASE, "agent");
      asm volatile("s_waitcnt vmcnt(0)" ::: "memory");
      const unsigned og = xb_add(&bar[XB_TOP], 1u);
      const unsigned tg = og / nx;
      if (og + 1u == (tg + 1u) * nx) xb_add(&bar[XB_TOPGEN], 1u);
      else XB_SPIN(xb_ld(&bar[XB_TOPGEN]) == tg, bar);
      __builtin_amdgcn_fence(__ATOMIC_ACQUIRE, "agent");
      xb_add(&bar[XB_XGEN(x)], 1u);
      asm volatile("s_waitcnt vmcnt(0)" ::: "memory");
    } else {
      XB_SPIN(xb_ld(&bar[XB_XGEN(x)]) == gen, bar);
      __builtin_amdgcn_fence(__ATOMIC_ACQUIRE, "agent");
      asm volatile("s_waitcnt vmcnt(0)" ::: "memory");
    }
  }
  __syncthreads();
}

DI void phase_mods(float* mods, char* smem, int wv_) {
  const KPtr p = kp();
  float* sil = (float*)smem;
  const int tid = tid_opaque(wv_);
  for (int w = blockIdx.x; w < 192; w += gridDim.x) {
    const int l = w / 96, n0 = (w % 96) * 64;
    __syncthreads();
    for (int idx = tid; idx < 17 * 1024; idx += NTHR) {
      const int b = idx >> 10, k = idx & 1023;
      const float v = (b < 16) ? p->c[b * 1024 + k] : p->c_ctx[k];
      sil[idx] = v / (1.f + expf(-v));
    }
    __syncthreads();
    const int kq = tid >> 6, nn = tid & 63;
    float acc[17];
#pragma unroll
    for (int b = 0; b < 17; ++b) acc[b] = 0.f;
    const float* wp = p->w_ada + (size_t)l * 1024 * 6144 + (size_t)(kq * 128) * 6144 + n0 + nn;
    const float* sp = sil + kq * 128;
#pragma unroll 4
    for (int k = 0; k < 128; ++k) {
      const float wv = wp[(size_t)k * 6144];
#pragma unroll
      for (int b = 0; b < 17; ++b) acc[b] += sp[b * 1024 + k] * wv;
    }
    __syncthreads();
    float* red = (float*)smem;
#pragma unroll
    for (int b = 0; b < 17; ++b) red[(kq * 17 + b) * 64 + nn] = acc[b];
    __syncthreads();
    for (int idx = tid; idx < 17 * 64; idx += NTHR) {
      float s = p->b_ada[l * 6144 + n0 + (idx & 63)];
#pragma unroll
      for (int q = 0; q < 8; ++q) s += red[q * 17 * 64 + idx];
      mods[((size_t)l * 17 + (idx >> 6)) * 6144 + n0 + (idx & 63)] = s;
    }
  }
  __syncthreads();
}

DI void tconv_job(const float* src, int ld, int c0, int K, int Kvalid, int Nvalid, int Npad, half_t* dst, int& base,
                  float* tile, int wv_) {
  const int nnt = Npad / 64, tot = (K / 64) * nnt;
  const int G = gridDim.x;
  const int start = (int)((blockIdx.x + G - (base % G)) % G);
  const int tid_ = tid_opaque(wv_);
  const int tx = tid_ & 63, ty = tid_ >> 6;
  for (int t = start; t < tot; t += G) {
    const int kt = t / nnt, nt = t % nnt;
    __syncthreads();
#pragma unroll 4
    for (int i = 0; i < 8; ++i) {
      const int k = i * 8 + ty, n = nt * 64 + tx;
      tile[k * 65 + tx] = (n < Nvalid && kt * 64 + k < Kvalid) ? src[(size_t)(kt * 64 + k) * ld + c0 + n] : 0.f;
    }
    __syncthreads();
#pragma unroll 4
    for (int i = 0; i < 8; ++i) {
      const int n = i * 8 + ty;
      dst[(size_t)(nt * 64 + n) * K + kt * 64 + tx] = (half_t)tile[tx * 65 + n];
    }
  }
  base += tot;
}

DI void phase_norm(const float* xl, const float* xc, const float* gam, const float* mods_l, int sh_off,
                   int sc_off, half_t* h, bool skip_ctx, const float* part, float* xc_store, int wv_) {
  const int tid_ = tid_opaque(wv_);
  const int wave = tid_ >> 6, lane = tid_ & 63;
  for (int g = blockIdx.x * NWAVE + wave; g < NTOK; g += gridDim.x * NWAVE) {
    const int b = g / TOK, t = g - b * TOK;
    const bool isctx = t >= SEQ;
    if (isctx && skip_ctx) continue;
    const float* src = isctx ? xc + ((size_t)b * CTX + (t - SEQ)) * 1024 : xl + ((size_t)b * SEQ + t) * 1024;
    const float* mod = mods_l + (size_t)(isctx ? 16 : b) * 6144;
    float4 v[4];
    float ss = 0.f;
#pragma unroll
    for (int i = 0; i < 4; ++i) {
      v[i] = *(const float4*)(src + i * 256 + lane * 4);
      ss += v[i].x * v[i].x + v[i].y * v[i].y + v[i].z * v[i].z + v[i].w * v[i].w;
    }
    if (isctx && part != nullptr) {
      const size_t ro = ((size_t)b * CTX + (t - SEQ)) * 1024;
      ss = 0.f;
#pragma unroll
      for (int i = 0; i < 4; ++i) {
#pragma unroll
        for (int ks = 0; ks < 4; ++ks) {
          const float4 pv = *(const float4*)(part + (size_t)ks * NB * CTX * 1024 + ro + i * 256 + lane * 4);
          v[i].x += pv.x; v[i].y += pv.y; v[i].z += pv.z; v[i].w += pv.w;
        }
        ss += v[i].x * v[i].x + v[i].y * v[i].y + v[i].z * v[i].z + v[i].w * v[i].w;
        if (xc_store != nullptr) *(float4*)(xc_store + ro + i * 256 + lane * 4) = v[i];
      }
    }
    ss = wave_sum(ss);
    const float rstd = rsqrtf(ss * (1.f / 1024.f) + EPS);
#pragma unroll
    for (int i = 0; i < 4; ++i) {
      const int col = i * 256 + lane * 4;
      const float4 gg = *(const float4*)(gam + col);
      const float4 sc = *(const float4*)(mod + sc_off + col);
      const float4 sh = *(const float4*)(mod + sh_off + col);
      h4 o;
      o[0] = (half_t)(v[i].x * rstd * gg.x * (1.f + sc.x) + sh.x);
      o[1] = (half_t)(v[i].y * rstd * gg.y * (1.f + sc.y) + sh.y);
      o[2] = (half_t)(v[i].z * rstd * gg.z * (1.f + sc.z) + sh.z);
      o[3] = (half_t)(v[i].w * rstd * gg.w * (1.f + sc.w) + sh.w);
      *(h4*)(h + (size_t)g * 1024 + col) = o;
    }
  }
}

constexpr int BK = 64, HALF = 128, HTB = HALF * BK * 2;
DI int lds_byte(int r, int c) { const int st = (r >> 4) * 2 + (c >> 5), rr = r & 15, cc = c & 31, ob = rr * 64 + cc * 2; return st * 1024 + (ob ^ (((ob >> 9) & 1) << 5)); }
DI void stage_rc(int b, int& R, int& C) { const int st = b / 1024, sb = b % 1024, swz = sb ^ (((sb >> 9) & 1) << 5); R = (st >> 1) * 16 + swz / 64; C = (st & 1) * 32 + (swz % 64) / 2; }
DI int perm32(int rho) { const int n = rho >> 4, i = rho & 15; return 8 * (i >> 2) + 4 * n + (i & 3); }

struct GUnit { const char* A; const char* B; int nt, pm, pn, aux, ks; };

DI bool tile_map(int L, int nM, int nN, int& pm, int& pn) {
  const int nwg = nM * nN;
  if (L >= nwg) return false;
  int wgid = L;
  { const int q = nwg / 8, r = nwg % 8, xcd = wgid % 8, off = wgid / 8; wgid = (xcd < r ? xcd * (q + 1) : r * (q + 1) + (xcd - r) * q) + off; }
  const int nig = 8 * nN, gid = wgid / nig, fm = gid * 8, gsz = (nM - fm) < 8 ? (nM - fm) : 8;
  pm = fm + ((wgid % nig) % gsz); pn = (wgid % nig) / gsz;
  return true;
}

template <bool PERM, class Sched, class Epi>
DI void gemm256(LAS unsigned char* lds, const Sched& S, const Epi& E, int wv_) {
  const int tid = tid_opaque(wv_), wid = __builtin_amdgcn_readfirstlane(tid >> 6), lane = tid & 63, wr = wid >> 2, wc = wid & 3, fr = lane & 15, fq = lane >> 4;
  unsigned cvA0, cvA1, cvB0, cvB1;
  { int R, C;
    stage_rc(tid * 16, R, C); cvA0 = (unsigned)R * S.lda2 + C * 2; cvB0 = (unsigned)(PERM ? ((R & ~31) + perm32(R & 31)) : R) * S.ldb2 + C * 2;
    stage_rc(tid * 16 + 8192, R, C); cvA1 = (unsigned)R * S.lda2 + C * 2; cvB1 = (unsigned)(PERM ? ((R & ~31) + perm32(R & 31)) : R) * S.ldb2 + C * 2; }
  const size_t chA = (size_t)HALF * S.lda2, chB = (size_t)HALF * S.ldb2;
  const size_t kstep = (size_t)(BK * 2);
  const unsigned ldsw = (unsigned)wid * 1024u;
  const int aoff = lds_byte(wr * 64 + fr, fq * 8), boff = lds_byte(wc * 32 + fr, fq * 8);
#define G_SA(b, h) (((b) * 2 + (h)) * HTB)
#define G_SB(b, h) ((4 + (b) * 2 + (h)) * HTB)
#define G_STAGE(bufoff, gbase, v0, v1) do { \
    __builtin_amdgcn_global_load_lds((const unsigned*)((const char*)(gbase) + (v0)), (LAS unsigned*)(lds + (bufoff) + ldsw), 16, 0, 0); \
    __builtin_amdgcn_global_load_lds((const unsigned*)((const char*)(gbase) + (v1)), (LAS unsigned*)(lds + (bufoff) + ldsw + 8192), 16, 0, 0); } while (0)
#define G_LDA(dst, b, h) do { _Pragma("unroll") for (int m = 0; m < 4; ++m) _Pragma("unroll") for (int k = 0; k < 2; ++k) dst[m][k] = *(const LAS h8*)(lds + G_SA(b, h) + aoff + m * 2048 + k * 1024); } while (0)
#define G_LDB(dst, b, h) do { _Pragma("unroll") for (int n = 0; n < 2; ++n) _Pragma("unroll") for (int k = 0; k < 2; ++k) dst[n][k] = *(const LAS h8*)(lds + G_SB(b, h) + boff + n * 2048 + k * 1024); } while (0)
#define G_MMA(ai, bj, At, Bt) do { __builtin_amdgcn_s_setprio(1); _Pragma("unroll") for (int m = 0; m < 4; ++m) _Pragma("unroll") for (int n = 0; n < 2; ++n) _Pragma("unroll") for (int k = 0; k < 2; ++k) \
    acc[ai][bj][m][n] = __builtin_amdgcn_mfma_f32_16x16x32_f16(Bt[n][k], At[m][k], acc[ai][bj][m][n], 0, 0, 0); __builtin_amdgcn_s_setprio(0); } while (0)
#define G_WAIT_V(n) asm volatile("s_waitcnt vmcnt(" #n ")" ::: "memory")
#define G_WAIT_L(n) asm volatile("s_waitcnt lgkmcnt(" #n ")" ::: "memory")
#define G_BAR __builtin_amdgcn_s_barrier()
#define G_SCHED __builtin_amdgcn_sched_barrier(0)
  GUnit cur, nxt;
  int ui = 0;
  if (!S.next(0, cur)) return;
  f4 acc[2][2][4][2];
#pragma unroll
  for (int a = 0; a < 2; ++a)
#pragma unroll
    for (int b = 0; b < 2; ++b)
#pragma unroll
      for (int m = 0; m < 4; ++m)
#pragma unroll
        for (int n = 0; n < 2; ++n) acc[a][b][m][n] = f4{0.f, 0.f, 0.f, 0.f};
  h8 At[4][2], B0[2][2], B1[2][2];
  const char* cA = cur.A;
  const char* cB = cur.B;
  G_STAGE(G_SB(0, 0), cB, cvB0, cvB1); G_STAGE(G_SA(0, 0), cA, cvA0, cvA1); G_STAGE(G_SB(0, 1), cB + chB, cvB0, cvB1); G_STAGE(G_SA(0, 1), cA + chA, cvA0, cvA1);
  if (wr == 1) G_BAR;
  G_WAIT_V(4); G_BAR;
  G_STAGE(G_SB(1, 0), cB + kstep, cvB0, cvB1); G_STAGE(G_SA(1, 0), cA + kstep, cvA0, cvA1); G_STAGE(G_SB(1, 1), cB + chB + kstep, cvB0, cvB1);
  G_WAIT_V(6); G_BAR;
  for (;;) {
    const bool has_next = S.next(ui + 1, nxt);
    const char* nA = has_next ? nxt.A : cA;
    const char* nB = has_next ? nxt.B : cB;
    int nt = cur.nt;
    asm volatile("" : "+s"(nt));
    for (int t = 0; t < nt; t += 2) {
      const bool last = (t == nt - 2);
      const char* a1 = cA + (size_t)(t + 1) * kstep;
      const char* a2 = last ? nA : cA + (size_t)(t + 2) * kstep;
      const char* b2 = last ? nB : cB + (size_t)(t + 2) * kstep;
      const char* a3 = a2 + kstep;
      const char* b3 = b2 + kstep;
      G_LDB(B0, 0, 0); G_SCHED; G_LDA(At, 0, 0); G_STAGE(G_SA(1, 1), a1 + chA, cvA0, cvA1);
      G_WAIT_L(8); G_BAR; G_WAIT_L(0); G_MMA(0, 0, At, B0); G_BAR; G_SCHED;
      G_LDB(B1, 0, 1); G_STAGE(G_SB(0, 0), b2, cvB0, cvB1);
      G_BAR; G_WAIT_L(0); G_MMA(0, 1, At, B1); G_BAR;
      G_LDA(At, 0, 1); G_STAGE(G_SA(0, 0), a2, cvA0, cvA1);
      G_BAR; G_WAIT_L(0); G_MMA(1, 0, At, B0); G_BAR; G_SCHED;
      G_STAGE(G_SB(0, 1), b2 + chB, cvB0, cvB1);
      G_WAIT_V(6); G_BAR; G_MMA(1, 1, At, B1); G_BAR;
      G_LDB(B0, 1, 0); G_SCHED; G_LDA(At, 1, 0); G_STAGE(G_SA(0, 1), a2 + chA, cvA0, cvA1);
      G_WAIT_L(8); G_BAR; G_WAIT_L(0); G_MMA(0, 0, At, B0); G_BAR; G_SCHED;
      G_LDB(B1, 1, 1); G_STAGE(G_SB(1, 0), b3, cvB0, cvB1);
      G_BAR; G_WAIT_L(0); G_MMA(0, 1, At, B1); G_BAR;
      G_LDA(At, 1, 1); G_STAGE(G_SA(1, 0), a3, cvA0, cvA1);
      G_BAR; G_WAIT_L(0); G_MMA(1, 0, At, B0); G_BAR; G_SCHED;
      G_STAGE(G_SB(1, 1), b3 + chB, cvB0, cvB1);
      G_WAIT_V(6); G_BAR; G_MMA(1, 1, At, B1); G_BAR;
    }
    E(acc, cur, wr, wc, fr, fq);
    if (!has_next) break;
#pragma unroll
    for (int a = 0; a < 2; ++a)
#pragma unroll
      for (int b = 0; b < 2; ++b)
#pragma unroll
        for (int m = 0; m < 4; ++m)
#pragma unroll
          for (int n = 0; n < 2; ++n) acc[a][b][m][n] = f4{0.f, 0.f, 0.f, 0.f};
    cur = nxt; cA = nA; cB = nB; ++ui;
  }
  G_WAIT_V(0);
  if (wr == 0) G_BAR;
  G_BAR;
#undef G_SA
#undef G_SB
#undef G_STAGE
#undef G_LDA
#undef G_LDB
#undef G_MMA
#undef G_WAIT_V
#undef G_WAIT_L
#undef G_BAR
#undef G_SCHED
}

DI h8 pack8(const f4& a, const f4& b) {
  h8 o;
  o[0] = (half_t)a[0]; o[1] = (half_t)a[1]; o[2] = (half_t)a[2]; o[3] = (half_t)a[3];
  o[4] = (half_t)b[0]; o[5] = (half_t)b[1]; o[6] = (half_t)b[2]; o[7] = (half_t)b[3];
  return o;
}
DI int row0_of(int pm, int mode) { return mode == 0 ? pm * 256 : (mode == 1 ? (pm >> 3) * TOK + (pm & 7) * 256 : pm * TOK + SEQ); }

struct SchedInproj {
  const half_t* hbuf; const half_t* Wl; int G, c;
  static constexpr unsigned lda2 = 2048, ldb2 = 2048;
  DI bool next(int i, GUnit& u) const {
    const int L = i * G + c;
    u.nt = 16;
    if (L < 144 * 8) {
      tile_map(L, 144, 8, u.pm, u.pn);
      u.A = (const char*)(hbuf + (size_t)u.pm * 256 * 1024); u.B = (const char*)(Wl + W_QK + (size_t)u.pn * 256 * 1024); u.aux = 0;
      return true;
    }
    if (!tile_map(L - 144 * 8, 3, 144, u.pm, u.pn)) return false;
    u.A = (const char*)(Wl + W_V + (size_t)u.pm * 256 * 1024); u.B = (const char*)(hbuf + (size_t)u.pn * 256 * 1024); u.aux = 1;
    return true;
  }
};
struct EpiInproj {
  half_t* big;
  DI void operator()(const f4 (&acc)[2][2][4][2], const GUnit& u, int wr, int wc, int fr, int fq) const {
    if (u.aux == 0) {
      const int g0 = u.pm * 256, b = g0 / TOK, t0 = g0 - b * TOK + wr * 64;
#pragma unroll
      for (int bj = 0; bj < 2; ++bj) {
        const int cb = u.pn * 256 + bj * 128 + wc * 32;
        half_t* ptr; int ts;
        if (cb < 576) { ptr = big + B_ZMLA + (size_t)b * TOK * ZS + cb; ts = ZS; }
        else if (cb < 1088) { const int c = cb - 576, part = c >> 8, hh = (c >> 6) & 3; ptr = big + (part ? B_KNA : B_QNA) + (size_t)(b * 4 + hh) * TOK * 64 + (c & 63); ts = 64; }
        else if (cb < 1600) { const int c = cb - 1088, part = c >> 8, hm = (c >> 5) & 7; ptr = big + (part ? B_KDF : B_QDF) + (size_t)(b * 8 + hm) * TOK * 32; ts = 32; }
        else if (cb < 1856) { const int c = cb - 1600; ptr = big + B_QG + (size_t)(b * 4 + (c >> 6)) * TOK * 64 + (c & 63); ts = 64; }
        else if (cb < 1984) { const int c = cb - 1856; ptr = big + B_KG + (size_t)(b * 2 + (c >> 6)) * TOK * 64 + (c & 63); ts = 64; }
        else continue;
        const unsigned lo = (unsigned)(fr * ts + 8 * fq) * 2u;
        char* rb = (char*)(ptr + (size_t)t0 * ts);
#pragma unroll
        for (int ai = 0; ai < 2; ++ai)
#pragma unroll
          for (int m = 0; m < 4; ++m)
            *(h8*)(rb + (size_t)((ai * 128 + m * 16) * ts) * 2 + lo) = pack8(acc[ai][bj][m][0], acc[ai][bj][m][1]);
      }
    } else {
      const int g0 = u.pn * 256, b = g0 / TOK, t0 = g0 - b * TOK;
      const int nh = (u.pm == 2) ? 2 : 4;
      char* vt = (char*)(big + (u.pm == 0 ? B_VTNA : (u.pm == 1 ? B_VTDF : B_VTG)) + (size_t)b * nh * 64 * TOK + (size_t)(wr * 64) * TOK + t0 + wc * 32);
      const unsigned lo = (unsigned)(fr * TOK + 8 * fq) * 2u;
#pragma unroll
      for (int ai = 0; ai < 2; ++ai) {
        if (u.pm == 2 && ai == 1) continue;
#pragma unroll
        for (int m = 0; m < 4; ++m)
#pragma unroll
          for (int bj = 0; bj < 2; ++bj)
            *(h8*)(vt + ((size_t)(ai * 128 + m * 16) * TOK + bj * 128) * 2 + lo) = pack8(acc[ai][bj][m][0], acc[ai][bj][m][1]);
      }
    }
  }
};

struct SchedMlaQK {
  const half_t* Wl; const half_t* zmla; int G, c;
  static constexpr unsigned lda2 = ZS * 2, ldb2 = 512;
  DI bool next(int i, GUnit& u) const {
    const int L = i * G + c;
    u.nt = 4;
    if (L < 288) {
      tile_map(L, 144, 2, u.pm, u.pn);
      u.A = (const char*)(zmla + (size_t)u.pm * 256 * ZS);
      u.B = (const char*)(Wl + W_UQ + (size_t)u.pn * 256 * 256); u.aux = 0;
      return true;
    }
    if (L < 432) {
      u.pm = L - 288; u.pn = 0;
      u.A = (const char*)(zmla + 256 + (size_t)u.pm * 256 * ZS);
      u.B = (const char*)(Wl + W_UK); u.aux = 1;
      return true;
    }
    return false;
  }
};
struct SchedMlaV {
  const half_t* Wl; const half_t* zmla; int G, c;
  static constexpr unsigned lda2 = 512, ldb2 = ZS * 2;
  DI bool next(int i, GUnit& u) const {
    const int L = i * G + c;
    if (L >= 144) return false;
    u.nt = 4; u.pm = 0; u.pn = L;
    u.A = (const char*)(Wl + W_UV);
    u.B = (const char*)(zmla + 256 + (size_t)u.pn * 256 * ZS); u.aux = 2;
    return true;
  }
};
struct EpiMla {
  half_t* big;
  DI void operator()(const f4 (&acc)[2][2][4][2], const GUnit& u, int wr, int wc, int fr, int fq) const {
    if (u.aux < 2) {
      const int g0 = u.pm * 256, b = g0 / TOK, t0 = g0 - b * TOK + wr * 64;
      const unsigned lo = (unsigned)(fr * 96 + 8 * fq) * 2u;
#pragma unroll
      for (int bj = 0; bj < 2; ++bj) {
        const int cb = u.pn * 256 + bj * 128 + wc * 32;
        half_t* ptr;
        if (u.aux == 0) {
          if (cb >= 384) continue;
          const int hh = cb / 96, dd = cb - hh * 96;
          ptr = big + B_QM + (size_t)(b * 4 + hh) * TOK * 96 + dd;
        } else {
          ptr = big + B_KM + (size_t)(b * 4 + (cb >> 6)) * TOK * 96 + (cb & 63);
        }
        char* rb = (char*)(ptr + (size_t)t0 * 96);
#pragma unroll
        for (int ai = 0; ai < 2; ++ai)
#pragma unroll
          for (int m = 0; m < 4; ++m)
            *(h8*)(rb + (size_t)((ai * 128 + m * 16) * 96) * 2 + lo) = pack8(acc[ai][bj][m][0], acc[ai][bj][m][1]);
      }
    } else {
      const int g0 = u.pn * 256, b = g0 / TOK, t0 = g0 - b * TOK;
      char* vt = (char*)(big + B_VTM + (size_t)b * 4 * 64 * TOK + (size_t)(wr * 64) * TOK + t0 + wc * 32);
      const unsigned lo = (unsigned)(fr * TOK + 8 * fq) * 2u;
#pragma unroll
      for (int ai = 0; ai < 2; ++ai)
#pragma unroll
        for (int m = 0; m < 4; ++m)
#pragma unroll
          for (int bj = 0; bj < 2; ++bj)
            *(h8*)(vt + ((size_t)(ai * 128 + m * 16) * TOK + bj * 128) * 2 + lo) = pack8(acc[ai][bj][m][0], acc[ai][bj][m][1]);
    }
  }
};

struct SchedRows {
  const half_t* A; const half_t* B; int K, nM, nN, G, c; int mode; unsigned lda2, ldb2;
  DI bool next(int i, GUnit& u) const {
    if (!tile_map(i * G + c, nM, nN, u.pm, u.pn)) return false;
    u.A = (const char*)(A + (size_t)row0_of(u.pm, mode) * K); u.B = (const char*)(B + (size_t)u.pn * 256 * K);
    u.nt = K >> 6; u.aux = 0;
    return true;
  }
};
struct SchedResid {
  const half_t* A; const half_t* B; int K, nN, nctx, G, c; unsigned lda2, ldb2;
  DI bool next(int i, GUnit& u) const {
    const int L = i * G + c, nfull = 128 * nN;
    if (L < nfull) {
      tile_map(L, 128, nN, u.pm, u.pn);
      u.A = (const char*)(A + (size_t)row0_of(u.pm, 1) * K); u.B = (const char*)(B + (size_t)u.pn * 256 * K);
      u.nt = K >> 6; u.aux = 0;
      return true;
    }
    const int L2 = L - nfull;
    if (L2 >= nctx * nN * 4) return false;
    const int ks = L2 & 3, t = L2 >> 2;
    u.pm = t / nN; u.pn = t - u.pm * nN;
    const int kq = K >> 2;
    u.A = (const char*)(A + (size_t)row0_of(u.pm, 2) * K + ks * kq); u.B = (const char*)(B + (size_t)u.pn * 256 * K + ks * kq);
    u.nt = kq >> 6; u.aux = 1; u.ks = ks;
    return true;
  }
};
struct EpiResid {
  const float* xl_src; float* xl_dst; float* part; const float* mods_l; int gt_off;
  DI void operator()(const f4 (&acc)[2][2][4][2], const GUnit& u, int wr, int wc, int fr, int fq) const {
    const bool isctx = u.aux == 1;
    const int g0 = row0_of(u.pm, isctx ? 2 : 1), b = g0 / TOK, t0 = g0 - b * TOK;
    const int col0 = u.pn * 256 + wc * 32;
    const size_t rowoff = (size_t)(wr * 64) * 1024 + col0;
    const char* src = (const char*)(xl_src + ((size_t)b * SEQ + (isctx ? 0 : t0)) * 1024 + rowoff);
    char* dst = (char*)(xl_dst + ((size_t)b * SEQ + (isctx ? 0 : t0)) * 1024 + rowoff);
    const char* gt = (const char*)(mods_l + (size_t)(isctx ? 16 : b) * 6144 + gt_off + col0);
    const unsigned lo = (unsigned)(fr * 1024 + 4 * fq) * 4u, glo = (unsigned)(4 * fq) * 4u;
    f4 gv[2][2];
#pragma unroll
    for (int bj = 0; bj < 2; ++bj)
#pragma unroll
      for (int n = 0; n < 2; ++n) gv[bj][n] = *(const f4*)(gt + (bj * 128 + n * 16) * 4 + glo);
    if (!isctx) {
#pragma unroll
      for (int ai = 0; ai < 2; ++ai)
#pragma unroll
        for (int mh = 0; mh < 2; ++mh) {
          f4 xv[2][2][2];
#pragma unroll
          for (int mm = 0; mm < 2; ++mm)
#pragma unroll
            for (int bj = 0; bj < 2; ++bj)
#pragma unroll
              for (int n = 0; n < 2; ++n)
                xv[mm][bj][n] = *(const f4*)(src + ((size_t)(ai * 128 + (mh * 2 + mm) * 16) * 1024 + bj * 128 + n * 16) * 4 + lo);
#pragma unroll
          for (int mm = 0; mm < 2; ++mm)
#pragma unroll
            for (int bj = 0; bj < 2; ++bj)
#pragma unroll
              for (int n = 0; n < 2; ++n)
                *(f4*)(dst + ((size_t)(ai * 128 + (mh * 2 + mm) * 16) * 1024 + bj * 128 + n * 16) * 4 + lo) =
                    xv[mm][bj][n] + gv[bj][n] * acc[ai][bj][mh * 2 + mm][n];
        }
    } else {
      char* pp = (char*)(part + ((size_t)u.ks * NB * CTX + (size_t)b * CTX + (t0 - SEQ) + wr * 64) * 1024 + col0);
#pragma unroll
      for (int ai = 0; ai < 2; ++ai)
#pragma unroll
        for (int m = 0; m < 4; ++m)
#pragma unroll
          for (int bj = 0; bj < 2; ++bj)
#pragma unroll
            for (int n = 0; n < 2; ++n)
              *(f4*)(pp + ((size_t)(ai * 128 + m * 16) * 1024 + bj * 128 + n * 16) * 4 + lo) = gv[bj][n] * acc[ai][bj][m][n];
    }
  }
};
struct EpiUp {
  half_t* ubuf; int skip_ctx;
  DI void operator()(const f4 (&acc)[2][2][4][2], const GUnit& u, int wr, int wc, int fr, int fq) const {
    const int g0 = row0_of(u.pm, skip_ctx);
    char* rb = (char*)(ubuf + (size_t)(g0 + wr * 64) * 4096 + u.pn * 256 + wc * 32);
    const unsigned lo = (unsigned)(fr * 4096 + 8 * fq) * 2u;
#pragma unroll
    for (int ai = 0; ai < 2; ++ai)
#pragma unroll
      for (int m = 0; m < 4; ++m)
#pragma unroll
        for (int bj = 0; bj < 2; ++bj) {
          f4 a = acc[ai][bj][m][0], c = acc[ai][bj][m][1];
#pragma unroll
          for (int j = 0; j < 4; ++j) { a[j] = fmaxf(a[j], 0.f); a[j] *= a[j]; c[j] = fmaxf(c[j], 0.f); c[j] *= c[j]; }
          *(h8*)(rb + ((size_t)(ai * 128 + m * 16) * 4096 + bj * 128) * 2 + lo) = pack8(a, c);
        }
  }
};

template <int DLEN, int LPR, int ROPE, bool KR>
DI void norm_rows(half_t* base, int stride, int nrows, const float* gain, float oscale, const half_t* zmla, int wv_) {
  const int tid_ = tid_opaque(wv_);
  const int lane = tid_ & 63, wave = tid_ >> 6;
  constexpr int RPW = 64 / LPR;
  const int s = lane % LPR, sub = lane / LPR;
  const bool active = s * 8 < DLEN;
  float gn[8];
#pragma unroll
  for (int i = 0; i < 8; ++i) gn[i] = active ? gain[s * 8 + i] : 0.f;
  for (int r0 = (blockIdx.x * NWAVE + wave) * RPW; r0 < nrows; r0 += gridDim.x * NWAVE * RPW) {
    const int rho = r0 + sub;
    const int t = rho % TOK;
    half_t* ptr = base + (size_t)rho * stride + s * 8;
    const half_t* src = ptr;
    if (KR && s >= 8) {
      const int b = rho / (4 * TOK);
      src = zmla + ((size_t)b * TOK + t) * ZS + 512 + (s - 8) * 8;
    }
    float f[8];
    float ss = 0.f;
    if (active) {
      const h8 v = *(const h8*)src;
#pragma unroll
      for (int i = 0; i < 8; ++i) { f[i] = (float)v[i]; ss += f[i] * f[i]; }
    } else {
#pragma unroll
      for (int i = 0; i < 8; ++i) f[i] = 0.f;
    }
#pragma unroll
    for (int o = LPR / 2; o > 0; o >>= 1) ss += __shfl_xor(ss, o);
    const float rstd = rsqrtf(ss * (1.f / DLEN) + EPS);
#pragma unroll
    for (int i = 0; i < 8; ++i) f[i] = f[i] * rstd * gn[i];
    if (ROPE != 0) {
      constexpr int PX = (ROPE == 64) ? 2 : 1;
      float pf[8];
#pragma unroll
      for (int i = 0; i < 8; ++i) pf[i] = __shfl_xor(f[i], PX);
      constexpr int RB = (DLEN - ROPE) / 8;
      if (t < SEQ && s >= RB && active) {
        const int sr = s - RB;
        const int q = (ROPE == 64) ? (sr >> 1) : sr;
        const float pos = (float)((q < 2) ? (t >> 6) : (t & 63));
        const float sgn = (q & 1) ? 1.f : -1.f;
#pragma unroll
        for (int i = 0; i < 8; ++i) {
          const int idx = (ROPE == 64) ? ((sr & 1) * 8 + i) : i;
          constexpr float NF = (ROPE == 64) ? 16.f : 8.f;
          const float invf = exp2f(-(float)idx * (13.287712379549449f / NF));
          const float ang = pos * invf;
          float sn, cs;
          sincosf(ang, &sn, &cs);
          f[i] = f[i] * cs + sgn * pf[i] * sn;
        }
      }
    }
    if (active) {
      h8 o;
#pragma unroll
      for (int i = 0; i < 8; ++i) o[i] = (half_t)(f[i] * oscale);
      *(h8*)ptr = o;
    }
  }
}

constexpr int ATT_STAGE = 22528, ATT_VOFF = 13312, ATT_STASH = 49152;
template <int DQ, bool NA, int NQG>
DI void attn_wg(const half_t* Qp, const half_t* Kp, const half_t* Vp, int q0, bool active, int seg0_start, int seg0_tiles,
                int seg1_start, int seg1_tiles, const float* rpb_h, int rq, char* smem, int tid, f16v (&O)[2][NQG]) {
  constexpr int NKS = DQ / 16, KSTR = DQ + 8, VSTR = 72, CPK = DQ / 8, KCH = 64 * CPK;
  const int lane = tid & 63, r = lane & 31, h = lane >> 5;
  h8 qf[NQG][NKS];
#pragma unroll
  for (int qg = 0; qg < NQG; ++qg)
#pragma unroll
    for (int ks = 0; ks < NKS; ++ks) qf[qg][ks] = *(const h8*)(Qp + (size_t)(q0 + qg * 32 + r) * DQ + ks * 16 + h * 8);
  float mrun[NQG], lrun[NQG];
#pragma unroll
  for (int qg = 0; qg < NQG; ++qg) { mrun[qg] = -1e30f; lrun[qg] = 0.f; }
#pragma unroll
  for (int a = 0; a < 2; ++a)
#pragma unroll
    for (int c = 0; c < NQG; ++c)
#pragma unroll
      for (int i = 0; i < 16; ++i) O[a][c][i] = 0.f;
  const int ntiles = seg0_tiles + seg1_tiles;
  const int kc0 = tid, kc1 = tid + 512;
  const half_t* kg0 = Kp + kc0 * 8;
  const half_t* kg1 = Kp + kc1 * 8;
  const half_t* vg = Vp + (size_t)(tid >> 3) * TOK + (tid & 7) * 8;
  const int ks0 = (kc0 / CPK) * KSTR + (kc0 % CPK) * 8, ks1 = (kc1 / CPK) * KSTR + (kc1 % CPK) * 8, vs0 = (tid >> 3) * VSTR + (tid & 7) * 8;
  uint4 kreg0 = {0, 0, 0, 0}, kreg1 = {0, 0, 0, 0}, vreg;
  const int r0w = min(max(rq - 4, 0), 24);
  {
    const int k0 = (0 < seg0_tiles) ? seg0_start : seg1_start;
    if (kc0 < KCH) kreg0 = *(const uint4*)(kg0 + (size_t)k0 * DQ);
    if (DQ == 96 && kc1 < KCH) kreg1 = *(const uint4*)(kg1 + (size_t)k0 * DQ);
    vreg = *(const uint4*)(vg + k0);
    if (kc0 < KCH) *(uint4*)((half_t*)smem + ks0) = kreg0;
    if (DQ == 96 && kc1 < KCH) *(uint4*)((half_t*)smem + ks1) = kreg1;
    *(uint4*)((half_t*)(smem + ATT_VOFF) + vs0) = vreg;
  }
  __syncthreads();
  for (int it = 0; it < ntiles; ++it) {
    const int k0 = (it < seg0_tiles) ? seg0_start + it * 64 : seg1_start + (it - seg0_tiles) * 64;
    const bool more = it + 1 < ntiles;
    if (more) {
      const int itn = it + 1;
      const int k1 = (itn < seg0_tiles) ? seg0_start + itn * 64 : seg1_start + (itn - seg0_tiles) * 64;
      if (kc0 < KCH) kreg0 = *(const uint4*)(kg0 + (size_t)k1 * DQ);
      if (DQ == 96 && kc1 < KCH) kreg1 = *(const uint4*)(kg1 + (size_t)k1 * DQ);
      vreg = *(const uint4*)(vg + k1);
    }
    const half_t* ksm = (const half_t*)(smem + (it & 1) * ATT_STAGE) + r * KSTR + h * 8;
    const half_t* vsm = (const half_t*)(smem + (it & 1) * ATT_STAGE + ATT_VOFF) + r * VSTR + h * 4;
    const bool masked = NA && it < seg0_tiles;
    const int krow = k0 >> 6;
    const bool need = active && (!masked || (krow >= r0w && krow < r0w + 8));
    if (need) {
#pragma unroll 1
      for (int st = 0; st < 2; ++st) {
        f16v S[NQG];
#pragma unroll
        for (int qg = 0; qg < NQG; ++qg)
#pragma unroll
          for (int i = 0; i < 16; ++i) S[qg][i] = 0.f;
#pragma unroll
        for (int ks = 0; ks < NKS; ++ks) {
          const h8 kf = *(const h8*)(ksm + (st * 32) * KSTR + ks * 16);
#pragma unroll
          for (int qg = 0; qg < NQG; ++qg) S[qg] = __builtin_amdgcn_mfma_f32_32x32x16_f16(kf, qf[qg][ks], S[qg], 0, 0, 0);
        }
        if (masked) {
          const int cb = st * 32;
          const int dr = krow - rq + 7;
#pragma unroll
          for (int qg = 0; qg < NQG; ++qg) {
            const int qc = qg * 32 + r;
            const int cs = min(max(qc - 8, 0), 48);
#pragma unroll
            for (int i = 0; i < 16; ++i) {
              const int c = cb + (i & 3) + 8 * (i >> 2) + 4 * h;
              const bool valid = (c >= cs) && (c < cs + 16);
              float bias = 0.f;
              if (valid) bias = rpb_h[dr * 31 + (c - qc + 15)] * LOG2E;
              S[qg][i] = valid ? S[qg][i] + bias : -1e30f;
            }
          }
        }
        h4 vf[2][2][2];
#pragma unroll
        for (int dvt = 0; dvt < 2; ++dvt)
#pragma unroll
          for (int sx = 0; sx < 2; ++sx)
#pragma unroll
            for (int hf = 0; hf < 2; ++hf) vf[dvt][sx][hf] = *(const h4*)(vsm + (dvt * 32) * VSTR + st * 32 + sx * 16 + hf * 8);
#pragma unroll
        for (int qg = 0; qg < NQG; ++qg) {
          h8 P[2];
          float mx = S[qg][0];
#pragma unroll
          for (int i = 1; i < 16; ++i) mx = fmaxf(mx, S[qg][i]);
          mx = fmaxf(mx, __shfl_xor(mx, 32));
          const float mn = fmaxf(mrun[qg], mx);
          if (__builtin_amdgcn_ballot_w64(mn > mrun[qg]) != 0ull) {
            const float alpha = __builtin_amdgcn_exp2f(mrun[qg] - mn);
            lrun[qg] *= alpha;
#pragma unroll
            for (int dvt = 0; dvt < 2; ++dvt)
#pragma unroll
              for (int i = 0; i < 16; ++i) O[dvt][qg][i] *= alpha;
            mrun[qg] = mn;
          }
          float rs = 0.f;
#pragma unroll
          for (int i = 0; i < 16; ++i) {
            float pv = __builtin_amdgcn_exp2f(S[qg][i] - mn);
            if (NA) pv = (S[qg][i] <= -1e29f) ? 0.f : pv;
            rs += pv;
            P[i >> 3][i & 7] = (half_t)pv;
          }
          lrun[qg] += rs;
#pragma unroll
          for (int dvt = 0; dvt < 2; ++dvt) {
#pragma unroll
            for (int sx = 0; sx < 2; ++sx) {
              const h8 va = __builtin_shufflevector(vf[dvt][sx][0], vf[dvt][sx][1], 0, 1, 2, 3, 4, 5, 6, 7);
              O[dvt][qg] = __builtin_amdgcn_mfma_f32_32x32x16_f16(va, P[sx], O[dvt][qg], 0, 0, 0);
            }
          }
        }
      }
    }
    if (more) {
      char* nb = smem + ((it + 1) & 1) * ATT_STAGE;
      if (kc0 < KCH) *(uint4*)((half_t*)nb + ks0) = kreg0;
      if (DQ == 96 && kc1 < KCH) *(uint4*)((half_t*)nb + ks1) = kreg1;
      *(uint4*)((half_t*)(nb + ATT_VOFF) + vs0) = vreg;
    }
    __syncthreads();
  }
#pragma unroll
  for (int qg = 0; qg < NQG; ++qg) {
    const float lt = lrun[qg] + __shfl_xor(lrun[qg], 32);
    const float inv = 1.f / lt;
#pragma unroll
    for (int dvt = 0; dvt < 2; ++dvt)
#pragma unroll
      for (int i = 0; i < 16; ++i) O[dvt][qg][i] *= inv;
  }
}

template <int NQG>
DI void store_o(const f16v (&O)[2][NQG], half_t* orow0  , int lane) {
  const int r = lane & 31, h = lane >> 5;
#pragma unroll
  for (int qg = 0; qg < NQG; ++qg)
#pragma unroll
    for (int dvt = 0; dvt < 2; ++dvt)
#pragma unroll
      for (int c = 0; c < 4; ++c) {
        h4 o;
#pragma unroll
        for (int j = 0; j < 4; ++j) o[j] = (half_t)O[dvt][qg][4 * c + j];
        *(h4*)(orow0 + (size_t)(qg * 32 + r) * 1024 + dvt * 32 + 8 * c + 4 * h) = o;
      }
}

DI void phase_attn(int l, half_t* big, bool need_ctx, char* smem, int wv_) {
  const KPtr p = kp();
  const int wave = wv_;
  const int NQB = need_ctx ? 5 : 4;
  half_t* obuf = big + B_O;
  const float lam_init = 0.8f - 0.6f * expf(-0.3f * (float)l);
  float lam;
  {
    float d1 = 0.f, d2 = 0.f;
#pragma unroll 1
    for (int i = 0; i < 32; ++i) {
      d1 += p->lq1[l * 32 + i] * p->lk1[l * 32 + i];
      d2 += p->lq2[l * 32 + i] * p->lk2[l * 32 + i];
    }
    lam = expf(d1) - expf(d2) + lam_init;
    lam = __builtin_bit_cast(float, __builtin_amdgcn_readfirstlane(__builtin_bit_cast(int, lam)));
  }
  const float one_m_li = __builtin_bit_cast(float, __builtin_amdgcn_readfirstlane(__builtin_bit_cast(int, 1.f - lam_init)));
  const int per = 4 * 16 * NQB;
#pragma unroll
  for (int mixer = 0; mixer < 4; ++mixer) {
    const int lo = mixer * per;
    const int first = lo + (int)((blockIdx.x + gridDim.x - (lo % gridDim.x)) % gridDim.x);
    const int tid_m = tid_opaque(wv_);
    const int lane = tid_m & 63, h = lane >> 5;
#pragma unroll 1
    for (int item = first; item < lo + per; item += gridDim.x) {
      const int hi = item / (16 * NQB);
      const int rem = item - hi * 16 * NQB;
      const int b = rem / NQB, qb = rem - b * NQB;
      const bool qctx = qb == 4;
      const bool active = !qctx || wave < 4;
      const int q0 = active ? qb * 512 + wave * 64 : SEQ;
      const int hh = hi & 3;
      const int s0 = qctx ? SEQ : 0, n0t = qctx ? 4 : 36;
      f16v O[2][2];
      half_t* orow = obuf + (size_t)(b * TOK + q0) * 1024 + hh * 64;
      if (mixer == 0) {
        half_t* stash = (half_t*)(smem + ATT_STASH) + wave * 4096;
        attn_wg<32, false, 2>(big + B_QDF + (size_t)(b * 8 + hh * 2) * TOK * 32, big + B_KDF + (size_t)(b * 8 + hh * 2) * TOK * 32,
                              big + B_VTDF + (size_t)(b * 4 + hh) * 64 * TOK, q0, active, s0, n0t, 0, 0, nullptr, 0, smem, tid_m, O);
#pragma unroll
        for (int dvt = 0; dvt < 2; ++dvt)
#pragma unroll
          for (int qg = 0; qg < 2; ++qg)
#pragma unroll
            for (int i = 0; i < 16; ++i) stash[((dvt * 2 + qg) * 16 + i) * 64 + lane] = (half_t)O[dvt][qg][i];
        attn_wg<32, false, 2>(big + B_QDF + (size_t)(b * 8 + hh * 2 + 1) * TOK * 32, big + B_KDF + (size_t)(b * 8 + hh * 2 + 1) * TOK * 32,
                              big + B_VTDF + (size_t)(b * 4 + hh) * 64 * TOK, q0, active, s0, n0t, 0, 0, nullptr, 0, smem, tid_m, O);
#pragma unroll
        for (int qg = 0; qg < 2; ++qg) {
          float ss = 0.f;
#pragma unroll
          for (int dvt = 0; dvt < 2; ++dvt)
#pragma unroll
            for (int i = 0; i < 16; ++i) {
              const float v = (float)stash[((dvt * 2 + qg) * 16 + i) * 64 + lane] - lam * O[dvt][qg][i];
              O[dvt][qg][i] = v;
              ss += v * v;
            }
          ss += __shfl_xor(ss, 32);
          const float rstd = rsqrtf(ss * (1.f / 64.f) + EPS) * one_m_li;
#pragma unroll
          for (int dvt = 0; dvt < 2; ++dvt)
#pragma unroll
            for (int i = 0; i < 16; ++i) {
              const int dv = dvt * 32 + (i & 3) + 8 * (i >> 2) + 4 * h;
              O[dvt][qg][i] *= rstd * p->g_diff_sub[l * 64 + dv];
            }
        }
        if (active) store_o<2>(O, orow + 2 * 256, lane);
      } else if (mixer == 1) {
        attn_wg<96, false, 2>(big + B_QM + (size_t)(b * 4 + hh) * TOK * 96, big + B_KM + (size_t)(b * 4 + hh) * TOK * 96,
                              big + B_VTM + (size_t)(b * 4 + hh) * 64 * TOK, q0, active, s0, n0t, 0, 0, nullptr, 0, smem, tid_m, O);
        if (active) store_o<2>(O, orow + 0 * 256, lane);
      } else if (mixer == 2) {
        const int kv = hh >> 1;
        attn_wg<64, false, 2>(big + B_QG + (size_t)(b * 4 + hh) * TOK * 64, big + B_KG + (size_t)(b * 2 + kv) * TOK * 64,
                              big + B_VTG + (size_t)(b * 2 + kv) * 64 * TOK, q0, active, s0, n0t, 0, 0, nullptr, 0, smem, tid_m, O);
        if (active) store_o<2>(O, orow + 3 * 256, lane);
      } else {
        const int rq = q0 >> 6;
        const int rq0 = qb * 8;
        const int rlo = min(max(rq0 - 4, 0), 24), rhi = min(max(rq0 + 7 - 4, 0), 24) + 8;
        const int seg0s = rlo * 64, seg0n = qctx ? 0 : (rhi - rlo);
        attn_wg<64, true, 2>(big + B_QNA + (size_t)(b * 4 + hh) * TOK * 64, big + B_KNA + (size_t)(b * 4 + hh) * TOK * 64,
                             big + B_VTNA + (size_t)(b * 4 + hh) * 64 * TOK, q0, active, seg0s, seg0n, SEQ, 4,
                             p->na_rpb + (size_t)(l * 4 + hh) * 15 * 31, rq, smem, tid_m, O);
        if (active) store_o<2>(O, orow + 1 * 256, lane);
      }
    }
  }
}

struct SchedGate {
  const half_t* hbuf; const half_t* Wl; int pm0, cnt, G, c, mode;
  static constexpr unsigned lda2 = 2048, ldb2 = 2048;
  DI bool next(int i, GUnit& u) const {
    int pm, pn;
    if (!tile_map(i * G + c, cnt, 16, pm, pn)) return false;
    u.pm = pm0 + pm; u.pn = pn; u.nt = 16; u.aux = 0;
    u.A = (const char*)(hbuf + (size_t)row0_of(u.pm, mode) * 1024); u.B = (const char*)(Wl + W_GATE + (size_t)pn * 256 * 1024);
    return true;
  }
};
struct EpiGate {
  half_t* gb; int pm0;
  DI void operator()(const f4 (&acc)[2][2][4][2], const GUnit& u, int wr, int wc, int fr, int fq) const {
    char* rb = (char*)(gb + (size_t)((u.pm - pm0) * 256 + wr * 64) * 4096 + u.pn * 256 + wc * 32);
    const unsigned lo = (unsigned)(fr * 4096 + 8 * fq) * 2u;
#pragma unroll
    for (int ai = 0; ai < 2; ++ai)
#pragma unroll
      for (int m = 0; m < 4; ++m)
#pragma unroll
        for (int bj = 0; bj < 2; ++bj) {
          f4 a = acc[ai][bj][m][0], c = acc[ai][bj][m][1];
#pragma unroll
          for (int j = 0; j < 4; ++j) { a[j] = __builtin_amdgcn_rcpf(1.f + __expf(-a[j])); c[j] = __builtin_amdgcn_rcpf(1.f + __expf(-c[j])); }
          *(h8*)(rb + ((size_t)(ai * 128 + m * 16) * 4096 + bj * 128) * 2 + lo) = pack8(a, c);
        }
  }
};
struct SchedProj {
  const half_t* obuf; const half_t* Wl; int pm0, cnt, G, c, mode;
  static constexpr unsigned lda2 = 2048, ldb2 = 512;
  DI bool next(int i, GUnit& u) const {
    int pm, pn;
    if (!tile_map((i >> 2) * G + c, cnt, 4, pm, pn)) return false;
    const int br = i & 3;
    u.pm = pm0 + pm; u.pn = pn; u.nt = 4; u.aux = br;
    u.A = (const char*)(obuf + (size_t)row0_of(u.pm, mode) * 1024 + br * 256);
    u.B = (const char*)(Wl + W_BR + (size_t)(br * 1024 + pn * 256) * 256);
    return true;
  }
};
struct EpiProj {
  const half_t* gb; half_t* mbuf; int pm0, mode;
  DI void operator()(const f4 (&acc)[2][2][4][2], const GUnit& u, int wr, int wc, int fr, int fq) const {
    const int br = u.aux;
    const char* gp = (const char*)(gb + (size_t)((u.pm - pm0) * 256 + wr * 64) * 4096 + br * 1024 + u.pn * 256 + wc * 32);
    char* mp = (char*)(mbuf + (size_t)(row0_of(u.pm, mode) + wr * 64) * 1024 + u.pn * 256 + wc * 32);
    const unsigned glo = (unsigned)(fr * 4096 + 8 * fq) * 2u, mlo = (unsigned)(fr * 1024 + 8 * fq) * 2u;
#pragma unroll
    for (int ai = 0; ai < 2; ++ai) {
      h8 gq[4][2], mq[4][2];
#pragma unroll
      for (int m = 0; m < 4; ++m)
#pragma unroll
        for (int bj = 0; bj < 2; ++bj) gq[m][bj] = *(const h8*)(gp + ((size_t)(ai * 128 + m * 16) * 4096 + bj * 128) * 2 + glo);
      if (br > 0) {
#pragma unroll
        for (int m = 0; m < 4; ++m)
#pragma unroll
          for (int bj = 0; bj < 2; ++bj) mq[m][bj] = *(const h8*)(mp + ((size_t)(ai * 128 + m * 16) * 1024 + bj * 128) * 2 + mlo);
      }
#pragma unroll
      for (int m = 0; m < 4; ++m)
#pragma unroll
        for (int bj = 0; bj < 2; ++bj) {
          f4 a = acc[ai][bj][m][0], c = acc[ai][bj][m][1];
#pragma unroll
          for (int j = 0; j < 4; ++j) { a[j] *= (float)gq[m][bj][j]; c[j] *= (float)gq[m][bj][4 + j]; }
          if (br > 0) {
#pragma unroll
            for (int j = 0; j < 4; ++j) { a[j] += (float)mq[m][bj][j]; c[j] += (float)mq[m][bj][4 + j]; }
          }
          *(h8*)(mp + ((size_t)(ai * 128 + m * 16) * 1024 + bj * 128) * 2 + mlo) = pack8(a, c);
        }
    }
  }
};

__global__ void __launch_bounds__(NTHR) hybrid_block_megakernel(Params p) {
  __shared__ __attribute__((aligned(16))) char smem[SMEM_BYTES];
  char* ws = kp()->ws;
  if (ws == nullptr) cg::this_grid().sync();
  half_t* W = (half_t*)(ws + OFF_W);
  float* mods = (float*)(ws + OFF_MOD);
  float* xc = (float*)(ws + OFF_XC);
  half_t* hbuf = (half_t*)(ws + OFF_H);
  half_t* big = (half_t*)(ws + OFF_BIG);
  float* part = (float*)(ws + OFF_PART);
  LAS unsigned char* lds = (LAS unsigned char*)smem;
  const int G = gridDim.x, cblk = blockIdx.x;

  const int wv_ = __builtin_amdgcn_readfirstlane((int)threadIdx.x >> 6);
  volatile LAS unsigned* st = (volatile LAS unsigned*)(lds + GEMM_LDS);
  if (threadIdx.x < 4) st[threadIdx.x] = 0u;
  __syncthreads();
  xcd_barrier_post((unsigned*)(ws + OFF_BAR), wv_);

  phase_mods(mods, smem, wv_);
  {
    int base = 0;
    float* tile = (float*)smem;
    for (int l = 0; l < 2; ++l) {
      half_t* Wl = W + (size_t)l * W_LAYER;
      const float* win = kp()->w_in + (size_t)l * 1024 * 6496;
      tconv_job(win, 6496, 0, 1024, 1024, 192, 256, Wl + W_QK, base, tile, wv_);
      tconv_job(win, 6496, 192, 1024, 1024, 128, 256, Wl + W_QK + (size_t)256 * 1024, base, tile, wv_);
      tconv_job(win, 6496, 320, 1024, 1024, 32, 64, Wl + W_QK + (size_t)512 * 1024, base, tile, wv_);
      tconv_job(win, 6496, 352, 1024, 1024, 256, 256, Wl + W_QK + (size_t)576 * 1024, base, tile, wv_);
      tconv_job(win, 6496, 608, 1024, 1024, 256, 256, Wl + W_QK + (size_t)832 * 1024, base, tile, wv_);
      tconv_job(win, 6496, 1120, 1024, 1024, 256, 256, Wl + W_QK + (size_t)1088 * 1024, base, tile, wv_);
      tconv_job(win, 6496, 1376, 1024, 1024, 256, 256, Wl + W_QK + (size_t)1344 * 1024, base, tile, wv_);
      tconv_job(win, 6496, 1888, 1024, 1024, 256, 256, Wl + W_QK + (size_t)1600 * 1024, base, tile, wv_);
      tconv_job(win, 6496, 2144, 1024, 1024, 128, 192, Wl + W_QK + (size_t)1856 * 1024, base, tile, wv_);
      tconv_job(win, 6496, 864, 1024, 1024, 256, 256, Wl + W_V, base, tile, wv_);
      tconv_job(win, 6496, 1632, 1024, 1024, 256, 256, Wl + W_V + (size_t)256 * 1024, base, tile, wv_);
      tconv_job(win, 6496, 2272, 1024, 1024, 128, 256, Wl + W_V + (size_t)512 * 1024, base, tile, wv_);
      tconv_job(win, 6496, 2400, 1024, 1024, 4096, 4096, Wl + W_GATE, base, tile, wv_);
      for (int br = 0; br < 4; ++br)
        tconv_job(kp()->w_branch + ((size_t)l * 4 + br) * 256 * 1024, 1024, 0, 256, 256, 1024, 1024, Wl + W_BR + (size_t)br * 1024 * 256, base, tile, wv_);
      tconv_job(kp()->w_out + (size_t)l * 1024 * 1024, 1024, 0, 1024, 1024, 1024, 1024, Wl + W_OUT, base, tile, wv_);
      tconv_job(kp()->w_up + (size_t)l * 1024 * 4096, 4096, 0, 1024, 1024, 4096, 4096, Wl + W_UP, base, tile, wv_);
      tconv_job(kp()->w_down + (size_t)l * 4096 * 1024, 1024, 0, 4096, 4096, 1024, 1024, Wl + W_DOWN, base, tile, wv_);
      tconv_job(kp()->w_mla_uq + (size_t)l * 192 * 384, 384, 0, 256, 192, 384, 512, Wl + W_UQ, base, tile, wv_);
      for (int hh = 0; hh < 4; ++hh) {
        tconv_job(kp()->w_mla_ukv + (size_t)l * 128 * 512, 512, hh * 128, 256, 128, 64, 64, Wl + W_UK + (size_t)hh * 64 * 256, base, tile, wv_);
        tconv_job(kp()->w_mla_ukv + (size_t)l * 128 * 512, 512, hh * 128 + 64, 256, 128, 64, 64, Wl + W_UV + (size_t)hh * 64 * 256, base, tile, wv_);
      }
    }
  }
  xcd_barrier(ws, lds, wv_);

  for (int l = 0; l < 2; ++l) {
    const bool need_ctx = (l == 0);
    const bool skip_ctx = !need_ctx;
    const half_t* Wl = W + (size_t)l * W_LAYER;
    const float* mods_l = mods + (size_t)l * 17 * 6144;
    const float* xl_src = (l == 0) ? kp()->x : kp()->out;
    const float* xc_src = (l == 0) ? kp()->ctx : xc;
    const int nrt = skip_ctx ? 128 : 144;

    phase_norm(xl_src, xc_src, kp()->g_norm1 + l * 1024, mods_l, 0, 1024, hbuf, false, (l == 1) ? part : nullptr, nullptr, wv_);
    xcd_barrier(ws, lds, wv_);
    {
      SchedInproj S{hbuf, Wl, G, cblk};
      EpiInproj E{big};
      gemm256<true>(lds, S, E, wv_);
    }
    xcd_barrier(ws, lds, wv_);
    {
      half_t* zmla = big + B_ZMLA;
      norm_rows<192, 32, 0, false>(zmla, ZS, NTOK, kp()->g_mla_qa + l * 192, 1.f, nullptr, wv_);
      norm_rows<128, 16, 0, false>(zmla + 256, ZS, NTOK, kp()->g_mla_kva + l * 128, 1.f, nullptr, wv_);
      norm_rows<64, 8, 0, false>(big + B_QNA, 64, NTOK * 4, kp()->g_na_q + l * 64, 0.125f * LOG2E, nullptr, wv_);
      norm_rows<64, 8, 0, false>(big + B_KNA, 64, NTOK * 4, kp()->g_na_k + l * 64, 1.f, nullptr, wv_);
      norm_rows<32, 4, 32, false>(big + B_QDF, 32, NTOK * 8, kp()->g_diff_q + l * 32, 0.17677669529663687f * LOG2E, nullptr, wv_);
      norm_rows<32, 4, 32, false>(big + B_KDF, 32, NTOK * 8, kp()->g_diff_k + l * 32, 1.f, nullptr, wv_);
      norm_rows<64, 8, 64, false>(big + B_QG, 64, NTOK * 4, kp()->g_gqa_q + l * 64, 0.125f * LOG2E, nullptr, wv_);
      norm_rows<64, 8, 64, false>(big + B_KG, 64, NTOK * 2, kp()->g_gqa_k + l * 64, 1.f, nullptr, wv_);
    }
    xcd_barrier(ws, lds, wv_);
    {
      SchedMlaQK S{Wl, big + B_ZMLA, G, cblk};
      EpiMla E{big};
      gemm256<true>(lds, S, E, wv_);
      SchedMlaV S2{Wl, big + B_ZMLA, G, cblk};
      gemm256<true>(lds, S2, E, wv_);
    }
    xcd_barrier(ws, lds, wv_);
    norm_rows<96, 16, 32, false>(big + B_QM, 96, NTOK * 4, kp()->g_mla_q + l * 96, 0.10206207261596575f * LOG2E, nullptr, wv_);
    norm_rows<96, 16, 32, true>(big + B_KM, 96, NTOK * 4, kp()->g_mla_k + l * 96, 1.f, big + B_ZMLA, wv_);
    xcd_barrier(ws, lds, wv_);
    phase_attn(l, big, need_ctx, smem, wv_);
    xcd_barrier(ws, lds, wv_);
    {
      const int nsp = need_ctx ? 3 : 2;
      for (int j = 0; j < nsp; ++j) {
        const int mode = (j < 2) ? 1 : 2, pm0 = (j < 2) ? j * 64 : 0, cnt = (j < 2) ? 64 : 16;
        {
          SchedGate S{hbuf, Wl, pm0, cnt, G, cblk, mode};
          EpiGate E{big + B_G0, pm0};
          gemm256<true>(lds, S, E, wv_);
        }
        xcd_barrier(ws, lds, wv_);
        {
          SchedProj S{big + B_O, Wl, pm0, cnt, G, cblk, mode};
          EpiProj E{big + B_G0, big + B_M, pm0, mode};
          gemm256<true>(lds, S, E, wv_);
        }
        xcd_barrier(ws, lds, wv_);
      }
    }
    {
      SchedResid S{big + B_M, Wl + W_OUT, 1024, 4, need_ctx ? 16 : 0, G, cblk, 2048u, 2048u};
      EpiResid E{xl_src, kp()->out, part, mods_l, 2048};
      gemm256<false>(lds, S, E, wv_);
    }
    xcd_barrier(ws, lds, wv_);
    phase_norm(kp()->out, xc_src, kp()->g_norm2 + l * 1024, mods_l, 3072, 4096, hbuf, skip_ctx, need_ctx ? part : nullptr, need_ctx ? xc : nullptr, wv_);
    xcd_barrier(ws, lds, wv_);
    {
      SchedRows S{hbuf, Wl + W_UP, 1024, nrt, 16, G, cblk, skip_ctx ? 1 : 0, 2048u, 2048u};
      EpiUp E{big + B_U, skip_ctx ? 1 : 0};
      gemm256<true>(lds, S, E, wv_);
    }
    xcd_barrier(ws, lds, wv_);
    {
      SchedResid S{big + B_U, Wl + W_DOWN, 4096, 4, need_ctx ? 16 : 0, G, cblk, 8192u, 8192u};
      EpiResid E{kp()->out, kp()->out, part, mods_l, 5120};
      gemm256<false>(lds, S, E, wv_);
    }
    if (l == 0) xcd_barrier(ws, lds, wv_);
  }
}

extern "C" void kernel_launch(void* const* d_in, const int* in_sizes, int n_in, void* d_out, int out_size, void* d_ws,
                              size_t ws_size, hipStream_t stream) {
  static int grid_blocks = 0;
  if (!grid_blocks) {
    int dev = 0, cus = 0, per_cu = 0;
    (void)hipGetDevice(&dev);
    (void)hipDeviceGetAttribute(&cus, hipDeviceAttributeMultiprocessorCount, dev);
    (void)hipOccupancyMaxActiveBlocksPerMultiprocessor(&per_cu, hybrid_block_megakernel, NTHR, 0);
    if (per_cu < 1) fprintf(stderr, "occupancy query returned %d\n", per_cu);
    grid_blocks = cus;
  }
  if (ws_size < WS_NEED) fprintf(stderr, "workspace too small: %zu < %zu\n", ws_size, (size_t)WS_NEED);
  (void)hipMemsetAsync((char*)d_ws + OFF_BAR, 0, XCD_BAR_WORDS * 4, stream);
  Params p{};
  const float** pf = (const float**)&p;
  for (int i = 0; i < 31; ++i) pf[i] = (const float*)d_in[i];
  p.out = (float*)d_out;
  p.ws = (char*)d_ws;
  void* args[] = {&p};
  hipError_t e = hipLaunchCooperativeKernel((void*)hybrid_block_megakernel, dim3(grid_blocks), dim3(NTHR), args, 0, stream);
  if (e != hipSuccess) fprintf(stderr, "cooperative launch failed: %s (grid %d)\n", hipGetErrorString(e), grid_blocks);
}
```

```cpp
#include <hip/hip_runtime.h>
#include <hip/hip_cooperative_groups.h>
#include <cstdio>
namespace cg = cooperative_groups;

typedef _Float16 half_t;
typedef __attribute__((ext_vector_type(8))) _Float16 h8;
typedef __attribute__((ext_vector_type(4))) _Float16 h4;
typedef __attribute__((ext_vector_type(4))) float f4;
typedef __attribute__((ext_vector_type(16))) float f16v;

#define DI __device__ __forceinline__
#define LAS __attribute__((address_space(3)))

constexpr int NB = 16, SEQ = 2048, CTX = 256, TOK = 2304, NTOK = NB * TOK;
constexpr float LOG2E = 1.4426950408889634f;
constexpr float EPS = 1e-6f;

constexpr int NQK = 2048;
constexpr int NVT = 768;
constexpr int ZS = 576;
constexpr size_t W_QK = 0;
constexpr size_t W_V = W_QK + (size_t)NQK * 1024;
constexpr size_t W_GATE = W_V + (size_t)NVT * 1024;
constexpr size_t W_BR = W_GATE + (size_t)4096 * 1024;
constexpr size_t W_OUT = W_BR + (size_t)4 * 1024 * 256;
constexpr size_t W_UP = W_OUT + (size_t)1024 * 1024;
constexpr size_t W_DOWN = W_UP + (size_t)4096 * 1024;
constexpr size_t W_UQ = W_DOWN + (size_t)1024 * 4096;
constexpr size_t W_UK = W_UQ + (size_t)512 * 256;
constexpr size_t W_UV = W_UK + (size_t)256 * 256;
constexpr size_t W_LAYER = W_UV + (size_t)256 * 256;

constexpr size_t al256(size_t x) { return (x + 255) & ~(size_t)255; }
constexpr size_t OFF_BAR = 0;
constexpr size_t OFF_W = 16384;
constexpr size_t OFF_MOD = al256(OFF_W + 2 * W_LAYER * 2);
constexpr size_t OFF_XC = al256(OFF_MOD + (size_t)2 * 17 * 6144 * 4);
constexpr size_t OFF_H = al256(OFF_XC + (size_t)NB * CTX * 1024 * 4);
constexpr size_t OFF_BIG = al256(OFF_H + (size_t)NTOK * 1024 * 2);
constexpr size_t B_O = 0;
constexpr size_t B_QM = B_O + (size_t)NTOK * 1024;
constexpr size_t B_KM = B_QM + (size_t)NTOK * 384;
constexpr size_t B_VTM = B_KM + (size_t)NTOK * 384;
constexpr size_t B_QNA = B_VTM + (size_t)NTOK * 256;
constexpr size_t B_KNA = B_QNA + (size_t)NTOK * 256;
constexpr size_t B_VTNA = B_KNA + (size_t)NTOK * 256;
constexpr size_t B_QDF = B_VTNA + (size_t)NTOK * 256;
constexpr size_t B_KDF = B_QDF + (size_t)NTOK * 256;
constexpr size_t B_VTDF = B_KDF + (size_t)NTOK * 256;
constexpr size_t B_QG = B_VTDF + (size_t)NTOK * 256;
constexpr size_t B_KG = B_QG + (size_t)NTOK * 256;
constexpr size_t B_VTG = B_KG + (size_t)NTOK * 128;
constexpr size_t B_ZMLA = B_VTG + (size_t)NTOK * 128;
constexpr size_t B_END = B_ZMLA + (size_t)NTOK * ZS;
constexpr size_t B_M = B_O + (size_t)NTOK * 1024;
constexpr size_t GSLAB = (size_t)64 * 256 * 4096;
constexpr size_t B_G0 = B_M + (size_t)NTOK * 1024;
constexpr size_t B_P5END = B_G0 + GSLAB;
constexpr size_t B_U = 0;
constexpr size_t B_MAX = B_END > B_P5END ? B_END : B_P5END;
constexpr size_t OFF_PART = OFF_BIG + (size_t)NTOK * 4096 * 2;
constexpr size_t WS_NEED = (OFF_BIG + B_MAX * 2) > (OFF_PART + (size_t)4 * NB * CTX * 1024 * 4) ? (OFF_BIG + B_MAX * 2) : (OFF_PART + (size_t)4 * NB * CTX * 1024 * 4);
static_assert(B_P5END * 2 <= (size_t)NTOK * 4096 * 2, "merge buffers must end before the partial buffer");
static_assert(B_MAX >= (size_t)NTOK * 4096, "u must fit");
static_assert(WS_NEED <= (size_t)536870912, "workspace budget");

constexpr int NTHR = 512, NWAVE = 8;
constexpr int GEMM_LDS = 131072;
constexpr int SMEM_BYTES = GEMM_LDS + 16;

struct Params {
  const float *x, *c, *ctx, *c_ctx, *w_ada, *b_ada, *g_norm1, *g_norm2, *w_in;
  const float *g_mla_qa, *w_mla_uq, *g_mla_kva, *w_mla_ukv, *g_mla_q, *g_mla_k;
  const float *g_na_q, *g_na_k, *na_rpb;
  const float *g_diff_q, *g_diff_k, *lq1, *lk1, *lq2, *lk2, *g_diff_sub;
  const float *g_gqa_q, *g_gqa_k, *w_branch, *w_out, *w_up, *w_down;
  float* out;
  char* ws;
};


typedef const Params __attribute__((address_space(4))) * KPtr;
DI KPtr kp() {
  KPtr q = (KPtr)__builtin_amdgcn_kernarg_segment_ptr();
  asm volatile("" : "+s"(q));
  return q;
}

DI int tid_opaque(int wv_) {
  unsigned z = 0u;
  asm volatile("" : "+v"(z));
  int t = (wv_ << 6) | (int)__builtin_amdgcn_mbcnt_hi(~0u, __builtin_amdgcn_mbcnt_lo(~0u, z));
  asm volatile("" : "+v"(t));
  return t;
}

DI float wave_sum(float v) {
#pragma unroll
  for (int o = 32; o > 0; o >>= 1) v += __shfl_xor(v, o);
  return v;
}

#define XB_TMO      128
#define XB_XCNT(j)  (256  + 64 * (j))
#define XB_XSUB(j)  (1280 + 64 * (j))
#define XB_XGEN(j)  (2304 + 64 * (j))
#define XB_TOP      3328
#define XB_TOPGEN   3392
#define XCD_BAR_WORDS 3456
#define XB_SPIN_CAP (1u << 22)
DI unsigned xb_ld(unsigned* p) { return __hip_atomic_load(p, __ATOMIC_RELAXED, __HIP_MEMORY_SCOPE_AGENT); }
DI unsigned xb_add(unsigned* p, unsigned v) { return __hip_atomic_fetch_add(p, v, __ATOMIC_RELAXED, __HIP_MEMORY_SCOPE_AGENT); }
DI unsigned xb_xcc_id() { return (unsigned)__builtin_amdgcn_s_getreg((3 << 11) | 20) & 0xFu; }
#define XB_SPIN(cond, bar) do { unsigned _sp = 0; while (cond) { __builtin_amdgcn_s_sleep(1); \
    if ((++_sp & 255u) == 0u) { if (xb_ld(&(bar)[XB_TMO])) break; if (_sp > XB_SPIN_CAP) { atomicAdd(&(bar)[XB_TMO], 1u); break; } } } } while (0)
DI void xcd_barrier_post(unsigned* bar, int wv_) {
  if (tid_opaque(wv_) == 0) (void)xb_add(&bar[XB_XCNT(xb_xcc_id())], 1u);
}
DI void xcd_barrier_complete(unsigned* bar, unsigned x, unsigned& nloc, unsigned& nx) {
  const unsigned G = gridDim.x * gridDim.y * gridDim.z;
  unsigned sum, cnt, mine, sp = 0u;
  for (;;) {
    sum = 0u; cnt = 0u; mine = 0u;
#pragma unroll
    for (unsigned j = 0; j < 16; ++j) { const unsigned c = xb_ld(&bar[XB_XCNT(j)]); sum += c; cnt += (c > 0u) ? 1u : 0u; mine = (j == x) ? c : mine; }
    if (sum == G) break;
    __builtin_amdgcn_s_sleep(1);
    if ((++sp & 255u) == 0u) { if (xb_ld(&bar[XB_TMO])) break; if (sp > XB_SPIN_CAP) { atomicAdd(&bar[XB_TMO], 1u); break; } }
  }
  nloc = mine > 0u ? mine : 1u; nx = cnt > 0u ? cnt : 1u;
}
DI void xcd_barrier(char* ws_, LAS unsigned char* lds_, int wv_) {
  asm volatile("s_waitcnt vmcnt(0)" ::: "memory");
  __syncthreads();
  if (tid_opaque(wv_) == 0) {
    char* wsl = ws_;
    asm volatile("" : "+s"(wsl));
    unsigned* bar = (unsigned*)(wsl + OFF_BAR);
    volatile LAS unsigned* st = (volatile LAS unsigned*)(lds_ + GEMM_LDS);
    const unsigned x = xb_xcc_id();
    __builtin_amdgcn_s_waitcnt(0);
    unsigned nloc = st[0], nx = st[1];
    if (nloc == 0u) { xcd_barrier_complete(bar, x, nloc, nx); st[0] = nloc; st[1] = nx; }
    const unsigned old = xb_add(&bar[XB_XSUB(x)], 1u);
    const unsigned gen = old / nloc;
    if (old + 1u == (gen + 1u) * nloc) {
      __builtin_amdgcn_fence(__ATOMIC_RELEASE, "agent");
      asm volatile("s_waitcnt vmcnt(0)" ::: "memory");
      const unsigned og = xb_add(&bar[XB_TOP], 1u);
      const unsigned tg = og / nx;
      if (og + 1u == (tg + 1u) * nx) xb_add(&bar[XB_TOPGEN], 1u);
      else XB_SPIN(xb_ld(&bar[XB_TOPGEN]) == tg, bar);
      __builtin_amdgcn_fence(__ATOMIC_ACQUIRE, "agent");
      xb_add(&bar[XB_XGEN(x)], 1u);
      asm volatile("s_waitcnt vmcnt(0)" ::: "memory");
    } else {
      XB_SPIN(xb_ld(&bar[XB_XGEN(x)]) == gen, bar);
      __builtin_amdgcn_fence(__ATOMIC_ACQUIRE, "agent");
      asm volatile("s_waitcnt vmcnt(0)" ::: "memory");
    }
  }
  __syncthreads();
}

DI void phase_mods(float* mods, char* smem, int wv_) {
  const KPtr p = kp();
  float* sil = (float*)smem;
  const int tid = tid_opaque(wv_);
  for (int w = blockIdx.x; w < 192; w += gridDim.x) {
    const int l = w / 96, n0 = (w % 96) * 64;
    __syncthreads();
    for (int idx = tid; idx < 17 * 1024; idx += NTHR) {
      const int b = idx >> 10, k = idx & 1023;
      const float v = (b < 16) ? p->c[b * 1024 + k] : p->c_ctx[k];
      sil[idx] = v / (1.f + expf(-v));
    }
    __syncthreads();
    const int kq = tid >> 6, nn = tid & 63;
    float acc[17];
#pragma unroll
    for (int b = 0; b < 17; ++b) acc[b] = 0.f;
    const float* wp = p->w_ada + (size_t)l * 1024 * 6144 + (size_t)(kq * 128) * 6144 + n0 + nn;
    const float* sp = sil + kq * 128;
#pragma unroll 4
    for (int k = 0; k < 128; ++k) {
      const float wv = wp[(size_t)k * 6144];
#pragma unroll
      for (int b = 0; b < 17; ++b) acc[b] += sp[b * 1024 + k] * wv;
    }
    __syncthreads();
    float* red = (float*)smem;
#pragma unroll
    for (int b = 0; b < 17; ++b) red[(kq * 17 + b) * 64 + nn] = acc[b];
    __syncthreads();
    for (int idx = tid; idx < 17 * 64; idx += NTHR) {
      float s = p->b_ada[l * 6144 + n0 + (idx & 63)];
#pragma unroll
      for (int q = 0; q < 8; ++q) s += red[q * 17 * 64 + idx];
      mods[((size_t)l * 17 + (idx >> 6)) * 6144 + n0 + (idx & 63)] = s;
    }
  }
  __syncthreads();
}

DI void tconv_job(const float* src, int ld, int c0, int K, int Kvalid, int Nvalid, int Npad, half_t* dst, int& base,
                  float* tile, int wv_) {
  const int nnt = Npad / 64, tot = (K / 64) * nnt;
  const int G = gridDim.x;
  const int start = (int)((blockIdx.x + G - (base % G)) % G);
  const int tid_ = tid_opaque(wv_);
  const int tx = tid_ & 63, ty = tid_ >> 6;
  for (int t = start; t < tot; t += 2 * G) {
    const int t2 = t + G;
    const bool has2 = t2 < tot;
    const int kt = t / nnt, nt = t % nnt, kt2 = has2 ? t2 / nnt : kt, nt2 = has2 ? t2 % nnt : nt;
    float r0[8], r1[8];
#pragma unroll
    for (int i = 0; i < 8; ++i) {
      const int k = i * 8 + ty, n = nt * 64 + tx, n2 = nt2 * 64 + tx;
      r0[i] = (n < Nvalid && kt * 64 + k < Kvalid) ? src[(size_t)(kt * 64 + k) * ld + c0 + n] : 0.f;
      r1[i] = (has2 && n2 < Nvalid && kt2 * 64 + k < Kvalid) ? src[(size_t)(kt2 * 64 + k) * ld + c0 + n2] : 0.f;
    }
    __syncthreads();
#pragma unroll
    for (int i = 0; i < 8; ++i) {
      tile[(i * 8 + ty) * 65 + tx] = r0[i];
      tile[64 * 65 + (i * 8 + ty) * 65 + tx] = r1[i];
    }
    __syncthreads();
#pragma unroll
    for (int i = 0; i < 8; ++i) {
      const int n = i * 8 + ty;
      dst[(size_t)(nt * 64 + n) * K + kt * 64 + tx] = (half_t)tile[tx * 65 + n];
      if (has2) dst[(size_t)(nt2 * 64 + n) * K + kt2 * 64 + tx] = (half_t)tile[64 * 65 + tx * 65 + n];
    }
  }
  base += tot;
}

struct NormRow { const float* mod; int g, b, t; bool valid, isctx; };
DI void norm_load(int g, const float* xl, const float* xc, const float* mods_l, bool skip_ctx, int lane, float4 (&v)[4], NormRow& r) {
  r.g = g; r.valid = g < NTOK;
  const int gg = r.valid ? g : 0;
  r.b = gg / TOK; r.t = gg - r.b * TOK;
  r.isctx = r.t >= SEQ;
  if (r.isctx && skip_ctx) r.valid = false;
  const float* src = r.isctx ? xc + ((size_t)r.b * CTX + (r.t - SEQ)) * 1024 : xl + ((size_t)r.b * SEQ + r.t) * 1024;
  r.mod = mods_l + (size_t)(r.isctx ? 16 : r.b) * 6144;
  if (r.valid) {
#pragma unroll
    for (int i = 0; i < 4; ++i) v[i] = *(const float4*)(src + i * 256 + lane * 4);
  } else {
#pragma unroll
    for (int i = 0; i < 4; ++i) v[i] = float4{0.f, 0.f, 0.f, 0.f};
  }
}
DI void norm_finish(float4 (&v)[4], const NormRow& r, const float* gam, int sh_off, int sc_off, half_t* h, const float* part, float* xc_store, int lane) {
  if (r.valid && r.isctx && part != nullptr) {
    const size_t ro = ((size_t)r.b * CTX + (r.t - SEQ)) * 1024;
#pragma unroll
    for (int i = 0; i < 4; ++i) {
#pragma unroll
      for (int ks = 0; ks < 4; ++ks) {
        const float4 pv = *(const float4*)(part + (size_t)ks * NB * CTX * 1024 + ro + i * 256 + lane * 4);
        v[i].x += pv.x; v[i].y += pv.y; v[i].z += pv.z; v[i].w += pv.w;
      }
      if (xc_store != nullptr) *(float4*)(xc_store + ro + i * 256 + lane * 4) = v[i];
    }
  }
  float ss = 0.f;
#pragma unroll
  for (int i = 0; i < 4; ++i) ss += v[i].x * v[i].x + v[i].y * v[i].y + v[i].z * v[i].z + v[i].w * v[i].w;
  ss = wave_sum(ss);
  if (!r.valid) return;
  const float rstd = rsqrtf(ss * (1.f / 1024.f) + EPS);
#pragma unroll
  for (int i = 0; i < 4; ++i) {
    const int col = i * 256 + lane * 4;
    const float4 gg = *(const float4*)(gam + col);
    const float4 sc = *(const float4*)(r.mod + sc_off + col);
    const float4 sh = *(const float4*)(r.mod + sh_off + col);
    h4 o;
    o[0] = (half_t)(v[i].x * rstd * gg.x * (1.f + sc.x) + sh.x);
    o[1] = (half_t)(v[i].y * rstd * gg.y * (1.f + sc.y) + sh.y);
    o[2] = (half_t)(v[i].z * rstd * gg.z * (1.f + sc.z) + sh.z);
    o[3] = (half_t)(v[i].w * rstd * gg.w * (1.f + sc.w) + sh.w);
    *(h4*)(h + (size_t)r.g * 1024 + col) = o;
  }
}
DI void phase_norm(const float* xl, const float* xc, const float* gam, const float* mods_l, int sh_off,
                   int sc_off, half_t* h, bool skip_ctx, const float* part, float* xc_store, int wv_) {
  const int tid_ = tid_opaque(wv_);
  const int wave = tid_ >> 6, lane = tid_ & 63;
  const int stride = gridDim.x * NWAVE;
  for (int g = blockIdx.x * NWAVE + wave; g < NTOK; g += 2 * stride) {
    float4 v0[4], v1[4];
    NormRow r0, r1;
    norm_load(g, xl, xc, mods_l, skip_ctx, lane, v0, r0);
    norm_load(g + stride, xl, xc, mods_l, skip_ctx, lane, v1, r1);
    norm_finish(v0, r0, gam, sh_off, sc_off, h, part, xc_store, lane);
    norm_finish(v1, r1, gam, sh_off, sc_off, h, part, xc_store, lane);
  }
}

constexpr int BK = 64, HALF = 128, HTB = HALF * BK * 2;
DI int lds_byte(int r, int c) { const int st = (r >> 4) * 2 + (c >> 5), rr = r & 15, cc = c & 31, ob = rr * 64 + cc * 2; return st * 1024 + (ob ^ (((ob >> 9) & 1) << 5)); }
DI void stage_rc(int b, int& R, int& C) { const int st = b / 1024, sb = b % 1024, swz = sb ^ (((sb >> 9) & 1) << 5); R = (st >> 1) * 16 + swz / 64; C = (st & 1) * 32 + (swz % 64) / 2; }
DI int perm32(int rho) { const int n = rho >> 4, i = rho & 15; return 8 * (i >> 2) + 4 * n + (i & 3); }

struct GUnit { const char* A; const char* B; int nt, pm, pn, aux, ks; };

DI bool tile_map(int L, int nM, int nN, int& pm, int& pn) {
  const int nwg = nM * nN;
  if (L >= nwg) return false;
  int wgid = L;
  { const int q = nwg / 8, r = nwg % 8, xcd = wgid % 8, off = wgid / 8; wgid = (xcd < r ? xcd * (q + 1) : r * (q + 1) + (xcd - r) * q) + off; }
  const int nig = 8 * nN, gid = wgid / nig, fm = gid * 8, gsz = (nM - fm) < 8 ? (nM - fm) : 8;
  pm = fm + ((wgid % nig) % gsz); pn = (wgid % nig) / gsz;
  return true;
}

template <bool PERM, class Sched, class Epi>
DI void gemm256(LAS unsigned char* lds, const Sched& S, const Epi& E, int wv_) {
  const int tid = tid_opaque(wv_), wid = __builtin_amdgcn_readfirstlane(tid >> 6), lane = tid & 63, wr = wid >> 2, wc = wid & 3, fr = lane & 15, fq = lane >> 4;
  unsigned cvA0, cvA1, cvB0, cvB1;
  { int R, C;
    stage_rc(tid * 16, R, C); cvA0 = (unsigned)R * S.lda2 + C * 2; cvB0 = (unsigned)(PERM ? ((R & ~31) + perm32(R & 31)) : R) * S.ldb2 + C * 2;
    stage_rc(tid * 16 + 8192, R, C); cvA1 = (unsigned)R * S.lda2 + C * 2; cvB1 = (unsigned)(PERM ? ((R & ~31) + perm32(R & 31)) : R) * S.ldb2 + C * 2; }
  const size_t chA = (size_t)HALF * S.lda2, chB = (size_t)HALF * S.ldb2;
  const size_t kstep = (size_t)(BK * 2);
  const unsigned ldsw = (unsigned)wid * 1024u;
  const int aoff = lds_byte(wr * 64 + fr, fq * 8), boff = lds_byte(wc * 32 + fr, fq * 8);
#define G_SA(b, h) (((b) * 2 + (h)) * HTB)
#define G_SB(b, h) ((4 + (b) * 2 + (h)) * HTB)
#define G_STAGE(bufoff, gbase, v0, v1) do { \
    __builtin_amdgcn_global_load_lds((const unsigned*)((const char*)(gbase) + (v0)), (LAS unsigned*)(lds + (bufoff) + ldsw), 16, 0, 0); \
    __builtin_amdgcn_global_load_lds((const unsigned*)((const char*)(gbase) + (v1)), (LAS unsigned*)(lds + (bufoff) + ldsw + 8192), 16, 0, 0); } while (0)
#define G_LDA(dst, b, h) do { _Pragma("unroll") for (int m = 0; m < 4; ++m) _Pragma("unroll") for (int k = 0; k < 2; ++k) dst[m][k] = *(const LAS h8*)(lds + G_SA(b, h) + aoff + m * 2048 + k * 1024); } while (0)
#define G_LDB(dst, b, h) do { _Pragma("unroll") for (int n = 0; n < 2; ++n) _Pragma("unroll") for (int k = 0; k < 2; ++k) dst[n][k] = *(const LAS h8*)(lds + G_SB(b, h) + boff + n * 2048 + k * 1024); } while (0)
#define G_MMA(ai, bj, At, Bt) do { __builtin_amdgcn_s_setprio(1); _Pragma("unroll") for (int m = 0; m < 4; ++m) _Pragma("unroll") for (int n = 0; n < 2; ++n) _Pragma("unroll") for (int k = 0; k < 2; ++k) \
    acc[ai][bj][m][n] = __builtin_amdgcn_mfma_f32_16x16x32_f16(Bt[n][k], At[m][k], acc[ai][bj][m][n], 0, 0, 0); __builtin_amdgcn_s_setprio(0); } while (0)
#define G_WAIT_V(n) asm volatile("s_waitcnt vmcnt(" #n ")" ::: "memory")
#define G_WAIT_L(n) asm volatile("s_waitcnt lgkmcnt(" #n ")" ::: "memory")
#define G_BAR __builtin_amdgcn_s_barrier()
#define G_SCHED __builtin_amdgcn_sched_barrier(0)
  GUnit cur, nxt;
  int ui = 0;
  if (!S.next(0, cur)) return;
  f4 acc[2][2][4][2];
#pragma unroll
  for (int a = 0; a < 2; ++a)
#pragma unroll
    for (int b = 0; b < 2; ++b)
#pragma unroll
      for (int m = 0; m < 4; ++m)
#pragma unroll
        for (int n = 0; n < 2; ++n) acc[a][b][m][n] = f4{0.f, 0.f, 0.f, 0.f};
  h8 At[4][2], B0[2][2], B1[2][2];
  const char* cA = cur.A;
  const char* cB = cur.B;
  G_STAGE(G_SB(0, 0), cB, cvB0, cvB1); G_STAGE(G_SA(0, 0), cA, cvA0, cvA1); G_STAGE(G_SB(0, 1), cB + chB, cvB0, cvB1); G_STAGE(G_SA(0, 1), cA + chA, cvA0, cvA1);
  if (wr == 1) G_BAR;
  G_WAIT_V(4); G_BAR;
  G_STAGE(G_SB(1, 0), cB + kstep, cvB0, cvB1); G_STAGE(G_SA(1, 0), cA + kstep, cvA0, cvA1); G_STAGE(G_SB(1, 1), cB + chB + kstep, cvB0, cvB1);
  G_WAIT_V(6); G_BAR;
  for (;;) {
    const bool has_next = S.next(ui + 1, nxt);
    const char* nA = has_next ? nxt.A : cA;
    const char* nB = has_next ? nxt.B : cB;
    int nt = cur.nt;
    asm volatile("" : "+s"(nt));
    for (int t = 0; t < nt; t += 2) {
      const bool last = (t == nt - 2);
      const char* a1 = cA + (size_t)(t + 1) * kstep;
      const char* a2 = last ? nA : cA + (size_t)(t + 2) * kstep;
      const char* b2 = last ? nB : cB + (size_t)(t + 2) * kstep;
      const char* a3 = a2 + kstep;
      const char* b3 = b2 + kstep;
      G_LDB(B0, 0, 0); G_SCHED; G_LDA(At, 0, 0); G_STAGE(G_SA(1, 1), a1 + chA, cvA0, cvA1);
      G_WAIT_L(8); G_BAR; G_WAIT_L(0); G_MMA(0, 0, At, B0); G_BAR; G_SCHED;
      G_LDB(B1, 0, 1); G_STAGE(G_SB(0, 0), b2, cvB0, cvB1);
      G_BAR; G_WAIT_L(0); G_MMA(0, 1, At, B1); G_BAR;
      G_LDA(At, 0, 1); G_STAGE(G_SA(0, 0), a2, cvA0, cvA1);
      G_BAR; G_WAIT_L(0); G_MMA(1, 0, At, B0); G_BAR; G_SCHED;
      G_STAGE(G_SB(0, 1), b2 + chB, cvB0, cvB1);
      G_WAIT_V(6); G_BAR; G_MMA(1, 1, At, B1); G_BAR;
      G_LDB(B0, 1, 0); G_SCHED; G_LDA(At, 1, 0); G_STAGE(G_SA(0, 1), a2 + chA, cvA0, cvA1);
      G_WAIT_L(8); G_BAR; G_WAIT_L(0); G_MMA(0, 0, At, B0); G_BAR; G_SCHED;
      G_LDB(B1, 1, 1); G_STAGE(G_SB(1, 0), b3, cvB0, cvB1);
      G_BAR; G_WAIT_L(0); G_MMA(0, 1, At, B1); G_BAR;
      G_LDA(At, 1, 1); G_STAGE(G_SA(1, 0), a3, cvA0, cvA1);
      G_BAR; G_WAIT_L(0); G_MMA(1, 0, At, B0); G_BAR; G_SCHED;
      G_STAGE(G_SB(1, 1), b3 + chB, cvB0, cvB1);
      G_WAIT_V(6); G_BAR; G_MMA(1, 1, At, B1); G_BAR;
    }
    E(acc, cur, wr, wc, fr, fq);
    if (!has_next) break;
#pragma unroll
    for (int a = 0; a < 2; ++a)
#pragma unroll
      for (int b = 0; b < 2; ++b)
#pragma unroll
        for (int m = 0; m < 4; ++m)
#pragma unroll
          for (int n = 0; n < 2; ++n) acc[a][b][m][n] = f4{0.f, 0.f, 0.f, 0.f};
    cur = nxt; cA = nA; cB = nB; ++ui;
  }
  G_WAIT_V(0);
  if (wr == 0) G_BAR;
  G_BAR;
#undef G_SA
#undef G_SB
#undef G_STAGE
#undef G_LDA
#undef G_LDB
#undef G_MMA
#undef G_WAIT_V
#undef G_WAIT_L
#undef G_BAR
#undef G_SCHED
}

DI h8 pack8(const f4& a, const f4& b) {
  h8 o;
  o[0] = (half_t)a[0]; o[1] = (half_t)a[1]; o[2] = (half_t)a[2]; o[3] = (half_t)a[3];
  o[4] = (half_t)b[0]; o[5] = (half_t)b[1]; o[6] = (half_t)b[2]; o[7] = (half_t)b[3];
  return o;
}
DI int row0_of(int pm, int mode) { return mode == 0 ? pm * 256 : (mode == 1 ? (pm >> 3) * TOK + (pm & 7) * 256 : pm * TOK + SEQ); }

struct SchedInproj {
  const half_t* hbuf; const half_t* Wl; int G, c;
  static constexpr unsigned lda2 = 2048, ldb2 = 2048;
  DI bool next(int i, GUnit& u) const {
    const int L = i * G + c;
    u.nt = 16;
    if (L < 144 * 8) {
      tile_map(L, 144, 8, u.pm, u.pn);
      u.A = (const char*)(hbuf + (size_t)u.pm * 256 * 1024); u.B = (const char*)(Wl + W_QK + (size_t)u.pn * 256 * 1024); u.aux = 0;
      return true;
    }
    if (!tile_map(L - 144 * 8, 3, 144, u.pm, u.pn)) return false;
    u.A = (const char*)(Wl + W_V + (size_t)u.pm * 256 * 1024); u.B = (const char*)(hbuf + (size_t)u.pn * 256 * 1024); u.aux = 1;
    return true;
  }
};
struct EpiInproj {
  half_t* big;
  DI void operator()(const f4 (&acc)[2][2][4][2], const GUnit& u, int wr, int wc, int fr, int fq) const {
    if (u.aux == 0) {
      const int g0 = u.pm * 256, b = g0 / TOK, t0 = g0 - b * TOK + wr * 64;
#pragma unroll
      for (int bj = 0; bj < 2; ++bj) {
        const int cb = u.pn * 256 + bj * 128 + wc * 32;
        half_t* ptr; int ts;
        if (cb < 576) { ptr = big + B_ZMLA + (size_t)b * TOK * ZS + cb; ts = ZS; }
        else if (cb < 1088) { const int c = cb - 576, part = c >> 8, hh = (c >> 6) & 3; ptr = big + (part ? B_KNA : B_QNA) + (size_t)(b * 4 + hh) * TOK * 64 + (c & 63); ts = 64; }
        else if (cb < 1600) { const int c = cb - 1088, part = c >> 8, hm = (c >> 5) & 7; ptr = big + (part ? B_KDF : B_QDF) + (size_t)(b * 8 + hm) * TOK * 32; ts = 32; }
        else if (cb < 1856) { const int c = cb - 1600; ptr = big + B_QG + (size_t)(b * 4 + (c >> 6)) * TOK * 64 + (c & 63); ts = 64; }
        else if (cb < 1984) { const int c = cb - 1856; ptr = big + B_KG + (size_t)(b * 2 + (c >> 6)) * TOK * 64 + (c & 63); ts = 64; }
        else continue;
        const unsigned lo = (unsigned)(fr * ts + 8 * fq) * 2u;
        char* rb = (char*)(ptr + (size_t)t0 * ts);
#pragma unroll
        for (int ai = 0; ai < 2; ++ai)
#pragma unroll
          for (int m = 0; m < 4; ++m)
            *(h8*)(rb + (size_t)((ai * 128 + m * 16) * ts) * 2 + lo) = pack8(acc[ai][bj][m][0], acc[ai][bj][m][1]);
      }
    } else {
      const int g0 = u.pn * 256, b = g0 / TOK, t0 = g0 - b * TOK;
      const int nh = (u.pm == 2) ? 2 : 4;
      char* vt = (char*)(big + (u.pm == 0 ? B_VTNA : (u.pm == 1 ? B_VTDF : B_VTG)) + (size_t)b * nh * 64 * TOK + (size_t)(wr * 64) * TOK + t0 + wc * 32);
      const unsigned lo = (unsigned)(fr * TOK + 8 * fq) * 2u;
#pragma unroll
      for (int ai = 0; ai < 2; ++ai) {
        if (u.pm == 2 && ai == 1) continue;
#pragma unroll
        for (int m = 0; m < 4; ++m)
#pragma unroll
          for (int bj = 0; bj < 2; ++bj)
            *(h8*)(vt + ((size_t)(ai * 128 + m * 16) * TOK + bj * 128) * 2 + lo) = pack8(acc[ai][bj][m][0], acc[ai][bj][m][1]);
      }
    }
  }
};

struct SchedMlaQK {
  const half_t* Wl; const half_t* zmla; int G, c;
  static constexpr unsigned lda2 = ZS * 2, ldb2 = 512;
  DI bool next(int i, GUnit& u) const {
    const int L = i * G + c;
    u.nt = 4;
    if (L < 288) {
      tile_map(L, 144, 2, u.pm, u.pn);
      u.A = (const char*)(zmla + (size_t)u.pm * 256 * ZS);
      u.B = (const char*)(Wl + W_UQ + (size_t)u.pn * 256 * 256); u.aux = 0;
      return true;
    }
    if (L < 432) {
      u.pm = L - 288; u.pn = 0;
      u.A = (const char*)(zmla + 256 + (size_t)u.pm * 256 * ZS);
      u.B = (const char*)(Wl + W_UK); u.aux = 1;
      return true;
    }
    return false;
  }
};
struct SchedMlaV {
  const half_t* Wl; const half_t* zmla; int G, c;
  static constexpr unsigned lda2 = 512, ldb2 = ZS * 2;
  DI bool next(int i, GUnit& u) const {
    const int L = i * G + c;
    if (L >= 144) return false;
    u.nt = 4; u.pm = 0; u.pn = L;
    u.A = (const char*)(Wl + W_UV);
    u.B = (const char*)(zmla + 256 + (size_t)u.pn * 256 * ZS); u.aux = 2;
    return true;
  }
};
struct EpiMla {
  half_t* big;
  DI void operator()(const f4 (&acc)[2][2][4][2], const GUnit& u, int wr, int wc, int fr, int fq) const {
    if (u.aux < 2) {
      const int g0 = u.pm * 256, b = g0 / TOK, t0 = g0 - b * TOK + wr * 64;
      const unsigned lo = (unsigned)(fr * 96 + 8 * fq) * 2u;
#pragma unroll
      for (int bj = 0; bj < 2; ++bj) {
        const int cb = u.pn * 256 + bj * 128 + wc * 32;
        half_t* ptr;
        if (u.aux == 0) {
          if (cb >= 384) continue;
          const int hh = cb / 96, dd = cb - hh * 96;
          ptr = big + B_QM + (size_t)(b * 4 + hh) * TOK * 96 + dd;
        } else {
          ptr = big + B_KM + (size_t)(b * 4 + (cb >> 6)) * TOK * 96 + (cb & 63);
        }
        char* rb = (char*)(ptr + (size_t)t0 * 96);
#pragma unroll
        for (int ai = 0; ai < 2; ++ai)
#pragma unroll
          for (int m = 0; m < 4; ++m)
            *(h8*)(rb + (size_t)((ai * 128 + m * 16) * 96) * 2 + lo) = pack8(acc[ai][bj][m][0], acc[ai][bj][m][1]);
      }
    } else {
      const int g0 = u.pn * 256, b = g0 / TOK, t0 = g0 - b * TOK;
      char* vt = (char*)(big + B_VTM + (size_t)b * 4 * 64 * TOK + (size_t)(wr * 64) * TOK + t0 + wc * 32);
      const unsigned lo = (unsigned)(fr * TOK + 8 * fq) * 2u;
#pragma unroll
      for (int ai = 0; ai < 2; ++ai)
#pragma unroll
        for (int m = 0; m < 4; ++m)
#pragma unroll
          for (int bj = 0; bj < 2; ++bj)
            *(h8*)(vt + ((size_t)(ai * 128 + m * 16) * TOK + bj * 128) * 2 + lo) = pack8(acc[ai][bj][m][0], acc[ai][bj][m][1]);
    }
  }
};

struct SchedRows {
  const half_t* A; const half_t* B; int K, nM, nN, G, c; int mode; unsigned lda2, ldb2;
  DI bool next(int i, GUnit& u) const {
    if (!tile_map(i * G + c, nM, nN, u.pm, u.pn)) return false;
    u.A = (const char*)(A + (size_t)row0_of(u.pm, mode) * K); u.B = (const char*)(B + (size_t)u.pn * 256 * K);
    u.nt = K >> 6; u.aux = 0;
    return true;
  }
};
struct SchedResid {
  const half_t* A; const half_t* B; int K, nN, nctx, G, c; unsigned lda2, ldb2;
  DI bool next(int i, GUnit& u) const {
    const int L = i * G + c, nfull = 128 * nN;
    if (L < nfull) {
      tile_map(L, 128, nN, u.pm, u.pn);
      u.A = (const char*)(A + (size_t)row0_of(u.pm, 1) * K); u.B = (const char*)(B + (size_t)u.pn * 256 * K);
      u.nt = K >> 6; u.aux = 0;
      return true;
    }
    const int L2 = L - nfull;
    if (L2 >= nctx * nN * 4) return false;
    const int ks = L2 & 3, t = L2 >> 2;
    u.pm = t / nN; u.pn = t - u.pm * nN;
    const int kq = K >> 2;
    u.A = (const char*)(A + (size_t)row0_of(u.pm, 2) * K + ks * kq); u.B = (const char*)(B + (size_t)u.pn * 256 * K + ks * kq);
    u.nt = kq >> 6; u.aux = 1; u.ks = ks;
    return true;
  }
};
struct EpiResid {
  const float* xl_src; float* xl_dst; float* part; const float* mods_l; int gt_off;
  DI void operator()(const f4 (&acc)[2][2][4][2], const GUnit& u, int wr, int wc, int fr, int fq) const {
    const bool isctx = u.aux == 1;
    const int g0 = row0_of(u.pm, isctx ? 2 : 1), b = g0 / TOK, t0 = g0 - b * TOK;
    const int col0 = u.pn * 256 + wc * 32;
    const size_t rowoff = (size_t)(wr * 64) * 1024 + col0;
    const char* src = (const char*)(xl_src + ((size_t)b * SEQ + (isctx ? 0 : t0)) * 1024 + rowoff);
    char* dst = (char*)(xl_dst + ((size_t)b * SEQ + (isctx ? 0 : t0)) * 1024 + rowoff);
    const char* gt = (const char*)(mods_l + (size_t)(isctx ? 16 : b) * 6144 + gt_off + col0);
    const unsigned lo = (unsigned)(fr * 1024 + 4 * fq) * 4u, glo = (unsigned)(4 * fq) * 4u;
    f4 gv[2][2];
#pragma unroll
    for (int bj = 0; bj < 2; ++bj)
#pragma unroll
      for (int n = 0; n < 2; ++n) gv[bj][n] = *(const f4*)(gt + (bj * 128 + n * 16) * 4 + glo);
    if (!isctx) {
#pragma unroll
      for (int ai = 0; ai < 2; ++ai)
#pragma unroll
        for (int mh = 0; mh < 2; ++mh) {
          f4 xv[2][2][2];
#pragma unroll
          for (int mm = 0; mm < 2; ++mm)
#pragma unroll
            for (int bj = 0; bj < 2; ++bj)
#pragma unroll
              for (int n = 0; n < 2; ++n)
                xv[mm][bj][n] = *(const f4*)(src + ((size_t)(ai * 128 + (mh * 2 + mm) * 16) * 1024 + bj * 128 + n * 16) * 4 + lo);
#pragma unroll
          for (int mm = 0; mm < 2; ++mm)
#pragma unroll
            for (int bj = 0; bj < 2; ++bj)
#pragma unroll
              for (int n = 0; n < 2; ++n)
                *(f4*)(dst + ((size_t)(ai * 128 + (mh * 2 + mm) * 16) * 1024 + bj * 128 + n * 16) * 4 + lo) =
                    xv[mm][bj][n] + gv[bj][n] * acc[ai][bj][mh * 2 + mm][n];
        }
    } else {
      char* pp = (char*)(part + ((size_t)u.ks * NB * CTX + (size_t)b * CTX + (t0 - SEQ) + wr * 64) * 1024 + col0);
#pragma unroll
      for (int ai = 0; ai < 2; ++ai)
#pragma unroll
        for (int m = 0; m < 4; ++m)
#pragma unroll
          for (int bj = 0; bj < 2; ++bj)
#pragma unroll
            for (int n = 0; n < 2; ++n)
              *(f4*)(pp + ((size_t)(ai * 128 + m * 16) * 1024 + bj * 128 + n * 16) * 4 + lo) = gv[bj][n] * acc[ai][bj][m][n];
    }
  }
};
struct EpiUp {
  half_t* ubuf; int skip_ctx;
  DI void operator()(const f4 (&acc)[2][2][4][2], const GUnit& u, int wr, int wc, int fr, int fq) const {
    const int g0 = row0_of(u.pm, skip_ctx);
    char* rb = (char*)(ubuf + (size_t)(g0 + wr * 64) * 4096 + u.pn * 256 + wc * 32);
    const unsigned lo = (unsigned)(fr * 4096 + 8 * fq) * 2u;
#pragma unroll
    for (int ai = 0; ai < 2; ++ai)
#pragma unroll
      for (int m = 0; m < 4; ++m)
#pragma unroll
        for (int bj = 0; bj < 2; ++bj) {
          f4 a = acc[ai][bj][m][0], c = acc[ai][bj][m][1];
#pragma unroll
          for (int j = 0; j < 4; ++j) { a[j] = fmaxf(a[j], 0.f); a[j] *= a[j]; c[j] = fmaxf(c[j], 0.f); c[j] *= c[j]; }
          *(h8*)(rb + ((size_t)(ai * 128 + m * 16) * 4096 + bj * 128) * 2 + lo) = pack8(a, c);
        }
  }
};

DI void build_rope_tables(float2* tab, int wv_) {
  const int tid_ = tid_opaque(wv_);
  __syncthreads();
  for (int idx = tid_; idx < 512 + 1024; idx += NTHR) {
    const bool big = idx >= 512;
    const int j = big ? idx - 512 : idx;
    const int pos = big ? (j >> 4) : (j >> 3), i = big ? (j & 15) : (j & 7);
    const float invf = exp2f(-(float)i * (13.287712379549449f / (big ? 16.f : 8.f)));
    const float ang = (float)pos * invf;
    float sn, cs;
    sincosf(ang, &sn, &cs);
    tab[idx] = float2{cs, sn};
  }
  __syncthreads();
}
template <int DLEN, int LPR, int ROPE, bool KR>
DI void norm_rows(half_t* base, int stride, int nrows, const float* gain, float oscale, const half_t* zmla, const float2* rtab, int wv_) {
  const int tid_ = tid_opaque(wv_);
  const int lane = tid_ & 63, wave = tid_ >> 6;
  constexpr int RPW = 64 / LPR;
  const int s = lane % LPR, sub = lane / LPR;
  const bool active = s * 8 < DLEN;
  float gn[8];
#pragma unroll
  for (int i = 0; i < 8; ++i) gn[i] = active ? gain[s * 8 + i] : 0.f;
  for (int r0 = (blockIdx.x * NWAVE + wave) * RPW; r0 < nrows; r0 += gridDim.x * NWAVE * RPW) {
    const int rho = r0 + sub;
    const int t = rho % TOK;
    half_t* ptr = base + (size_t)rho * stride + s * 8;
    const half_t* src = ptr;
    if (KR && s >= 8) {
      const int b = rho / (4 * TOK);
      src = zmla + ((size_t)b * TOK + t) * ZS + 512 + (s - 8) * 8;
    }
    float f[8];
    float ss = 0.f;
    if (active) {
      const h8 v = *(const h8*)src;
#pragma unroll
      for (int i = 0; i < 8; ++i) { f[i] = (float)v[i]; ss += f[i] * f[i]; }
    } else {
#pragma unroll
      for (int i = 0; i < 8; ++i) f[i] = 0.f;
    }
#pragma unroll
    for (int o = LPR / 2; o > 0; o >>= 1) ss += __shfl_xor(ss, o);
    const float rstd = rsqrtf(ss * (1.f / DLEN) + EPS);
#pragma unroll
    for (int i = 0; i < 8; ++i) f[i] = f[i] * rstd * gn[i];
    if (ROPE != 0) {
      constexpr int PX = (ROPE == 64) ? 2 : 1;
      float pf[8];
#pragma unroll
      for (int i = 0; i < 8; ++i) pf[i] = __shfl_xor(f[i], PX);
      constexpr int RB = (DLEN - ROPE) / 8;
      if (t < SEQ && s >= RB && active) {
        const int sr = s - RB;
        const int q = (ROPE == 64) ? (sr >> 1) : sr;
        const int pos = (q < 2) ? (t >> 6) : (t & 63);
        const float sgn = (q & 1) ? 1.f : -1.f;
        constexpr int NFI = (ROPE == 64) ? 16 : 8;
        const float2* tb = rtab + ((ROPE == 64) ? 512 : 0) + pos * NFI + ((ROPE == 64) ? (sr & 1) * 8 : 0);
#pragma unroll
        for (int i = 0; i < 8; ++i) {
          const float2 cssn = tb[i];
          f[i] = f[i] * cssn.x + sgn * pf[i] * cssn.y;
        }
      }
    }
    if (active) {
      h8 o;
#pragma unroll
      for (int i = 0; i < 8; ++i) o[i] = (half_t)(f[i] * oscale);
      *(h8*)ptr = o;
    }
  }
}

constexpr int ATT_STAGE = 22528, ATT_VOFF = 13312, ATT_STASH = 49152;
template <int DQ, bool NA, int NQG>
DI void attn_wg(const half_t* Qp, const half_t* Kp, const half_t* Vp, int q0, bool active, int seg0_start, int seg0_tiles,
                int seg1_start, int seg1_tiles, const float* rpb_h, int rq, char* smem, int tid, f16v (&O)[2][NQG]) {
  constexpr int NKS = DQ / 16, KSTR = DQ + 8, VSTR = 72, CPK = DQ / 8, KCH = 64 * CPK;
  const int lane = tid & 63, r = lane & 31, h = lane >> 5;
  h8 qf[NQG][NKS];
#pragma unroll
  for (int qg = 0; qg < NQG; ++qg)
#pragma unroll
    for (int ks = 0; ks < NKS; ++ks) qf[qg][ks] = *(const h8*)(Qp + (size_t)(q0 + qg * 32 + r) * DQ + ks * 16 + h * 8);
  float mrun[NQG], lrun[NQG];
#pragma unroll
  for (int qg = 0; qg < NQG; ++qg) { mrun[qg] = -1e30f; lrun[qg] = 0.f; }
#pragma unroll
  for (int a = 0; a < 2; ++a)
#pragma unroll
    for (int c = 0; c < NQG; ++c)
#pragma unroll
      for (int i = 0; i < 16; ++i) O[a][c][i] = 0.f;
  const int ntiles = seg0_tiles + seg1_tiles;
  const int kc0 = tid, kc1 = tid + 512;
  const half_t* kg0 = Kp + kc0 * 8;
  const half_t* kg1 = Kp + kc1 * 8;
  const half_t* vg = Vp + (size_t)(tid >> 3) * TOK + (tid & 7) * 8;
  const int ks0 = (kc0 / CPK) * KSTR + (kc0 % CPK) * 8, ks1 = (kc1 / CPK) * KSTR + (kc1 % CPK) * 8, vs0 = (tid >> 3) * VSTR + (tid & 7) * 8;
  uint4 kreg0 = {0, 0, 0, 0}, kreg1 = {0, 0, 0, 0}, vreg;
  const int r0w = min(max(rq - 4, 0), 24);
  {
    const int k0 = (0 < seg0_tiles) ? seg0_start : seg1_start;
    if (kc0 < KCH) kreg0 = *(const uint4*)(kg0 + (size_t)k0 * DQ);
    if (DQ == 96 && kc1 < KCH) kreg1 = *(const uint4*)(kg1 + (size_t)k0 * DQ);
    vreg = *(const uint4*)(vg + k0);
    if (kc0 < KCH) *(uint4*)((half_t*)smem + ks0) = kreg0;
    if (DQ == 96 && kc1 < KCH) *(uint4*)((half_t*)smem + ks1) = kreg1;
    *(uint4*)((half_t*)(smem + ATT_VOFF) + vs0) = vreg;
  }
  __syncthreads();
  for (int it = 0; it < ntiles; ++it) {
    const int k0 = (it < seg0_tiles) ? seg0_start + it * 64 : seg1_start + (it - seg0_tiles) * 64;
    const bool more = it + 1 < ntiles;
    if (more) {
      const int itn = it + 1;
      const int k1 = (itn < seg0_tiles) ? seg0_start + itn * 64 : seg1_start + (itn - seg0_tiles) * 64;
      if (kc0 < KCH) kreg0 = *(const uint4*)(kg0 + (size_t)k1 * DQ);
      if (DQ == 96 && kc1 < KCH) kreg1 = *(const uint4*)(kg1 + (size_t)k1 * DQ);
      vreg = *(const uint4*)(vg + k1);
    }
    const half_t* ksm = (const half_t*)(smem + (it & 1) * ATT_STAGE) + r * KSTR + h * 8;
    const half_t* vsm = (const half_t*)(smem + (it & 1) * ATT_STAGE + ATT_VOFF) + r * VSTR + h * 4;
    const bool masked = NA && it < seg0_tiles;
    const int krow = k0 >> 6;
    const bool need = active && (!masked || (krow >= r0w && krow < r0w + 8));
    if (need) {
#pragma unroll 1
      for (int st = 0; st < 2; ++st) {
        f16v S[NQG];
#pragma unroll
        for (int qg = 0; qg < NQG; ++qg)
#pragma unroll
          for (int i = 0; i < 16; ++i) S[qg][i] = 0.f;
#pragma unroll
        for (int ks = 0; ks < NKS; ++ks) {
          const h8 kf = *(const h8*)(ksm + (st * 32) * KSTR + ks * 16);
#pragma unroll
          for (int qg = 0; qg < NQG; ++qg) S[qg] = __builtin_amdgcn_mfma_f32_32x32x16_f16(kf, qf[qg][ks], S[qg], 0, 0, 0);
        }
        if (masked) {
          const int cb = st * 32;
          const int dr = krow - rq + 7;
#pragma unroll
          for (int qg = 0; qg < NQG; ++qg) {
            const int qc = qg * 32 + r;
            const int cs = min(max(qc - 8, 0), 48);
#pragma unroll
            for (int i = 0; i < 16; ++i) {
              const int c = cb + (i & 3) + 8 * (i >> 2) + 4 * h;
              const bool valid = (c >= cs) && (c < cs + 16);
              float bias = 0.f;
              if (valid) bias = rpb_h[dr * 31 + (c - qc + 15)] * LOG2E;
              S[qg][i] = valid ? S[qg][i] + bias : -1e30f;
            }
          }
        }
        h4 vf[2][2][2];
#pragma unroll
        for (int dvt = 0; dvt < 2; ++dvt)
#pragma unroll
          for (int sx = 0; sx < 2; ++sx)
#pragma unroll
            for (int hf = 0; hf < 2; ++hf) vf[dvt][sx][hf] = *(const h4*)(vsm + (dvt * 32) * VSTR + st * 32 + sx * 16 + hf * 8);
#pragma unroll
        for (int qg = 0; qg < NQG; ++qg) {
          h8 P[2];
          float mx = S[qg][0];
#pragma unroll
          for (int i = 1; i < 16; ++i) mx = fmaxf(mx, S[qg][i]);
          mx = fmaxf(mx, __shfl_xor(mx, 32));
          const float mn = fmaxf(mrun[qg], mx);
          if (__builtin_amdgcn_ballot_w64(mn > mrun[qg]) != 0ull) {
            const float alpha = __builtin_amdgcn_exp2f(mrun[qg] - mn);
            lrun[qg] *= alpha;
#pragma unroll
            for (int dvt = 0; dvt < 2; ++dvt)
#pragma unroll
              for (int i = 0; i < 16; ++i) O[dvt][qg][i] *= alpha;
            mrun[qg] = mn;
          }
          float rs = 0.f;
#pragma unroll
          for (int i = 0; i < 16; ++i) {
            float pv = __builtin_amdgcn_exp2f(S[qg][i] - mn);
            if (NA) pv = (S[qg][i] <= -1e29f) ? 0.f : pv;
            rs += pv;
            P[i >> 3][i & 7] = (half_t)pv;
          }
          lrun[qg] += rs;
#pragma unroll
          for (int dvt = 0; dvt < 2; ++dvt) {
#pragma unroll
            for (int sx = 0; sx < 2; ++sx) {
              const h8 va = __builtin_shufflevector(vf[dvt][sx][0], vf[dvt][sx][1], 0, 1, 2, 3, 4, 5, 6, 7);
              O[dvt][qg] = __builtin_amdgcn_mfma_f32_32x32x16_f16(va, P[sx], O[dvt][qg], 0, 0, 0);
            }
          }
        }
      }
    }
    if (more) {
      char* nb = smem + ((it + 1) & 1) * ATT_STAGE;
      if (kc0 < KCH) *(uint4*)((half_t*)nb + ks0) = kreg0;
      if (DQ == 96 && kc1 < KCH) *(uint4*)((half_t*)nb + ks1) = kreg1;
      *(uint4*)((half_t*)(nb + ATT_VOFF) + vs0) = vreg;
    }
    __syncthreads();
  }
#pragma unroll
  for (int qg = 0; qg < NQG; ++qg) {
    const float lt = lrun[qg] + __shfl_xor(lrun[qg], 32);
    const float inv = 1.f / lt;
#pragma unroll
    for (int dvt = 0; dvt < 2; ++dvt)
#pragma unroll
      for (int i = 0; i < 16; ++i) O[dvt][qg][i] *= inv;
  }
}

template <int NQG>
DI void store_o(const f16v (&O)[2][NQG], half_t* orow0  , int lane) {
  const int r = lane & 31, h = lane >> 5;
#pragma unroll
  for (int qg = 0; qg < NQG; ++qg)
#pragma unroll
    for (int dvt = 0; dvt < 2; ++dvt)
#pragma unroll
      for (int c = 0; c < 4; ++c) {
        h4 o;
#pragma unroll
        for (int j = 0; j < 4; ++j) o[j] = (half_t)O[dvt][qg][4 * c + j];
        *(h4*)(orow0 + (size_t)(qg * 32 + r) * 1024 + dvt * 32 + 8 * c + 4 * h) = o;
      }
}

DI void phase_attn(int l, half_t* big, bool need_ctx, char* smem, int wv_) {
  const KPtr p = kp();
  const int wave = wv_;
  const int NQB = need_ctx ? 5 : 4;
  half_t* obuf = big + B_O;
  const float lam_init = 0.8f - 0.6f * expf(-0.3f * (float)l);
  float lam;
  {
    float d1 = 0.f, d2 = 0.f;
#pragma unroll 1
    for (int i = 0; i < 32; ++i) {
      d1 += p->lq1[l * 32 + i] * p->lk1[l * 32 + i];
      d2 += p->lq2[l * 32 + i] * p->lk2[l * 32 + i];
    }
    lam = expf(d1) - expf(d2) + lam_init;
    lam = __builtin_bit_cast(float, __builtin_amdgcn_readfirstlane(__builtin_bit_cast(int, lam)));
  }
  const float one_m_li = __builtin_bit_cast(float, __builtin_amdgcn_readfirstlane(__builtin_bit_cast(int, 1.f - lam_init)));
  const int per = 4 * 16 * NQB;
#pragma unroll
  for (int mixer = 0; mixer < 4; ++mixer) {
    const int lo = mixer * per;
    const int first = lo + (int)((blockIdx.x + gridDim.x - (lo % gridDim.x)) % gridDim.x);
    const int tid_m = tid_opaque(wv_);
    const int lane = tid_m & 63, h = lane >> 5;
#pragma unroll 1
    for (int item = first; item < lo + per; item += gridDim.x) {
      const int hi = item / (16 * NQB);
      const int rem = item - hi * 16 * NQB;
      const int b = rem / NQB, qb = rem - b * NQB;
      const bool qctx = qb == 4;
      const bool active = !qctx || wave < 4;
      const int q0 = active ? qb * 512 + wave * 64 : SEQ;
      const int hh = hi & 3;
      const int s0 = qctx ? SEQ : 0, n0t = qctx ? 4 : 36;
      f16v O[2][2];
      half_t* orow = obuf + (size_t)(b * TOK + q0) * 1024 + hh * 64;
      if (mixer == 0) {
        half_t* stash = (half_t*)(smem + ATT_STASH) + wave * 4096;
        attn_wg<32, false, 2>(big + B_QDF + (size_t)(b * 8 + hh * 2) * TOK * 32, big + B_KDF + (size_t)(b * 8 + hh * 2) * TOK * 32,
                              big + B_VTDF + (size_t)(b * 4 + hh) * 64 * TOK, q0, active, s0, n0t, 0, 0, nullptr, 0, smem, tid_m, O);
#pragma unroll
        for (int dvt = 0; dvt < 2; ++dvt)
#pragma unroll
          for (int qg = 0; qg < 2; ++qg)
#pragma unroll
            for (int i = 0; i < 16; ++i) stash[((dvt * 2 + qg) * 16 + i) * 64 + lane] = (half_t)O[dvt][qg][i];
        attn_wg<32, false, 2>(big + B_QDF + (size_t)(b * 8 + hh * 2 + 1) * TOK * 32, big + B_KDF + (size_t)(b * 8 + hh * 2 + 1) * TOK * 32,
                              big + B_VTDF + (size_t)(b * 4 + hh) * 64 * TOK, q0, active, s0, n0t, 0, 0, nullptr, 0, smem, tid_m, O);
#pragma unroll
        for (int qg = 0; qg < 2; ++qg) {
          float ss = 0.f;
#pragma unroll
          for (int dvt = 0; dvt < 2; ++dvt)
#pragma unroll
            for (int i = 0; i < 16; ++i) {
              const float v = (float)stash[((dvt * 2 + qg) * 16 + i) * 64 + lane] - lam * O[dvt][qg][i];
              O[dvt][qg][i] = v;
              ss += v * v;
            }
          ss += __shfl_xor(ss, 32);
          const float rstd = rsqrtf(ss * (1.f / 64.f) + EPS) * one_m_li;
#pragma unroll
          for (int dvt = 0; dvt < 2; ++dvt)
#pragma unroll
            for (int i = 0; i < 16; ++i) {
              const int dv = dvt * 32 + (i & 3) + 8 * (i >> 2) + 4 * h;
              O[dvt][qg][i] *= rstd * p->g_diff_sub[l * 64 + dv];
            }
        }
        if (active) store_o<2>(O, orow + 2 * 256, lane);
      } else if (mixer == 1) {
        attn_wg<96, false, 2>(big + B_QM + (size_t)(b * 4 + hh) * TOK * 96, big + B_KM + (size_t)(b * 4 + hh) * TOK * 96,
                              big + B_VTM + (size_t)(b * 4 + hh) * 64 * TOK, q0, active, s0, n0t, 0, 0, nullptr, 0, smem, tid_m, O);
        if (active) store_o<2>(O, orow + 0 * 256, lane);
      } else if (mixer == 2) {
        const int kv = hh >> 1;
        attn_wg<64, false, 2>(big + B_QG + (size_t)(b * 4 + hh) * TOK * 64, big + B_KG + (size_t)(b * 2 + kv) * TOK * 64,
                              big + B_VTG + (size_t)(b * 2 + kv) * 64 * TOK, q0, active, s0, n0t, 0, 0, nullptr, 0, smem, tid_m, O);
        if (active) store_o<2>(O, orow + 3 * 256, lane);
      } else {
        const int rq = q0 >> 6;
        const int rq0 = qb * 8;
        const int rlo = min(max(rq0 - 4, 0), 24), rhi = min(max(rq0 + 7 - 4, 0), 24) + 8;
        const int seg0s = rlo * 64, seg0n = qctx ? 0 : (rhi - rlo);
        attn_wg<64, true, 2>(big + B_QNA + (size_t)(b * 4 + hh) * TOK * 64, big + B_KNA + (size_t)(b * 4 + hh) * TOK * 64,
                             big + B_VTNA + (size_t)(b * 4 + hh) * 64 * TOK, q0, active, seg0s, seg0n, SEQ, 4,
                             p->na_rpb + (size_t)(l * 4 + hh) * 15 * 31, rq, smem, tid_m, O);
        if (active) store_o<2>(O, orow + 1 * 256, lane);
      }
    }
  }
}

struct SchedGate {
  const half_t* hbuf; const half_t* Wl; int pm0, cnt, G, c, mode;
  static constexpr unsigned lda2 = 2048, ldb2 = 2048;
  DI bool next(int i, GUnit& u) const {
    int pm, pn;
    if (!tile_map(i * G + c, cnt, 16, pm, pn)) return false;
    u.pm = pm0 + pm; u.pn = pn; u.nt = 16; u.aux = 0;
    u.A = (const char*)(hbuf + (size_t)row0_of(u.pm, mode) * 1024); u.B = (const char*)(Wl + W_GATE + (size_t)pn * 256 * 1024);
    return true;
  }
};
struct EpiGate {
  half_t* gb; int pm0;
  DI void operator()(const f4 (&acc)[2][2][4][2], const GUnit& u, int wr, int wc, int fr, int fq) const {
    char* rb = (char*)(gb + (size_t)((u.pm - pm0) * 256 + wr * 64) * 4096 + u.pn * 256 + wc * 32);
    const unsigned lo = (unsigned)(fr * 4096 + 8 * fq) * 2u;
#pragma unroll
    for (int ai = 0; ai < 2; ++ai)
#pragma unroll
      for (int m = 0; m < 4; ++m)
#pragma unroll
        for (int bj = 0; bj < 2; ++bj) {
          f4 a = acc[ai][bj][m][0], c = acc[ai][bj][m][1];
#pragma unroll
          for (int j = 0; j < 4; ++j) { a[j] = __builtin_amdgcn_rcpf(1.f + __expf(-a[j])); c[j] = __builtin_amdgcn_rcpf(1.f + __expf(-c[j])); }
          *(h8*)(rb + ((size_t)(ai * 128 + m * 16) * 4096 + bj * 128) * 2 + lo) = pack8(a, c);
        }
  }
};
struct SchedProj {
  const half_t* obuf; const half_t* Wl; int pm0, cnt, G, c, mode;
  static constexpr unsigned lda2 = 2048, ldb2 = 512;
  DI bool next(int i, GUnit& u) const {
    int pm, pn;
    if (!tile_map((i >> 2) * G + c, cnt, 4, pm, pn)) return false;
    const int br = i & 3;
    u.pm = pm0 + pm; u.pn = pn; u.nt = 4; u.aux = br;
    u.A = (const char*)(obuf + (size_t)row0_of(u.pm, mode) * 1024 + br * 256);
    u.B = (const char*)(Wl + W_BR + (size_t)(br * 1024 + pn * 256) * 256);
    return true;
  }
};
struct EpiProj {
  const half_t* gb; half_t* mbuf; int pm0, mode;
  DI void operator()(const f4 (&acc)[2][2][4][2], const GUnit& u, int wr, int wc, int fr, int fq) const {
    const int br = u.aux;
    const char* gp = (const char*)(gb + (size_t)((u.pm - pm0) * 256 + wr * 64) * 4096 + br * 1024 + u.pn * 256 + wc * 32);
    char* mp = (char*)(mbuf + (size_t)(row0_of(u.pm, mode) + wr * 64) * 1024 + u.pn * 256 + wc * 32);
    const unsigned glo = (unsigned)(fr * 4096 + 8 * fq) * 2u, mlo = (unsigned)(fr * 1024 + 8 * fq) * 2u;
#pragma unroll
    for (int ai = 0; ai < 2; ++ai) {
      h8 gq[4][2], mq[4][2];
#pragma unroll
      for (int m = 0; m < 4; ++m)
#pragma unroll
        for (int bj = 0; bj < 2; ++bj) gq[m][bj] = *(const h8*)(gp + ((size_t)(ai * 128 + m * 16) * 4096 + bj * 128) * 2 + glo);
      if (br > 0) {
#pragma unroll
        for (int m = 0; m < 4; ++m)
#pragma unroll
          for (int bj = 0; bj < 2; ++bj) mq[m][bj] = *(const h8*)(mp + ((size_t)(ai * 128 + m * 16) * 1024 + bj * 128) * 2 + mlo);
      }
#pragma unroll
      for (int m = 0; m < 4; ++m)
#pragma unroll
        for (int bj = 0; bj < 2; ++bj) {
          f4 a = acc[ai][bj][m][0], c = acc[ai][bj][m][1];
#pragma unroll
          for (int j = 0; j < 4; ++j) { a[j] *= (float)gq[m][bj][j]; c[j] *= (float)gq[m][bj][4 + j]; }
          if (br > 0) {
#pragma unroll
            for (int j = 0; j < 4; ++j) { a[j] += (float)mq[m][bj][j]; c[j] += (float)mq[m][bj][4 + j]; }
          }
          *(h8*)(mp + ((size_t)(ai * 128 + m * 16) * 1024 + bj * 128) * 2 + mlo) = pack8(a, c);
        }
    }
  }
};

__global__ void __launch_bounds__(NTHR) hybrid_block_megakernel(Params p) {
  __shared__ __attribute__((aligned(16))) char smem[SMEM_BYTES];
  char* ws = kp()->ws;
  if (ws == nullptr) cg::this_grid().sync();
  half_t* W = (half_t*)(ws + OFF_W);
  float* mods = (float*)(ws + OFF_MOD);
  float* xc = (float*)(ws + OFF_XC);
  half_t* hbuf = (half_t*)(ws + OFF_H);
  half_t* big = (half_t*)(ws + OFF_BIG);
  float* part = (float*)(ws + OFF_PART);
  LAS unsigned char* lds = (LAS unsigned char*)smem;
  const int G = gridDim.x, cblk = blockIdx.x;

  const int wv_ = __builtin_amdgcn_readfirstlane((int)threadIdx.x >> 6);
  volatile LAS unsigned* st = (volatile LAS unsigned*)(lds + GEMM_LDS);
  if (threadIdx.x < 4) st[threadIdx.x] = 0u;
  __syncthreads();
  xcd_barrier_post((unsigned*)(ws + OFF_BAR), wv_);

  phase_mods(mods, smem, wv_);
  {
    int base = 0;
    float* tile = (float*)smem;
    for (int l = 0; l < 2; ++l) {
      half_t* Wl = W + (size_t)l * W_LAYER;
      const float* win = kp()->w_in + (size_t)l * 1024 * 6496;
      tconv_job(win, 6496, 0, 1024, 1024, 192, 256, Wl + W_QK, base, tile, wv_);
      tconv_job(win, 6496, 192, 1024, 1024, 128, 256, Wl + W_QK + (size_t)256 * 1024, base, tile, wv_);
      tconv_job(win, 6496, 320, 1024, 1024, 32, 64, Wl + W_QK + (size_t)512 * 1024, base, tile, wv_);
      tconv_job(win, 6496, 352, 1024, 1024, 256, 256, Wl + W_QK + (size_t)576 * 1024, base, tile, wv_);
      tconv_job(win, 6496, 608, 1024, 1024, 256, 256, Wl + W_QK + (size_t)832 * 1024, base, tile, wv_);
      tconv_job(win, 6496, 1120, 1024, 1024, 256, 256, Wl + W_QK + (size_t)1088 * 1024, base, tile, wv_);
      tconv_job(win, 6496, 1376, 1024, 1024, 256, 256, Wl + W_QK + (size_t)1344 * 1024, base, tile, wv_);
      tconv_job(win, 6496, 1888, 1024, 1024, 256, 256, Wl + W_QK + (size_t)1600 * 1024, base, tile, wv_);
      tconv_job(win, 6496, 2144, 1024, 1024, 128, 192, Wl + W_QK + (size_t)1856 * 1024, base, tile, wv_);
      tconv_job(win, 6496, 864, 1024, 1024, 256, 256, Wl + W_V, base, tile, wv_);
      tconv_job(win, 6496, 1632, 1024, 1024, 256, 256, Wl + W_V + (size_t)256 * 1024, base, tile, wv_);
      tconv_job(win, 6496, 2272, 1024, 1024, 128, 256, Wl + W_V + (size_t)512 * 1024, base, tile, wv_);
      tconv_job(win, 6496, 2400, 1024, 1024, 4096, 4096, Wl + W_GATE, base, tile, wv_);
      for (int br = 0; br < 4; ++br)
        tconv_job(kp()->w_branch + ((size_t)l * 4 + br) * 256 * 1024, 1024, 0, 256, 256, 1024, 1024, Wl + W_BR + (size_t)br * 1024 * 256, base, tile, wv_);
      tconv_job(kp()->w_out + (size_t)l * 1024 * 1024, 1024, 0, 1024, 1024, 1024, 1024, Wl + W_OUT, base, tile, wv_);
      tconv_job(kp()->w_up + (size_t)l * 1024 * 4096, 4096, 0, 1024, 1024, 4096, 4096, Wl + W_UP, base, tile, wv_);
      tconv_job(kp()->w_down + (size_t)l * 4096 * 1024, 1024, 0, 4096, 4096, 1024, 1024, Wl + W_DOWN, base, tile, wv_);
      tconv_job(kp()->w_mla_uq + (size_t)l * 192 * 384, 384, 0, 256, 192, 384, 512, Wl + W_UQ, base, tile, wv_);
      for (int hh = 0; hh < 4; ++hh) {
        tconv_job(kp()->w_mla_ukv + (size_t)l * 128 * 512, 512, hh * 128, 256, 128, 64, 64, Wl + W_UK + (size_t)hh * 64 * 256, base, tile, wv_);
        tconv_job(kp()->w_mla_ukv + (size_t)l * 128 * 512, 512, hh * 128 + 64, 256, 128, 64, 64, Wl + W_UV + (size_t)hh * 64 * 256, base, tile, wv_);
      }
    }
  }
  xcd_barrier(ws, lds, wv_);

  for (int l = 0; l < 2; ++l) {
    const bool need_ctx = (l == 0);
    const bool skip_ctx = !need_ctx;
    const half_t* Wl = W + (size_t)l * W_LAYER;
    const float* mods_l = mods + (size_t)l * 17 * 6144;
    const float* xl_src = (l == 0) ? kp()->x : kp()->out;
    const float* xc_src = (l == 0) ? kp()->ctx : xc;
    const int nrt = skip_ctx ? 128 : 144;

    phase_norm(xl_src, xc_src, kp()->g_norm1 + l * 1024, mods_l, 0, 1024, hbuf, false, (l == 1) ? part : nullptr, nullptr, wv_);
    xcd_barrier(ws, lds, wv_);
    {
      SchedInproj S{hbuf, Wl, G, cblk};
      EpiInproj E{big};
      gemm256<true>(lds, S, E, wv_);
    }
    xcd_barrier(ws, lds, wv_);
    {
      build_rope_tables((float2*)smem, wv_);
      half_t* zmla = big + B_ZMLA;
      norm_rows<192, 32, 0, false>(zmla, ZS, NTOK, kp()->g_mla_qa + l * 192, 1.f, nullptr, (const float2*)smem, wv_);
      norm_rows<128, 16, 0, false>(zmla + 256, ZS, NTOK, kp()->g_mla_kva + l * 128, 1.f, nullptr, (const float2*)smem, wv_);
      norm_rows<64, 8, 0, false>(big + B_QNA, 64, NTOK * 4, kp()->g_na_q + l * 64, 0.125f * LOG2E, nullptr, (const float2*)smem, wv_);
      norm_rows<64, 8, 0, false>(big + B_KNA, 64, NTOK * 4, kp()->g_na_k + l * 64, 1.f, nullptr, (const float2*)smem, wv_);
      norm_rows<32, 4, 32, false>(big + B_QDF, 32, NTOK * 8, kp()->g_diff_q + l * 32, 0.17677669529663687f * LOG2E, nullptr, (const float2*)smem, wv_);
      norm_rows<32, 4, 32, false>(big + B_KDF, 32, NTOK * 8, kp()->g_diff_k + l * 32, 1.f, nullptr, (const float2*)smem, wv_);
      norm_rows<64, 8, 64, false>(big + B_QG, 64, NTOK * 4, kp()->g_gqa_q + l * 64, 0.125f * LOG2E, nullptr, (const float2*)smem, wv_);
      norm_rows<64, 8, 64, false>(big + B_KG, 64, NTOK * 2, kp()->g_gqa_k + l * 64, 1.f, nullptr, (const float2*)smem, wv_);
    }
    xcd_barrier(ws, lds, wv_);
    {
      SchedMlaQK S{Wl, big + B_ZMLA, G, cblk};
      EpiMla E{big};
      gemm256<true>(lds, S, E, wv_);
      SchedMlaV S2{Wl, big + B_ZMLA, G, cblk};
      gemm256<true>(lds, S2, E, wv_);
    }
    xcd_barrier(ws, lds, wv_);
    build_rope_tables((float2*)smem, wv_);
    norm_rows<96, 16, 32, false>(big + B_QM, 96, NTOK * 4, kp()->g_mla_q + l * 96, 0.10206207261596575f * LOG2E, nullptr, (const float2*)smem, wv_);
    norm_rows<96, 16, 32, true>(big + B_KM, 96, NTOK * 4, kp()->g_mla_k + l * 96, 1.f, big + B_ZMLA, (const float2*)smem, wv_);
    xcd_barrier(ws, lds, wv_);
    phase_attn(l, big, need_ctx, smem, wv_);
    xcd_barrier(ws, lds, wv_);
    {
      const int nsp = need_ctx ? 3 : 2;
      for (int j = 0; j < nsp; ++j) {
        const int mode = (j < 2) ? 1 : 2, pm0 = (j < 2) ? j * 64 : 0, cnt = (j < 2) ? 64 : 16;
        {
          SchedGate S{hbuf, Wl, pm0, cnt, G, cblk, mode};
          EpiGate E{big + B_G0, pm0};
          gemm256<true>(lds, S, E, wv_);
        }
        xcd_barrier(ws, lds, wv_);
        {
          SchedProj S{big + B_O, Wl, pm0, cnt, G, cblk, mode};
          EpiProj E{big + B_G0, big + B_M, pm0, mode};
          gemm256<true>(lds, S, E, wv_);
        }
        xcd_barrier(ws, lds, wv_);
      }
    }
    {
      SchedResid S{big + B_M, Wl + W_OUT, 1024, 4, need_ctx ? 16 : 0, G, cblk, 2048u, 2048u};
      EpiResid E{xl_src, kp()->out, part, mods_l, 2048};
      gemm256<false>(lds, S, E, wv_);
    }
    xcd_barrier(ws, lds, wv_);
    phase_norm(kp()->out, xc_src, kp()->g_norm2 + l * 1024, mods_l, 3072, 4096, hbuf, skip_ctx, need_ctx ? part : nullptr, need_ctx ? xc : nullptr, wv_);
    xcd_barrier(ws, lds, wv_);
    {
      SchedRows S{hbuf, Wl + W_UP, 1024, nrt, 16, G, cblk, skip_ctx ? 1 : 0, 2048u, 2048u};
      EpiUp E{big + B_U, skip_ctx ? 1 : 0};
      gemm256<true>(lds, S, E, wv_);
    }
    xcd_barrier(ws, lds, wv_);
    {
      SchedResid S{big + B_U, Wl + W_DOWN, 4096, 4, need_ctx ? 16 : 0, G, cblk, 8192u, 8192u};
      EpiResid E{kp()->out, kp()->out, part, mods_l, 5120};
      gemm256<false>(lds, S, E, wv_);
    }
    if (l == 0) xcd_barrier(ws, lds, wv_);
  }
}

extern "C" void kernel_launch(void* const* d_in, const int* in_sizes, int n_in, void* d_out, int out_size, void* d_ws,
                              size_t ws_size, hipStream_t stream) {
  static int grid_blocks = 0;
  if (!grid_blocks) {
    int dev = 0, cus = 0, per_cu = 0;
    (void)hipGetDevice(&dev);
    (void)hipDeviceGetAttribute(&cus, hipDeviceAttributeMultiprocessorCount, dev);
    (void)hipOccupancyMaxActiveBlocksPerMultiprocessor(&per_cu, hybrid_block_megakernel, NTHR, 0);
    if (per_cu < 1) fprintf(stderr, "occupancy query returned %d\n", per_cu);
    grid_blocks = cus;
  }
  if (ws_size < WS_NEED) fprintf(stderr, "workspace too small: %zu < %zu\n", ws_size, (size_t)WS_NEED);
  (void)hipMemsetAsync((char*)d_ws + OFF_BAR, 0, XCD_BAR_WORDS * 4, stream);
  Params p{};
  const float** pf = (const float**)&p;
  for (int i = 0; i < 31; ++i) pf[i] = (const float*)d_in[i];
  p.out = (float*)d_out;
  p.ws = (char*)d_ws;
  void* args[] = {&p};
  hipError_t e = hipLaunchCooperativeKernel((void*)hybrid_block_megakernel, dim3(grid_blocks), dim3(NTHR), args, 0, stream);
  if (e != hipSuccess) fprintf(stderr, "cooperative launch failed: %s (grid %d)\n", hipGetErrorString(e), grid_blocks);
}
```

```cpp
#include <hip/hip_runtime.h>
#include <hip/hip_cooperative_groups.h>
#include <cstdio>
namespace cg = cooperative_groups;

typedef _Float16 half_t;
typedef __attribute__((ext_vector_type(8))) _Float16 h8;
typedef __attribute__((ext_vector_type(4))) _Float16 h4;
typedef __attribute__((ext_vector_type(4))) float f4;
typedef __attribute__((ext_vector_type(16))) float f16v;

#define DI __device__ __forceinline__
#define LAS __attribute__((address_space(3)))

constexpr int NB = 16, SEQ = 2048, CTX = 256, TOK = 2304, NTOK = NB * TOK;
constexpr float LOG2E = 1.4426950408889634f;
constexpr float EPS = 1e-6f;

constexpr int NQK = 2048;
constexpr int NVT = 768;
constexpr int ZS = 576;
constexpr size_t W_QK = 0;
constexpr size_t W_V = W_QK + (size_t)NQK * 1024;
constexpr size_t W_GATE = W_V + (size_t)NVT * 1024;
constexpr size_t W_BR = W_GATE + (size_t)4096 * 1024;
constexpr size_t W_OUT = W_BR + (size_t)4 * 1024 * 256;
constexpr size_t W_UP = W_OUT + (size_t)1024 * 1024;
constexpr size_t W_DOWN = W_UP + (size_t)4096 * 1024;
constexpr size_t W_UQ = W_DOWN + (size_t)1024 * 4096;
constexpr size_t W_UK = W_UQ + (size_t)512 * 256;
constexpr size_t W_UV = W_UK + (size_t)256 * 256;
constexpr size_t W_LAYER = W_UV + (size_t)256 * 256;

constexpr size_t al256(size_t x) { return (x + 255) & ~(size_t)255; }
constexpr size_t OFF_BAR = 0;
constexpr size_t OFF_W = 16384;
constexpr size_t OFF_MOD = al256(OFF_W + 2 * W_LAYER * 2);
constexpr size_t OFF_XC = al256(OFF_MOD + (size_t)2 * 17 * 6144 * 4);
constexpr size_t OFF_H = al256(OFF_XC + (size_t)NB * CTX * 1024 * 4);
constexpr size_t OFF_BIG = al256(OFF_H + (size_t)NTOK * 1024 * 2);
constexpr size_t B_O = 0;
constexpr size_t B_QM = B_O + (size_t)NTOK * 1024;
constexpr size_t B_KM = B_QM + (size_t)NTOK * 384;
constexpr size_t B_VTM = B_KM + (size_t)NTOK * 384;
constexpr size_t B_QNA = B_VTM + (size_t)NTOK * 256;
constexpr size_t B_KNA = B_QNA + (size_t)NTOK * 256;
constexpr size_t B_VTNA = B_KNA + (size_t)NTOK * 256;
constexpr size_t B_QDF = B_VTNA + (size_t)NTOK * 256;
constexpr size_t B_KDF = B_QDF + (size_t)NTOK * 256;
constexpr size_t B_VTDF = B_KDF + (size_t)NTOK * 256;
constexpr size_t B_QG = B_VTDF + (size_t)NTOK * 256;
constexpr size_t B_KG = B_QG + (size_t)NTOK * 256;
constexpr size_t B_VTG = B_KG + (size_t)NTOK * 128;
constexpr size_t B_ZMLA = B_VTG + (size_t)NTOK * 128;
constexpr size_t B_END = B_ZMLA + (size_t)NTOK * ZS;
constexpr size_t B_M = B_O + (size_t)NTOK * 1024;
constexpr size_t GSLAB = (size_t)64 * 256 * 4096;
constexpr size_t B_G0 = B_M + (size_t)NTOK * 1024;
constexpr size_t B_P5END = B_G0 + GSLAB;
constexpr size_t B_U = 0;
constexpr size_t B_MAX = B_END > B_P5END ? B_END : B_P5END;
constexpr size_t OFF_PART = OFF_BIG + (size_t)NTOK * 4096 * 2;
constexpr size_t WS_NEED = (OFF_BIG + B_MAX * 2) > (OFF_PART + (size_t)4 * NB * CTX * 1024 * 4) ? (OFF_BIG + B_MAX * 2) : (OFF_PART + (size_t)4 * NB * CTX * 1024 * 4);
static_assert(B_P5END * 2 <= (size_t)NTOK * 4096 * 2, "merge buffers must end before the partial buffer");
static_assert(B_MAX >= (size_t)NTOK * 4096, "u must fit");
static_assert(WS_NEED <= (size_t)536870912, "workspace budget");

constexpr int NTHR = 512, NWAVE = 8;
constexpr int GEMM_LDS = 131072;
constexpr int SMEM_BYTES = GEMM_LDS + 16;

struct Params {
  const float *x, *c, *ctx, *c_ctx, *w_ada, *b_ada, *g_norm1, *g_norm2, *w_in;
  const float *g_mla_qa, *w_mla_uq, *g_mla_kva, *w_mla_ukv, *g_mla_q, *g_mla_k;
  const float *g_na_q, *g_na_k, *na_rpb;
  const float *g_diff_q, *g_diff_k, *lq1, *lk1, *lq2, *lk2, *g_diff_sub;
  const float *g_gqa_q, *g_gqa_k, *w_branch, *w_out, *w_up, *w_down;
  float* out;
  char* ws;
};


typedef const Params __attribute__((address_space(4))) * KPtr;
DI KPtr kp() {
  KPtr q = (KPtr)__builtin_amdgcn_kernarg_segment_ptr();
  asm volatile("" : "+s"(q));
  return q;
}

DI int tid_opaque(int wv_) {
  unsigned z = 0u;
  asm volatile("" : "+v"(z));
  int t = (wv_ << 6) | (int)__builtin_amdgcn_mbcnt_hi(~0u, __builtin_amdgcn_mbcnt_lo(~0u, z));
  asm volatile("" : "+v"(t));
  return t;
}

DI float wave_sum(float v) {
#pragma unroll
  for (int o = 32; o > 0; o >>= 1) v += __shfl_xor(v, o);
  return v;
}

#define XB_TMO      128
#define XB_XCNT(j)  (256  + 64 * (j))
#define XB_XSUB(j)  (1280 + 64 * (j))
#define XB_XGEN(j)  (2304 + 64 * (j))
#define XB_TOP      3328
#define XB_TOPGEN   3392
#define XCD_BAR_WORDS 3456
#define XB_SPIN_CAP (1u << 22)
DI unsigned xb_ld(unsigned* p) { return __hip_atomic_load(p, __ATOMIC_RELAXED, __HIP_MEMORY_SCOPE_AGENT); }
DI unsigned xb_add(unsigned* p, unsigned v) { return __hip_atomic_fetch_add(p, v, __ATOMIC_RELAXED, __HIP_MEMORY_SCOPE_AGENT); }
DI unsigned xb_xcc_id() { return (unsigned)__builtin_amdgcn_s_getreg((3 << 11) | 20) & 0xFu; }
#define XB_SPIN(cond, bar) do { unsigned _sp = 0; while (cond) { __builtin_amdgcn_s_sleep(1); \
    if ((++_sp & 255u) == 0u) { if (xb_ld(&(bar)[XB_TMO])) break; if (_sp > XB_SPIN_CAP) { atomicAdd(&(bar)[XB_TMO], 1u); break; } } } } while (0)
DI void xcd_barrier_post(unsigned* bar, int wv_) {
  if (tid_opaque(wv_) == 0) (void)xb_add(&bar[XB_XCNT(xb_xcc_id())], 1u);
}
DI void xcd_barrier_complete(unsigned* bar, unsigned x, unsigned& nloc, unsigned& nx) {
  const unsigned G = gridDim.x * gridDim.y * gridDim.z;
  unsigned sum, cnt, mine, sp = 0u;
  for (;;) {
    sum = 0u; cnt = 0u; mine = 0u;
#pragma unroll
    for (unsigned j = 0; j < 16; ++j) { const unsigned c = xb_ld(&bar[XB_XCNT(j)]); sum += c; cnt += (c > 0u) ? 1u : 0u; mine = (j == x) ? c : mine; }
    if (sum == G) break;
    __builtin_amdgcn_s_sleep(1);
    if ((++sp & 255u) == 0u) { if (xb_ld(&bar[XB_TMO])) break; if (sp > XB_SPIN_CAP) { atomicAdd(&bar[XB_TMO], 1u); break; } }
  }
  nloc = mine > 0u ? mine : 1u; nx = cnt > 0u ? cnt : 1u;
}
DI void xcd_barrier(char* ws_, LAS unsigned char* lds_, int wv_) {
  asm volatile("s_waitcnt vmcnt(0)" ::: "memory");
  __syncthreads();
  if (tid_opaque(wv_) == 0) {
    char* wsl = ws_;
    asm volatile("" : "+s"(wsl));
    unsigned* bar = (unsigned*)(wsl + OFF_BAR);
    volatile LAS unsigned* st = (volatile LAS unsigned*)(lds_ + GEMM_LDS);
    const unsigned x = xb_xcc_id();
    __builtin_amdgcn_s_waitcnt(0);
    unsigned nloc = st[0], nx = st[1];
    if (nloc == 0u) { xcd_barrier_complete(bar, x, nloc, nx); st[0] = nloc; st[1] = nx; }
    const unsigned old = xb_add(&bar[XB_XSUB(x)], 1u);
    const unsigned gen = old / nloc;
    if (old + 1u == (gen + 1u) * nloc) {
      __builtin_amdgcn_fence(__ATOMIC_RELEASE, "agent");
      asm volatile("s_waitcnt vmcnt(0)" ::: "memory");
      const unsigned og = xb_add(&bar[XB_TOP], 1u);
      const unsigned tg = og / nx;
      if (og + 1u == (tg + 1u) * nx) xb_add(&bar[XB_TOPGEN], 1u);
      else XB_SPIN(xb_ld(&bar[XB_TOPGEN]) == tg, bar);
      __builtin_amdgcn_fence(__ATOMIC_ACQUIRE, "agent");
      xb_add(&bar[XB_XGEN(x)], 1u);
      asm volatile("s_waitcnt vmcnt(0)" ::: "memory");
    } else {
      XB_SPIN(xb_ld(&bar[XB_XGEN(x)]) == gen, bar);
      __builtin_amdgcn_fence(__ATOMIC_ACQUIRE, "agent");
      asm volatile("s_waitcnt vmcnt(0)" ::: "memory");
    }
  }
  __syncthreads();
}

DI void phase_mods(float* mods, char* smem, int wv_) {
  const KPtr p = kp();
  float* sil = (float*)smem;
  const int tid = tid_opaque(wv_);
  for (int w = blockIdx.x; w < 192; w += gridDim.x) {
    const int l = w / 96, n0 = (w % 96) * 64;
    __syncthreads();
    for (int idx = tid; idx < 17 * 1024; idx += NTHR) {
      const int b = idx >> 10, k = idx & 1023;
      const float v = (b < 16) ? p->c[b * 1024 + k] : p->c_ctx[k];
      sil[idx] = v / (1.f + expf(-v));
    }
    __syncthreads();
    const int kq = tid >> 6, nn = tid & 63;
    float acc[17];
#pragma unroll
    for (int b = 0; b < 17; ++b) acc[b] = 0.f;
    const float* wp = p->w_ada + (size_t)l * 1024 * 6144 + (size_t)(kq * 128) * 6144 + n0 + nn;
    const float* sp = sil + kq * 128;
#pragma unroll 4
    for (int k = 0; k < 128; ++k) {
      const float wv = wp[(size_t)k * 6144];
#pragma unroll
      for (int b = 0; b < 17; ++b) acc[b] += sp[b * 1024 + k] * wv;
    }
    __syncthreads();
    float* red = (float*)smem;
#pragma unroll
    for (int b = 0; b < 17; ++b) red[(kq * 17 + b) * 64 + nn] = acc[b];
    __syncthreads();
    for (int idx = tid; idx < 17 * 64; idx += NTHR) {
      float s = p->b_ada[l * 6144 + n0 + (idx & 63)];
#pragma unroll
      for (int q = 0; q < 8; ++q) s += red[q * 17 * 64 + idx];
      mods[((size_t)l * 17 + (idx >> 6)) * 6144 + n0 + (idx & 63)] = s;
    }
  }
  __syncthreads();
}

DI void tconv_job(const float* src, int ld, int c0, int K, int Kvalid, int Nvalid, int Npad, half_t* dst, int& base,
                  float* tile, int wv_) {
  const int nnt = Npad / 64, tot = (K / 64) * nnt;
  const int G = gridDim.x;
  const int start = (int)((blockIdx.x + G - (base % G)) % G);
  const int tid_ = tid_opaque(wv_);
  const int tx = tid_ & 63, ty = tid_ >> 6;
  for (int t = start; t < tot; t += 2 * G) {
    const int t2 = t + G;
    const bool has2 = t2 < tot;
    const int kt = t / nnt, nt = t % nnt, kt2 = has2 ? t2 / nnt : kt, nt2 = has2 ? t2 % nnt : nt;
    float r0[8], r1[8];
#pragma unroll
    for (int i = 0; i < 8; ++i) {
      const int k = i * 8 + ty, n = nt * 64 + tx, n2 = nt2 * 64 + tx;
      r0[i] = (n < Nvalid && kt * 64 + k < Kvalid) ? src[(size_t)(kt * 64 + k) * ld + c0 + n] : 0.f;
      r1[i] = (has2 && n2 < Nvalid && kt2 * 64 + k < Kvalid) ? src[(size_t)(kt2 * 64 + k) * ld + c0 + n2] : 0.f;
    }
    __syncthreads();
#pragma unroll
    for (int i = 0; i < 8; ++i) {
      tile[(i * 8 + ty) * 65 + tx] = r0[i];
      tile[64 * 65 + (i * 8 + ty) * 65 + tx] = r1[i];
    }
    __syncthreads();
#pragma unroll
    for (int i = 0; i < 8; ++i) {
      const int n = i * 8 + ty;
      dst[(size_t)(nt * 64 + n) * K + kt * 64 + tx] = (half_t)tile[tx * 65 + n];
      if (has2) dst[(size_t)(nt2 * 64 + n) * K + kt2 * 64 + tx] = (half_t)tile[64 * 65 + tx * 65 + n];
    }
  }
  base += tot;
}

struct NormRow { const float* mod; int g, b, t; bool valid, isctx; };
DI void norm_load(int g, const float* xl, const float* xc, const float* mods_l, bool skip_ctx, int lane, float4 (&v)[4], NormRow& r) {
  r.g = g; r.valid = g < NTOK;
  const int gg = r.valid ? g : 0;
  r.b = gg / TOK; r.t = gg - r.b * TOK;
  r.isctx = r.t >= SEQ;
  if (r.isctx && skip_ctx) r.valid = false;
  const float* src = r.isctx ? xc + ((size_t)r.b * CTX + (r.t - SEQ)) * 1024 : xl + ((size_t)r.b * SEQ + r.t) * 1024;
  r.mod = mods_l + (size_t)(r.isctx ? 16 : r.b) * 6144;
  if (r.valid) {
#pragma unroll
    for (int i = 0; i < 4; ++i) v[i] = *(const float4*)(src + i * 256 + lane * 4);
  } else {
#pragma unroll
    for (int i = 0; i < 4; ++i) v[i] = float4{0.f, 0.f, 0.f, 0.f};
  }
}
DI void norm_finish(float4 (&v)[4], const NormRow& r, const float* gam, int sh_off, int sc_off, half_t* h, const float* part, float* xc_store, int lane) {
  if (r.valid && r.isctx && part != nullptr) {
    const size_t ro = ((size_t)r.b * CTX + (r.t - SEQ)) * 1024;
#pragma unroll
    for (int i = 0; i < 4; ++i) {
#pragma unroll
      for (int ks = 0; ks < 4; ++ks) {
        const float4 pv = *(const float4*)(part + (size_t)ks * NB * CTX * 1024 + ro + i * 256 + lane * 4);
        v[i].x += pv.x; v[i].y += pv.y; v[i].z += pv.z; v[i].w += pv.w;
      }
      if (xc_store != nullptr) *(float4*)(xc_store + ro + i * 256 + lane * 4) = v[i];
    }
  }
  float ss = 0.f;
#pragma unroll
  for (int i = 0; i < 4; ++i) ss += v[i].x * v[i].x + v[i].y * v[i].y + v[i].z * v[i].z + v[i].w * v[i].w;
  ss = wave_sum(ss);
  if (!r.valid) return;
  const float rstd = rsqrtf(ss * (1.f / 1024.f) + EPS);
#pragma unroll
  for (int i = 0; i < 4; ++i) {
    const int col = i * 256 + lane * 4;
    const float4 gg = *(const float4*)(gam + col);
    const float4 sc = *(const float4*)(r.mod + sc_off + col);
    const float4 sh = *(const float4*)(r.mod + sh_off + col);
    h4 o;
    o[0] = (half_t)(v[i].x * rstd * gg.x * (1.f + sc.x) + sh.x);
    o[1] = (half_t)(v[i].y * rstd * gg.y * (1.f + sc.y) + sh.y);
    o[2] = (half_t)(v[i].z * rstd * gg.z * (1.f + sc.z) + sh.z);
    o[3] = (half_t)(v[i].w * rstd * gg.w * (1.f + sc.w) + sh.w);
    *(h4*)(h + (size_t)r.g * 1024 + col) = o;
  }
}
DI void phase_norm(const float* xl, const float* xc, const float* gam, const float* mods_l, int sh_off,
                   int sc_off, half_t* h, bool skip_ctx, const float* part, float* xc_store, int wv_) {
  const int tid_ = tid_opaque(wv_);
  const int wave = tid_ >> 6, lane = tid_ & 63;
  const int stride = gridDim.x * NWAVE;
  for (int g = blockIdx.x * NWAVE + wave; g < NTOK; g += 2 * stride) {
    float4 v0[4], v1[4];
    NormRow r0, r1;
    norm_load(g, xl, xc, mods_l, skip_ctx, lane, v0, r0);
    norm_load(g + stride, xl, xc, mods_l, skip_ctx, lane, v1, r1);
    norm_finish(v0, r0, gam, sh_off, sc_off, h, part, xc_store, lane);
    norm_finish(v1, r1, gam, sh_off, sc_off, h, part, xc_store, lane);
  }
}

constexpr int BK = 64, HALF = 128, HTB = HALF * BK * 2;
DI int lds_byte(int r, int c) { const int st = (r >> 4) * 2 + (c >> 5), rr = r & 15, cc = c & 31, ob = rr * 64 + cc * 2; return st * 1024 + (ob ^ (((ob >> 9) & 1) << 5)); }
DI void stage_rc(int b, int& R, int& C) { const int st = b / 1024, sb = b % 1024, swz = sb ^ (((sb >> 9) & 1) << 5); R = (st >> 1) * 16 + swz / 64; C = (st & 1) * 32 + (swz % 64) / 2; }
DI int perm32(int rho) { const int n = rho >> 4, i = rho & 15; return 8 * (i >> 2) + 4 * n + (i & 3); }

struct SchedBase {
  static DI int bmap(bool perm, int R) { return perm ? ((R & ~31) + perm32(R & 31)) : R; }
  static constexpr int BHALF = 128;
  static constexpr bool CHAIN = false;
};
struct GUnit { const char* A; const char* B; int nt, pm, pn, aux, ks; };

DI bool tile_map(int L, int nM, int nN, int& pm, int& pn) {
  const int nwg = nM * nN;
  if (L >= nwg) return false;
  int wgid = L;
  { const int q = nwg / 8, r = nwg % 8, xcd = wgid % 8, off = wgid / 8; wgid = (xcd < r ? xcd * (q + 1) : r * (q + 1) + (xcd - r) * q) + off; }
  const int nig = 8 * nN, gid = wgid / nig, fm = gid * 8, gsz = (nM - fm) < 8 ? (nM - fm) : 8;
  pm = fm + ((wgid % nig) % gsz); pn = (wgid % nig) / gsz;
  return true;
}

template <bool PERM, class Sched, class Epi>
DI void gemm256(LAS unsigned char* lds, const Sched& S, const Epi& E, int wv_) {
  const int tid = tid_opaque(wv_), wid = __builtin_amdgcn_readfirstlane(tid >> 6), lane = tid & 63, wr = wid >> 2, wc = wid & 3, fr = lane & 15, fq = lane >> 4;
  unsigned cvA0, cvA1, cvB0, cvB1;
  { int R, C;
    stage_rc(tid * 16, R, C); cvA0 = (unsigned)R * S.lda2 + C * 2; cvB0 = (unsigned)Sched::bmap(PERM, R) * S.ldb2 + C * 2;
    stage_rc(tid * 16 + 8192, R, C); cvA1 = (unsigned)R * S.lda2 + C * 2; cvB1 = (unsigned)Sched::bmap(PERM, R) * S.ldb2 + C * 2; }
  const size_t chA = (size_t)HALF * S.lda2, chB = (size_t)Sched::BHALF * S.ldb2;
  const size_t kstep = (size_t)(BK * 2);
  const unsigned ldsw = (unsigned)wid * 1024u;
  const int aoff = lds_byte(wr * 64 + fr, fq * 8), boff = lds_byte(wc * 32 + fr, fq * 8);
#define G_SA(b, h) (((b) * 2 + (h)) * HTB)
#define G_SB(b, h) ((4 + (b) * 2 + (h)) * HTB)
#define G_STAGE(bufoff, gbase, v0, v1) do { \
    __builtin_amdgcn_global_load_lds((const unsigned*)((const char*)(gbase) + (v0)), (LAS unsigned*)(lds + (bufoff) + ldsw), 16, 0, 0); \
    __builtin_amdgcn_global_load_lds((const unsigned*)((const char*)(gbase) + (v1)), (LAS unsigned*)(lds + (bufoff) + ldsw + 8192), 16, 0, 0); } while (0)
#define G_LDA(dst, b, h) do { _Pragma("unroll") for (int m = 0; m < 4; ++m) _Pragma("unroll") for (int k = 0; k < 2; ++k) dst[m][k] = *(const LAS h8*)(lds + G_SA(b, h) + aoff + m * 2048 + k * 1024); } while (0)
#define G_LDB(dst, b, h) do { _Pragma("unroll") for (int n = 0; n < 2; ++n) _Pragma("unroll") for (int k = 0; k < 2; ++k) dst[n][k] = *(const LAS h8*)(lds + G_SB(b, h) + boff + n * 2048 + k * 1024); } while (0)
#define G_MMA(ai, bj, At, Bt) do { __builtin_amdgcn_s_setprio(1); _Pragma("unroll") for (int m = 0; m < 4; ++m) _Pragma("unroll") for (int n = 0; n < 2; ++n) _Pragma("unroll") for (int k = 0; k < 2; ++k) \
    acc[ai][bj][m][n] = __builtin_amdgcn_mfma_f32_16x16x32_f16(Bt[n][k], At[m][k], acc[ai][bj][m][n], 0, 0, 0); __builtin_amdgcn_s_setprio(0); } while (0)
#define G_WAIT_V(n) asm volatile("s_waitcnt vmcnt(" #n ")" ::: "memory")
#define G_WAIT_L(n) asm volatile("s_waitcnt lgkmcnt(" #n ")" ::: "memory")
#define G_BAR __builtin_amdgcn_s_barrier()
#define G_SCHED __builtin_amdgcn_sched_barrier(0)
  GUnit cur, nxt;
  int ui = 0;
  if (!S.next(0, cur)) return;
  f4 acc[2][2][4][2];
#pragma unroll
  for (int a = 0; a < 2; ++a)
#pragma unroll
    for (int b = 0; b < 2; ++b)
#pragma unroll
      for (int m = 0; m < 4; ++m)
#pragma unroll
        for (int n = 0; n < 2; ++n) acc[a][b][m][n] = f4{0.f, 0.f, 0.f, 0.f};
  h8 At[4][2], B0[2][2], B1[2][2];
  const char* cA = cur.A;
  const char* cB = cur.B;
  G_STAGE(G_SB(0, 0), cB, cvB0, cvB1); G_STAGE(G_SA(0, 0), cA, cvA0, cvA1); G_STAGE(G_SB(0, 1), cB + chB, cvB0, cvB1); G_STAGE(G_SA(0, 1), cA + chA, cvA0, cvA1);
  if (wr == 1) G_BAR;
  G_WAIT_V(4); G_BAR;
  G_STAGE(G_SB(1, 0), cB + kstep, cvB0, cvB1); G_STAGE(G_SA(1, 0), cA + kstep, cvA0, cvA1); G_STAGE(G_SB(1, 1), cB + chB + kstep, cvB0, cvB1);
  G_WAIT_V(6); G_BAR;
  for (;;) {
    const bool has_next = S.next(ui + 1, nxt);
    const char* nA = has_next ? nxt.A : cA;
    const char* nB = has_next ? nxt.B : cB;
    int nt = cur.nt;
    asm volatile("" : "+s"(nt));
    for (int t = 0; t < nt; t += 2) {
      const bool last = (t == nt - 2);
      const char* a1 = cA + (size_t)(t + 1) * kstep;
      const char* a2 = last ? nA : cA + (size_t)(t + 2) * kstep;
      const char* b2 = last ? nB : cB + (size_t)(t + 2) * kstep;
      const char* a3 = a2 + kstep;
      const char* b3 = b2 + kstep;
      G_LDB(B0, 0, 0); G_SCHED; G_LDA(At, 0, 0); G_STAGE(G_SA(1, 1), a1 + chA, cvA0, cvA1);
      G_WAIT_L(8); G_BAR; G_WAIT_L(0); G_MMA(0, 0, At, B0); G_BAR; G_SCHED;
      G_LDB(B1, 0, 1); G_STAGE(G_SB(0, 0), b2, cvB0, cvB1);
      G_BAR; G_WAIT_L(0); G_MMA(0, 1, At, B1); G_BAR;
      G_LDA(At, 0, 1); G_STAGE(G_SA(0, 0), a2, cvA0, cvA1);
      G_BAR; G_WAIT_L(0); G_MMA(1, 0, At, B0); G_BAR; G_SCHED;
      G_STAGE(G_SB(0, 1), b2 + chB, cvB0, cvB1);
      G_WAIT_V(6); G_BAR; G_MMA(1, 1, At, B1); G_BAR;
      G_LDB(B0, 1, 0); G_SCHED; G_LDA(At, 1, 0); G_STAGE(G_SA(0, 1), a2 + chA, cvA0, cvA1);
      G_WAIT_L(8); G_BAR; G_WAIT_L(0); G_MMA(0, 0, At, B0); G_BAR; G_SCHED;
      G_LDB(B1, 1, 1); G_STAGE(G_SB(1, 0), b3, cvB0, cvB1);
      G_BAR; G_WAIT_L(0); G_MMA(0, 1, At, B1); G_BAR;
      G_LDA(At, 1, 1); G_STAGE(G_SA(1, 0), a3, cvA0, cvA1);
      G_BAR; G_WAIT_L(0); G_MMA(1, 0, At, B0); G_BAR; G_SCHED;
      G_STAGE(G_SB(1, 1), b3 + chB, cvB0, cvB1);
      G_WAIT_V(6); G_BAR; G_MMA(1, 1, At, B1); G_BAR;
    }
    bool keep = false;
    if constexpr (Sched::CHAIN) keep = E(acc, cur, wr, wc, fr, fq); else E(acc, cur, wr, wc, fr, fq);
    if (!has_next) break;
    if (!keep) {
#pragma unroll
      for (int a = 0; a < 2; ++a)
#pragma unroll
        for (int b = 0; b < 2; ++b)
#pragma unroll
          for (int m = 0; m < 4; ++m)
#pragma unroll
            for (int n = 0; n < 2; ++n) acc[a][b][m][n] = f4{0.f, 0.f, 0.f, 0.f};
    }
    cur = nxt; cA = nA; cB = nB; ++ui;
  }
  G_WAIT_V(0);
  if (wr == 0) G_BAR;
  G_BAR;
#undef G_SA
#undef G_SB
#undef G_STAGE
#undef G_LDA
#undef G_LDB
#undef G_MMA
#undef G_WAIT_V
#undef G_WAIT_L
#undef G_BAR
#undef G_SCHED
}

DI h8 pack8(const f4& a, const f4& b) {
  h8 o;
  o[0] = (half_t)a[0]; o[1] = (half_t)a[1]; o[2] = (half_t)a[2]; o[3] = (half_t)a[3];
  o[4] = (half_t)b[0]; o[5] = (half_t)b[1]; o[6] = (half_t)b[2]; o[7] = (half_t)b[3];
  return o;
}
DI int row0_of(int pm, int mode) { return mode == 0 ? pm * 256 : (mode == 1 ? (pm >> 3) * TOK + (pm & 7) * 256 : pm * TOK + SEQ); }

struct SchedInproj : SchedBase {
  const half_t* hbuf; const half_t* Wl; int G, c;
  static constexpr unsigned lda2 = 2048, ldb2 = 2048;
  DI bool next(int i, GUnit& u) const {
    const int L = i * G + c;
    u.nt = 16;
    if (L < 144 * 8) {
      tile_map(L, 144, 8, u.pm, u.pn);
      u.A = (const char*)(hbuf + (size_t)u.pm * 256 * 1024); u.B = (const char*)(Wl + W_QK + (size_t)u.pn * 256 * 1024); u.aux = 0;
      return true;
    }
    if (!tile_map(L - 144 * 8, 3, 144, u.pm, u.pn)) return false;
    u.A = (const char*)(Wl + W_V + (size_t)u.pm * 256 * 1024); u.B = (const char*)(hbuf + (size_t)u.pn * 256 * 1024); u.aux = 1;
    return true;
  }
};
struct EpiInproj {
  half_t* big;
  DI void operator()(const f4 (&acc)[2][2][4][2], const GUnit& u, int wr, int wc, int fr, int fq) const {
    if (u.aux == 0) {
      const int g0 = u.pm * 256, b = g0 / TOK, t0 = g0 - b * TOK + wr * 64;
#pragma unroll
      for (int bj = 0; bj < 2; ++bj) {
        const int cb = u.pn * 256 + bj * 128 + wc * 32;
        half_t* ptr; int ts;
        if (cb < 576) { ptr = big + B_ZMLA + (size_t)b * TOK * ZS + cb; ts = ZS; }
        else if (cb < 1088) { const int c = cb - 576, part = c >> 8, hh = (c >> 6) & 3; ptr = big + (part ? B_KNA : B_QNA) + (size_t)(b * 4 + hh) * TOK * 64 + (c & 63); ts = 64; }
        else if (cb < 1600) { const int c = cb - 1088, part = c >> 8, hm = (c >> 5) & 7; ptr = big + (part ? B_KDF : B_QDF) + (size_t)(b * 8 + hm) * TOK * 32; ts = 32; }
        else if (cb < 1856) { const int c = cb - 1600; ptr = big + B_QG + (size_t)(b * 4 + (c >> 6)) * TOK * 64 + (c & 63); ts = 64; }
        else if (cb < 1984) { const int c = cb - 1856; ptr = big + B_KG + (size_t)(b * 2 + (c >> 6)) * TOK * 64 + (c & 63); ts = 64; }
        else continue;
        const unsigned lo = (unsigned)(fr * ts + 8 * fq) * 2u;
        char* rb = (char*)(ptr + (size_t)t0 * ts);
#pragma unroll
        for (int ai = 0; ai < 2; ++ai)
#pragma unroll
          for (int m = 0; m < 4; ++m)
            *(h8*)(rb + (size_t)((ai * 128 + m * 16) * ts) * 2 + lo) = pack8(acc[ai][bj][m][0], acc[ai][bj][m][1]);
      }
    } else {
      const int g0 = u.pn * 256, b = g0 / TOK, t0 = g0 - b * TOK;
      const int nh = (u.pm == 2) ? 2 : 4;
      char* vt = (char*)(big + (u.pm == 0 ? B_VTNA : (u.pm == 1 ? B_VTDF : B_VTG)) + (size_t)b * nh * 64 * TOK + (size_t)(wr * 64) * TOK + t0 + wc * 32);
      const unsigned lo = (unsigned)(fr * TOK + 8 * fq) * 2u;
#pragma unroll
      for (int ai = 0; ai < 2; ++ai) {
        if (u.pm == 2 && ai == 1) continue;
#pragma unroll
        for (int m = 0; m < 4; ++m)
#pragma unroll
          for (int bj = 0; bj < 2; ++bj)
            *(h8*)(vt + ((size_t)(ai * 128 + m * 16) * TOK + bj * 128) * 2 + lo) = pack8(acc[ai][bj][m][0], acc[ai][bj][m][1]);
      }
    }
  }
};

struct SchedMlaQK : SchedBase {
  const half_t* Wl; const half_t* zmla; int G, c;
  static constexpr unsigned lda2 = ZS * 2, ldb2 = 512;
  DI bool next(int i, GUnit& u) const {
    const int L = i * G + c;
    u.nt = 4;
    if (L < 288) {
      tile_map(L, 144, 2, u.pm, u.pn);
      u.A = (const char*)(zmla + (size_t)u.pm * 256 * ZS);
      u.B = (const char*)(Wl + W_UQ + (size_t)u.pn * 256 * 256); u.aux = 0;
      return true;
    }
    if (L < 432) {
      u.pm = L - 288; u.pn = 0;
      u.A = (const char*)(zmla + 256 + (size_t)u.pm * 256 * ZS);
      u.B = (const char*)(Wl + W_UK); u.aux = 1;
      return true;
    }
    return false;
  }
};
struct SchedMlaV : SchedBase {
  const half_t* Wl; const half_t* zmla; int G, c;
  static constexpr unsigned lda2 = 512, ldb2 = ZS * 2;
  DI bool next(int i, GUnit& u) const {
    const int L = i * G + c;
    if (L >= 144) return false;
    u.nt = 4; u.pm = 0; u.pn = L;
    u.A = (const char*)(Wl + W_UV);
    u.B = (const char*)(zmla + 256 + (size_t)u.pn * 256 * ZS); u.aux = 2;
    return true;
  }
};
struct EpiMla {
  half_t* big;
  DI void operator()(const f4 (&acc)[2][2][4][2], const GUnit& u, int wr, int wc, int fr, int fq) const {
    if (u.aux < 2) {
      const int g0 = u.pm * 256, b = g0 / TOK, t0 = g0 - b * TOK + wr * 64;
      const unsigned lo = (unsigned)(fr * 96 + 8 * fq) * 2u;
#pragma unroll
      for (int bj = 0; bj < 2; ++bj) {
        const int cb = u.pn * 256 + bj * 128 + wc * 32;
        half_t* ptr;
        if (u.aux == 0) {
          if (cb >= 384) continue;
          const int hh = cb / 96, dd = cb - hh * 96;
          ptr = big + B_QM + (size_t)(b * 4 + hh) * TOK * 96 + dd;
        } else {
          ptr = big + B_KM + (size_t)(b * 4 + (cb >> 6)) * TOK * 96 + (cb & 63);
        }
        char* rb = (char*)(ptr + (size_t)t0 * 96);
#pragma unroll
        for (int ai = 0; ai < 2; ++ai)
#pragma unroll
          for (int m = 0; m < 4; ++m)
            *(h8*)(rb + (size_t)((ai * 128 + m * 16) * 96) * 2 + lo) = pack8(acc[ai][bj][m][0], acc[ai][bj][m][1]);
      }
    } else {
      const int g0 = u.pn * 256, b = g0 / TOK, t0 = g0 - b * TOK;
      char* vt = (char*)(big + B_VTM + (size_t)b * 4 * 64 * TOK + (size_t)(wr * 64) * TOK + t0 + wc * 32);
      const unsigned lo = (unsigned)(fr * TOK + 8 * fq) * 2u;
#pragma unroll
      for (int ai = 0; ai < 2; ++ai)
#pragma unroll
        for (int m = 0; m < 4; ++m)
#pragma unroll
          for (int bj = 0; bj < 2; ++bj)
            *(h8*)(vt + ((size_t)(ai * 128 + m * 16) * TOK + bj * 128) * 2 + lo) = pack8(acc[ai][bj][m][0], acc[ai][bj][m][1]);
    }
  }
};

struct SchedRows : SchedBase {
  const half_t* A; const half_t* B; int K, nM, nN, G, c; int mode; unsigned lda2, ldb2;
  DI bool next(int i, GUnit& u) const {
    if (!tile_map(i * G + c, nM, nN, u.pm, u.pn)) return false;
    u.A = (const char*)(A + (size_t)row0_of(u.pm, mode) * K); u.B = (const char*)(B + (size_t)u.pn * 256 * K);
    u.nt = K >> 6; u.aux = 0;
    return true;
  }
};
struct SchedResid : SchedBase {
  const half_t* A; const half_t* B; int K, nN, nctx, G, c; unsigned lda2, ldb2;
  DI bool next(int i, GUnit& u) const {
    const int L = i * G + c, nfull = 128 * nN;
    if (L < nfull) {
      tile_map(L, 128, nN, u.pm, u.pn);
      u.A = (const char*)(A + (size_t)row0_of(u.pm, 1) * K); u.B = (const char*)(B + (size_t)u.pn * 256 * K);
      u.nt = K >> 6; u.aux = 0;
      return true;
    }
    const int L2 = L - nfull;
    if (L2 >= nctx * nN * 4) return false;
    const int ks = L2 & 3, t = L2 >> 2;
    u.pm = t / nN; u.pn = t - u.pm * nN;
    const int kq = K >> 2;
    u.A = (const char*)(A + (size_t)row0_of(u.pm, 2) * K + ks * kq); u.B = (const char*)(B + (size_t)u.pn * 256 * K + ks * kq);
    u.nt = kq >> 6; u.aux = 1; u.ks = ks;
    return true;
  }
};
struct EpiResid {
  const float* xl_src; float* xl_dst; float* part; const float* mods_l; int gt_off;
  DI void operator()(const f4 (&acc)[2][2][4][2], const GUnit& u, int wr, int wc, int fr, int fq) const {
    const bool isctx = u.aux == 1;
    const int g0 = row0_of(u.pm, isctx ? 2 : 1), b = g0 / TOK, t0 = g0 - b * TOK;
    const int col0 = u.pn * 256 + wc * 32;
    const size_t rowoff = (size_t)(wr * 64) * 1024 + col0;
    const char* src = (const char*)(xl_src + ((size_t)b * SEQ + (isctx ? 0 : t0)) * 1024 + rowoff);
    char* dst = (char*)(xl_dst + ((size_t)b * SEQ + (isctx ? 0 : t0)) * 1024 + rowoff);
    const char* gt = (const char*)(mods_l + (size_t)(isctx ? 16 : b) * 6144 + gt_off + col0);
    const unsigned lo = (unsigned)(fr * 1024 + 4 * fq) * 4u, glo = (unsigned)(4 * fq) * 4u;
    f4 gv[2][2];
#pragma unroll
    for (int bj = 0; bj < 2; ++bj)
#pragma unroll
      for (int n = 0; n < 2; ++n) gv[bj][n] = *(const f4*)(gt + (bj * 128 + n * 16) * 4 + glo);
    if (!isctx) {
#pragma unroll
      for (int ai = 0; ai < 2; ++ai)
#pragma unroll
        for (int mh = 0; mh < 2; ++mh) {
          f4 xv[2][2][2];
#pragma unroll
          for (int mm = 0; mm < 2; ++mm)
#pragma unroll
            for (int bj = 0; bj < 2; ++bj)
#pragma unroll
              for (int n = 0; n < 2; ++n)
                xv[mm][bj][n] = *(const f4*)(src + ((size_t)(ai * 128 + (mh * 2 + mm) * 16) * 1024 + bj * 128 + n * 16) * 4 + lo);
#pragma unroll
          for (int mm = 0; mm < 2; ++mm)
#pragma unroll
            for (int bj = 0; bj < 2; ++bj)
#pragma unroll
              for (int n = 0; n < 2; ++n)
                *(f4*)(dst + ((size_t)(ai * 128 + (mh * 2 + mm) * 16) * 1024 + bj * 128 + n * 16) * 4 + lo) =
                    xv[mm][bj][n] + gv[bj][n] * acc[ai][bj][mh * 2 + mm][n];
        }
    } else {
      char* pp = (char*)(part + ((size_t)u.ks * NB * CTX + (size_t)b * CTX + (t0 - SEQ) + wr * 64) * 1024 + col0);
#pragma unroll
      for (int ai = 0; ai < 2; ++ai)
#pragma unroll
        for (int m = 0; m < 4; ++m)
#pragma unroll
          for (int bj = 0; bj < 2; ++bj)
#pragma unroll
            for (int n = 0; n < 2; ++n)
              *(f4*)(pp + ((size_t)(ai * 128 + m * 16) * 1024 + bj * 128 + n * 16) * 4 + lo) = gv[bj][n] * acc[ai][bj][m][n];
    }
  }
};
struct EpiUp {
  half_t* ubuf; int skip_ctx;
  DI void operator()(const f4 (&acc)[2][2][4][2], const GUnit& u, int wr, int wc, int fr, int fq) const {
    const int g0 = row0_of(u.pm, skip_ctx);
    char* rb = (char*)(ubuf + (size_t)(g0 + wr * 64) * 4096 + u.pn * 256 + wc * 32);
    const unsigned lo = (unsigned)(fr * 4096 + 8 * fq) * 2u;
#pragma unroll
    for (int ai = 0; ai < 2; ++ai)
#pragma unroll
      for (int m = 0; m < 4; ++m)
#pragma unroll
        for (int bj = 0; bj < 2; ++bj) {
          f4 a = acc[ai][bj][m][0], c = acc[ai][bj][m][1];
#pragma unroll
          for (int j = 0; j < 4; ++j) { a[j] = fmaxf(a[j], 0.f); a[j] *= a[j]; c[j] = fmaxf(c[j], 0.f); c[j] *= c[j]; }
          *(h8*)(rb + ((size_t)(ai * 128 + m * 16) * 4096 + bj * 128) * 2 + lo) = pack8(a, c);
        }
  }
};

DI void build_rope_tables(float2* tab, int wv_) {
  const int tid_ = tid_opaque(wv_);
  __syncthreads();
  for (int idx = tid_; idx < 512 + 1024; idx += NTHR) {
    const bool big = idx >= 512;
    const int j = big ? idx - 512 : idx;
    const int pos = big ? (j >> 4) : (j >> 3), i = big ? (j & 15) : (j & 7);
    const float invf = exp2f(-(float)i * (13.287712379549449f / (big ? 16.f : 8.f)));
    const float ang = (float)pos * invf;
    float sn, cs;
    sincosf(ang, &sn, &cs);
    tab[idx] = float2{cs, sn};
  }
  __syncthreads();
}
template <int DLEN, int LPR, int ROPE, bool KR>
DI void norm_rows(half_t* base, int stride, int nrows, const float* gain, float oscale, const half_t* zmla, const float2* rtab, int wv_) {
  const int tid_ = tid_opaque(wv_);
  const int lane = tid_ & 63, wave = tid_ >> 6;
  constexpr int RPW = 64 / LPR;
  const int s = lane % LPR, sub = lane / LPR;
  const bool active = s * 8 < DLEN;
  float gn[8];
#pragma unroll
  for (int i = 0; i < 8; ++i) gn[i] = active ? gain[s * 8 + i] : 0.f;
  for (int r0 = (blockIdx.x * NWAVE + wave) * RPW; r0 < nrows; r0 += gridDim.x * NWAVE * RPW) {
    const int rho = r0 + sub;
    const int t = rho % TOK;
    half_t* ptr = base + (size_t)rho * stride + s * 8;
    const half_t* src = ptr;
    if (KR && s >= 8) {
      const int b = rho / (4 * TOK);
      src = zmla + ((size_t)b * TOK + t) * ZS + 512 + (s - 8) * 8;
    }
    float f[8];
    float ss = 0.f;
    if (active) {
      const h8 v = *(const h8*)src;
#pragma unroll
      for (int i = 0; i < 8; ++i) { f[i] = (float)v[i]; ss += f[i] * f[i]; }
    } else {
#pragma unroll
      for (int i = 0; i < 8; ++i) f[i] = 0.f;
    }
#pragma unroll
    for (int o = LPR / 2; o > 0; o >>= 1) ss += __shfl_xor(ss, o);
    const float rstd = rsqrtf(ss * (1.f / DLEN) + EPS);
#pragma unroll
    for (int i = 0; i < 8; ++i) f[i] = f[i] * rstd * gn[i];
    if (ROPE != 0) {
      constexpr int PX = (ROPE == 64) ? 2 : 1;
      float pf[8];
#pragma unroll
      for (int i = 0; i < 8; ++i) pf[i] = __shfl_xor(f[i], PX);
      constexpr int RB = (DLEN - ROPE) / 8;
      if (t < SEQ && s >= RB && active) {
        const int sr = s - RB;
        const int q = (ROPE == 64) ? (sr >> 1) : sr;
        const int pos = (q < 2) ? (t >> 6) : (t & 63);
        const float sgn = (q & 1) ? 1.f : -1.f;
        constexpr int NFI = (ROPE == 64) ? 16 : 8;
        const float2* tb = rtab + ((ROPE == 64) ? 512 : 0) + pos * NFI + ((ROPE == 64) ? (sr & 1) * 8 : 0);
#pragma unroll
        for (int i = 0; i < 8; ++i) {
          const float2 cssn = tb[i];
          f[i] = f[i] * cssn.x + sgn * pf[i] * cssn.y;
        }
      }
    }
    if (active) {
      h8 o;
#pragma unroll
      for (int i = 0; i < 8; ++i) o[i] = (half_t)(f[i] * oscale);
      *(h8*)ptr = o;
    }
  }
}

constexpr int ATT_STAGE = 22528, ATT_VOFF = 13312, ATT_STASH = 49152;
template <int DQ, bool NA, int NQG>
DI void attn_wg(const half_t* Qp, const half_t* Kp, const half_t* Vp, int q0, bool active, int seg0_start, int seg0_tiles,
                int seg1_start, int seg1_tiles, const float* rpb_h, int rq, char* smem, int tid, f16v (&O)[2][NQG]) {
  constexpr int NKS = DQ / 16, KSTR = DQ + 8, VSTR = 72, CPK = DQ / 8, KCH = 64 * CPK;
  const int lane = tid & 63, r = lane & 31, h = lane >> 5;
  h8 qf[NQG][NKS];
#pragma unroll
  for (int qg = 0; qg < NQG; ++qg)
#pragma unroll
    for (int ks = 0; ks < NKS; ++ks) qf[qg][ks] = *(const h8*)(Qp + (size_t)(q0 + qg * 32 + r) * DQ + ks * 16 + h * 8);
  float mrun[NQG], lrun[NQG];
#pragma unroll
  for (int qg = 0; qg < NQG; ++qg) { mrun[qg] = -1e30f; lrun[qg] = 0.f; }
#pragma unroll
  for (int a = 0; a < 2; ++a)
#pragma unroll
    for (int c = 0; c < NQG; ++c)
#pragma unroll
      for (int i = 0; i < 16; ++i) O[a][c][i] = 0.f;
  const int ntiles = seg0_tiles + seg1_tiles;
  const int kc0 = tid, kc1 = tid + 512;
  const half_t* kg0 = Kp + kc0 * 8;
  const half_t* kg1 = Kp + kc1 * 8;
  const half_t* vg = Vp + (size_t)(tid >> 3) * TOK + (tid & 7) * 8;
  const int ks0 = (kc0 / CPK) * KSTR + (kc0 % CPK) * 8, ks1 = (kc1 / CPK) * KSTR + (kc1 % CPK) * 8, vs0 = (tid >> 3) * VSTR + (tid & 7) * 8;
  uint4 kreg0 = {0, 0, 0, 0}, kreg1 = {0, 0, 0, 0}, vreg;
  const int r0w = min(max(rq - 4, 0), 24);
  {
    const int k0 = (0 < seg0_tiles) ? seg0_start : seg1_start;
    if (kc0 < KCH) kreg0 = *(const uint4*)(kg0 + (size_t)k0 * DQ);
    if (DQ == 96 && kc1 < KCH) kreg1 = *(const uint4*)(kg1 + (size_t)k0 * DQ);
    vreg = *(const uint4*)(vg + k0);
    if (kc0 < KCH) *(uint4*)((half_t*)smem + ks0) = kreg0;
    if (DQ == 96 && kc1 < KCH) *(uint4*)((half_t*)smem + ks1) = kreg1;
    *(uint4*)((half_t*)(smem + ATT_VOFF) + vs0) = vreg;
  }
  __syncthreads();
  for (int it = 0; it < ntiles; ++it) {
    const int k0 = (it < seg0_tiles) ? seg0_start + it * 64 : seg1_start + (it - seg0_tiles) * 64;
    const bool more = it + 1 < ntiles;
    if (more) {
      const int itn = it + 1;
      const int k1 = (itn < seg0_tiles) ? seg0_start + itn * 64 : seg1_start + (itn - seg0_tiles) * 64;
      if (kc0 < KCH) kreg0 = *(const uint4*)(kg0 + (size_t)k1 * DQ);
      if (DQ == 96 && kc1 < KCH) kreg1 = *(const uint4*)(kg1 + (size_t)k1 * DQ);
      vreg = *(const uint4*)(vg + k1);
    }
    const half_t* ksm = (const half_t*)(smem + (it & 1) * ATT_STAGE) + r * KSTR + h * 8;
    const half_t* vsm = (const half_t*)(smem + (it & 1) * ATT_STAGE + ATT_VOFF) + r * VSTR + h * 4;
    const bool masked = NA && it < seg0_tiles;
    const int krow = k0 >> 6;
    const bool need = active && (!masked || (krow >= r0w && krow < r0w + 8));
    if (need) {
#pragma unroll 1
      for (int st = 0; st < 2; ++st) {
        f16v S[NQG];
#pragma unroll
        for (int qg = 0; qg < NQG; ++qg)
#pragma unroll
          for (int i = 0; i < 16; ++i) S[qg][i] = 0.f;
#pragma unroll
        for (int ks = 0; ks < NKS; ++ks) {
          const h8 kf = *(const h8*)(ksm + (st * 32) * KSTR + ks * 16);
#pragma unroll
          for (int qg = 0; qg < NQG; ++qg) S[qg] = __builtin_amdgcn_mfma_f32_32x32x16_f16(kf, qf[qg][ks], S[qg], 0, 0, 0);
        }
        if (masked) {
          const int cb = st * 32;
          const int dr = krow - rq + 7;
#pragma unroll
          for (int qg = 0; qg < NQG; ++qg) {
            const int qc = qg * 32 + r;
            const int cs = min(max(qc - 8, 0), 48);
#pragma unroll
            for (int i = 0; i < 16; ++i) {
              const int c = cb + (i & 3) + 8 * (i >> 2) + 4 * h;
              const bool valid = (c >= cs) && (c < cs + 16);
              float bias = 0.f;
              if (valid) bias = rpb_h[dr * 31 + (c - qc + 15)] * LOG2E;
              S[qg][i] = valid ? S[qg][i] + bias : -1e30f;
            }
          }
        }
        h4 vf[2][2][2];
#pragma unroll
        for (int dvt = 0; dvt < 2; ++dvt)
#pragma unroll
          for (int sx = 0; sx < 2; ++sx)
#pragma unroll
            for (int hf = 0; hf < 2; ++hf) vf[dvt][sx][hf] = *(const h4*)(vsm + (dvt * 32) * VSTR + st * 32 + sx * 16 + hf * 8);
#pragma unroll
        for (int qg = 0; qg < NQG; ++qg) {
          h8 P[2];
          float mx = S[qg][0];
#pragma unroll
          for (int i = 1; i < 16; ++i) mx = fmaxf(mx, S[qg][i]);
          mx = fmaxf(mx, __shfl_xor(mx, 32));
          const float mn = fmaxf(mrun[qg], mx);
          if (__builtin_amdgcn_ballot_w64(mn > mrun[qg]) != 0ull) {
            const float alpha = __builtin_amdgcn_exp2f(mrun[qg] - mn);
            lrun[qg] *= alpha;
#pragma unroll
            for (int dvt = 0; dvt < 2; ++dvt)
#pragma unroll
              for (int i = 0; i < 16; ++i) O[dvt][qg][i] *= alpha;
            mrun[qg] = mn;
          }
          float rs = 0.f;
#pragma unroll
          for (int i = 0; i < 16; ++i) {
            float pv = __builtin_amdgcn_exp2f(S[qg][i] - mn);
            if (NA) pv = (S[qg][i] <= -1e29f) ? 0.f : pv;
            rs += pv;
            P[i >> 3][i & 7] = (half_t)pv;
          }
          lrun[qg] += rs;
#pragma unroll
          for (int dvt = 0; dvt < 2; ++dvt) {
#pragma unroll
            for (int sx = 0; sx < 2; ++sx) {
              const h8 va = __builtin_shufflevector(vf[dvt][sx][0], vf[dvt][sx][1], 0, 1, 2, 3, 4, 5, 6, 7);
              O[dvt][qg] = __builtin_amdgcn_mfma_f32_32x32x16_f16(va, P[sx], O[dvt][qg], 0, 0, 0);
            }
          }
        }
      }
    }
    if (more) {
      char* nb = smem + ((it + 1) & 1) * ATT_STAGE;
      if (kc0 < KCH) *(uint4*)((half_t*)nb + ks0) = kreg0;
      if (DQ == 96 && kc1 < KCH) *(uint4*)((half_t*)nb + ks1) = kreg1;
      *(uint4*)((half_t*)(nb + ATT_VOFF) + vs0) = vreg;
    }
    __syncthreads();
  }
#pragma unroll
  for (int qg = 0; qg < NQG; ++qg) {
    const float lt = lrun[qg] + __shfl_xor(lrun[qg], 32);
    const float inv = 1.f / lt;
#pragma unroll
    for (int dvt = 0; dvt < 2; ++dvt)
#pragma unroll
      for (int i = 0; i < 16; ++i) O[dvt][qg][i] *= inv;
  }
}

template <int NQG>
DI void store_o(const f16v (&O)[2][NQG], half_t* orow0  , int lane) {
  const int r = lane & 31, h = lane >> 5;
#pragma unroll
  for (int qg = 0; qg < NQG; ++qg)
#pragma unroll
    for (int dvt = 0; dvt < 2; ++dvt)
#pragma unroll
      for (int c = 0; c < 4; ++c) {
        h4 o;
#pragma unroll
        for (int j = 0; j < 4; ++j) o[j] = (half_t)O[dvt][qg][4 * c + j];
        *(h4*)(orow0 + (size_t)(qg * 32 + r) * 1024 + dvt * 32 + 8 * c + 4 * h) = o;
      }
}

DI void phase_attn(int l, half_t* big, bool need_ctx, char* smem, int wv_) {
  const KPtr p = kp();
  const int wave = wv_;
  const int NQB = need_ctx ? 5 : 4;
  half_t* obuf = big + B_O;
  const float lam_init = 0.8f - 0.6f * expf(-0.3f * (float)l);
  float lam;
  {
    float d1 = 0.f, d2 = 0.f;
#pragma unroll 1
    for (int i = 0; i < 32; ++i) {
      d1 += p->lq1[l * 32 + i] * p->lk1[l * 32 + i];
      d2 += p->lq2[l * 32 + i] * p->lk2[l * 32 + i];
    }
    lam = expf(d1) - expf(d2) + lam_init;
    lam = __builtin_bit_cast(float, __builtin_amdgcn_readfirstlane(__builtin_bit_cast(int, lam)));
  }
  const float one_m_li = __builtin_bit_cast(float, __builtin_amdgcn_readfirstlane(__builtin_bit_cast(int, 1.f - lam_init)));
  const int per = 4 * 16 * NQB;
#pragma unroll
  for (int mixer = 0; mixer < 4; ++mixer) {
    const int lo = mixer * per;
    const int first = lo + (int)((blockIdx.x + gridDim.x - (lo % gridDim.x)) % gridDim.x);
    const int tid_m = tid_opaque(wv_);
    const int lane = tid_m & 63, h = lane >> 5;
#pragma unroll 1
    for (int item = first; item < lo + per; item += gridDim.x) {
      const int hi = item / (16 * NQB);
      const int rem = item - hi * 16 * NQB;
      const int b = rem / NQB, qb = rem - b * NQB;
      const bool qctx = qb == 4;
      const bool active = !qctx || wave < 4;
      const int q0 = active ? qb * 512 + wave * 64 : SEQ;
      const int hh = hi & 3;
      const int s0 = qctx ? SEQ : 0, n0t = qctx ? 4 : 36;
      f16v O[2][2];
      half_t* orow = obuf + (size_t)(b * TOK + q0) * 1024 + hh * 64;
      if (mixer == 0) {
        half_t* stash = (half_t*)(smem + ATT_STASH) + wave * 4096;
        attn_wg<32, false, 2>(big + B_QDF + (size_t)(b * 8 + hh * 2) * TOK * 32, big + B_KDF + (size_t)(b * 8 + hh * 2) * TOK * 32,
                              big + B_VTDF + (size_t)(b * 4 + hh) * 64 * TOK, q0, active, s0, n0t, 0, 0, nullptr, 0, smem, tid_m, O);
#pragma unroll
        for (int dvt = 0; dvt < 2; ++dvt)
#pragma unroll
          for (int qg = 0; qg < 2; ++qg)
#pragma unroll
            for (int i = 0; i < 16; ++i) stash[((dvt * 2 + qg) * 16 + i) * 64 + lane] = (half_t)O[dvt][qg][i];
        attn_wg<32, false, 2>(big + B_QDF + (size_t)(b * 8 + hh * 2 + 1) * TOK * 32, big + B_KDF + (size_t)(b * 8 + hh * 2 + 1) * TOK * 32,
                              big + B_VTDF + (size_t)(b * 4 + hh) * 64 * TOK, q0, active, s0, n0t, 0, 0, nullptr, 0, smem, tid_m, O);
#pragma unroll
        for (int qg = 0; qg < 2; ++qg) {
          float ss = 0.f;
#pragma unroll
          for (int dvt = 0; dvt < 2; ++dvt)
#pragma unroll
            for (int i = 0; i < 16; ++i) {
              const float v = (float)stash[((dvt * 2 + qg) * 16 + i) * 64 + lane] - lam * O[dvt][qg][i];
              O[dvt][qg][i] = v;
              ss += v * v;
            }
          ss += __shfl_xor(ss, 32);
          const float rstd = rsqrtf(ss * (1.f / 64.f) + EPS) * one_m_li;
#pragma unroll
          for (int dvt = 0; dvt < 2; ++dvt)
#pragma unroll
            for (int i = 0; i < 16; ++i) {
              const int dv = dvt * 32 + (i & 3) + 8 * (i >> 2) + 4 * h;
              O[dvt][qg][i] *= rstd * p->g_diff_sub[l * 64 + dv];
            }
        }
        if (active) store_o<2>(O, orow + 2 * 256, lane);
      } else if (mixer == 1) {
        attn_wg<96, false, 2>(big + B_QM + (size_t)(b * 4 + hh) * TOK * 96, big + B_KM + (size_t)(b * 4 + hh) * TOK * 96,
                              big + B_VTM + (size_t)(b * 4 + hh) * 64 * TOK, q0, active, s0, n0t, 0, 0, nullptr, 0, smem, tid_m, O);
        if (active) store_o<2>(O, orow + 0 * 256, lane);
      } else if (mixer == 2) {
        const int kv = hh >> 1;
        attn_wg<64, false, 2>(big + B_QG + (size_t)(b * 4 + hh) * TOK * 64, big + B_KG + (size_t)(b * 2 + kv) * TOK * 64,
                              big + B_VTG + (size_t)(b * 2 + kv) * 64 * TOK, q0, active, s0, n0t, 0, 0, nullptr, 0, smem, tid_m, O);
        if (active) store_o<2>(O, orow + 3 * 256, lane);
      } else {
        const int rq = q0 >> 6;
        const int rq0 = qb * 8;
        const int rlo = min(max(rq0 - 4, 0), 24), rhi = min(max(rq0 + 7 - 4, 0), 24) + 8;
        const int seg0s = rlo * 64, seg0n = qctx ? 0 : (rhi - rlo);
        attn_wg<64, true, 2>(big + B_QNA + (size_t)(b * 4 + hh) * TOK * 64, big + B_KNA + (size_t)(b * 4 + hh) * TOK * 64,
                             big + B_VTNA + (size_t)(b * 4 + hh) * 64 * TOK, q0, active, seg0s, seg0n, SEQ, 4,
                             p->na_rpb + (size_t)(l * 4 + hh) * 15 * 31, rq, smem, tid_m, O);
        if (active) store_o<2>(O, orow + 1 * 256, lane);
      }
    }
  }
}

struct SchedGate : SchedBase {
  const half_t* hbuf; const half_t* Wl; int pm0, cnt, G, c, mode;
  static constexpr unsigned lda2 = 2048, ldb2 = 2048;
  static DI int bmap(bool, int R) { return ((R >> 4) & 1) * 1024 + (R >> 5) * 16 + (R & 15); }
  static constexpr int BHALF = 2048;
  DI bool next(int i, GUnit& u) const {
    int pm, pn;
    if (!tile_map(i * G + c, cnt, 16, pm, pn)) return false;
    u.pm = pm0 + pm; u.pn = pn; u.nt = 16; u.aux = 0;
    u.A = (const char*)(hbuf + (size_t)row0_of(u.pm, mode) * 1024); u.B = (const char*)(Wl + W_GATE + (size_t)pn * 64 * 1024);
    return true;
  }
};
DI float gate_clamped(float x) { return fmaxf(__builtin_amdgcn_rcpf(1.f + __expf(-x)), 6.103515625e-05f); }
struct EpiGate {
  half_t* gb; int pm0;
  DI void operator()(const f4 (&acc)[2][2][4][2], const GUnit& u, int wr, int wc, int fr, int fq) const {
    char* rb = (char*)(gb + (size_t)((u.pm - pm0) * 256 + wr * 64) * 4096 + u.pn * 64 + wc * 16);
    const unsigned lo = (unsigned)(fr * 4096 + 4 * fq) * 2u;
#pragma unroll
    for (int ai = 0; ai < 2; ++ai)
#pragma unroll
      for (int m = 0; m < 4; ++m) {
        f4 gq[4];
#pragma unroll
        for (int br = 0; br < 4; ++br)
#pragma unroll
          for (int j = 0; j < 4; ++j) gq[br][j] = gate_clamped(acc[ai][br >> 1][m][br & 1][j]);
#pragma unroll
        for (int br = 0; br < 4; ++br) {
          h4 o;
#pragma unroll
          for (int j = 0; j < 4; ++j) o[j] = (half_t)(br < 3 ? gq[br][j] * __builtin_amdgcn_rcpf(gq[br + 1][j]) : gq[3][j]);
          *(h4*)(rb + ((size_t)(ai * 128 + m * 16) * 4096 + br * 1024) * 2 + lo) = o;
        }
      }
  }
};
struct SchedProj : SchedBase {
  const half_t* obuf; const half_t* Wl; int pm0, cnt, G, c, mode;
  static constexpr unsigned lda2 = 2048, ldb2 = 512;
  static constexpr bool CHAIN = true;
  DI bool next(int i, GUnit& u) const {
    int pm, pn;
    if (!tile_map((i >> 2) * G + c, cnt, 4, pm, pn)) return false;
    const int br = i & 3;
    u.pm = pm0 + pm; u.pn = pn; u.nt = 4; u.aux = br;
    u.A = (const char*)(obuf + (size_t)row0_of(u.pm, mode) * 1024 + br * 256);
    u.B = (const char*)(Wl + W_BR + (size_t)(br * 1024 + pn * 256) * 256);
    return true;
  }
};
struct EpiProj {
  const half_t* gb; half_t* mbuf; int pm0, mode;
  DI bool operator()(f4 (&acc)[2][2][4][2], const GUnit& u, int wr, int wc, int fr, int fq) const {
    const int br = u.aux;
    const char* gp = (const char*)(gb + (size_t)((u.pm - pm0) * 256 + wr * 64) * 4096 + br * 1024 + u.pn * 256 + wc * 32);
    const unsigned glo = (unsigned)(fr * 4096 + 8 * fq) * 2u;
    h8 gq[2][4][2];
#pragma unroll
    for (int ai = 0; ai < 2; ++ai)
#pragma unroll
      for (int m = 0; m < 4; ++m)
#pragma unroll
        for (int bj = 0; bj < 2; ++bj) gq[ai][m][bj] = *(const h8*)(gp + ((size_t)(ai * 128 + m * 16) * 4096 + bj * 128) * 2 + glo);
#pragma unroll
    for (int ai = 0; ai < 2; ++ai)
#pragma unroll
      for (int m = 0; m < 4; ++m)
#pragma unroll
        for (int bj = 0; bj < 2; ++bj)
#pragma unroll
          for (int j = 0; j < 4; ++j) { acc[ai][bj][m][0][j] *= (float)gq[ai][m][bj][j]; acc[ai][bj][m][1][j] *= (float)gq[ai][m][bj][4 + j]; }
    if (br < 3) return true;
    char* mp = (char*)(mbuf + (size_t)(row0_of(u.pm, mode) + wr * 64) * 1024 + u.pn * 256 + wc * 32);
    const unsigned mlo = (unsigned)(fr * 1024 + 8 * fq) * 2u;
#pragma unroll
    for (int ai = 0; ai < 2; ++ai)
#pragma unroll
      for (int m = 0; m < 4; ++m)
#pragma unroll
        for (int bj = 0; bj < 2; ++bj)
          *(h8*)(mp + ((size_t)(ai * 128 + m * 16) * 1024 + bj * 128) * 2 + mlo) = pack8(acc[ai][bj][m][0], acc[ai][bj][m][1]);
    return false;
  }
};

__global__ void __launch_bounds__(NTHR) hybrid_block_megakernel(Params p) {
  __shared__ __attribute__((aligned(16))) char smem[SMEM_BYTES];
  char* ws = kp()->ws;
  if (ws == nullptr) cg::this_grid().sync();
  half_t* W = (half_t*)(ws + OFF_W);
  float* mods = (float*)(ws + OFF_MOD);
  float* xc = (float*)(ws + OFF_XC);
  half_t* hbuf = (half_t*)(ws + OFF_H);
  half_t* big = (half_t*)(ws + OFF_BIG);
  float* part = (float*)(ws + OFF_PART);
  LAS unsigned char* lds = (LAS unsigned char*)smem;
  const int G = gridDim.x, cblk = blockIdx.x;

  const int wv_ = __builtin_amdgcn_readfirstlane((int)threadIdx.x >> 6);
  volatile LAS unsigned* st = (volatile LAS unsigned*)(lds + GEMM_LDS);
  if (threadIdx.x < 4) st[threadIdx.x] = 0u;
  __syncthreads();
  xcd_barrier_post((unsigned*)(ws + OFF_BAR), wv_);

  phase_mods(mods, smem, wv_);
  {
    int base = 0;
    float* tile = (float*)smem;
    for (int l = 0; l < 2; ++l) {
      half_t* Wl = W + (size_t)l * W_LAYER;
      const float* win = kp()->w_in + (size_t)l * 1024 * 6496;
      tconv_job(win, 6496, 0, 1024, 1024, 192, 256, Wl + W_QK, base, tile, wv_);
      tconv_job(win, 6496, 192, 1024, 1024, 128, 256, Wl + W_QK + (size_t)256 * 1024, base, tile, wv_);
      tconv_job(win, 6496, 320, 1024, 1024, 32, 64, Wl + W_QK + (size_t)512 * 1024, base, tile, wv_);
      tconv_job(win, 6496, 352, 1024, 1024, 256, 256, Wl + W_QK + (size_t)576 * 1024, base, tile, wv_);
      tconv_job(win, 6496, 608, 1024, 1024, 256, 256, Wl + W_QK + (size_t)832 * 1024, base, tile, wv_);
      tconv_job(win, 6496, 1120, 1024, 1024, 256, 256, Wl + W_QK + (size_t)1088 * 1024, base, tile, wv_);
      tconv_job(win, 6496, 1376, 1024, 1024, 256, 256, Wl + W_QK + (size_t)1344 * 1024, base, tile, wv_);
      tconv_job(win, 6496, 1888, 1024, 1024, 256, 256, Wl + W_QK + (size_t)1600 * 1024, base, tile, wv_);
      tconv_job(win, 6496, 2144, 1024, 1024, 128, 192, Wl + W_QK + (size_t)1856 * 1024, base, tile, wv_);
      tconv_job(win, 6496, 864, 1024, 1024, 256, 256, Wl + W_V, base, tile, wv_);
      tconv_job(win, 6496, 1632, 1024, 1024, 256, 256, Wl + W_V + (size_t)256 * 1024, base, tile, wv_);
      tconv_job(win, 6496, 2272, 1024, 1024, 128, 256, Wl + W_V + (size_t)512 * 1024, base, tile, wv_);
      tconv_job(win, 6496, 2400, 1024, 1024, 4096, 4096, Wl + W_GATE, base, tile, wv_);
      for (int br = 0; br < 4; ++br)
        tconv_job(kp()->w_branch + ((size_t)l * 4 + br) * 256 * 1024, 1024, 0, 256, 256, 1024, 1024, Wl + W_BR + (size_t)br * 1024 * 256, base, tile, wv_);
      tconv_job(kp()->w_out + (size_t)l * 1024 * 1024, 1024, 0, 1024, 1024, 1024, 1024, Wl + W_OUT, base, tile, wv_);
      tconv_job(kp()->w_up + (size_t)l * 1024 * 4096, 4096, 0, 1024, 1024, 4096, 4096, Wl + W_UP, base, tile, wv_);
      tconv_job(kp()->w_down + (size_t)l * 4096 * 1024, 1024, 0, 4096, 4096, 1024, 1024, Wl + W_DOWN, base, tile, wv_);
      tconv_job(kp()->w_mla_uq + (size_t)l * 192 * 384, 384, 0, 256, 192, 384, 512, Wl + W_UQ, base, tile, wv_);
      for (int hh = 0; hh < 4; ++hh) {
        tconv_job(kp()->w_mla_ukv + (size_t)l * 128 * 512, 512, hh * 128, 256, 128, 64, 64, Wl + W_UK + (size_t)hh * 64 * 256, base, tile, wv_);
        tconv_job(kp()->w_mla_ukv + (size_t)l * 128 * 512, 512, hh * 128 + 64, 256, 128, 64, 64, Wl + W_UV + (size_t)hh * 64 * 256, base, tile, wv_);
      }
    }
  }
  xcd_barrier(ws, lds, wv_);

  for (int l = 0; l < 2; ++l) {
    const bool need_ctx = (l == 0);
    const bool skip_ctx = !need_ctx;
    const half_t* Wl = W + (size_t)l * W_LAYER;
    const float* mods_l = mods + (size_t)l * 17 * 6144;
    const float* xl_src = (l == 0) ? kp()->x : kp()->out;
    const float* xc_src = (l == 0) ? kp()->ctx : xc;
    const int nrt = skip_ctx ? 128 : 144;

    phase_norm(xl_src, xc_src, kp()->g_norm1 + l * 1024, mods_l, 0, 1024, hbuf, false, (l == 1) ? part : nullptr, nullptr, wv_);
    xcd_barrier(ws, lds, wv_);
    {
      SchedInproj S{{}, hbuf, Wl, G, cblk};
      EpiInproj E{big};
      gemm256<true>(lds, S, E, wv_);
    }
    xcd_barrier(ws, lds, wv_);
    {
      build_rope_tables((float2*)smem, wv_);
      half_t* zmla = big + B_ZMLA;
      norm_rows<192, 32, 0, false>(zmla, ZS, NTOK, kp()->g_mla_qa + l * 192, 1.f, nullptr, (const float2*)smem, wv_);
      norm_rows<128, 16, 0, false>(zmla + 256, ZS, NTOK, kp()->g_mla_kva + l * 128, 1.f, nullptr, (const float2*)smem, wv_);
      norm_rows<64, 8, 0, false>(big + B_QNA, 64, NTOK * 4, kp()->g_na_q + l * 64, 0.125f * LOG2E, nullptr, (const float2*)smem, wv_);
      norm_rows<64, 8, 0, false>(big + B_KNA, 64, NTOK * 4, kp()->g_na_k + l * 64, 1.f, nullptr, (const float2*)smem, wv_);
      norm_rows<32, 4, 32, false>(big + B_QDF, 32, NTOK * 8, kp()->g_diff_q + l * 32, 0.17677669529663687f * LOG2E, nullptr, (const float2*)smem, wv_);
      norm_rows<32, 4, 32, false>(big + B_KDF, 32, NTOK * 8, kp()->g_diff_k + l * 32, 1.f, nullptr, (const float2*)smem, wv_);
      norm_rows<64, 8, 64, false>(big + B_QG, 64, NTOK * 4, kp()->g_gqa_q + l * 64, 0.125f * LOG2E, nullptr, (const float2*)smem, wv_);
      norm_rows<64, 8, 64, false>(big + B_KG, 64, NTOK * 2, kp()->g_gqa_k + l * 64, 1.f, nullptr, (const float2*)smem, wv_);
    }
    xcd_barrier(ws, lds, wv_);
    {
      SchedMlaQK S{{}, Wl, big + B_ZMLA, G, cblk};
      EpiMla E{big};
      gemm256<true>(lds, S, E, wv_);
      SchedMlaV S2{{}, Wl, big + B_ZMLA, G, cblk};
      gemm256<true>(lds, S2, E, wv_);
    }
    xcd_barrier(ws, lds, wv_);
    build_rope_tables((float2*)smem, wv_);
    norm_rows<96, 16, 32, false>(big + B_QM, 96, NTOK * 4, kp()->g_mla_q + l * 96, 0.10206207261596575f * LOG2E, nullptr, (const float2*)smem, wv_);
    norm_rows<96, 16, 32, true>(big + B_KM, 96, NTOK * 4, kp()->g_mla_k + l * 96, 1.f, big + B_ZMLA, (const float2*)smem, wv_);
    xcd_barrier(ws, lds, wv_);
    phase_attn(l, big, need_ctx, smem, wv_);
    xcd_barrier(ws, lds, wv_);
    {
      const int nsp = need_ctx ? 3 : 2;
      for (int j = 0; j < nsp; ++j) {
        const int mode = (j < 2) ? 1 : 2, pm0 = (j < 2) ? j * 64 : 0, cnt = (j < 2) ? 64 : 16;
        {
          SchedGate S{{}, hbuf, Wl, pm0, cnt, G, cblk, mode};
          EpiGate E{big + B_G0, pm0};
          gemm256<false>(lds, S, E, wv_);
        }
        xcd_barrier(ws, lds, wv_);
        {
          SchedProj S{{}, big + B_O, Wl, pm0, cnt, G, cblk, mode};
          EpiProj E{big + B_G0, big + B_M, pm0, mode};
          gemm256<true>(lds, S, E, wv_);
        }
        xcd_barrier(ws, lds, wv_);
      }
    }
    {
      SchedResid S{{}, big + B_M, Wl + W_OUT, 1024, 4, need_ctx ? 16 : 0, G, cblk, 2048u, 2048u};
      EpiResid E{xl_src, kp()->out, part, mods_l, 2048};
      gemm256<false>(lds, S, E, wv_);
    }
    xcd_barrier(ws, lds, wv_);
    phase_norm(kp()->out, xc_src, kp()->g_norm2 + l * 1024, mods_l, 3072, 4096, hbuf, skip_ctx, need_ctx ? part : nullptr, need_ctx ? xc : nullptr, wv_);
    xcd_barrier(ws, lds, wv_);
    {
      SchedRows S{{}, hbuf, Wl + W_UP, 1024, nrt, 16, G, cblk, skip_ctx ? 1 : 0, 2048u, 2048u};
      EpiUp E{big + B_U, skip_ctx ? 1 : 0};
      gemm256<true>(lds, S, E, wv_);
    }
    xcd_barrier(ws, lds, wv_);
    {
      SchedResid S{{}, big + B_U, Wl + W_DOWN, 4096, 4, need_ctx ? 16 : 0, G, cblk, 8192u, 8192u};
      EpiResid E{kp()->out, kp()->out, part, mods_l, 5120};
      gemm256<false>(lds, S, E, wv_);
    }
    if (l == 0) xcd_barrier(ws, lds, wv_);
  }
}

extern "C" void kernel_launch(void* const* d_in, const int* in_sizes, int n_in, void* d_out, int out_size, void* d_ws,
                              size_t ws_size, hipStream_t stream) {
  static int grid_blocks = 0;
  if (!grid_blocks) {
    int dev = 0, cus = 0, per_cu = 0;
    (void)hipGetDevice(&dev);
    (void)hipDeviceGetAttribute(&cus, hipDeviceAttributeMultiprocessorCount, dev);
    (void)hipOccupancyMaxActiveBlocksPerMultiprocessor(&per_cu, hybrid_block_megakernel, NTHR, 0);
    if (per_cu < 1) fprintf(stderr, "occupancy query returned %d\n", per_cu);
    grid_blocks = cus;
  }
  if (ws_size < WS_NEED) fprintf(stderr, "workspace too small: %zu < %zu\n", ws_size, (size_t)WS_NEED);
  (void)hipMemsetAsync((char*)d_ws + OFF_BAR, 0, XCD_BAR_WORDS * 4, stream);
  Params p{};
  const float** pf = (const float**)&p;
  for (int i = 0; i < 31; ++i) pf[i] = (const float*)d_in[i];
  p.out = (float*)d_out;
  p.ws = (char*)d_ws;
  void* args[] = {&p};
  hipError_t e = hipLaunchCooperativeKernel((void*)hybrid_block_megakernel, dim3(grid_blocks), dim3(NTHR), args, 0, stream);
  if (e != hipSuccess) fprintf(stderr, "cooperative launch failed: %s (grid %d)\n", hipGetErrorString(e), grid_blocks);
}
```

```cpp
#include <hip/hip_runtime.h>
#include <hip/hip_cooperative_groups.h>
#include <cstdio>
namespace cg = cooperative_groups;

typedef _Float16 half_t;
typedef __attribute__((ext_vector_type(8))) _Float16 h8;
typedef __attribute__((ext_vector_type(4))) _Float16 h4;
typedef __attribute__((ext_vector_type(4))) float f4;
typedef __attribute__((ext_vector_type(2))) float f2;
typedef __attribute__((ext_vector_type(16))) float f16v;

#define DI __device__ __forceinline__
#define LAS __attribute__((address_space(3)))

constexpr int NB = 16, SEQ = 2048, CTX = 256, TOK = 2304, NTOK = NB * TOK;
constexpr float LOG2E = 1.4426950408889634f;
constexpr float EPS = 1e-6f;

constexpr int NQK = 2048;
constexpr int NVT = 768;
constexpr int ZS = 576;
constexpr size_t W_QK = 0;
constexpr size_t W_V = W_QK + (size_t)NQK * 1024;
constexpr size_t W_GATE = W_V + (size_t)NVT * 1024;
constexpr size_t W_BR = W_GATE + (size_t)4096 * 1024;
constexpr size_t W_OUT = W_BR + (size_t)4 * 1024 * 256;
constexpr size_t W_UP = W_OUT + (size_t)1024 * 1024;
constexpr size_t W_DOWN = W_UP + (size_t)4096 * 1024;
constexpr size_t W_UQ = W_DOWN + (size_t)1024 * 4096;
constexpr size_t W_UK = W_UQ + (size_t)512 * 256;
constexpr size_t W_UV = W_UK + (size_t)256 * 256;
constexpr size_t W_LAYER = W_UV + (size_t)256 * 256;

constexpr size_t al256(size_t x) { return (x + 255) & ~(size_t)255; }
constexpr size_t OFF_BAR = 0;
constexpr size_t OFF_W = 16384;
constexpr size_t OFF_MOD = al256(OFF_W + 2 * W_LAYER * 2);
constexpr size_t OFF_XC = al256(OFF_MOD + (size_t)2 * 17 * 6144 * 4);
constexpr size_t OFF_H = al256(OFF_XC + (size_t)NB * CTX * 1024 * 4);
constexpr size_t OFF_BIG = al256(OFF_H + (size_t)NTOK * 1024 * 2);
constexpr size_t B_O = 0;
constexpr size_t B_QM = B_O + (size_t)NTOK * 1024;
constexpr size_t B_KM = B_QM + (size_t)NTOK * 384;
constexpr size_t B_VTM = B_KM + (size_t)NTOK * 384;
constexpr size_t B_QNA = B_VTM + (size_t)NTOK * 256;
constexpr size_t B_KNA = B_QNA + (size_t)NTOK * 256;
constexpr size_t B_VTNA = B_KNA + (size_t)NTOK * 256;
constexpr size_t B_QDF = B_VTNA + (size_t)NTOK * 256;
constexpr size_t B_KDF = B_QDF + (size_t)NTOK * 256;
constexpr size_t B_VTDF = B_KDF + (size_t)NTOK * 256;
constexpr size_t B_QG = B_VTDF + (size_t)NTOK * 256;
constexpr size_t B_KG = B_QG + (size_t)NTOK * 256;
constexpr size_t B_VTG = B_KG + (size_t)NTOK * 128;
constexpr size_t B_ZMLA = B_VTG + (size_t)NTOK * 128;
constexpr size_t B_END = B_ZMLA + (size_t)NTOK * ZS;
constexpr size_t B_M = B_O + (size_t)NTOK * 1024;
constexpr size_t GSLAB = (size_t)64 * 256 * 4096;
constexpr size_t B_G0 = B_M + (size_t)NTOK * 1024;
constexpr size_t B_P5END = B_G0 + GSLAB;
constexpr size_t B_U = 0;
constexpr size_t B_MAX = B_END > B_P5END ? B_END : B_P5END;
constexpr size_t OFF_PART = OFF_BIG + (size_t)NTOK * 4096 * 2;
constexpr size_t WS_NEED = (OFF_BIG + B_MAX * 2) > (OFF_PART + (size_t)4 * NB * CTX * 1024 * 4) ? (OFF_BIG + B_MAX * 2) : (OFF_PART + (size_t)4 * NB * CTX * 1024 * 4);
static_assert(B_P5END * 2 <= (size_t)NTOK * 4096 * 2, "merge buffers must end before the partial buffer");
static_assert(B_MAX >= (size_t)NTOK * 4096, "u must fit");
static_assert(WS_NEED <= (size_t)536870912, "workspace budget");

constexpr int NTHR = 512, NWAVE = 8;
constexpr int GEMM_LDS = 131072;
constexpr int SMEM_BYTES = GEMM_LDS + 16;

struct Params {
  const float *x, *c, *ctx, *c_ctx, *w_ada, *b_ada, *g_norm1, *g_norm2, *w_in;
  const float *g_mla_qa, *w_mla_uq, *g_mla_kva, *w_mla_ukv, *g_mla_q, *g_mla_k;
  const float *g_na_q, *g_na_k, *na_rpb;
  const float *g_diff_q, *g_diff_k, *lq1, *lk1, *lq2, *lk2, *g_diff_sub;
  const float *g_gqa_q, *g_gqa_k, *w_branch, *w_out, *w_up, *w_down;
  float* out;
  char* ws;
};


typedef const Params __attribute__((address_space(4))) * KPtr;
DI KPtr kp() {
  KPtr q = (KPtr)__builtin_amdgcn_kernarg_segment_ptr();
  asm volatile("" : "+s"(q));
  return q;
}

DI int tid_opaque(int wv_) {
  unsigned z = 0u;
  asm volatile("" : "+v"(z));
  int t = (wv_ << 6) | (int)__builtin_amdgcn_mbcnt_hi(~0u, __builtin_amdgcn_mbcnt_lo(~0u, z));
  asm volatile("" : "+v"(t));
  return t;
}

DI float wave_sum(float v) {
#pragma unroll
  for (int o = 32; o > 0; o >>= 1) v += __shfl_xor(v, o);
  return v;
}

#define XB_TMO      128
#define XB_XCNT(j)  (256  + 64 * (j))
#define XB_XSUB(j)  (1280 + 64 * (j))
#define XB_XGEN(j)  (2304 + 64 * (j))
#define XB_TOP      3328
#define XB_TOPGEN   3392
#define XCD_BAR_WORDS 3456
#define XB_SPIN_CAP (1u << 22)
DI unsigned xb_ld(unsigned* p) { return __hip_atomic_load(p, __ATOMIC_RELAXED, __HIP_MEMORY_SCOPE_AGENT); }
DI unsigned xb_add(unsigned* p, unsigned v) { return __hip_atomic_fetch_add(p, v, __ATOMIC_RELAXED, __HIP_MEMORY_SCOPE_AGENT); }
DI unsigned xb_xcc_id() { return (unsigned)__builtin_amdgcn_s_getreg((3 << 11) | 20) & 0xFu; }
#define XB_SPIN(cond, bar) do { unsigned _sp = 0; while (cond) { __builtin_amdgcn_s_sleep(1); \
    if ((++_sp & 255u) == 0u) { if (xb_ld(&(bar)[XB_TMO])) break; if (_sp > XB_SPIN_CAP) { atomicAdd(&(bar)[XB_TMO], 1u); break; } } } } while (0)
DI void xcd_barrier_post(unsigned* bar, int wv_) {
  if (tid_opaque(wv_) == 0) (void)xb_add(&bar[XB_XCNT(xb_xcc_id())], 1u);
}
DI void xcd_barrier_complete(unsigned* bar, unsigned x, unsigned& nloc, unsigned& nx) {
  const unsigned G = gridDim.x * gridDim.y * gridDim.z;
  unsigned sum, cnt, mine, sp = 0u;
  for (;;) {
    sum = 0u; cnt = 0u; mine = 0u;
#pragma unroll
    for (unsigned j = 0; j < 16; ++j) { const unsigned c = xb_ld(&bar[XB_XCNT(j)]); sum += c; cnt += (c > 0u) ? 1u : 0u; mine = (j == x) ? c : mine; }
    if (sum == G) break;
    __builtin_amdgcn_s_sleep(1);
    if ((++sp & 255u) == 0u) { if (xb_ld(&bar[XB_TMO])) break; if (sp > XB_SPIN_CAP) { atomicAdd(&bar[XB_TMO], 1u); break; } }
  }
  nloc = mine > 0u ? mine : 1u; nx = cnt > 0u ? cnt : 1u;
}
DI void xcd_barrier(char* ws_, LAS unsigned char* lds_, int wv_) {
  asm volatile("s_waitcnt vmcnt(0)" ::: "memory");
  __syncthreads();
  if (tid_opaque(wv_) == 0) {
    char* wsl = ws_;
    asm volatile("" : "+s"(wsl));
    unsigned* bar = (unsigned*)(wsl + OFF_BAR);
    volatile LAS unsigned* st = (volatile LAS unsigned*)(lds_ + GEMM_LDS);
    const unsigned x = xb_xcc_id();
    __builtin_amdgcn_s_waitcnt(0);
    unsigned nloc = st[0], nx = st[1];
    if (nloc == 0u) { xcd_barrier_complete(bar, x, nloc, nx); st[0] = nloc; st[1] = nx; }
    const unsigned old = xb_add(&bar[XB_XSUB(x)], 1u);
    const unsigned gen = old / nloc;
    if (old + 1u == (gen + 1u) * nloc) {
      __builtin_amdgcn_fence(__ATOMIC_RELEASE, "agent");
      asm volatile("s_waitcnt vmcnt(0)" ::: "memory");
      const unsigned og = xb_add(&bar[XB_TOP], 1u);
      const unsigned tg = og / nx;
      if (og + 1u == (tg + 1u) * nx) xb_add(&bar[XB_TOPGEN], 1u);
      else XB_SPIN(xb_ld(&bar[XB_TOPGEN]) == tg, bar);
      __builtin_amdgcn_fence(__ATOMIC_ACQUIRE, "agent");
      xb_add(&bar[XB_XGEN(x)], 1u);
      asm volatile("s_waitcnt vmcnt(0)" ::: "memory");
    } else {
      XB_SPIN(xb_ld(&bar[XB_XGEN(x)]) == gen, bar);
      __builtin_amdgcn_fence(__ATOMIC_ACQUIRE, "agent");
      asm volatile("s_waitcnt vmcnt(0)" ::: "memory");
    }
  }
  __syncthreads();
}

DI void phase_mods(float* mods, char* smem, int wv_) {
  const KPtr p = kp();
  float* sil = (float*)smem;
  const int tid = tid_opaque(wv_);
  for (int w = blockIdx.x; w < 192; w += gridDim.x) {
    const int l = w / 96, n0 = (w % 96) * 64;
    __syncthreads();
    for (int idx = tid; idx < 17 * 1024; idx += NTHR) {
      const int b = idx >> 10, k = idx & 1023;
      const float v = (b < 16) ? p->c[b * 1024 + k] : p->c_ctx[k];
      sil[idx] = v / (1.f + expf(-v));
    }
    __syncthreads();
    const int kq = tid >> 6, nn = tid & 63;
    float acc[17];
#pragma unroll
    for (int b = 0; b < 17; ++b) acc[b] = 0.f;
    const float* wp = p->w_ada + (size_t)l * 1024 * 6144 + (size_t)(kq * 128) * 6144 + n0 + nn;
    const float* sp = sil + kq * 128;
#pragma unroll 4
    for (int k = 0; k < 128; ++k) {
      const float wv = wp[(size_t)k * 6144];
#pragma unroll
      for (int b = 0; b < 17; ++b) acc[b] += sp[b * 1024 + k] * wv;
    }
    __syncthreads();
    float* red = (float*)smem;
#pragma unroll
    for (int b = 0; b < 17; ++b) red[(kq * 17 + b) * 64 + nn] = acc[b];
    __syncthreads();
    for (int idx = tid; idx < 17 * 64; idx += NTHR) {
      float s = p->b_ada[l * 6144 + n0 + (idx & 63)];
#pragma unroll
      for (int q = 0; q < 8; ++q) s += red[q * 17 * 64 + idx];
      mods[((size_t)l * 17 + (idx >> 6)) * 6144 + n0 + (idx & 63)] = s;
    }
  }
  __syncthreads();
}

DI void tconv_job(const float* src, int ld, int c0, int K, int Kvalid, int Nvalid, int Npad, half_t* dst, int& base,
                  float* tile, int wv_) {
  const int nnt = Npad / 64, tot = (K / 64) * nnt;
  const int G = gridDim.x;
  const int start = (int)((blockIdx.x + G - (base % G)) % G);
  const int tid_ = tid_opaque(wv_);
  const int tx = tid_ & 63, ty = tid_ >> 6;
  for (int t = start; t < tot; t += 2 * G) {
    const int t2 = t + G;
    const bool has2 = t2 < tot;
    const int kt = t / nnt, nt = t % nnt, kt2 = has2 ? t2 / nnt : kt, nt2 = has2 ? t2 % nnt : nt;
    float r0[8], r1[8];
#pragma unroll
    for (int i = 0; i < 8; ++i) {
      const int k = i * 8 + ty, n = nt * 64 + tx, n2 = nt2 * 64 + tx;
      r0[i] = (n < Nvalid && kt * 64 + k < Kvalid) ? src[(size_t)(kt * 64 + k) * ld + c0 + n] : 0.f;
      r1[i] = (has2 && n2 < Nvalid && kt2 * 64 + k < Kvalid) ? src[(size_t)(kt2 * 64 + k) * ld + c0 + n2] : 0.f;
    }
    __syncthreads();
#pragma unroll
    for (int i = 0; i < 8; ++i) {
      tile[(i * 8 + ty) * 65 + tx] = r0[i];
      tile[64 * 65 + (i * 8 + ty) * 65 + tx] = r1[i];
    }
    __syncthreads();
#pragma unroll
    for (int i = 0; i < 8; ++i) {
      const int n = i * 8 + ty;
      dst[(size_t)(nt * 64 + n) * K + kt * 64 + tx] = (half_t)tile[tx * 65 + n];
      if (has2) dst[(size_t)(nt2 * 64 + n) * K + kt2 * 64 + tx] = (half_t)tile[64 * 65 + tx * 65 + n];
    }
  }
  base += tot;
}

struct NormRow { const float* mod; int g, b, t; bool valid, isctx; };
DI void norm_load(int g, const float* xl, const float* xc, const float* mods_l, bool skip_ctx, int lane, float4 (&v)[4], NormRow& r) {
  r.g = g; r.valid = g < NTOK;
  const int gg = r.valid ? g : 0;
  r.b = gg / TOK; r.t = gg - r.b * TOK;
  r.isctx = r.t >= SEQ;
  if (r.isctx && skip_ctx) r.valid = false;
  const float* src = r.isctx ? xc + ((size_t)r.b * CTX + (r.t - SEQ)) * 1024 : xl + ((size_t)r.b * SEQ + r.t) * 1024;
  r.mod = mods_l + (size_t)(r.isctx ? 16 : r.b) * 6144;
  if (r.valid) {
#pragma unroll
    for (int i = 0; i < 4; ++i) v[i] = *(const float4*)(src + i * 256 + lane * 4);
  } else {
#pragma unroll
    for (int i = 0; i < 4; ++i) v[i] = float4{0.f, 0.f, 0.f, 0.f};
  }
}
DI void norm_finish(float4 (&v)[4], const NormRow& r, const float* gam, int sh_off, int sc_off, half_t* h, const float* part, float* xc_store, int lane) {
  if (r.valid && r.isctx && part != nullptr) {
    const size_t ro = ((size_t)r.b * CTX + (r.t - SEQ)) * 1024;
#pragma unroll
    for (int i = 0; i < 4; ++i) {
#pragma unroll
      for (int ks = 0; ks < 4; ++ks) {
        const float4 pv = *(const float4*)(part + (size_t)ks * NB * CTX * 1024 + ro + i * 256 + lane * 4);
        v[i].x += pv.x; v[i].y += pv.y; v[i].z += pv.z; v[i].w += pv.w;
      }
      if (xc_store != nullptr) *(float4*)(xc_store + ro + i * 256 + lane * 4) = v[i];
    }
  }
  float ss = 0.f;
#pragma unroll
  for (int i = 0; i < 4; ++i) ss += v[i].x * v[i].x + v[i].y * v[i].y + v[i].z * v[i].z + v[i].w * v[i].w;
  ss = wave_sum(ss);
  if (!r.valid) return;
  const float rstd = rsqrtf(ss * (1.f / 1024.f) + EPS);
#pragma unroll
  for (int i = 0; i < 4; ++i) {
    const int col = i * 256 + lane * 4;
    const float4 gg = *(const float4*)(gam + col);
    const float4 sc = *(const float4*)(r.mod + sc_off + col);
    const float4 sh = *(const float4*)(r.mod + sh_off + col);
    h4 o;
    o[0] = (half_t)(v[i].x * rstd * gg.x * (1.f + sc.x) + sh.x);
    o[1] = (half_t)(v[i].y * rstd * gg.y * (1.f + sc.y) + sh.y);
    o[2] = (half_t)(v[i].z * rstd * gg.z * (1.f + sc.z) + sh.z);
    o[3] = (half_t)(v[i].w * rstd * gg.w * (1.f + sc.w) + sh.w);
    *(h4*)(h + (size_t)r.g * 1024 + col) = o;
  }
}
DI void phase_norm(const float* xl, const float* xc, const float* gam, const float* mods_l, int sh_off,
                   int sc_off, half_t* h, bool skip_ctx, const float* part, float* xc_store, int wv_) {
  const int tid_ = tid_opaque(wv_);
  const int wave = tid_ >> 6, lane = tid_ & 63;
  const int stride = gridDim.x * NWAVE;
  for (int g = blockIdx.x * NWAVE + wave; g < NTOK; g += 2 * stride) {
    float4 v0[4], v1[4];
    NormRow r0, r1;
    norm_load(g, xl, xc, mods_l, skip_ctx, lane, v0, r0);
    norm_load(g + stride, xl, xc, mods_l, skip_ctx, lane, v1, r1);
    norm_finish(v0, r0, gam, sh_off, sc_off, h, part, xc_store, lane);
    norm_finish(v1, r1, gam, sh_off, sc_off, h, part, xc_store, lane);
  }
}

constexpr int BK = 64, HALF = 128, HTB = HALF * BK * 2;
DI int lds_byte(int r, int c) { const int st = (r >> 4) * 2 + (c >> 5), rr = r & 15, cc = c & 31, ob = rr * 64 + cc * 2; return st * 1024 + (ob ^ (((ob >> 9) & 1) << 5)); }
DI void stage_rc(int b, int& R, int& C) { const int st = b / 1024, sb = b % 1024, swz = sb ^ (((sb >> 9) & 1) << 5); R = (st >> 1) * 16 + swz / 64; C = (st & 1) * 32 + (swz % 64) / 2; }
DI int perm32(int rho) { const int n = rho >> 4, i = rho & 15; return 8 * (i >> 2) + 4 * n + (i & 3); }

struct SchedBase {
  static DI int bmap(bool perm, int R) { return perm ? ((R & ~31) + perm32(R & 31)) : R; }
  static constexpr int BHALF = 128;
  static constexpr bool CHAIN = false;
};
struct GUnit { const char* A; const char* B; int nt, pm, pn, aux, ks; };

DI bool tile_map(int L, int nM, int nN, int& pm, int& pn) {
  const int nwg = nM * nN;
  if (L >= nwg) return false;
  int wgid = L;
  { const int q = nwg / 8, r = nwg % 8, xcd = wgid % 8, off = wgid / 8; wgid = (xcd < r ? xcd * (q + 1) : r * (q + 1) + (xcd - r) * q) + off; }
  const int nig = 8 * nN, gid = wgid / nig, fm = gid * 8, gsz = (nM - fm) < 8 ? (nM - fm) : 8;
  pm = fm + ((wgid % nig) % gsz); pn = (wgid % nig) / gsz;
  return true;
}

template <bool PERM, class Sched, class Epi>
DI void gemm256(LAS unsigned char* lds, const Sched& S, const Epi& E, int wv_) {
  const int tid = tid_opaque(wv_), wid = __builtin_amdgcn_readfirstlane(tid >> 6), lane = tid & 63, wr = wid >> 2, wc = wid & 3, fr = lane & 15, fq = lane >> 4;
  unsigned cvA0, cvA1, cvB0, cvB1;
  { int R, C;
    stage_rc(tid * 16, R, C); cvA0 = (unsigned)R * S.lda2 + C * 2; cvB0 = (unsigned)Sched::bmap(PERM, R) * S.ldb2 + C * 2;
    stage_rc(tid * 16 + 8192, R, C); cvA1 = (unsigned)R * S.lda2 + C * 2; cvB1 = (unsigned)Sched::bmap(PERM, R) * S.ldb2 + C * 2; }
  const size_t chA = (size_t)HALF * S.lda2, chB = (size_t)Sched::BHALF * S.ldb2;
  const size_t kstep = (size_t)(BK * 2);
  const unsigned ldsw = (unsigned)wid * 1024u;
  const int aoff = lds_byte(wr * 64 + fr, fq * 8), boff = lds_byte(wc * 32 + fr, fq * 8);
#define G_SA(b, h) (((b) * 2 + (h)) * HTB)
#define G_SB(b, h) ((4 + (b) * 2 + (h)) * HTB)
#define G_STAGE(bufoff, gbase, v0, v1) do { \
    __builtin_amdgcn_global_load_lds((const unsigned*)((const char*)(gbase) + (v0)), (LAS unsigned*)(lds + (bufoff) + ldsw), 16, 0, 0); \
    __builtin_amdgcn_global_load_lds((const unsigned*)((const char*)(gbase) + (v1)), (LAS unsigned*)(lds + (bufoff) + ldsw + 8192), 16, 0, 0); } while (0)
#define G_LDA(dst, b, h) do { _Pragma("unroll") for (int m = 0; m < 4; ++m) _Pragma("unroll") for (int k = 0; k < 2; ++k) dst[m][k] = *(const LAS h8*)(lds + G_SA(b, h) + aoff + m * 2048 + k * 1024); } while (0)
#define G_LDB(dst, b, h) do { _Pragma("unroll") for (int n = 0; n < 2; ++n) _Pragma("unroll") for (int k = 0; k < 2; ++k) dst[n][k] = *(const LAS h8*)(lds + G_SB(b, h) + boff + n * 2048 + k * 1024); } while (0)
#define G_MMA(ai, bj, At, Bt) do { __builtin_amdgcn_s_setprio(1); _Pragma("unroll") for (int m = 0; m < 4; ++m) _Pragma("unroll") for (int n = 0; n < 2; ++n) _Pragma("unroll") for (int k = 0; k < 2; ++k) \
    acc[ai][bj][m][n] = __builtin_amdgcn_mfma_f32_16x16x32_f16(Bt[n][k], At[m][k], acc[ai][bj][m][n], 0, 0, 0); __builtin_amdgcn_s_setprio(0); } while (0)
#define G_WAIT_V(n) asm volatile("s_waitcnt vmcnt(" #n ")" ::: "memory")
#define G_WAIT_L(n) asm volatile("s_waitcnt lgkmcnt(" #n ")" ::: "memory")
#define G_BAR __builtin_amdgcn_s_barrier()
#define G_SCHED __builtin_amdgcn_sched_barrier(0)
  GUnit cur, nxt;
  int ui = 0;
  if (!S.next(0, cur)) return;
  f4 acc[2][2][4][2];
#pragma unroll
  for (int a = 0; a < 2; ++a)
#pragma unroll
    for (int b = 0; b < 2; ++b)
#pragma unroll
      for (int m = 0; m < 4; ++m)
#pragma unroll
        for (int n = 0; n < 2; ++n) acc[a][b][m][n] = f4{0.f, 0.f, 0.f, 0.f};
  h8 At[4][2], B0[2][2], B1[2][2];
  const char* cA = cur.A;
  const char* cB = cur.B;
  G_STAGE(G_SB(0, 0), cB, cvB0, cvB1); G_STAGE(G_SA(0, 0), cA, cvA0, cvA1); G_STAGE(G_SB(0, 1), cB + chB, cvB0, cvB1); G_STAGE(G_SA(0, 1), cA + chA, cvA0, cvA1);
  if (wr == 1) G_BAR;
  G_WAIT_V(4); G_BAR;
  G_STAGE(G_SB(1, 0), cB + kstep, cvB0, cvB1); G_STAGE(G_SA(1, 0), cA + kstep, cvA0, cvA1); G_STAGE(G_SB(1, 1), cB + chB + kstep, cvB0, cvB1);
  G_WAIT_V(6); G_BAR;
  for (;;) {
    const bool has_next = S.next(ui + 1, nxt);
    const char* nA = has_next ? nxt.A : cA;
    const char* nB = has_next ? nxt.B : cB;
    int nt = cur.nt;
    asm volatile("" : "+s"(nt));
    for (int t = 0; t < nt; t += 2) {
      const bool last = (t == nt - 2);
      const char* a1 = cA + (size_t)(t + 1) * kstep;
      const char* a2 = last ? nA : cA + (size_t)(t + 2) * kstep;
      const char* b2 = last ? nB : cB + (size_t)(t + 2) * kstep;
      const char* a3 = a2 + kstep;
      const char* b3 = b2 + kstep;
      G_LDB(B0, 0, 0); G_SCHED; G_LDA(At, 0, 0); G_STAGE(G_SA(1, 1), a1 + chA, cvA0, cvA1);
      G_WAIT_L(8); G_BAR; G_WAIT_L(0); G_MMA(0, 0, At, B0); G_BAR; G_SCHED;
      G_LDB(B1, 0, 1); G_STAGE(G_SB(0, 0), b2, cvB0, cvB1);
      G_BAR; G_WAIT_L(0); G_MMA(0, 1, At, B1); G_BAR;
      G_LDA(At, 0, 1); G_STAGE(G_SA(0, 0), a2, cvA0, cvA1);
      G_BAR; G_WAIT_L(0); G_MMA(1, 0, At, B0); G_BAR; G_SCHED;
      G_STAGE(G_SB(0, 1), b2 + chB, cvB0, cvB1);
      G_WAIT_V(6); G_BAR; G_MMA(1, 1, At, B1); G_BAR;
      G_LDB(B0, 1, 0); G_SCHED; G_LDA(At, 1, 0); G_STAGE(G_SA(0, 1), a2 + chA, cvA0, cvA1);
      G_WAIT_L(8); G_BAR; G_WAIT_L(0); G_MMA(0, 0, At, B0); G_BAR; G_SCHED;
      G_LDB(B1, 1, 1); G_STAGE(G_SB(1, 0), b3, cvB0, cvB1);
      G_BAR; G_WAIT_L(0); G_MMA(0, 1, At, B1); G_BAR;
      G_LDA(At, 1, 1); G_STAGE(G_SA(1, 0), a3, cvA0, cvA1);
      G_BAR; G_WAIT_L(0); G_MMA(1, 0, At, B0); G_BAR; G_SCHED;
      G_STAGE(G_SB(1, 1), b3 + chB, cvB0, cvB1);
      G_WAIT_V(6); G_BAR; G_MMA(1, 1, At, B1); G_BAR;
    }
    bool keep = false;
    if constexpr (Sched::CHAIN) keep = E(acc, cur, wr, wc, fr, fq); else E(acc, cur, wr, wc, fr, fq);
    if (!has_next) break;
    if (!keep) {
#pragma unroll
      for (int a = 0; a < 2; ++a)
#pragma unroll
        for (int b = 0; b < 2; ++b)
#pragma unroll
          for (int m = 0; m < 4; ++m)
#pragma unroll
            for (int n = 0; n < 2; ++n) acc[a][b][m][n] = f4{0.f, 0.f, 0.f, 0.f};
    }
    cur = nxt; cA = nA; cB = nB; ++ui;
  }
  G_WAIT_V(0);
  if (wr == 0) G_BAR;
  G_BAR;
#undef G_SA
#undef G_SB
#undef G_STAGE
#undef G_LDA
#undef G_LDB
#undef G_MMA
#undef G_WAIT_V
#undef G_WAIT_L
#undef G_BAR
#undef G_SCHED
}

DI h8 pack8(const f4& a, const f4& b) {
  h8 o;
  o[0] = (half_t)a[0]; o[1] = (half_t)a[1]; o[2] = (half_t)a[2]; o[3] = (half_t)a[3];
  o[4] = (half_t)b[0]; o[5] = (half_t)b[1]; o[6] = (half_t)b[2]; o[7] = (half_t)b[3];
  return o;
}
DI int row0_of(int pm, int mode) { return mode == 0 ? pm * 256 : (mode == 1 ? (pm >> 3) * TOK + (pm & 7) * 256 : pm * TOK + SEQ); }

struct SchedInproj : SchedBase {
  const half_t* hbuf; const half_t* Wl; int G, c;
  static constexpr unsigned lda2 = 2048, ldb2 = 2048;
  DI bool next(int i, GUnit& u) const {
    const int L = i * G + c;
    u.nt = 16;
    if (L < 144 * 8) {
      tile_map(L, 144, 8, u.pm, u.pn);
      u.A = (const char*)(hbuf + (size_t)u.pm * 256 * 1024); u.B = (const char*)(Wl + W_QK + (size_t)u.pn * 256 * 1024); u.aux = 0;
      return true;
    }
    if (!tile_map(L - 144 * 8, 3, 144, u.pm, u.pn)) return false;
    u.A = (const char*)(Wl + W_V + (size_t)u.pm * 256 * 1024); u.B = (const char*)(hbuf + (size_t)u.pn * 256 * 1024); u.aux = 1;
    return true;
  }
};
struct EpiInproj {
  half_t* big;
  DI void operator()(const f4 (&acc)[2][2][4][2], const GUnit& u, int wr, int wc, int fr, int fq) const {
    if (u.aux == 0) {
      const int g0 = u.pm * 256, b = g0 / TOK, t0 = g0 - b * TOK + wr * 64;
#pragma unroll
      for (int bj = 0; bj < 2; ++bj) {
        const int cb = u.pn * 256 + bj * 128 + wc * 32;
        half_t* ptr; int ts;
        if (cb < 576) { ptr = big + B_ZMLA + (size_t)b * TOK * ZS + cb; ts = ZS; }
        else if (cb < 1088) { const int c = cb - 576, part = c >> 8, hh = (c >> 6) & 3; ptr = big + (part ? B_KNA : B_QNA) + (size_t)(b * 4 + hh) * TOK * 64 + (c & 63); ts = 64; }
        else if (cb < 1600) { const int c = cb - 1088, part = c >> 8, hm = (c >> 5) & 7; ptr = big + (part ? B_KDF : B_QDF) + (size_t)(b * 8 + hm) * TOK * 32; ts = 32; }
        else if (cb < 1856) { const int c = cb - 1600; ptr = big + B_QG + (size_t)(b * 4 + (c >> 6)) * TOK * 64 + (c & 63); ts = 64; }
        else if (cb < 1984) { const int c = cb - 1856; ptr = big + B_KG + (size_t)(b * 2 + (c >> 6)) * TOK * 64 + (c & 63); ts = 64; }
        else continue;
        const unsigned lo = (unsigned)(fr * ts + 8 * fq) * 2u;
        char* rb = (char*)(ptr + (size_t)t0 * ts);
#pragma unroll
        for (int ai = 0; ai < 2; ++ai)
#pragma unroll
          for (int m = 0; m < 4; ++m)
            *(h8*)(rb + (size_t)((ai * 128 + m * 16) * ts) * 2 + lo) = pack8(acc[ai][bj][m][0], acc[ai][bj][m][1]);
      }
    } else {
      const int g0 = u.pn * 256, b = g0 / TOK, t0 = g0 - b * TOK;
      const int nh = (u.pm == 2) ? 2 : 4;
      char* vt = (char*)(big + (u.pm == 0 ? B_VTNA : (u.pm == 1 ? B_VTDF : B_VTG)) + (size_t)b * nh * 64 * TOK + (size_t)(wr * 64) * TOK + t0 + wc * 32);
      const unsigned lo = (unsigned)(fr * TOK + 8 * fq) * 2u;
#pragma unroll
      for (int ai = 0; ai < 2; ++ai) {
        if (u.pm == 2 && ai == 1) continue;
#pragma unroll
        for (int m = 0; m < 4; ++m)
#pragma unroll
          for (int bj = 0; bj < 2; ++bj)
            *(h8*)(vt + ((size_t)(ai * 128 + m * 16) * TOK + bj * 128) * 2 + lo) = pack8(acc[ai][bj][m][0], acc[ai][bj][m][1]);
      }
    }
  }
};

struct SchedMlaQK : SchedBase {
  const half_t* Wl; const half_t* zmla; int G, c;
  static constexpr unsigned lda2 = ZS * 2, ldb2 = 512;
  DI bool next(int i, GUnit& u) const {
    const int L = i * G + c;
    u.nt = 4;
    if (L < 288) {
      tile_map(L, 144, 2, u.pm, u.pn);
      u.A = (const char*)(zmla + (size_t)u.pm * 256 * ZS);
      u.B = (const char*)(Wl + W_UQ + (size_t)u.pn * 256 * 256); u.aux = 0;
      return true;
    }
    if (L < 432) {
      u.pm = L - 288; u.pn = 0;
      u.A = (const char*)(zmla + 256 + (size_t)u.pm * 256 * ZS);
      u.B = (const char*)(Wl + W_UK); u.aux = 1;
      return true;
    }
    return false;
  }
};
struct SchedMlaV : SchedBase {
  const half_t* Wl; const half_t* zmla; int G, c;
  static constexpr unsigned lda2 = 512, ldb2 = ZS * 2;
  DI bool next(int i, GUnit& u) const {
    const int L = i * G + c;
    if (L >= 144) return false;
    u.nt = 4; u.pm = 0; u.pn = L;
    u.A = (const char*)(Wl + W_UV);
    u.B = (const char*)(zmla + 256 + (size_t)u.pn * 256 * ZS); u.aux = 2;
    return true;
  }
};
struct EpiMla {
  half_t* big;
  DI void operator()(const f4 (&acc)[2][2][4][2], const GUnit& u, int wr, int wc, int fr, int fq) const {
    if (u.aux < 2) {
      const int g0 = u.pm * 256, b = g0 / TOK, t0 = g0 - b * TOK + wr * 64;
      const unsigned lo = (unsigned)(fr * 96 + 8 * fq) * 2u;
#pragma unroll
      for (int bj = 0; bj < 2; ++bj) {
        const int cb = u.pn * 256 + bj * 128 + wc * 32;
        half_t* ptr;
        if (u.aux == 0) {
          if (cb >= 384) continue;
          const int hh = cb / 96, dd = cb - hh * 96;
          ptr = big + B_QM + (size_t)(b * 4 + hh) * TOK * 96 + dd;
        } else {
          ptr = big + B_KM + (size_t)(b * 4 + (cb >> 6)) * TOK * 96 + (cb & 63);
        }
        char* rb = (char*)(ptr + (size_t)t0 * 96);
#pragma unroll
        for (int ai = 0; ai < 2; ++ai)
#pragma unroll
          for (int m = 0; m < 4; ++m)
            *(h8*)(rb + (size_t)((ai * 128 + m * 16) * 96) * 2 + lo) = pack8(acc[ai][bj][m][0], acc[ai][bj][m][1]);
      }
    } else {
      const int g0 = u.pn * 256, b = g0 / TOK, t0 = g0 - b * TOK;
      char* vt = (char*)(big + B_VTM + (size_t)b * 4 * 64 * TOK + (size_t)(wr * 64) * TOK + t0 + wc * 32);
      const unsigned lo = (unsigned)(fr * TOK + 8 * fq) * 2u;
#pragma unroll
      for (int ai = 0; ai < 2; ++ai)
#pragma unroll
        for (int m = 0; m < 4; ++m)
#pragma unroll
          for (int bj = 0; bj < 2; ++bj)
            *(h8*)(vt + ((size_t)(ai * 128 + m * 16) * TOK + bj * 128) * 2 + lo) = pack8(acc[ai][bj][m][0], acc[ai][bj][m][1]);
    }
  }
};

struct SchedRows : SchedBase {
  const half_t* A; const half_t* B; int K, nM, nN, G, c; int mode; unsigned lda2, ldb2;
  DI bool next(int i, GUnit& u) const {
    if (!tile_map(i * G + c, nM, nN, u.pm, u.pn)) return false;
    u.A = (const char*)(A + (size_t)row0_of(u.pm, mode) * K); u.B = (const char*)(B + (size_t)u.pn * 256 * K);
    u.nt = K >> 6; u.aux = 0;
    return true;
  }
};
struct SchedResid : SchedBase {
  const half_t* A; const half_t* B; int K, nN, nctx, G, c; unsigned lda2, ldb2;
  DI bool next(int i, GUnit& u) const {
    const int L = i * G + c, nfull = 128 * nN;
    if (L < nfull) {
      tile_map(L, 128, nN, u.pm, u.pn);
      u.A = (const char*)(A + (size_t)row0_of(u.pm, 1) * K); u.B = (const char*)(B + (size_t)u.pn * 256 * K);
      u.nt = K >> 6; u.aux = 0;
      return true;
    }
    const int L2 = L - nfull;
    if (L2 >= nctx * nN * 4) return false;
    const int ks = L2 & 3, t = L2 >> 2;
    u.pm = t / nN; u.pn = t - u.pm * nN;
    const int kq = K >> 2;
    u.A = (const char*)(A + (size_t)row0_of(u.pm, 2) * K + ks * kq); u.B = (const char*)(B + (size_t)u.pn * 256 * K + ks * kq);
    u.nt = kq >> 6; u.aux = 1; u.ks = ks;
    return true;
  }
};
struct EpiResid {
  const float* xl_src; float* xl_dst; float* part; const float* mods_l; int gt_off;
  DI void operator()(const f4 (&acc)[2][2][4][2], const GUnit& u, int wr, int wc, int fr, int fq) const {
    const bool isctx = u.aux == 1;
    const int g0 = row0_of(u.pm, isctx ? 2 : 1), b = g0 / TOK, t0 = g0 - b * TOK;
    const int col0 = u.pn * 256 + wc * 32;
    const size_t rowoff = (size_t)(wr * 64) * 1024 + col0;
    const char* src = (const char*)(xl_src + ((size_t)b * SEQ + (isctx ? 0 : t0)) * 1024 + rowoff);
    char* dst = (char*)(xl_dst + ((size_t)b * SEQ + (isctx ? 0 : t0)) * 1024 + rowoff);
    const char* gt = (const char*)(mods_l + (size_t)(isctx ? 16 : b) * 6144 + gt_off + col0);
    const unsigned lo = (unsigned)(fr * 1024 + 4 * fq) * 4u, glo = (unsigned)(4 * fq) * 4u;
    f4 gv[2][2];
#pragma unroll
    for (int bj = 0; bj < 2; ++bj)
#pragma unroll
      for (int n = 0; n < 2; ++n) gv[bj][n] = *(const f4*)(gt + (bj * 128 + n * 16) * 4 + glo);
    if (!isctx) {
#pragma unroll
      for (int ai = 0; ai < 2; ++ai)
#pragma unroll
        for (int mh = 0; mh < 2; ++mh) {
          f4 xv[2][2][2];
#pragma unroll
          for (int mm = 0; mm < 2; ++mm)
#pragma unroll
            for (int bj = 0; bj < 2; ++bj)
#pragma unroll
              for (int n = 0; n < 2; ++n)
                xv[mm][bj][n] = *(const f4*)(src + ((size_t)(ai * 128 + (mh * 2 + mm) * 16) * 1024 + bj * 128 + n * 16) * 4 + lo);
#pragma unroll
          for (int mm = 0; mm < 2; ++mm)
#pragma unroll
            for (int bj = 0; bj < 2; ++bj)
#pragma unroll
              for (int n = 0; n < 2; ++n)
                *(f4*)(dst + ((size_t)(ai * 128 + (mh * 2 + mm) * 16) * 1024 + bj * 128 + n * 16) * 4 + lo) =
                    xv[mm][bj][n] + gv[bj][n] * acc[ai][bj][mh * 2 + mm][n];
        }
    } else {
      char* pp = (char*)(part + ((size_t)u.ks * NB * CTX + (size_t)b * CTX + (t0 - SEQ) + wr * 64) * 1024 + col0);
#pragma unroll
      for (int ai = 0; ai < 2; ++ai)
#pragma unroll
        for (int m = 0; m < 4; ++m)
#pragma unroll
          for (int bj = 0; bj < 2; ++bj)
#pragma unroll
            for (int n = 0; n < 2; ++n)
              *(f4*)(pp + ((size_t)(ai * 128 + m * 16) * 1024 + bj * 128 + n * 16) * 4 + lo) = gv[bj][n] * acc[ai][bj][m][n];
    }
  }
};
struct EpiUp {
  half_t* ubuf; int skip_ctx;
  DI void operator()(const f4 (&acc)[2][2][4][2], const GUnit& u, int wr, int wc, int fr, int fq) const {
    const int g0 = row0_of(u.pm, skip_ctx);
    char* rb = (char*)(ubuf + (size_t)(g0 + wr * 64) * 4096 + u.pn * 256 + wc * 32);
    const unsigned lo = (unsigned)(fr * 4096 + 8 * fq) * 2u;
#pragma unroll
    for (int ai = 0; ai < 2; ++ai)
#pragma unroll
      for (int m = 0; m < 4; ++m)
#pragma unroll
        for (int bj = 0; bj < 2; ++bj) {
          f4 a = acc[ai][bj][m][0], c = acc[ai][bj][m][1];
#pragma unroll
          for (int j = 0; j < 4; ++j) { a[j] = fmaxf(a[j], 0.f); a[j] *= a[j]; c[j] = fmaxf(c[j], 0.f); c[j] *= c[j]; }
          *(h8*)(rb + ((size_t)(ai * 128 + m * 16) * 4096 + bj * 128) * 2 + lo) = pack8(a, c);
        }
  }
};

DI void build_rope_tables(float2* tab, int wv_) {
  const int tid_ = tid_opaque(wv_);
  __syncthreads();
  for (int idx = tid_; idx < 512 + 1024; idx += NTHR) {
    const bool big = idx >= 512;
    const int j = big ? idx - 512 : idx;
    const int pos = big ? (j >> 4) : (j >> 3), i = big ? (j & 15) : (j & 7);
    const float invf = exp2f(-(float)i * (13.287712379549449f / (big ? 16.f : 8.f)));
    const float ang = (float)pos * invf;
    float sn, cs;
    sincosf(ang, &sn, &cs);
    tab[idx] = float2{cs, sn};
  }
  __syncthreads();
}
template <int DLEN, int LPR, int ROPE, bool KR>
DI void norm_rows(half_t* base, int stride, int nrows, const float* gain, float oscale, const half_t* zmla, const float2* rtab, int wv_) {
  const int tid_ = tid_opaque(wv_);
  const int lane = tid_ & 63, wave = tid_ >> 6;
  constexpr int RPW = 64 / LPR;
  const int s = lane % LPR, sub = lane / LPR;
  const bool active = s * 8 < DLEN;
  float gn[8];
#pragma unroll
  for (int i = 0; i < 8; ++i) gn[i] = active ? gain[s * 8 + i] : 0.f;
  for (int r0 = (blockIdx.x * NWAVE + wave) * RPW; r0 < nrows; r0 += gridDim.x * NWAVE * RPW) {
    const int rho = r0 + sub;
    const int t = rho % TOK;
    half_t* ptr = base + (size_t)rho * stride + s * 8;
    const half_t* src = ptr;
    if (KR && s >= 8) {
      const int b = rho / (4 * TOK);
      src = zmla + ((size_t)b * TOK + t) * ZS + 512 + (s - 8) * 8;
    }
    float f[8];
    float ss = 0.f;
    if (active) {
      const h8 v = *(const h8*)src;
#pragma unroll
      for (int i = 0; i < 8; ++i) { f[i] = (float)v[i]; ss += f[i] * f[i]; }
    } else {
#pragma unroll
      for (int i = 0; i < 8; ++i) f[i] = 0.f;
    }
#pragma unroll
    for (int o = LPR / 2; o > 0; o >>= 1) ss += __shfl_xor(ss, o);
    const float rstd = rsqrtf(ss * (1.f / DLEN) + EPS);
#pragma unroll
    for (int i = 0; i < 8; ++i) f[i] = f[i] * rstd * gn[i];
    if (ROPE != 0) {
      constexpr int PX = (ROPE == 64) ? 2 : 1;
      float pf[8];
#pragma unroll
      for (int i = 0; i < 8; ++i) pf[i] = __shfl_xor(f[i], PX);
      constexpr int RB = (DLEN - ROPE) / 8;
      if (t < SEQ && s >= RB && active) {
        const int sr = s - RB;
        const int q = (ROPE == 64) ? (sr >> 1) : sr;
        const int pos = (q < 2) ? (t >> 6) : (t & 63);
        const float sgn = (q & 1) ? 1.f : -1.f;
        constexpr int NFI = (ROPE == 64) ? 16 : 8;
        const float2* tb = rtab + ((ROPE == 64) ? 512 : 0) + pos * NFI + ((ROPE == 64) ? (sr & 1) * 8 : 0);
#pragma unroll
        for (int i = 0; i < 8; ++i) {
          const float2 cssn = tb[i];
          f[i] = f[i] * cssn.x + sgn * pf[i] * cssn.y;
        }
      }
    }
    if (active) {
      h8 o;
#pragma unroll
      for (int i = 0; i < 8; ++i) o[i] = (half_t)(f[i] * oscale);
      *(h8*)ptr = o;
    }
  }
}

constexpr int ATT_STAGE = 22528, ATT_VOFF = 13312, ATT_STASH = 49152;
template <int DQ, bool NA, int NQG>
DI void attn_wg(const half_t* Qp, const half_t* Kp, const half_t* Vp, int q0, bool active, int seg0_start, int seg0_tiles,
                int seg1_start, int seg1_tiles, const float* rpb_h, int rq, char* smem, int tid, f16v (&O)[2][NQG]) {
  constexpr int NKS = DQ / 16, KSTR = DQ + 8, VSTR = 72, CPK = DQ / 8, KCH = 64 * CPK;
  const int lane = tid & 63, r = lane & 31, h = lane >> 5;
  h8 qf[NQG][NKS];
#pragma unroll
  for (int qg = 0; qg < NQG; ++qg)
#pragma unroll
    for (int ks = 0; ks < NKS; ++ks) qf[qg][ks] = *(const h8*)(Qp + (size_t)(q0 + qg * 32 + r) * DQ + ks * 16 + h * 8);
  float mrun[NQG], lrun[NQG];
#pragma unroll
  for (int qg = 0; qg < NQG; ++qg) { mrun[qg] = -1e30f; lrun[qg] = 0.f; }
#pragma unroll
  for (int a = 0; a < 2; ++a)
#pragma unroll
    for (int c = 0; c < NQG; ++c)
#pragma unroll
      for (int i = 0; i < 16; ++i) O[a][c][i] = 0.f;
  const int ntiles = seg0_tiles + seg1_tiles;
  const int kc0 = tid, kc1 = tid + 512;
  const half_t* kg0 = Kp + kc0 * 8;
  const half_t* kg1 = Kp + kc1 * 8;
  const half_t* vg = Vp + (size_t)(tid >> 3) * TOK + (tid & 7) * 8;
  const int ks0 = (kc0 / CPK) * KSTR + (kc0 % CPK) * 8, ks1 = (kc1 / CPK) * KSTR + (kc1 % CPK) * 8, vs0 = (tid >> 3) * VSTR + (tid & 7) * 8;
  uint4 kreg0 = {0, 0, 0, 0}, kreg1 = {0, 0, 0, 0}, vreg;
  const int r0w = min(max(rq - 4, 0), 24);
  {
    const int k0 = (0 < seg0_tiles) ? seg0_start : seg1_start;
    if (kc0 < KCH) kreg0 = *(const uint4*)(kg0 + (size_t)k0 * DQ);
    if (DQ == 96 && kc1 < KCH) kreg1 = *(const uint4*)(kg1 + (size_t)k0 * DQ);
    vreg = *(const uint4*)(vg + k0);
    if (kc0 < KCH) *(uint4*)((half_t*)smem + ks0) = kreg0;
    if (DQ == 96 && kc1 < KCH) *(uint4*)((half_t*)smem + ks1) = kreg1;
    *(uint4*)((half_t*)(smem + ATT_VOFF) + vs0) = vreg;
  }
  __syncthreads();
  for (int it = 0; it < ntiles; ++it) {
    const int k0 = (it < seg0_tiles) ? seg0_start + it * 64 : seg1_start + (it - seg0_tiles) * 64;
    const bool more = it + 1 < ntiles;
    if (more) {
      const int itn = it + 1;
      const int k1 = (itn < seg0_tiles) ? seg0_start + itn * 64 : seg1_start + (itn - seg0_tiles) * 64;
      if (kc0 < KCH) kreg0 = *(const uint4*)(kg0 + (size_t)k1 * DQ);
      if (DQ == 96 && kc1 < KCH) kreg1 = *(const uint4*)(kg1 + (size_t)k1 * DQ);
      vreg = *(const uint4*)(vg + k1);
    }
    const half_t* ksm = (const half_t*)(smem + (it & 1) * ATT_STAGE) + r * KSTR + h * 8;
    const half_t* vsm = (const half_t*)(smem + (it & 1) * ATT_STAGE + ATT_VOFF) + r * VSTR + h * 4;
    const bool masked = NA && it < seg0_tiles;
    const int krow = k0 >> 6;
    const bool need = active && (!masked || (krow >= r0w && krow < r0w + 8));
    if (need) {
#pragma unroll 1
      for (int st = 0; st < 2; ++st) {
        f16v S[NQG];
#pragma unroll
        for (int qg = 0; qg < NQG; ++qg)
#pragma unroll
          for (int i = 0; i < 16; ++i) S[qg][i] = 0.f;
#pragma unroll
        for (int ks = 0; ks < NKS; ++ks) {
          const h8 kf = *(const h8*)(ksm + (st * 32) * KSTR + ks * 16);
#pragma unroll
          for (int qg = 0; qg < NQG; ++qg) S[qg] = __builtin_amdgcn_mfma_f32_32x32x16_f16(kf, qf[qg][ks], S[qg], 0, 0, 0);
        }
        if (masked) {
          const int cb = st * 32;
          const int dr = krow - rq + 7;
#pragma unroll
          for (int qg = 0; qg < NQG; ++qg) {
            const int qc = qg * 32 + r;
            const int cs = min(max(qc - 8, 0), 48);
#pragma unroll
            for (int i = 0; i < 16; ++i) {
              const int c = cb + (i & 3) + 8 * (i >> 2) + 4 * h;
              const bool valid = (c >= cs) && (c < cs + 16);
              float bias = 0.f;
              if (valid) bias = rpb_h[dr * 31 + (c - qc + 15)] * LOG2E;
              S[qg][i] = valid ? S[qg][i] + bias : -1e30f;
            }
          }
        }
        h4 vf[2][2][2];
#pragma unroll
        for (int dvt = 0; dvt < 2; ++dvt)
#pragma unroll
          for (int sx = 0; sx < 2; ++sx)
#pragma unroll
            for (int hf = 0; hf < 2; ++hf) vf[dvt][sx][hf] = *(const h4*)(vsm + (dvt * 32) * VSTR + st * 32 + sx * 16 + hf * 8);
#pragma unroll
        for (int qg = 0; qg < NQG; ++qg) {
          h8 P[2];
          float mx = S[qg][0];
#pragma unroll
          for (int i = 1; i < 16; ++i) mx = fmaxf(mx, S[qg][i]);
          mx = fmaxf(mx, __shfl_xor(mx, 32));
          const float mn = fmaxf(mrun[qg], mx);
          if (__builtin_amdgcn_ballot_w64(mn > mrun[qg]) != 0ull) {
            const float alpha = __builtin_amdgcn_exp2f(mrun[qg] - mn);
            lrun[qg] *= alpha;
#pragma unroll
            for (int dvt = 0; dvt < 2; ++dvt)
#pragma unroll
              for (int i = 0; i < 16; ++i) O[dvt][qg][i] *= alpha;
            mrun[qg] = mn;
          }
          f2 rs2 = {0.f, 0.f};
          const f2 mn2 = {mn, mn};
#pragma unroll
          for (int i = 0; i < 16; i += 2) {
            const f2 s2 = {S[qg][i], S[qg][i + 1]};
            const f2 d2 = s2 - mn2;
            f2 p2;
            p2.x = __builtin_amdgcn_exp2f(d2.x);
            p2.y = __builtin_amdgcn_exp2f(d2.y);
            if (NA) { p2.x = (s2.x <= -1e29f) ? 0.f : p2.x; p2.y = (s2.y <= -1e29f) ? 0.f : p2.y; }
            rs2 += p2;
            P[i >> 3][i & 7] = (half_t)p2.x;
            P[i >> 3][(i & 7) + 1] = (half_t)p2.y;
          }
          lrun[qg] += rs2.x + rs2.y;
#pragma unroll
          for (int dvt = 0; dvt < 2; ++dvt) {
#pragma unroll
            for (int sx = 0; sx < 2; ++sx) {
              const h8 va = __builtin_shufflevector(vf[dvt][sx][0], vf[dvt][sx][1], 0, 1, 2, 3, 4, 5, 6, 7);
              O[dvt][qg] = __builtin_amdgcn_mfma_f32_32x32x16_f16(va, P[sx], O[dvt][qg], 0, 0, 0);
            }
          }
        }
      }
    }
    if (more) {
      char* nb = smem + ((it + 1) & 1) * ATT_STAGE;
      if (kc0 < KCH) *(uint4*)((half_t*)nb + ks0) = kreg0;
      if (DQ == 96 && kc1 < KCH) *(uint4*)((half_t*)nb + ks1) = kreg1;
      *(uint4*)((half_t*)(nb + ATT_VOFF) + vs0) = vreg;
    }
    __syncthreads();
  }
#pragma unroll
  for (int qg = 0; qg < NQG; ++qg) {
    const float lt = lrun[qg] + __shfl_xor(lrun[qg], 32);
    const float inv = 1.f / lt;
#pragma unroll
    for (int dvt = 0; dvt < 2; ++dvt)
#pragma unroll
      for (int i = 0; i < 16; ++i) O[dvt][qg][i] *= inv;
  }
}

template <int NQG>
DI void store_o(const f16v (&O)[2][NQG], half_t* orow0  , int lane) {
  const int r = lane & 31, h = lane >> 5;
#pragma unroll
  for (int qg = 0; qg < NQG; ++qg)
#pragma unroll
    for (int dvt = 0; dvt < 2; ++dvt)
#pragma unroll
      for (int c = 0; c < 4; ++c) {
        h4 o;
#pragma unroll
        for (int j = 0; j < 4; ++j) o[j] = (half_t)O[dvt][qg][4 * c + j];
        *(h4*)(orow0 + (size_t)(qg * 32 + r) * 1024 + dvt * 32 + 8 * c + 4 * h) = o;
      }
}

DI void phase_attn(int l, half_t* big, bool need_ctx, char* smem, int wv_) {
  const KPtr p = kp();
  const int wave = wv_;
  const int NQB = need_ctx ? 5 : 4;
  half_t* obuf = big + B_O;
  const float lam_init = 0.8f - 0.6f * expf(-0.3f * (float)l);
  float lam;
  {
    float d1 = 0.f, d2 = 0.f;
#pragma unroll 1
    for (int i = 0; i < 32; ++i) {
      d1 += p->lq1[l * 32 + i] * p->lk1[l * 32 + i];
      d2 += p->lq2[l * 32 + i] * p->lk2[l * 32 + i];
    }
    lam = expf(d1) - expf(d2) + lam_init;
    lam = __builtin_bit_cast(float, __builtin_amdgcn_readfirstlane(__builtin_bit_cast(int, lam)));
  }
  const float one_m_li = __builtin_bit_cast(float, __builtin_amdgcn_readfirstlane(__builtin_bit_cast(int, 1.f - lam_init)));
  const int per = 4 * 16 * NQB;
#pragma unroll
  for (int mixer = 0; mixer < 4; ++mixer) {
    const int lo = mixer * per;
    const int first = lo + (int)((blockIdx.x + gridDim.x - (lo % gridDim.x)) % gridDim.x);
    const int tid_m = tid_opaque(wv_);
    const int lane = tid_m & 63, h = lane >> 5;
#pragma unroll 1
    for (int item = first; item < lo + per; item += gridDim.x) {
      const int hi = item / (16 * NQB);
      const int rem = item - hi * 16 * NQB;
      const int b = rem / NQB, qb = rem - b * NQB;
      const bool qctx = qb == 4;
      const bool active = !qctx || wave < 4;
      const int q0 = active ? qb * 512 + wave * 64 : SEQ;
      const int hh = hi & 3;
      const int s0 = qctx ? SEQ : 0, n0t = qctx ? 4 : 36;
      f16v O[2][2];
      half_t* orow = obuf + (size_t)(b * TOK + q0) * 1024 + hh * 64;
      if (mixer == 0) {
        half_t* stash = (half_t*)(smem + ATT_STASH) + wave * 4096;
        attn_wg<32, false, 2>(big + B_QDF + (size_t)(b * 8 + hh * 2) * TOK * 32, big + B_KDF + (size_t)(b * 8 + hh * 2) * TOK * 32,
                              big + B_VTDF + (size_t)(b * 4 + hh) * 64 * TOK, q0, active, s0, n0t, 0, 0, nullptr, 0, smem, tid_m, O);
#pragma unroll
        for (int dvt = 0; dvt < 2; ++dvt)
#pragma unroll
          for (int qg = 0; qg < 2; ++qg)
#pragma unroll
            for (int i = 0; i < 16; ++i) stash[((dvt * 2 + qg) * 16 + i) * 64 + lane] = (half_t)O[dvt][qg][i];
        attn_wg<32, false, 2>(big + B_QDF + (size_t)(b * 8 + hh * 2 + 1) * TOK * 32, big + B_KDF + (size_t)(b * 8 + hh * 2 + 1) * TOK * 32,
                              big + B_VTDF + (size_t)(b * 4 + hh) * 64 * TOK, q0, active, s0, n0t, 0, 0, nullptr, 0, smem, tid_m, O);
#pragma unroll
        for (int qg = 0; qg < 2; ++qg) {
          float ss = 0.f;
#pragma unroll
          for (int dvt = 0; dvt < 2; ++dvt)
#pragma unroll
            for (int i = 0; i < 16; ++i) {
              const float v = (float)stash[((dvt * 2 + qg) * 16 + i) * 64 + lane] - lam * O[dvt][qg][i];
              O[dvt][qg][i] = v;
              ss += v * v;
            }
          ss += __shfl_xor(ss, 32);
          const float rstd = rsqrtf(ss * (1.f / 64.f) + EPS) * one_m_li;
#pragma unroll
          for (int dvt = 0; dvt < 2; ++dvt)
#pragma unroll
            for (int i = 0; i < 16; ++i) {
              const int dv = dvt * 32 + (i & 3) + 8 * (i >> 2) + 4 * h;
              O[dvt][qg][i] *= rstd * p->g_diff_sub[l * 64 + dv];
            }
        }
        if (active) store_o<2>(O, orow + 2 * 256, lane);
      } else if (mixer == 1) {
        attn_wg<96, false, 2>(big + B_QM + (size_t)(b * 4 + hh) * TOK * 96, big + B_KM + (size_t)(b * 4 + hh) * TOK * 96,
                              big + B_VTM + (size_t)(b * 4 + hh) * 64 * TOK, q0, active, s0, n0t, 0, 0, nullptr, 0, smem, tid_m, O);
        if (active) store_o<2>(O, orow + 0 * 256, lane);
      } else if (mixer == 2) {
        const int kv = hh >> 1;
        attn_wg<64, false, 2>(big + B_QG + (size_t)(b * 4 + hh) * TOK * 64, big + B_KG + (size_t)(b * 2 + kv) * TOK * 64,
                              big + B_VTG + (size_t)(b * 2 + kv) * 64 * TOK, q0, active, s0, n0t, 0, 0, nullptr, 0, smem, tid_m, O);
        if (active) store_o<2>(O, orow + 3 * 256, lane);
      } else {
        const int rq = q0 >> 6;
        const int rq0 = qb * 8;
        const int rlo = min(max(rq0 - 4, 0), 24), rhi = min(max(rq0 + 7 - 4, 0), 24) + 8;
        const int seg0s = rlo * 64, seg0n = qctx ? 0 : (rhi - rlo);
        attn_wg<64, true, 2>(big + B_QNA + (size_t)(b * 4 + hh) * TOK * 64, big + B_KNA + (size_t)(b * 4 + hh) * TOK * 64,
                             big + B_VTNA + (size_t)(b * 4 + hh) * 64 * TOK, q0, active, seg0s, seg0n, SEQ, 4,
                             p->na_rpb + (size_t)(l * 4 + hh) * 15 * 31, rq, smem, tid_m, O);
        if (active) store_o<2>(O, orow + 1 * 256, lane);
      }
    }
  }
}

struct SchedGate : SchedBase {
  const half_t* hbuf; const half_t* Wl; int pm0, cnt, G, c, mode;
  static constexpr unsigned lda2 = 2048, ldb2 = 2048;
  static DI int bmap(bool, int R) { return ((R >> 4) & 1) * 1024 + (R >> 5) * 16 + (R & 15); }
  static constexpr int BHALF = 2048;
  DI bool next(int i, GUnit& u) const {
    int pm, pn;
    if (!tile_map(i * G + c, cnt, 16, pm, pn)) return false;
    u.pm = pm0 + pm; u.pn = pn; u.nt = 16; u.aux = 0;
    u.A = (const char*)(hbuf + (size_t)row0_of(u.pm, mode) * 1024); u.B = (const char*)(Wl + W_GATE + (size_t)pn * 64 * 1024);
    return true;
  }
};
DI float gate_clamped(float x) { return fmaxf(__builtin_amdgcn_rcpf(1.f + __expf(-x)), 6.103515625e-05f); }
struct EpiGate {
  half_t* gb; int pm0;
  DI void operator()(const f4 (&acc)[2][2][4][2], const GUnit& u, int wr, int wc, int fr, int fq) const {
    char* rb = (char*)(gb + (size_t)((u.pm - pm0) * 256 + wr * 64) * 4096 + u.pn * 64 + wc * 16);
    const unsigned lo = (unsigned)(fr * 4096 + 4 * fq) * 2u;
#pragma unroll
    for (int ai = 0; ai < 2; ++ai)
#pragma unroll
      for (int m = 0; m < 4; ++m) {
        f4 gq[4];
#pragma unroll
        for (int br = 0; br < 4; ++br)
#pragma unroll
          for (int j = 0; j < 4; ++j) gq[br][j] = gate_clamped(acc[ai][br >> 1][m][br & 1][j]);
#pragma unroll
        for (int br = 0; br < 4; ++br) {
          h4 o;
#pragma unroll
          for (int j = 0; j < 4; ++j) o[j] = (half_t)(br < 3 ? gq[br][j] * __builtin_amdgcn_rcpf(gq[br + 1][j]) : gq[3][j]);
          *(h4*)(rb + ((size_t)(ai * 128 + m * 16) * 4096 + br * 1024) * 2 + lo) = o;
        }
      }
  }
};
struct SchedProj : SchedBase {
  const half_t* obuf; const half_t* Wl; int pm0, cnt, G, c, mode;
  static constexpr unsigned lda2 = 2048, ldb2 = 512;
  static constexpr bool CHAIN = true;
  DI bool next(int i, GUnit& u) const {
    int pm, pn;
    if (!tile_map((i >> 2) * G + c, cnt, 4, pm, pn)) return false;
    const int br = i & 3;
    u.pm = pm0 + pm; u.pn = pn; u.nt = 4; u.aux = br;
    u.A = (const char*)(obuf + (size_t)row0_of(u.pm, mode) * 1024 + br * 256);
    u.B = (const char*)(Wl + W_BR + (size_t)(br * 1024 + pn * 256) * 256);
    return true;
  }
};
struct EpiProj {
  const half_t* gb; half_t* mbuf; int pm0, mode;
  DI bool operator()(f4 (&acc)[2][2][4][2], const GUnit& u, int wr, int wc, int fr, int fq) const {
    const int br = u.aux;
    const char* gp = (const char*)(gb + (size_t)((u.pm - pm0) * 256 + wr * 64) * 4096 + br * 1024 + u.pn * 256 + wc * 32);
    const unsigned glo = (unsigned)(fr * 4096 + 8 * fq) * 2u;
    h8 gq[2][4][2];
#pragma unroll
    for (int ai = 0; ai < 2; ++ai)
#pragma unroll
      for (int m = 0; m < 4; ++m)
#pragma unroll
        for (int bj = 0; bj < 2; ++bj) gq[ai][m][bj] = *(const h8*)(gp + ((size_t)(ai * 128 + m * 16) * 4096 + bj * 128) * 2 + glo);
#pragma unroll
    for (int ai = 0; ai < 2; ++ai)
#pragma unroll
      for (int m = 0; m < 4; ++m)
#pragma unroll
        for (int bj = 0; bj < 2; ++bj)
#pragma unroll
          for (int j = 0; j < 4; ++j) { acc[ai][bj][m][0][j] *= (float)gq[ai][m][bj][j]; acc[ai][bj][m][1][j] *= (float)gq[ai][m][bj][4 + j]; }
    if (br < 3) return true;
    char* mp = (char*)(mbuf + (size_t)(row0_of(u.pm, mode) + wr * 64) * 1024 + u.pn * 256 + wc * 32);
    const unsigned mlo = (unsigned)(fr * 1024 + 8 * fq) * 2u;
#pragma unroll
    for (int ai = 0; ai < 2; ++ai)
#pragma unroll
      for (int m = 0; m < 4; ++m)
#pragma unroll
        for (int bj = 0; bj < 2; ++bj)
          *(h8*)(mp + ((size_t)(ai * 128 + m * 16) * 1024 + bj * 128) * 2 + mlo) = pack8(acc[ai][bj][m][0], acc[ai][bj][m][1]);
    return false;
  }
};

__global__ void __launch_bounds__(NTHR) hybrid_block_megakernel(Params p) {
  __shared__ __attribute__((aligned(16))) char smem[SMEM_BYTES];
  char* ws = kp()->ws;
  if (ws == nullptr) cg::this_grid().sync();
  half_t* W = (half_t*)(ws + OFF_W);
  float* mods = (float*)(ws + OFF_MOD);
  float* xc = (float*)(ws + OFF_XC);
  half_t* hbuf = (half_t*)(ws + OFF_H);
  half_t* big = (half_t*)(ws + OFF_BIG);
  float* part = (float*)(ws + OFF_PART);
  LAS unsigned char* lds = (LAS unsigned char*)smem;
  const int G = gridDim.x, cblk = blockIdx.x;

  const int wv_ = __builtin_amdgcn_readfirstlane((int)threadIdx.x >> 6);
  volatile LAS unsigned* st = (volatile LAS unsigned*)(lds + GEMM_LDS);
  if (threadIdx.x < 4) st[threadIdx.x] = 0u;
  __syncthreads();
  xcd_barrier_post((unsigned*)(ws + OFF_BAR), wv_);

  phase_mods(mods, smem, wv_);
  {
    int base = 0;
    float* tile = (float*)smem;
    for (int l = 0; l < 2; ++l) {
      half_t* Wl = W + (size_t)l * W_LAYER;
      const float* win = kp()->w_in + (size_t)l * 1024 * 6496;
      tconv_job(win, 6496, 0, 1024, 1024, 192, 256, Wl + W_QK, base, tile, wv_);
      tconv_job(win, 6496, 192, 1024, 1024, 128, 256, Wl + W_QK + (size_t)256 * 1024, base, tile, wv_);
      tconv_job(win, 6496, 320, 1024, 1024, 32, 64, Wl + W_QK + (size_t)512 * 1024, base, tile, wv_);
      tconv_job(win, 6496, 352, 1024, 1024, 256, 256, Wl + W_QK + (size_t)576 * 1024, base, tile, wv_);
      tconv_job(win, 6496, 608, 1024, 1024, 256, 256, Wl + W_QK + (size_t)832 * 1024, base, tile, wv_);
      tconv_job(win, 6496, 1120, 1024, 1024, 256, 256, Wl + W_QK + (size_t)1088 * 1024, base, tile, wv_);
      tconv_job(win, 6496, 1376, 1024, 1024, 256, 256, Wl + W_QK + (size_t)1344 * 1024, base, tile, wv_);
      tconv_job(win, 6496, 1888, 1024, 1024, 256, 256, Wl + W_QK + (size_t)1600 * 1024, base, tile, wv_);
      tconv_job(win, 6496, 2144, 1024, 1024, 128, 192, Wl + W_QK + (size_t)1856 * 1024, base, tile, wv_);
      tconv_job(win, 6496, 864, 1024, 1024, 256, 256, Wl + W_V, base, tile, wv_);
      tconv_job(win, 6496, 1632, 1024, 1024, 256, 256, Wl + W_V + (size_t)256 * 1024, base, tile, wv_);
      tconv_job(win, 6496, 2272, 1024, 1024, 128, 256, Wl + W_V + (size_t)512 * 1024, base, tile, wv_);
      tconv_job(win, 6496, 2400, 1024, 1024, 4096, 4096, Wl + W_GATE, base, tile, wv_);
      for (int br = 0; br < 4; ++br)
        tconv_job(kp()->w_branch + ((size_t)l * 4 + br) * 256 * 1024, 1024, 0, 256, 256, 1024, 1024, Wl + W_BR + (size_t)br * 1024 * 256, base, tile, wv_);
      tconv_job(kp()->w_out + (size_t)l * 1024 * 1024, 1024, 0, 1024, 1024, 1024, 1024, Wl + W_OUT, base, tile, wv_);
      tconv_job(kp()->w_up + (size_t)l * 1024 * 4096, 4096, 0, 1024, 1024, 4096, 4096, Wl + W_UP, base, tile, wv_);
      tconv_job(kp()->w_down + (size_t)l * 4096 * 1024, 1024, 0, 4096, 4096, 1024, 1024, Wl + W_DOWN, base, tile, wv_);
      tconv_job(kp()->w_mla_uq + (size_t)l * 192 * 384, 384, 0, 256, 192, 384, 512, Wl + W_UQ, base, tile, wv_);
      for (int hh = 0; hh < 4; ++hh) {
        tconv_job(kp()->w_mla_ukv + (size_t)l * 128 * 512, 512, hh * 128, 256, 128, 64, 64, Wl + W_UK + (size_t)hh * 64 * 256, base, tile, wv_);
        tconv_job(kp()->w_mla_ukv + (size_t)l * 128 * 512, 512, hh * 128 + 64, 256, 128, 64, 64, Wl + W_UV + (size_t)hh * 64 * 256, base, tile, wv_);
      }
    }
  }
  xcd_barrier(ws, lds, wv_);

  for (int l = 0; l < 2; ++l) {
    const bool need_ctx = (l == 0);
    const bool skip_ctx = !need_ctx;
    const half_t* Wl = W + (size_t)l * W_LAYER;
    const float* mods_l = mods + (size_t)l * 17 * 6144;
    const float* xl_src = (l == 0) ? kp()->x : kp()->out;
    const float* xc_src = (l == 0) ? kp()->ctx : xc;
    const int nrt = skip_ctx ? 128 : 144;

    phase_norm(xl_src, xc_src, kp()->g_norm1 + l * 1024, mods_l, 0, 1024, hbuf, false, (l == 1) ? part : nullptr, nullptr, wv_);
    xcd_barrier(ws, lds, wv_);
    {
      SchedInproj S{{}, hbuf, Wl, G, cblk};
      EpiInproj E{big};
      gemm256<true>(lds, S, E, wv_);
    }
    xcd_barrier(ws, lds, wv_);
    {
      build_rope_tables((float2*)smem, wv_);
      half_t* zmla = big + B_ZMLA;
      norm_rows<192, 32, 0, false>(zmla, ZS, NTOK, kp()->g_mla_qa + l * 192, 1.f, nullptr, (const float2*)smem, wv_);
      norm_rows<128, 16, 0, false>(zmla + 256, ZS, NTOK, kp()->g_mla_kva + l * 128, 1.f, nullptr, (const float2*)smem, wv_);
      norm_rows<64, 8, 0, false>(big + B_QNA, 64, NTOK * 4, kp()->g_na_q + l * 64, 0.125f * LOG2E, nullptr, (const float2*)smem, wv_);
      norm_rows<64, 8, 0, false>(big + B_KNA, 64, NTOK * 4, kp()->g_na_k + l * 64, 1.f, nullptr, (const float2*)smem, wv_);
      norm_rows<32, 4, 32, false>(big + B_QDF, 32, NTOK * 8, kp()->g_diff_q + l * 32, 0.17677669529663687f * LOG2E, nullptr, (const float2*)smem, wv_);
      norm_rows<32, 4, 32, false>(big + B_KDF, 32, NTOK * 8, kp()->g_diff_k + l * 32, 1.f, nullptr, (const float2*)smem, wv_);
      norm_rows<64, 8, 64, false>(big + B_QG, 64, NTOK * 4, kp()->g_gqa_q + l * 64, 0.125f * LOG2E, nullptr, (const float2*)smem, wv_);
      norm_rows<64, 8, 64, false>(big + B_KG, 64, NTOK * 2, kp()->g_gqa_k + l * 64, 1.f, nullptr, (const float2*)smem, wv_);
    }
    xcd_barrier(ws, lds, wv_);
    {
      SchedMlaQK S{{}, Wl, big + B_ZMLA, G, cblk};
      EpiMla E{big};
      gemm256<true>(lds, S, E, wv_);
      SchedMlaV S2{{}, Wl, big + B_ZMLA, G, cblk};
      gemm256<true>(lds, S2, E, wv_);
    }
    xcd_barrier(ws, lds, wv_);
    build_rope_tables((float2*)smem, wv_);
    norm_rows<96, 16, 32, false>(big + B_QM, 96, NTOK * 4, kp()->g_mla_q + l * 96, 0.10206207261596575f * LOG2E, nullptr, (const float2*)smem, wv_);
    norm_rows<96, 16, 32, true>(big + B_KM, 96, NTOK * 4, kp()->g_mla_k + l * 96, 1.f, big + B_ZMLA, (const float2*)smem, wv_);
    xcd_barrier(ws, lds, wv_);
    phase_attn(l, big, need_ctx, smem, wv_);
    xcd_barrier(ws, lds, wv_);
    {
      const int nsp = need_ctx ? 3 : 2;
      for (int j = 0; j < nsp; ++j) {
        const int mode = (j < 2) ? 1 : 2, pm0 = (j < 2) ? j * 64 : 0, cnt = (j < 2) ? 64 : 16;
        {
          SchedGate S{{}, hbuf, Wl, pm0, cnt, G, cblk, mode};
          EpiGate E{big + B_G0, pm0};
          gemm256<false>(lds, S, E, wv_);
        }
        xcd_barrier(ws, lds, wv_);
        {
          SchedProj S{{}, big + B_O, Wl, pm0, cnt, G, cblk, mode};
          EpiProj E{big + B_G0, big + B_M, pm0, mode};
          gemm256<true>(lds, S, E, wv_);
        }
        xcd_barrier(ws, lds, wv_);
      }
    }
    {
      SchedResid S{{}, big + B_M, Wl + W_OUT, 1024, 4, need_ctx ? 16 : 0, G, cblk, 2048u, 2048u};
      EpiResid E{xl_src, kp()->out, part, mods_l, 2048};
      gemm256<false>(lds, S, E, wv_);
    }
    xcd_barrier(ws, lds, wv_);
    phase_norm(kp()->out, xc_src, kp()->g_norm2 + l * 1024, mods_l, 3072, 4096, hbuf, skip_ctx, need_ctx ? part : nullptr, need_ctx ? xc : nullptr, wv_);
    xcd_barrier(ws, lds, wv_);
    {
      SchedRows S{{}, hbuf, Wl + W_UP, 1024, nrt, 16, G, cblk, skip_ctx ? 1 : 0, 2048u, 2048u};
      EpiUp E{big + B_U, skip_ctx ? 1 : 0};
      gemm256<true>(lds, S, E, wv_);
    }
    xcd_barrier(ws, lds, wv_);
    {
      SchedResid S{{}, big + B_U, Wl + W_DOWN, 4096, 4, need_ctx ? 16 : 0, G, cblk, 8192u, 8192u};
      EpiResid E{kp()->out, kp()->out, part, mods_l, 5120};
      gemm256<false>(lds, S, E, wv_);
    }
    if (l == 0) xcd_barrier(ws, lds, wv_);
  }
}

extern "C" void kernel_launch(void* const* d_in, const int* in_sizes, int n_in, void* d_out, int out_size, void* d_ws,
                              size_t ws_size, hipStream_t stream) {
  static int grid_blocks = 0;
  if (!grid_blocks) {
    int dev = 0, cus = 0, per_cu = 0;
    (void)hipGetDevice(&dev);
    (void)hipDeviceGetAttribute(&cus, hipDeviceAttributeMultiprocessorCount, dev);
    (void)hipOccupancyMaxActiveBlocksPerMultiprocessor(&per_cu, hybrid_block_megakernel, NTHR, 0);
    if (per_cu < 1) fprintf(stderr, "occupancy query returned %d\n", per_cu);
    grid_blocks = cus;
  }
  if (ws_size < WS_NEED) fprintf(stderr, "workspace too small: %zu < %zu\n", ws_size, (size_t)WS_NEED);
  (void)hipMemsetAsync((char*)d_ws + OFF_BAR, 0, XCD_BAR_WORDS * 4, stream);
  Params p{};
  const float** pf = (const float**)&p;
  for (int i = 0; i < 31; ++i) pf[i] = (const float*)d_in[i];
  p.out = (float*)d_out;
  p.ws = (char*)d_ws;
  void* args[] = {&p};
  hipError_t e = hipLaunchCooperativeKernel((void*)hybrid_block_megakernel, dim3(grid_blocks), dim3(NTHR), args, 0, stream);
  if (e != hipSuccess) fprintf(stderr, "cooperative launch failed: %s (grid %d)\n", hipGetErrorString(e), grid_blocks);
}
```

```cpp
#include <hip/hip_runtime.h>
#include <hip/hip_cooperative_groups.h>
#include <cstdio>
namespace cg = cooperative_groups;

typedef _Float16 half_t;
typedef __attribute__((ext_vector_type(8))) _Float16 h8;
typedef __attribute__((ext_vector_type(4))) _Float16 h4;
typedef __attribute__((ext_vector_type(4))) float f4;
typedef __attribute__((ext_vector_type(2))) float f2;
typedef __attribute__((ext_vector_type(16))) float f16v;

#define DI __device__ __forceinline__
#define LAS __attribute__((address_space(3)))

constexpr int NB = 16, SEQ = 2048, CTX = 256, TOK = 2304, NTOK = NB * TOK;
constexpr float LOG2E = 1.4426950408889634f;
constexpr float EPS = 1e-6f;

constexpr int NQK = 1792;
constexpr int NVT = 768;
constexpr int ZS = 352;
constexpr size_t W_QK = 0;
constexpr size_t W_V = W_QK + (size_t)NQK * 1024;
constexpr size_t W_GATE = W_V + (size_t)NVT * 1024;
constexpr size_t W_BR = W_GATE + (size_t)4096 * 1024;
constexpr size_t W_OUT = W_BR + (size_t)4 * 1024 * 256;
constexpr size_t W_UP = W_OUT + (size_t)1024 * 1024;
constexpr size_t W_DOWN = W_UP + (size_t)4096 * 1024;
constexpr size_t W_UQ = W_DOWN + (size_t)1024 * 4096;
constexpr size_t W_UK = W_UQ + (size_t)512 * 256;
constexpr size_t W_UV = W_UK + (size_t)256 * 256;
constexpr size_t W_LAYER = W_UV + (size_t)256 * 256;

constexpr size_t al256(size_t x) { return (x + 255) & ~(size_t)255; }
constexpr size_t OFF_BAR = 0;
constexpr size_t OFF_W = 16384;
constexpr size_t OFF_MOD = al256(OFF_W + 2 * W_LAYER * 2);
constexpr size_t OFF_XC = al256(OFF_MOD + (size_t)2 * 17 * 6144 * 4);
constexpr size_t OFF_H = al256(OFF_XC + (size_t)NB * CTX * 1024 * 4);
constexpr size_t OFF_BIG = al256(OFF_H + (size_t)NTOK * 1024 * 2);
constexpr size_t B_O = 0;
constexpr size_t B_QM = B_O + (size_t)NTOK * 1024;
constexpr size_t B_KM = B_QM + (size_t)NTOK * 384;
constexpr size_t B_VTM = B_KM + (size_t)NTOK * 384;
constexpr size_t B_QNA = B_VTM + (size_t)NTOK * 256;
constexpr size_t B_KNA = B_QNA + (size_t)NTOK * 256;
constexpr size_t B_VTNA = B_KNA + (size_t)NTOK * 256;
constexpr size_t B_QDF = B_VTNA + (size_t)NTOK * 256;
constexpr size_t B_KDF = B_QDF + (size_t)NTOK * 256;
constexpr size_t B_VTDF = B_KDF + (size_t)NTOK * 256;
constexpr size_t B_QG = B_VTDF + (size_t)NTOK * 256;
constexpr size_t B_KG = B_QG + (size_t)NTOK * 256;
constexpr size_t B_VTG = B_KG + (size_t)NTOK * 128;
constexpr size_t B_ZMLA = B_VTG + (size_t)NTOK * 128;
constexpr size_t B_END = B_ZMLA + (size_t)NTOK * ZS;
constexpr size_t B_M = B_O + (size_t)NTOK * 1024;
constexpr size_t GSLAB = (size_t)64 * 256 * 4096;
constexpr size_t B_G0 = B_M + (size_t)NTOK * 1024;
constexpr size_t B_P5END = B_G0 + GSLAB;
constexpr size_t B_U = 0;
constexpr size_t B_MAX = B_END > B_P5END ? B_END : B_P5END;
constexpr size_t OFF_PART = OFF_BIG + (size_t)NTOK * 4096 * 2;
constexpr size_t WS_NEED = (OFF_BIG + B_MAX * 2) > (OFF_PART + (size_t)4 * NB * CTX * 1024 * 4) ? (OFF_BIG + B_MAX * 2) : (OFF_PART + (size_t)4 * NB * CTX * 1024 * 4);
static_assert(B_P5END * 2 <= (size_t)NTOK * 4096 * 2, "merge buffers must end before the partial buffer");
static_assert(B_MAX >= (size_t)NTOK * 4096, "u must fit");
static_assert(WS_NEED <= (size_t)536870912, "workspace budget");

constexpr int NTHR = 512, NWAVE = 8;
constexpr int GEMM_LDS = 131072;
constexpr int SMEM_BYTES = GEMM_LDS + 16;

struct Params {
  const float *x, *c, *ctx, *c_ctx, *w_ada, *b_ada, *g_norm1, *g_norm2, *w_in;
  const float *g_mla_qa, *w_mla_uq, *g_mla_kva, *w_mla_ukv, *g_mla_q, *g_mla_k;
  const float *g_na_q, *g_na_k, *na_rpb;
  const float *g_diff_q, *g_diff_k, *lq1, *lk1, *lq2, *lk2, *g_diff_sub;
  const float *g_gqa_q, *g_gqa_k, *w_branch, *w_out, *w_up, *w_down;
  float* out;
  char* ws;
};


typedef const Params __attribute__((address_space(4))) * KPtr;
DI KPtr kp() {
  KPtr q = (KPtr)__builtin_amdgcn_kernarg_segment_ptr();
  asm volatile("" : "+s"(q));
  return q;
}

DI int tid_opaque(int wv_) {
  unsigned z = 0u;
  asm volatile("" : "+v"(z));
  int t = (wv_ << 6) | (int)__builtin_amdgcn_mbcnt_hi(~0u, __builtin_amdgcn_mbcnt_lo(~0u, z));
  asm volatile("" : "+v"(t));
  return t;
}

DI float wave_sum(float v) {
#pragma unroll
  for (int o = 32; o > 0; o >>= 1) v += __shfl_xor(v, o);
  return v;
}

#define XB_TMO      128
#define XB_XCNT(j)  (256  + 64 * (j))
#define XB_XSUB(j)  (1280 + 64 * (j))
#define XB_XGEN(j)  (2304 + 64 * (j))
#define XB_TOP      3328
#define XB_TOPGEN   3392
#define XCD_BAR_WORDS 3456
#define XB_SPIN_CAP (1u << 22)
DI unsigned xb_ld(unsigned* p) { return __hip_atomic_load(p, __ATOMIC_RELAXED, __HIP_MEMORY_SCOPE_AGENT); }
DI unsigned xb_add(unsigned* p, unsigned v) { return __hip_atomic_fetch_add(p, v, __ATOMIC_RELAXED, __HIP_MEMORY_SCOPE_AGENT); }
DI unsigned xb_xcc_id() { return (unsigned)__builtin_amdgcn_s_getreg((3 << 11) | 20) & 0xFu; }
#define XB_SPIN(cond, bar) do { unsigned _sp = 0; while (cond) { __builtin_amdgcn_s_sleep(1); \
    if ((++_sp & 255u) == 0u) { if (xb_ld(&(bar)[XB_TMO])) break; if (_sp > XB_SPIN_CAP) { atomicAdd(&(bar)[XB_TMO], 1u); break; } } } } while (0)
DI void xcd_barrier_post(unsigned* bar, int wv_) {
  if (tid_opaque(wv_) == 0) (void)xb_add(&bar[XB_XCNT(xb_xcc_id())], 1u);
}
DI void xcd_barrier_complete(unsigned* bar, unsigned x, unsigned& nloc, unsigned& nx) {
  const unsigned G = gridDim.x * gridDim.y * gridDim.z;
  unsigned sum, cnt, mine, sp = 0u;
  for (;;) {
    sum = 0u; cnt = 0u; mine = 0u;
#pragma unroll
    for (unsigned j = 0; j < 16; ++j) { const unsigned c = xb_ld(&bar[XB_XCNT(j)]); sum += c; cnt += (c > 0u) ? 1u : 0u; mine = (j == x) ? c : mine; }
    if (sum == G) break;
    __builtin_amdgcn_s_sleep(1);
    if ((++sp & 255u) == 0u) { if (xb_ld(&bar[XB_TMO])) break; if (sp > XB_SPIN_CAP) { atomicAdd(&bar[XB_TMO], 1u); break; } }
  }
  nloc = mine > 0u ? mine : 1u; nx = cnt > 0u ? cnt : 1u;
}
DI void xcd_barrier(char* ws_, LAS unsigned char* lds_, int wv_) {
  asm volatile("s_waitcnt vmcnt(0)" ::: "memory");
  __syncthreads();
  if (tid_opaque(wv_) == 0) {
    char* wsl = ws_;
    asm volatile("" : "+s"(wsl));
    unsigned* bar = (unsigned*)(wsl + OFF_BAR);
    volatile LAS unsigned* st = (volatile LAS unsigned*)(lds_ + GEMM_LDS);
    const unsigned x = xb_xcc_id();
    __builtin_amdgcn_s_waitcnt(0);
    unsigned nloc = st[0], nx = st[1];
    if (nloc == 0u) { xcd_barrier_complete(bar, x, nloc, nx); st[0] = nloc; st[1] = nx; }
    const unsigned old = xb_add(&bar[XB_XSUB(x)], 1u);
    const unsigned gen = old / nloc;
    if (old + 1u == (gen + 1u) * nloc) {
      __builtin_amdgcn_fence(__ATOMIC_RELEASE, "agent");
      asm volatile("s_waitcnt vmcnt(0)" ::: "memory");
      const unsigned og = xb_add(&bar[XB_TOP], 1u);
      const unsigned tg = og / nx;
      if (og + 1u == (tg + 1u) * nx) xb_add(&bar[XB_TOPGEN], 1u);
      else XB_SPIN(xb_ld(&bar[XB_TOPGEN]) == tg, bar);
      __builtin_amdgcn_fence(__ATOMIC_ACQUIRE, "agent");
      xb_add(&bar[XB_XGEN(x)], 1u);
      asm volatile("s_waitcnt vmcnt(0)" ::: "memory");
    } else {
      XB_SPIN(xb_ld(&bar[XB_XGEN(x)]) == gen, bar);
      __builtin_amdgcn_fence(__ATOMIC_ACQUIRE, "agent");
      asm volatile("s_waitcnt vmcnt(0)" ::: "memory");
    }
  }
  __syncthreads();
}

DI void phase_mods(float* mods, char* smem, int wv_) {
  const KPtr p = kp();
  float* sil = (float*)smem;
  const int tid = tid_opaque(wv_);
  for (int w = blockIdx.x; w < 192; w += gridDim.x) {
    const int l = w / 96, n0 = (w % 96) * 64;
    __syncthreads();
    for (int idx = tid; idx < 17 * 1024; idx += NTHR) {
      const int b = idx >> 10, k = idx & 1023;
      const float v = (b < 16) ? p->c[b * 1024 + k] : p->c_ctx[k];
      sil[idx] = v / (1.f + expf(-v));
    }
    __syncthreads();
    const int kq = tid >> 6, nn = tid & 63;
    float acc[17];
#pragma unroll
    for (int b = 0; b < 17; ++b) acc[b] = 0.f;
    const float* wp = p->w_ada + (size_t)l * 1024 * 6144 + (size_t)(kq * 128) * 6144 + n0 + nn;
    const float* sp = sil + kq * 128;
#pragma unroll 4
    for (int k = 0; k < 128; ++k) {
      const float wv = wp[(size_t)k * 6144];
#pragma unroll
      for (int b = 0; b < 17; ++b) acc[b] += sp[b * 1024 + k] * wv;
    }
    __syncthreads();
    float* red = (float*)smem;
#pragma unroll
    for (int b = 0; b < 17; ++b) red[(kq * 17 + b) * 64 + nn] = acc[b];
    __syncthreads();
    for (int idx = tid; idx < 17 * 64; idx += NTHR) {
      float s = p->b_ada[l * 6144 + n0 + (idx & 63)];
#pragma unroll
      for (int q = 0; q < 8; ++q) s += red[q * 17 * 64 + idx];
      mods[((size_t)l * 17 + (idx >> 6)) * 6144 + n0 + (idx & 63)] = s;
    }
  }
  __syncthreads();
}

DI void tconv_job(const float* src, int ld, int c0, int K, int Kvalid, int Nvalid, int Npad, half_t* dst, int& base,
                  float* tile, int wv_, int Nwrite = -1, int kshift = 0) {
  if (Nwrite < 0) Nwrite = Npad;
  const int nnt = Npad / 64, tot = (K / 64) * nnt;
  const int G = gridDim.x;
  const int start = (int)((blockIdx.x + G - (base % G)) % G);
  const int tid_ = tid_opaque(wv_);
  const int tx = tid_ & 63, ty = tid_ >> 6;
  for (int t = start; t < tot; t += 2 * G) {
    const int t2 = t + G;
    const bool has2 = t2 < tot;
    const int kt = t / nnt, nt = t % nnt, kt2 = has2 ? t2 / nnt : kt, nt2 = has2 ? t2 % nnt : nt;
    float r0[8], r1[8];
#pragma unroll
    for (int i = 0; i < 8; ++i) {
      const int k = i * 8 + ty, n = nt * 64 + tx, n2 = nt2 * 64 + tx;
      const int ks0 = kt * 64 + k - kshift, ks1 = kt2 * 64 + k - kshift;
      r0[i] = (n < Nvalid && ks0 >= 0 && ks0 < Kvalid) ? src[(size_t)ks0 * ld + c0 + n] : 0.f;
      r1[i] = (has2 && n2 < Nvalid && ks1 >= 0 && ks1 < Kvalid) ? src[(size_t)ks1 * ld + c0 + n2] : 0.f;
    }
    __syncthreads();
#pragma unroll
    for (int i = 0; i < 8; ++i) {
      tile[(i * 8 + ty) * 65 + tx] = r0[i];
      tile[64 * 65 + (i * 8 + ty) * 65 + tx] = r1[i];
    }
    __syncthreads();
#pragma unroll
    for (int i = 0; i < 8; ++i) {
      const int n = i * 8 + ty;
      if (nt * 64 + n < Nwrite) dst[(size_t)(nt * 64 + n) * K + kt * 64 + tx] = (half_t)tile[tx * 65 + n];
      if (has2 && nt2 * 64 + n < Nwrite) dst[(size_t)(nt2 * 64 + n) * K + kt2 * 64 + tx] = (half_t)tile[64 * 65 + tx * 65 + n];
    }
  }
  base += tot;
}

struct NormRow { const float* mod; int g, b, t; bool valid, isctx; };
DI void norm_load(int g, const float* xl, const float* xc, const float* mods_l, bool skip_ctx, int lane, float4 (&v)[4], NormRow& r) {
  r.g = g; r.valid = g < NTOK;
  const int gg = r.valid ? g : 0;
  r.b = gg / TOK; r.t = gg - r.b * TOK;
  r.isctx = r.t >= SEQ;
  if (r.isctx && skip_ctx) r.valid = false;
  const float* src = r.isctx ? xc + ((size_t)r.b * CTX + (r.t - SEQ)) * 1024 : xl + ((size_t)r.b * SEQ + r.t) * 1024;
  r.mod = mods_l + (size_t)(r.isctx ? 16 : r.b) * 6144;
  if (r.valid) {
#pragma unroll
    for (int i = 0; i < 4; ++i) v[i] = *(const float4*)(src + i * 256 + lane * 4);
  } else {
#pragma unroll
    for (int i = 0; i < 4; ++i) v[i] = float4{0.f, 0.f, 0.f, 0.f};
  }
}
DI void norm_finish(float4 (&v)[4], const NormRow& r, const float* gam, int sh_off, int sc_off, half_t* h, const float* part, float* xc_store, int lane) {
  if (r.valid && r.isctx && part != nullptr) {
    const size_t ro = ((size_t)r.b * CTX + (r.t - SEQ)) * 1024;
#pragma unroll
    for (int i = 0; i < 4; ++i) {
#pragma unroll
      for (int ks = 0; ks < 4; ++ks) {
        const float4 pv = *(const float4*)(part + (size_t)ks * NB * CTX * 1024 + ro + i * 256 + lane * 4);
        v[i].x += pv.x; v[i].y += pv.y; v[i].z += pv.z; v[i].w += pv.w;
      }
      if (xc_store != nullptr) *(float4*)(xc_store + ro + i * 256 + lane * 4) = v[i];
    }
  }
  float ss = 0.f;
#pragma unroll
  for (int i = 0; i < 4; ++i) ss += v[i].x * v[i].x + v[i].y * v[i].y + v[i].z * v[i].z + v[i].w * v[i].w;
  ss = wave_sum(ss);
  if (!r.valid) return;
  const float rstd = rsqrtf(ss * (1.f / 1024.f) + EPS);
#pragma unroll
  for (int i = 0; i < 4; ++i) {
    const int col = i * 256 + lane * 4;
    const float4 gg = *(const float4*)(gam + col);
    const float4 sc = *(const float4*)(r.mod + sc_off + col);
    const float4 sh = *(const float4*)(r.mod + sh_off + col);
    h4 o;
    o[0] = (half_t)(v[i].x * rstd * gg.x * (1.f + sc.x) + sh.x);
    o[1] = (half_t)(v[i].y * rstd * gg.y * (1.f + sc.y) + sh.y);
    o[2] = (half_t)(v[i].z * rstd * gg.z * (1.f + sc.z) + sh.z);
    o[3] = (half_t)(v[i].w * rstd * gg.w * (1.f + sc.w) + sh.w);
    *(h4*)(h + (size_t)r.g * 1024 + col) = o;
  }
}
DI void phase_norm(const float* xl, const float* xc, const float* gam, const float* mods_l, int sh_off,
                   int sc_off, half_t* h, bool skip_ctx, const float* part, float* xc_store, int wv_) {
  const int tid_ = tid_opaque(wv_);
  const int wave = tid_ >> 6, lane = tid_ & 63;
  const int stride = gridDim.x * NWAVE;
  for (int g = blockIdx.x * NWAVE + wave; g < NTOK; g += 2 * stride) {
    float4 v0[4], v1[4];
    NormRow r0, r1;
    norm_load(g, xl, xc, mods_l, skip_ctx, lane, v0, r0);
    norm_load(g + stride, xl, xc, mods_l, skip_ctx, lane, v1, r1);
    norm_finish(v0, r0, gam, sh_off, sc_off, h, part, xc_store, lane);
    norm_finish(v1, r1, gam, sh_off, sc_off, h, part, xc_store, lane);
  }
}

constexpr int BK = 64, HALF = 128, HTB = HALF * BK * 2;
DI int lds_byte(int r, int c) { const int st = (r >> 4) * 2 + (c >> 5), rr = r & 15, cc = c & 31, ob = rr * 64 + cc * 2; return st * 1024 + (ob ^ (((ob >> 9) & 1) << 5)); }
DI void stage_rc(int b, int& R, int& C) { const int st = b / 1024, sb = b % 1024, swz = sb ^ (((sb >> 9) & 1) << 5); R = (st >> 1) * 16 + swz / 64; C = (st & 1) * 32 + (swz % 64) / 2; }
DI int perm32(int rho) { const int n = rho >> 4, i = rho & 15; return 8 * (i >> 2) + 4 * n + (i & 3); }

struct SchedBase {
  static DI int bmap(bool perm, int R) { return perm ? ((R & ~31) + perm32(R & 31)) : R; }
  static constexpr int BHALF = 128;
  static constexpr bool CHAIN = false;
};
struct GUnit { const char* A; const char* B; int nt, pm, pn, aux, ks; };

DI bool tile_map(int L, int nM, int nN, int& pm, int& pn) {
  const int nwg = nM * nN;
  if (L >= nwg) return false;
  int wgid = L;
  { const int q = nwg / 8, r = nwg % 8, xcd = wgid % 8, off = wgid / 8; wgid = (xcd < r ? xcd * (q + 1) : r * (q + 1) + (xcd - r) * q) + off; }
  const int nig = 8 * nN, gid = wgid / nig, fm = gid * 8, gsz = (nM - fm) < 8 ? (nM - fm) : 8;
  pm = fm + ((wgid % nig) % gsz); pn = (wgid % nig) / gsz;
  return true;
}

template <bool PERM, class Sched, class Epi>
DI void gemm256(LAS unsigned char* lds, const Sched& S, const Epi& E, int wv_) {
  const int tid = tid_opaque(wv_), wid = __builtin_amdgcn_readfirstlane(tid >> 6), lane = tid & 63, wr = wid >> 2, wc = wid & 3, fr = lane & 15, fq = lane >> 4;
  unsigned cvA0, cvA1, cvB0, cvB1;
  { int R, C;
    stage_rc(tid * 16, R, C); cvA0 = (unsigned)R * S.lda2 + C * 2; cvB0 = (unsigned)Sched::bmap(PERM, R) * S.ldb2 + C * 2;
    stage_rc(tid * 16 + 8192, R, C); cvA1 = (unsigned)R * S.lda2 + C * 2; cvB1 = (unsigned)Sched::bmap(PERM, R) * S.ldb2 + C * 2; }
  const size_t chA = (size_t)HALF * S.lda2, chB = (size_t)Sched::BHALF * S.ldb2;
  const size_t kstep = (size_t)(BK * 2);
  const unsigned ldsw = (unsigned)wid * 1024u;
  const int aoff = lds_byte(wr * 64 + fr, fq * 8), boff = lds_byte(wc * 32 + fr, fq * 8);
#define G_SA(b, h) (((b) * 2 + (h)) * HTB)
#define G_SB(b, h) ((4 + (b) * 2 + (h)) * HTB)
#define G_STAGE(bufoff, gbase, v0, v1) do { \
    __builtin_amdgcn_global_load_lds((const unsigned*)((const char*)(gbase) + (v0)), (LAS unsigned*)(lds + (bufoff) + ldsw), 16, 0, 0); \
    __builtin_amdgcn_global_load_lds((const unsigned*)((const char*)(gbase) + (v1)), (LAS unsigned*)(lds + (bufoff) + ldsw + 8192), 16, 0, 0); } while (0)
#define G_LDA(dst, b, h) do { _Pragma("unroll") for (int m = 0; m < 4; ++m) _Pragma("unroll") for (int k = 0; k < 2; ++k) dst[m][k] = *(const LAS h8*)(lds + G_SA(b, h) + aoff + m * 2048 + k * 1024); } while (0)
#define G_LDB(dst, b, h) do { _Pragma("unroll") for (int n = 0; n < 2; ++n) _Pragma("unroll") for (int k = 0; k < 2; ++k) dst[n][k] = *(const LAS h8*)(lds + G_SB(b, h) + boff + n * 2048 + k * 1024); } while (0)
#define G_MMA(ai, bj, At, Bt) do { __builtin_amdgcn_s_setprio(1); _Pragma("unroll") for (int m = 0; m < 4; ++m) _Pragma("unroll") for (int n = 0; n < 2; ++n) _Pragma("unroll") for (int k = 0; k < 2; ++k) \
    acc[ai][bj][m][n] = __builtin_amdgcn_mfma_f32_16x16x32_f16(Bt[n][k], At[m][k], acc[ai][bj][m][n], 0, 0, 0); __builtin_amdgcn_s_setprio(0); } while (0)
#define G_WAIT_V(n) asm volatile("s_waitcnt vmcnt(" #n ")" ::: "memory")
#define G_WAIT_L(n) asm volatile("s_waitcnt lgkmcnt(" #n ")" ::: "memory")
#define G_BAR __builtin_amdgcn_s_barrier()
#define G_SCHED __builtin_amdgcn_sched_barrier(0)
  GUnit cur, nxt;
  int ui = 0;
  if (!S.next(0, cur)) return;
  f4 acc[2][2][4][2];
#pragma unroll
  for (int a = 0; a < 2; ++a)
#pragma unroll
    for (int b = 0; b < 2; ++b)
#pragma unroll
      for (int m = 0; m < 4; ++m)
#pragma unroll
        for (int n = 0; n < 2; ++n) acc[a][b][m][n] = f4{0.f, 0.f, 0.f, 0.f};
  h8 At[4][2], B0[2][2], B1[2][2];
  const char* cA = cur.A;
  const char* cB = cur.B;
  G_STAGE(G_SB(0, 0), cB, cvB0, cvB1); G_STAGE(G_SA(0, 0), cA, cvA0, cvA1); G_STAGE(G_SB(0, 1), cB + chB, cvB0, cvB1); G_STAGE(G_SA(0, 1), cA + chA, cvA0, cvA1);
  if (wr == 1) G_BAR;
  G_WAIT_V(4); G_BAR;
  G_STAGE(G_SB(1, 0), cB + kstep, cvB0, cvB1); G_STAGE(G_SA(1, 0), cA + kstep, cvA0, cvA1); G_STAGE(G_SB(1, 1), cB + chB + kstep, cvB0, cvB1);
  G_WAIT_V(6); G_BAR;
  for (;;) {
    const bool has_next = S.next(ui + 1, nxt);
    const char* nA = has_next ? nxt.A : cA;
    const char* nB = has_next ? nxt.B : cB;
    int nt = cur.nt;
    asm volatile("" : "+s"(nt));
    for (int t = 0; t < nt; t += 2) {
      const bool last = (t == nt - 2);
      const char* a1 = cA + (size_t)(t + 1) * kstep;
      const char* a2 = last ? nA : cA + (size_t)(t + 2) * kstep;
      const char* b2 = last ? nB : cB + (size_t)(t + 2) * kstep;
      const char* a3 = a2 + kstep;
      const char* b3 = b2 + kstep;
      G_LDB(B0, 0, 0); G_SCHED; G_LDA(At, 0, 0); G_STAGE(G_SA(1, 1), a1 + chA, cvA0, cvA1);
      G_WAIT_L(8); G_BAR; G_WAIT_L(0); G_MMA(0, 0, At, B0); G_BAR; G_SCHED;
      G_LDB(B1, 0, 1); G_STAGE(G_SB(0, 0), b2, cvB0, cvB1);
      G_BAR; G_WAIT_L(0); G_MMA(0, 1, At, B1); G_BAR;
      G_LDA(At, 0, 1); G_STAGE(G_SA(0, 0), a2, cvA0, cvA1);
      G_BAR; G_WAIT_L(0); G_MMA(1, 0, At, B0); G_BAR; G_SCHED;
      G_STAGE(G_SB(0, 1), b2 + chB, cvB0, cvB1);
      G_WAIT_V(6); G_BAR; G_MMA(1, 1, At, B1); G_BAR;
      G_LDB(B0, 1, 0); G_SCHED; G_LDA(At, 1, 0); G_STAGE(G_SA(0, 1), a2 + chA, cvA0, cvA1);
      G_WAIT_L(8); G_BAR; G_WAIT_L(0); G_MMA(0, 0, At, B0); G_BAR; G_SCHED;
      G_LDB(B1, 1, 1); G_STAGE(G_SB(1, 0), b3, cvB0, cvB1);
      G_BAR; G_WAIT_L(0); G_MMA(0, 1, At, B1); G_BAR;
      G_LDA(At, 1, 1); G_STAGE(G_SA(1, 0), a3, cvA0, cvA1);
      G_BAR; G_WAIT_L(0); G_MMA(1, 0, At, B0); G_BAR; G_SCHED;
      G_STAGE(G_SB(1, 1), b3 + chB, cvB0, cvB1);
      G_WAIT_V(6); G_BAR; G_MMA(1, 1, At, B1); G_BAR;
    }
    bool keep = false;
    if constexpr (Sched::CHAIN) keep = E(acc, cur, wr, wc, fr, fq); else E(acc, cur, wr, wc, fr, fq);
    if (!has_next) break;
    if (!keep) {
#pragma unroll
      for (int a = 0; a < 2; ++a)
#pragma unroll
        for (int b = 0; b < 2; ++b)
#pragma unroll
          for (int m = 0; m < 4; ++m)
#pragma unroll
            for (int n = 0; n < 2; ++n) acc[a][b][m][n] = f4{0.f, 0.f, 0.f, 0.f};
    }
    cur = nxt; cA = nA; cB = nB; ++ui;
  }
  G_WAIT_V(0);
  if (wr == 0) G_BAR;
  G_BAR;
#undef G_SA
#undef G_SB
#undef G_STAGE
#undef G_LDA
#undef G_LDB
#undef G_MMA
#undef G_WAIT_V
#undef G_WAIT_L
#undef G_BAR
#undef G_SCHED
}

DI h8 pack8(const f4& a, const f4& b) {
  h8 o;
  o[0] = (half_t)a[0]; o[1] = (half_t)a[1]; o[2] = (half_t)a[2]; o[3] = (half_t)a[3];
  o[4] = (half_t)b[0]; o[5] = (half_t)b[1]; o[6] = (half_t)b[2]; o[7] = (half_t)b[3];
  return o;
}
DI int row0_of(int pm, int mode) { return mode == 0 ? pm * 256 : (mode == 1 ? (pm >> 3) * TOK + (pm & 7) * 256 : pm * TOK + SEQ); }

struct SchedInproj : SchedBase {
  const half_t* hbuf; const half_t* Wl; int G, c;
  static constexpr unsigned lda2 = 2048, ldb2 = 2048;
  DI bool next(int i, GUnit& u) const {
    const int L = i * G + c;
    u.nt = 16;
    if (L < 144 * 7) {
      tile_map(L, 144, 7, u.pm, u.pn);
      u.A = (const char*)(hbuf + (size_t)u.pm * 256 * 1024); u.B = (const char*)(Wl + W_QK + (size_t)u.pn * 256 * 1024); u.aux = 0;
      return true;
    }
    if (!tile_map(L - 144 * 7, 3, 144, u.pm, u.pn)) return false;
    u.A = (const char*)(Wl + W_V + (size_t)u.pm * 256 * 1024); u.B = (const char*)(hbuf + (size_t)u.pn * 256 * 1024); u.aux = 1;
    return true;
  }
};
struct EpiInproj {
  half_t* big;
  DI void operator()(const f4 (&acc)[2][2][4][2], const GUnit& u, int wr, int wc, int fr, int fq) const {
    if (u.aux == 0) {
      const int g0 = u.pm * 256, b = g0 / TOK, t0 = g0 - b * TOK + wr * 64;
#pragma unroll
      for (int bj = 0; bj < 2; ++bj) {
        const int cb = u.pn * 256 + bj * 128 + wc * 32;
        half_t* ptr; int ts;
        if (cb < 352) { ptr = big + B_ZMLA + (size_t)b * TOK * ZS + cb; ts = ZS; }
        else if (cb < 864) { const int c = cb - 352, part = c >> 8, hh = (c >> 6) & 3; ptr = big + (part ? B_KNA : B_QNA) + (size_t)(b * 4 + hh) * TOK * 64 + (c & 63); ts = 64; }
        else if (cb < 1376) { const int c = cb - 864, part = c >> 8, hm = (c >> 5) & 7; ptr = big + (part ? B_KDF : B_QDF) + (size_t)(b * 8 + hm) * TOK * 32; ts = 32; }
        else if (cb < 1632) { const int c = cb - 1376; ptr = big + B_QG + (size_t)(b * 4 + (c >> 6)) * TOK * 64 + (c & 63); ts = 64; }
        else if (cb < 1760) { const int c = cb - 1632; ptr = big + B_KG + (size_t)(b * 2 + (c >> 6)) * TOK * 64 + (c & 63); ts = 64; }
        else continue;
        const unsigned lo = (unsigned)(fr * ts + 8 * fq) * 2u;
        char* rb = (char*)(ptr + (size_t)t0 * ts);
#pragma unroll
        for (int ai = 0; ai < 2; ++ai)
#pragma unroll
          for (int m = 0; m < 4; ++m)
            *(h8*)(rb + (size_t)((ai * 128 + m * 16) * ts) * 2 + lo) = pack8(acc[ai][bj][m][0], acc[ai][bj][m][1]);
      }
    } else {
      const int g0 = u.pn * 256, b = g0 / TOK, t0 = g0 - b * TOK;
      const int nh = (u.pm == 2) ? 2 : 4;
      char* vt = (char*)(big + (u.pm == 0 ? B_VTNA : (u.pm == 1 ? B_VTDF : B_VTG)) + (size_t)b * nh * 64 * TOK + (size_t)(wr * 64) * TOK + t0 + wc * 32);
      const unsigned lo = (unsigned)(fr * TOK + 8 * fq) * 2u;
#pragma unroll
      for (int ai = 0; ai < 2; ++ai) {
        if (u.pm == 2 && ai == 1) continue;
#pragma unroll
        for (int m = 0; m < 4; ++m)
#pragma unroll
          for (int bj = 0; bj < 2; ++bj)
            *(h8*)(vt + ((size_t)(ai * 128 + m * 16) * TOK + bj * 128) * 2 + lo) = pack8(acc[ai][bj][m][0], acc[ai][bj][m][1]);
      }
    }
  }
};

struct SchedMlaQK : SchedBase {
  const half_t* Wl; const half_t* zmla; int G, c;
  static constexpr unsigned lda2 = ZS * 2, ldb2 = 512;
  DI bool next(int i, GUnit& u) const {
    const int L = i * G + c;
    u.nt = 4;
    if (L < 288) {
      tile_map(L, 144, 2, u.pm, u.pn);
      u.A = (const char*)(zmla + 96 + (size_t)u.pm * 256 * ZS);
      u.B = (const char*)(Wl + W_UQ + (size_t)u.pn * 256 * 256); u.aux = 0;
      return true;
    }
    if (L < 432) {
      u.pm = L - 288; u.pn = 0;
      u.A = (const char*)(zmla + (size_t)u.pm * 256 * ZS);
      u.B = (const char*)(Wl + W_UK); u.aux = 1;
      return true;
    }
    return false;
  }
};
struct SchedMlaV : SchedBase {
  const half_t* Wl; const half_t* zmla; int G, c;
  static constexpr unsigned lda2 = 512, ldb2 = ZS * 2;
  DI bool next(int i, GUnit& u) const {
    const int L = i * G + c;
    if (L >= 144) return false;
    u.nt = 4; u.pm = 0; u.pn = L;
    u.A = (const char*)(Wl + W_UV);
    u.B = (const char*)(zmla + (size_t)u.pn * 256 * ZS); u.aux = 2;
    return true;
  }
};
struct EpiMla {
  half_t* big;
  DI void operator()(const f4 (&acc)[2][2][4][2], const GUnit& u, int wr, int wc, int fr, int fq) const {
    if (u.aux < 2) {
      const int g0 = u.pm * 256, b = g0 / TOK, t0 = g0 - b * TOK + wr * 64;
      const unsigned lo = (unsigned)(fr * 96 + 8 * fq) * 2u;
#pragma unroll
      for (int bj = 0; bj < 2; ++bj) {
        const int cb = u.pn * 256 + bj * 128 + wc * 32;
        half_t* ptr;
        if (u.aux == 0) {
          if (cb >= 384) continue;
          const int hh = cb / 96, dd = cb - hh * 96;
          ptr = big + B_QM + (size_t)(b * 4 + hh) * TOK * 96 + dd;
        } else {
          ptr = big + B_KM + (size_t)(b * 4 + (cb >> 6)) * TOK * 96 + (cb & 63);
        }
        char* rb = (char*)(ptr + (size_t)t0 * 96);
#pragma unroll
        for (int ai = 0; ai < 2; ++ai)
#pragma unroll
          for (int m = 0; m < 4; ++m)
            *(h8*)(rb + (size_t)((ai * 128 + m * 16) * 96) * 2 + lo) = pack8(acc[ai][bj][m][0], acc[ai][bj][m][1]);
      }
    } else {
      const int g0 = u.pn * 256, b = g0 / TOK, t0 = g0 - b * TOK;
      char* vt = (char*)(big + B_VTM + (size_t)b * 4 * 64 * TOK + (size_t)(wr * 64) * TOK + t0 + wc * 32);
      const unsigned lo = (unsigned)(fr * TOK + 8 * fq) * 2u;
#pragma unroll
      for (int ai = 0; ai < 2; ++ai)
#pragma unroll
        for (int m = 0; m < 4; ++m)
#pragma unroll
          for (int bj = 0; bj < 2; ++bj)
            *(h8*)(vt + ((size_t)(ai * 128 + m * 16) * TOK + bj * 128) * 2 + lo) = pack8(acc[ai][bj][m][0], acc[ai][bj][m][1]);
    }
  }
};

struct SchedRows : SchedBase {
  const half_t* A; const half_t* B; int K, nM, nN, G, c; int mode; unsigned lda2, ldb2;
  DI bool next(int i, GUnit& u) const {
    if (!tile_map(i * G + c, nM, nN, u.pm, u.pn)) return false;
    u.A = (const char*)(A + (size_t)row0_of(u.pm, mode) * K); u.B = (const char*)(B + (size_t)u.pn * 256 * K);
    u.nt = K >> 6; u.aux = 0;
    return true;
  }
};
struct SchedResid : SchedBase {
  const half_t* A; const half_t* B; int K, nN, nctx, G, c; unsigned lda2, ldb2;
  DI bool next(int i, GUnit& u) const {
    const int L = i * G + c, nfull = 128 * nN;
    if (L < nfull) {
      tile_map(L, 128, nN, u.pm, u.pn);
      u.A = (const char*)(A + (size_t)row0_of(u.pm, 1) * K); u.B = (const char*)(B + (size_t)u.pn * 256 * K);
      u.nt = K >> 6; u.aux = 0;
      return true;
    }
    const int L2 = L - nfull;
    if (L2 >= nctx * nN * 4) return false;
    const int ks = L2 & 3, t = L2 >> 2;
    u.pm = t / nN; u.pn = t - u.pm * nN;
    const int kq = K >> 2;
    u.A = (const char*)(A + (size_t)row0_of(u.pm, 2) * K + ks * kq); u.B = (const char*)(B + (size_t)u.pn * 256 * K + ks * kq);
    u.nt = kq >> 6; u.aux = 1; u.ks = ks;
    return true;
  }
};
struct EpiResid {
  const float* xl_src; float* xl_dst; float* part; const float* mods_l; int gt_off;
  DI void operator()(const f4 (&acc)[2][2][4][2], const GUnit& u, int wr, int wc, int fr, int fq) const {
    const bool isctx = u.aux == 1;
    const int g0 = row0_of(u.pm, isctx ? 2 : 1), b = g0 / TOK, t0 = g0 - b * TOK;
    const int col0 = u.pn * 256 + wc * 32;
    const size_t rowoff = (size_t)(wr * 64) * 1024 + col0;
    const char* src = (const char*)(xl_src + ((size_t)b * SEQ + (isctx ? 0 : t0)) * 1024 + rowoff);
    char* dst = (char*)(xl_dst + ((size_t)b * SEQ + (isctx ? 0 : t0)) * 1024 + rowoff);
    const char* gt = (const char*)(mods_l + (size_t)(isctx ? 16 : b) * 6144 + gt_off + col0);
    const unsigned lo = (unsigned)(fr * 1024 + 4 * fq) * 4u, glo = (unsigned)(4 * fq) * 4u;
    f4 gv[2][2];
#pragma unroll
    for (int bj = 0; bj < 2; ++bj)
#pragma unroll
      for (int n = 0; n < 2; ++n) gv[bj][n] = *(const f4*)(gt + (bj * 128 + n * 16) * 4 + glo);
    if (!isctx) {
#pragma unroll
      for (int ai = 0; ai < 2; ++ai)
#pragma unroll
        for (int mh = 0; mh < 2; ++mh) {
          f4 xv[2][2][2];
#pragma unroll
          for (int mm = 0; mm < 2; ++mm)
#pragma unroll
            for (int bj = 0; bj < 2; ++bj)
#pragma unroll
              for (int n = 0; n < 2; ++n)
                xv[mm][bj][n] = *(const f4*)(src + ((size_t)(ai * 128 + (mh * 2 + mm) * 16) * 1024 + bj * 128 + n * 16) * 4 + lo);
#pragma unroll
          for (int mm = 0; mm < 2; ++mm)
#pragma unroll
            for (int bj = 0; bj < 2; ++bj)
#pragma unroll
              for (int n = 0; n < 2; ++n)
                *(f4*)(dst + ((size_t)(ai * 128 + (mh * 2 + mm) * 16) * 1024 + bj * 128 + n * 16) * 4 + lo) =
                    xv[mm][bj][n] + gv[bj][n] * acc[ai][bj][mh * 2 + mm][n];
        }
    } else {
      char* pp = (char*)(part + ((size_t)u.ks * NB * CTX + (size_t)b * CTX + (t0 - SEQ) + wr * 64) * 1024 + col0);
#pragma unroll
      for (int ai = 0; ai < 2; ++ai)
#pragma unroll
        for (int m = 0; m < 4; ++m)
#pragma unroll
          for (int bj = 0; bj < 2; ++bj)
#pragma unroll
            for (int n = 0; n < 2; ++n)
              *(f4*)(pp + ((size_t)(ai * 128 + m * 16) * 1024 + bj * 128 + n * 16) * 4 + lo) = gv[bj][n] * acc[ai][bj][m][n];
    }
  }
};
struct EpiUp {
  half_t* ubuf; int skip_ctx;
  DI void operator()(const f4 (&acc)[2][2][4][2], const GUnit& u, int wr, int wc, int fr, int fq) const {
    const int g0 = row0_of(u.pm, skip_ctx);
    char* rb = (char*)(ubuf + (size_t)(g0 + wr * 64) * 4096 + u.pn * 256 + wc * 32);
    const unsigned lo = (unsigned)(fr * 4096 + 8 * fq) * 2u;
#pragma unroll
    for (int ai = 0; ai < 2; ++ai)
#pragma unroll
      for (int m = 0; m < 4; ++m)
#pragma unroll
        for (int bj = 0; bj < 2; ++bj) {
          f4 a = acc[ai][bj][m][0], c = acc[ai][bj][m][1];
#pragma unroll
          for (int j = 0; j < 4; ++j) { a[j] = fmaxf(a[j], 0.f); a[j] *= a[j]; c[j] = fmaxf(c[j], 0.f); c[j] *= c[j]; }
          *(h8*)(rb + ((size_t)(ai * 128 + m * 16) * 4096 + bj * 128) * 2 + lo) = pack8(a, c);
        }
  }
};

DI void build_rope_tables(float2* tab, int wv_) {
  const int tid_ = tid_opaque(wv_);
  __syncthreads();
  for (int idx = tid_; idx < 512 + 1024; idx += NTHR) {
    const bool big = idx >= 512;
    const int j = big ? idx - 512 : idx;
    const int pos = big ? (j >> 4) : (j >> 3), i = big ? (j & 15) : (j & 7);
    const float invf = exp2f(-(float)i * (13.287712379549449f / (big ? 16.f : 8.f)));
    const float ang = (float)pos * invf;
    float sn, cs;
    sincosf(ang, &sn, &cs);
    tab[idx] = float2{cs, sn};
  }
  __syncthreads();
}
template <int DLEN, int LPR, int ROPE, bool KR>
DI void norm_rows(half_t* base, int stride, int nrows, const float* gain, float oscale, const half_t* zmla, const float2* rtab, int wv_) {
  const int tid_ = tid_opaque(wv_);
  const int lane = tid_ & 63, wave = tid_ >> 6;
  constexpr int RPW = 64 / LPR;
  const int s = lane % LPR, sub = lane / LPR;
  const bool active = s * 8 < DLEN;
  float gn[8];
#pragma unroll
  for (int i = 0; i < 8; ++i) gn[i] = active ? gain[s * 8 + i] : 0.f;
  for (int r0 = (blockIdx.x * NWAVE + wave) * RPW; r0 < nrows; r0 += gridDim.x * NWAVE * RPW) {
    const int rho = r0 + sub;
    const int t = rho % TOK;
    half_t* ptr = base + (size_t)rho * stride + s * 8;
    const half_t* src = ptr;
    if (KR && s >= 8) {
      const int b = rho / (4 * TOK);
      src = zmla + ((size_t)b * TOK + t) * ZS + 128 + (s - 8) * 8;
    }
    float f[8];
    float ss = 0.f;
    if (active) {
      const h8 v = *(const h8*)src;
#pragma unroll
      for (int i = 0; i < 8; ++i) { f[i] = (float)v[i]; ss += f[i] * f[i]; }
    } else {
#pragma unroll
      for (int i = 0; i < 8; ++i) f[i] = 0.f;
    }
#pragma unroll
    for (int o = LPR / 2; o > 0; o >>= 1) ss += __shfl_xor(ss, o);
    const float rstd = rsqrtf(ss * (1.f / DLEN) + EPS);
#pragma unroll
    for (int i = 0; i < 8; ++i) f[i] = f[i] * rstd * gn[i];
    if (ROPE != 0) {
      constexpr int PX = (ROPE == 64) ? 2 : 1;
      float pf[8];
#pragma unroll
      for (int i = 0; i < 8; ++i) pf[i] = __shfl_xor(f[i], PX);
      constexpr int RB = (DLEN - ROPE) / 8;
      if (t < SEQ && s >= RB && active) {
        const int sr = s - RB;
        const int q = (ROPE == 64) ? (sr >> 1) : sr;
        const int pos = (q < 2) ? (t >> 6) : (t & 63);
        const float sgn = (q & 1) ? 1.f : -1.f;
        constexpr int NFI = (ROPE == 64) ? 16 : 8;
        const float2* tb = rtab + ((ROPE == 64) ? 512 : 0) + pos * NFI + ((ROPE == 64) ? (sr & 1) * 8 : 0);
#pragma unroll
        for (int i = 0; i < 8; ++i) {
          const float2 cssn = tb[i];
          f[i] = f[i] * cssn.x + sgn * pf[i] * cssn.y;
        }
      }
    }
    if (active) {
      h8 o;
#pragma unroll
      for (int i = 0; i < 8; ++i) o[i] = (half_t)(f[i] * oscale);
      *(h8*)ptr = o;
    }
  }
}

constexpr int ATT_STAGE = 22528, ATT_VOFF = 13312, ATT_STASH = 49152;
template <int DQ, bool NA, int NQG>
DI void attn_wg(const half_t* Qp, const half_t* Kp, const half_t* Vp, int q0, bool active, int seg0_start, int seg0_tiles,
                int seg1_start, int seg1_tiles, const float* rpb_h, int rq, char* smem, int tid, f16v (&O)[2][NQG]) {
  constexpr int NKS = DQ / 16, KSTR = DQ + 8, VSTR = 72, CPK = DQ / 8, KCH = 64 * CPK;
  const int lane = tid & 63, r = lane & 31, h = lane >> 5;
  h8 qf[NQG][NKS];
#pragma unroll
  for (int qg = 0; qg < NQG; ++qg)
#pragma unroll
    for (int ks = 0; ks < NKS; ++ks) qf[qg][ks] = *(const h8*)(Qp + (size_t)(q0 + qg * 32 + r) * DQ + ks * 16 + h * 8);
  float mrun[NQG], lrun[NQG];
#pragma unroll
  for (int qg = 0; qg < NQG; ++qg) { mrun[qg] = -1e30f; lrun[qg] = 0.f; }
#pragma unroll
  for (int a = 0; a < 2; ++a)
#pragma unroll
    for (int c = 0; c < NQG; ++c)
#pragma unroll
      for (int i = 0; i < 16; ++i) O[a][c][i] = 0.f;
  const int ntiles = seg0_tiles + seg1_tiles;
  const int kc0 = tid, kc1 = tid + 512;
  const half_t* kg0 = Kp + kc0 * 8;
  const half_t* kg1 = Kp + kc1 * 8;
  const half_t* vg = Vp + (size_t)(tid >> 3) * TOK + (tid & 7) * 8;
  const int ks0 = (kc0 / CPK) * KSTR + (kc0 % CPK) * 8, ks1 = (kc1 / CPK) * KSTR + (kc1 % CPK) * 8, vs0 = (tid >> 3) * VSTR + (tid & 7) * 8;
  uint4 kreg0 = {0, 0, 0, 0}, kreg1 = {0, 0, 0, 0}, vreg;
  const int r0w = min(max(rq - 4, 0), 24);
  {
    const int k0 = (0 < seg0_tiles) ? seg0_start : seg1_start;
    if (kc0 < KCH) kreg0 = *(const uint4*)(kg0 + (size_t)k0 * DQ);
    if (DQ == 96 && kc1 < KCH) kreg1 = *(const uint4*)(kg1 + (size_t)k0 * DQ);
    vreg = *(const uint4*)(vg + k0);
    if (kc0 < KCH) *(uint4*)((half_t*)smem + ks0) = kreg0;
    if (DQ == 96 && kc1 < KCH) *(uint4*)((half_t*)smem + ks1) = kreg1;
    *(uint4*)((half_t*)(smem + ATT_VOFF) + vs0) = vreg;
  }
  __syncthreads();
  for (int it = 0; it < ntiles; ++it) {
    const int k0 = (it < seg0_tiles) ? seg0_start + it * 64 : seg1_start + (it - seg0_tiles) * 64;
    const bool more = it + 1 < ntiles;
    if (more) {
      const int itn = it + 1;
      const int k1 = (itn < seg0_tiles) ? seg0_start + itn * 64 : seg1_start + (itn - seg0_tiles) * 64;
      if (kc0 < KCH) kreg0 = *(const uint4*)(kg0 + (size_t)k1 * DQ);
      if (DQ == 96 && kc1 < KCH) kreg1 = *(const uint4*)(kg1 + (size_t)k1 * DQ);
      vreg = *(const uint4*)(vg + k1);
    }
    const half_t* ksm = (const half_t*)(smem + (it & 1) * ATT_STAGE) + r * KSTR + h * 8;
    const half_t* vsm = (const half_t*)(smem + (it & 1) * ATT_STAGE + ATT_VOFF) + r * VSTR + h * 4;
    const bool masked = NA && it < seg0_tiles;
    const int krow = k0 >> 6;
    const bool need = active && (!masked || (krow >= r0w && krow < r0w + 8));
    if (need) {
#pragma unroll 1
      for (int st = 0; st < 2; ++st) {
        f16v S[NQG];
#pragma unroll
        for (int qg = 0; qg < NQG; ++qg)
#pragma unroll
          for (int i = 0; i < 16; ++i) S[qg][i] = 0.f;
#pragma unroll
        for (int ks = 0; ks < NKS; ++ks) {
          const h8 kf = *(const h8*)(ksm + (st * 32) * KSTR + ks * 16);
#pragma unroll
          for (int qg = 0; qg < NQG; ++qg) S[qg] = __builtin_amdgcn_mfma_f32_32x32x16_f16(kf, qf[qg][ks], S[qg], 0, 0, 0);
        }
        if (masked) {
          const int cb = st * 32;
          const int dr = krow - rq + 7;
#pragma unroll
          for (int qg = 0; qg < NQG; ++qg) {
            const int qc = qg * 32 + r;
            const int cs = min(max(qc - 8, 0), 48);
#pragma unroll
            for (int i = 0; i < 16; ++i) {
              const int c = cb + (i & 3) + 8 * (i >> 2) + 4 * h;
              const bool valid = (c >= cs) && (c < cs + 16);
              float bias = 0.f;
              if (valid) bias = rpb_h[dr * 31 + (c - qc + 15)] * LOG2E;
              S[qg][i] = valid ? S[qg][i] + bias : -1e30f;
            }
          }
        }
        h4 vf[2][2][2];
#pragma unroll
        for (int dvt = 0; dvt < 2; ++dvt)
#pragma unroll
          for (int sx = 0; sx < 2; ++sx)
#pragma unroll
            for (int hf = 0; hf < 2; ++hf) vf[dvt][sx][hf] = *(const h4*)(vsm + (dvt * 32) * VSTR + st * 32 + sx * 16 + hf * 8);
#pragma unroll
        for (int qg = 0; qg < NQG; ++qg) {
          h8 P[2];
          float mx = S[qg][0];
#pragma unroll
          for (int i = 1; i < 16; ++i) mx = fmaxf(mx, S[qg][i]);
          mx = fmaxf(mx, __shfl_xor(mx, 32));
          const float mn = fmaxf(mrun[qg], mx);
          if (__builtin_amdgcn_ballot_w64(mn > mrun[qg]) != 0ull) {
            const float alpha = __builtin_amdgcn_exp2f(mrun[qg] - mn);
            lrun[qg] *= alpha;
#pragma unroll
            for (int dvt = 0; dvt < 2; ++dvt)
#pragma unroll
              for (int i = 0; i < 16; ++i) O[dvt][qg][i] *= alpha;
            mrun[qg] = mn;
          }
          f2 rs2 = {0.f, 0.f};
          const f2 mn2 = {mn, mn};
#pragma unroll
          for (int i = 0; i < 16; i += 2) {
            const f2 s2 = {S[qg][i], S[qg][i + 1]};
            const f2 d2 = s2 - mn2;
            f2 p2;
            p2.x = __builtin_amdgcn_exp2f(d2.x);
            p2.y = __builtin_amdgcn_exp2f(d2.y);
            if (NA) { p2.x = (s2.x <= -1e29f) ? 0.f : p2.x; p2.y = (s2.y <= -1e29f) ? 0.f : p2.y; }
            rs2 += p2;
            P[i >> 3][i & 7] = (half_t)p2.x;
            P[i >> 3][(i & 7) + 1] = (half_t)p2.y;
          }
          lrun[qg] += rs2.x + rs2.y;
#pragma unroll
          for (int dvt = 0; dvt < 2; ++dvt) {
#pragma unroll
            for (int sx = 0; sx < 2; ++sx) {
              const h8 va = __builtin_shufflevector(vf[dvt][sx][0], vf[dvt][sx][1], 0, 1, 2, 3, 4, 5, 6, 7);
              O[dvt][qg] = __builtin_amdgcn_mfma_f32_32x32x16_f16(va, P[sx], O[dvt][qg], 0, 0, 0);
            }
          }
        }
      }
    }
    if (more) {
      char* nb = smem + ((it + 1) & 1) * ATT_STAGE;
      if (kc0 < KCH) *(uint4*)((half_t*)nb + ks0) = kreg0;
      if (DQ == 96 && kc1 < KCH) *(uint4*)((half_t*)nb + ks1) = kreg1;
      *(uint4*)((half_t*)(nb + ATT_VOFF) + vs0) = vreg;
    }
    __syncthreads();
  }
#pragma unroll
  for (int qg = 0; qg < NQG; ++qg) {
    const float lt = lrun[qg] + __shfl_xor(lrun[qg], 32);
    const float inv = 1.f / lt;
#pragma unroll
    for (int dvt = 0; dvt < 2; ++dvt)
#pragma unroll
      for (int i = 0; i < 16; ++i) O[dvt][qg][i] *= inv;
  }
}

template <int NQG>
DI void store_o(const f16v (&O)[2][NQG], half_t* orow0  , int lane) {
  const int r = lane & 31, h = lane >> 5;
#pragma unroll
  for (int qg = 0; qg < NQG; ++qg)
#pragma unroll
    for (int dvt = 0; dvt < 2; ++dvt)
#pragma unroll
      for (int c = 0; c < 4; ++c) {
        h4 o;
#pragma unroll
        for (int j = 0; j < 4; ++j) o[j] = (half_t)O[dvt][qg][4 * c + j];
        *(h4*)(orow0 + (size_t)(qg * 32 + r) * 1024 + dvt * 32 + 8 * c + 4 * h) = o;
      }
}

DI void phase_attn(int l, half_t* big, bool need_ctx, char* smem, int wv_) {
  const KPtr p = kp();
  const int wave = wv_;
  const int NQB = need_ctx ? 5 : 4;
  half_t* obuf = big + B_O;
  const float lam_init = 0.8f - 0.6f * expf(-0.3f * (float)l);
  float lam;
  {
    float d1 = 0.f, d2 = 0.f;
#pragma unroll 1
    for (int i = 0; i < 32; ++i) {
      d1 += p->lq1[l * 32 + i] * p->lk1[l * 32 + i];
      d2 += p->lq2[l * 32 + i] * p->lk2[l * 32 + i];
    }
    lam = expf(d1) - expf(d2) + lam_init;
    lam = __builtin_bit_cast(float, __builtin_amdgcn_readfirstlane(__builtin_bit_cast(int, lam)));
  }
  const float one_m_li = __builtin_bit_cast(float, __builtin_amdgcn_readfirstlane(__builtin_bit_cast(int, 1.f - lam_init)));
  const int per = 4 * 16 * NQB;
#pragma unroll
  for (int mixer = 0; mixer < 4; ++mixer) {
    const int lo = mixer * per;
    const int first = lo + (int)((blockIdx.x + gridDim.x - (lo % gridDim.x)) % gridDim.x);
    const int tid_m = tid_opaque(wv_);
    const int lane = tid_m & 63, h = lane >> 5;
#pragma unroll 1
    for (int item = first; item < lo + per; item += gridDim.x) {
      const int hi = item / (16 * NQB);
      const int rem = item - hi * 16 * NQB;
      const int b = rem / NQB, qb = rem - b * NQB;
      const bool qctx = qb == 4;
      const bool active = !qctx || wave < 4;
      const int q0 = active ? qb * 512 + wave * 64 : SEQ;
      const int hh = hi & 3;
      const int s0 = qctx ? SEQ : 0, n0t = qctx ? 4 : 36;
      f16v O[2][2];
      half_t* orow = obuf + (size_t)(b * TOK + q0) * 1024 + hh * 64;
      if (mixer == 0) {
        half_t* stash = (half_t*)(smem + ATT_STASH) + wave * 4096;
        attn_wg<32, false, 2>(big + B_QDF + (size_t)(b * 8 + hh * 2) * TOK * 32, big + B_KDF + (size_t)(b * 8 + hh * 2) * TOK * 32,
                              big + B_VTDF + (size_t)(b * 4 + hh) * 64 * TOK, q0, active, s0, n0t, 0, 0, nullptr, 0, smem, tid_m, O);
#pragma unroll
        for (int dvt = 0; dvt < 2; ++dvt)
#pragma unroll
          for (int qg = 0; qg < 2; ++qg)
#pragma unroll
            for (int i = 0; i < 16; ++i) stash[((dvt * 2 + qg) * 16 + i) * 64 + lane] = (half_t)O[dvt][qg][i];
        attn_wg<32, false, 2>(big + B_QDF + (size_t)(b * 8 + hh * 2 + 1) * TOK * 32, big + B_KDF + (size_t)(b * 8 + hh * 2 + 1) * TOK * 32,
                              big + B_VTDF + (size_t)(b * 4 + hh) * 64 * TOK, q0, active, s0, n0t, 0, 0, nullptr, 0, smem, tid_m, O);
#pragma unroll
        for (int qg = 0; qg < 2; ++qg) {
          float ss = 0.f;
#pragma unroll
          for (int dvt = 0; dvt < 2; ++dvt)
#pragma unroll
            for (int i = 0; i < 16; ++i) {
              const float v = (float)stash[((dvt * 2 + qg) * 16 + i) * 64 + lane] - lam * O[dvt][qg][i];
              O[dvt][qg][i] = v;
              ss += v * v;
            }
          ss += __shfl_xor(ss, 32);
          const float rstd = rsqrtf(ss * (1.f / 64.f) + EPS) * one_m_li;
#pragma unroll
          for (int dvt = 0; dvt < 2; ++dvt)
#pragma unroll
            for (int i = 0; i < 16; ++i) {
              const int dv = dvt * 32 + (i & 3) + 8 * (i >> 2) + 4 * h;
              O[dvt][qg][i] *= rstd * p->g_diff_sub[l * 64 + dv];
            }
        }
        if (active) store_o<2>(O, orow + 2 * 256, lane);
      } else if (mixer == 1) {
        attn_wg<96, false, 2>(big + B_QM + (size_t)(b * 4 + hh) * TOK * 96, big + B_KM + (size_t)(b * 4 + hh) * TOK * 96,
                              big + B_VTM + (size_t)(b * 4 + hh) * 64 * TOK, q0, active, s0, n0t, 0, 0, nullptr, 0, smem, tid_m, O);
        if (active) store_o<2>(O, orow + 0 * 256, lane);
      } else if (mixer == 2) {
        const int kv = hh >> 1;
        attn_wg<64, false, 2>(big + B_QG + (size_t)(b * 4 + hh) * TOK * 64, big + B_KG + (size_t)(b * 2 + kv) * TOK * 64,
                              big + B_VTG + (size_t)(b * 2 + kv) * 64 * TOK, q0, active, s0, n0t, 0, 0, nullptr, 0, smem, tid_m, O);
        if (active) store_o<2>(O, orow + 3 * 256, lane);
      } else {
        const int rq = q0 >> 6;
        const int rq0 = qb * 8;
        const int rlo = min(max(rq0 - 4, 0), 24), rhi = min(max(rq0 + 7 - 4, 0), 24) + 8;
        const int seg0s = rlo * 64, seg0n = qctx ? 0 : (rhi - rlo);
        attn_wg<64, true, 2>(big + B_QNA + (size_t)(b * 4 + hh) * TOK * 64, big + B_KNA + (size_t)(b * 4 + hh) * TOK * 64,
                             big + B_VTNA + (size_t)(b * 4 + hh) * 64 * TOK, q0, active, seg0s, seg0n, SEQ, 4,
                             p->na_rpb + (size_t)(l * 4 + hh) * 15 * 31, rq, smem, tid_m, O);
        if (active) store_o<2>(O, orow + 1 * 256, lane);
      }
    }
  }
}

struct SchedGate : SchedBase {
  const half_t* hbuf; const half_t* Wl; int pm0, cnt, G, c, mode;
  static constexpr unsigned lda2 = 2048, ldb2 = 2048;
  static DI int bmap(bool, int R) { return ((R >> 4) & 1) * 1024 + (R >> 5) * 16 + (R & 15); }
  static constexpr int BHALF = 2048;
  DI bool next(int i, GUnit& u) const {
    int pm, pn;
    if (!tile_map(i * G + c, cnt, 16, pm, pn)) return false;
    u.pm = pm0 + pm; u.pn = pn; u.nt = 16; u.aux = 0;
    u.A = (const char*)(hbuf + (size_t)row0_of(u.pm, mode) * 1024); u.B = (const char*)(Wl + W_GATE + (size_t)pn * 64 * 1024);
    return true;
  }
};
DI float gate_clamped(float x) { return fmaxf(__builtin_amdgcn_rcpf(1.f + __expf(-x)), 6.103515625e-05f); }
struct EpiGate {
  half_t* gb; int pm0;
  DI void operator()(const f4 (&acc)[2][2][4][2], const GUnit& u, int wr, int wc, int fr, int fq) const {
    char* rb = (char*)(gb + (size_t)((u.pm - pm0) * 256 + wr * 64) * 4096 + u.pn * 64 + wc * 16);
    const unsigned lo = (unsigned)(fr * 4096 + 4 * fq) * 2u;
#pragma unroll
    for (int ai = 0; ai < 2; ++ai)
#pragma unroll
      for (int m = 0; m < 4; ++m) {
        f4 gq[4];
#pragma unroll
        for (int br = 0; br < 4; ++br)
#pragma unroll
          for (int j = 0; j < 4; ++j) gq[br][j] = gate_clamped(acc[ai][br >> 1][m][br & 1][j]);
#pragma unroll
        for (int br = 0; br < 4; ++br) {
          h4 o;
#pragma unroll
          for (int j = 0; j < 4; ++j) o[j] = (half_t)(br < 3 ? gq[br][j] * __builtin_amdgcn_rcpf(gq[br + 1][j]) : gq[3][j]);
          *(h4*)(rb + ((size_t)(ai * 128 + m * 16) * 4096 + br * 1024) * 2 + lo) = o;
        }
      }
  }
};
struct SchedProj : SchedBase {
  const half_t* obuf; const half_t* Wl; int pm0, cnt, G, c, mode;
  static constexpr unsigned lda2 = 2048, ldb2 = 512;
  static constexpr bool CHAIN = true;
  DI bool next(int i, GUnit& u) const {
    int pm, pn;
    if (!tile_map((i >> 2) * G + c, cnt, 4, pm, pn)) return false;
    const int br = i & 3;
    u.pm = pm0 + pm; u.pn = pn; u.nt = 4; u.aux = br;
    u.A = (const char*)(obuf + (size_t)row0_of(u.pm, mode) * 1024 + br * 256);
    u.B = (const char*)(Wl + W_BR + (size_t)(br * 1024 + pn * 256) * 256);
    return true;
  }
};
struct EpiProj {
  const half_t* gb; half_t* mbuf; int pm0, mode;
  DI bool operator()(f4 (&acc)[2][2][4][2], const GUnit& u, int wr, int wc, int fr, int fq) const {
    const int br = u.aux;
    const char* gp = (const char*)(gb + (size_t)((u.pm - pm0) * 256 + wr * 64) * 4096 + br * 1024 + u.pn * 256 + wc * 32);
    const unsigned glo = (unsigned)(fr * 4096 + 8 * fq) * 2u;
    h8 gq[2][4][2];
#pragma unroll
    for (int ai = 0; ai < 2; ++ai)
#pragma unroll
      for (int m = 0; m < 4; ++m)
#pragma unroll
        for (int bj = 0; bj < 2; ++bj) gq[ai][m][bj] = *(const h8*)(gp + ((size_t)(ai * 128 + m * 16) * 4096 + bj * 128) * 2 + glo);
#pragma unroll
    for (int ai = 0; ai < 2; ++ai)
#pragma unroll
      for (int m = 0; m < 4; ++m)
#pragma unroll
        for (int bj = 0; bj < 2; ++bj)
#pragma unroll
          for (int j = 0; j < 4; ++j) { acc[ai][bj][m][0][j] *= (float)gq[ai][m][bj][j]; acc[ai][bj][m][1][j] *= (float)gq[ai][m][bj][4 + j]; }
    if (br < 3) return true;
    char* mp = (char*)(mbuf + (size_t)(row0_of(u.pm, mode) + wr * 64) * 1024 + u.pn * 256 + wc * 32);
    const unsigned mlo = (unsigned)(fr * 1024 + 8 * fq) * 2u;
#pragma unroll
    for (int ai = 0; ai < 2; ++ai)
#pragma unroll
      for (int m = 0; m < 4; ++m)
#pragma unroll
        for (int bj = 0; bj < 2; ++bj)
          *(h8*)(mp + ((size_t)(ai * 128 + m * 16) * 1024 + bj * 128) * 2 + mlo) = pack8(acc[ai][bj][m][0], acc[ai][bj][m][1]);
    return false;
  }
};

__global__ void __launch_bounds__(NTHR) hybrid_block_megakernel(Params p) {
  __shared__ __attribute__((aligned(16))) char smem[SMEM_BYTES];
  char* ws = kp()->ws;
  if (ws == nullptr) cg::this_grid().sync();
  half_t* W = (half_t*)(ws + OFF_W);
  float* mods = (float*)(ws + OFF_MOD);
  float* xc = (float*)(ws + OFF_XC);
  half_t* hbuf = (half_t*)(ws + OFF_H);
  half_t* big = (half_t*)(ws + OFF_BIG);
  float* part = (float*)(ws + OFF_PART);
  LAS unsigned char* lds = (LAS unsigned char*)smem;
  const int G = gridDim.x, cblk = blockIdx.x;

  const int wv_ = __builtin_amdgcn_readfirstlane((int)threadIdx.x >> 6);
  volatile LAS unsigned* st = (volatile LAS unsigned*)(lds + GEMM_LDS);
  if (threadIdx.x < 4) st[threadIdx.x] = 0u;
  __syncthreads();
  xcd_barrier_post((unsigned*)(ws + OFF_BAR), wv_);

  phase_mods(mods, smem, wv_);
  {
    int base = 0;
    float* tile = (float*)smem;
    for (int l = 0; l < 2; ++l) {
      half_t* Wl = W + (size_t)l * W_LAYER;
      const float* win = kp()->w_in + (size_t)l * 1024 * 6496;
      tconv_job(win, 6496, 192, 1024, 1024, 160, 192, Wl + W_QK, base, tile, wv_, 160);
      tconv_job(win, 6496, 0, 1024, 1024, 192, 192, Wl + W_QK + (size_t)160 * 1024, base, tile, wv_);
      tconv_job(win, 6496, 352, 1024, 1024, 512, 512, Wl + W_QK + (size_t)352 * 1024, base, tile, wv_);
      tconv_job(win, 6496, 1120, 1024, 1024, 512, 512, Wl + W_QK + (size_t)864 * 1024, base, tile, wv_);
      tconv_job(win, 6496, 1888, 1024, 1024, 384, 384, Wl + W_QK + (size_t)1376 * 1024, base, tile, wv_);
      tconv_job(win, 6496, 0, 1024, 1024, 0, 64, Wl + W_QK + (size_t)1760 * 1024, base, tile, wv_, 32);
      tconv_job(win, 6496, 864, 1024, 1024, 256, 256, Wl + W_V, base, tile, wv_);
      tconv_job(win, 6496, 1632, 1024, 1024, 256, 256, Wl + W_V + (size_t)256 * 1024, base, tile, wv_);
      tconv_job(win, 6496, 2272, 1024, 1024, 128, 256, Wl + W_V + (size_t)512 * 1024, base, tile, wv_);
      tconv_job(win, 6496, 2400, 1024, 1024, 4096, 4096, Wl + W_GATE, base, tile, wv_);
      for (int br = 0; br < 4; ++br)
        tconv_job(kp()->w_branch + ((size_t)l * 4 + br) * 256 * 1024, 1024, 0, 256, 256, 1024, 1024, Wl + W_BR + (size_t)br * 1024 * 256, base, tile, wv_);
      tconv_job(kp()->w_out + (size_t)l * 1024 * 1024, 1024, 0, 1024, 1024, 1024, 1024, Wl + W_OUT, base, tile, wv_);
      tconv_job(kp()->w_up + (size_t)l * 1024 * 4096, 4096, 0, 1024, 1024, 4096, 4096, Wl + W_UP, base, tile, wv_);
      tconv_job(kp()->w_down + (size_t)l * 4096 * 1024, 1024, 0, 4096, 4096, 1024, 1024, Wl + W_DOWN, base, tile, wv_);
      tconv_job(kp()->w_mla_uq + (size_t)l * 192 * 384, 384, 0, 256, 192, 384, 512, Wl + W_UQ, base, tile, wv_, -1, 64);
      for (int hh = 0; hh < 4; ++hh) {
        tconv_job(kp()->w_mla_ukv + (size_t)l * 128 * 512, 512, hh * 128, 256, 128, 64, 64, Wl + W_UK + (size_t)hh * 64 * 256, base, tile, wv_);
        tconv_job(kp()->w_mla_ukv + (size_t)l * 128 * 512, 512, hh * 128 + 64, 256, 128, 64, 64, Wl + W_UV + (size_t)hh * 64 * 256, base, tile, wv_);
      }
    }
  }
  xcd_barrier(ws, lds, wv_);

  for (int l = 0; l < 2; ++l) {
    const bool need_ctx = (l == 0);
    const bool skip_ctx = !need_ctx;
    const half_t* Wl = W + (size_t)l * W_LAYER;
    const float* mods_l = mods + (size_t)l * 17 * 6144;
    const float* xl_src = (l == 0) ? kp()->x : kp()->out;
    const float* xc_src = (l == 0) ? kp()->ctx : xc;
    const int nrt = skip_ctx ? 128 : 144;

    phase_norm(xl_src, xc_src, kp()->g_norm1 + l * 1024, mods_l, 0, 1024, hbuf, false, (l == 1) ? part : nullptr, nullptr, wv_);
    xcd_barrier(ws, lds, wv_);
    {
      SchedInproj S{{}, hbuf, Wl, G, cblk};
      EpiInproj E{big};
      gemm256<true>(lds, S, E, wv_);
    }
    xcd_barrier(ws, lds, wv_);
    {
      build_rope_tables((float2*)smem, wv_);
      half_t* zmla = big + B_ZMLA;
      norm_rows<192, 32, 0, false>(zmla + 160, ZS, NTOK, kp()->g_mla_qa + l * 192, 1.f, nullptr, (const float2*)smem, wv_);
      norm_rows<128, 16, 0, false>(zmla, ZS, NTOK, kp()->g_mla_kva + l * 128, 1.f, nullptr, (const float2*)smem, wv_);
      norm_rows<64, 8, 0, false>(big + B_QNA, 64, NTOK * 4, kp()->g_na_q + l * 64, 0.125f * LOG2E, nullptr, (const float2*)smem, wv_);
      norm_rows<64, 8, 0, false>(big + B_KNA, 64, NTOK * 4, kp()->g_na_k + l * 64, 1.f, nullptr, (const float2*)smem, wv_);
      norm_rows<32, 4, 32, false>(big + B_QDF, 32, NTOK * 8, kp()->g_diff_q + l * 32, 0.17677669529663687f * LOG2E, nullptr, (const float2*)smem, wv_);
      norm_rows<32, 4, 32, false>(big + B_KDF, 32, NTOK * 8, kp()->g_diff_k + l * 32, 1.f, nullptr, (const float2*)smem, wv_);
      norm_rows<64, 8, 64, false>(big + B_QG, 64, NTOK * 4, kp()->g_gqa_q + l * 64, 0.125f * LOG2E, nullptr, (const float2*)smem, wv_);
      norm_rows<64, 8, 64, false>(big + B_KG, 64, NTOK * 2, kp()->g_gqa_k + l * 64, 1.f, nullptr, (const float2*)smem, wv_);
    }
    xcd_barrier(ws, lds, wv_);
    {
      SchedMlaQK S{{}, Wl, big + B_ZMLA, G, cblk};
      EpiMla E{big};
      gemm256<true>(lds, S, E, wv_);
      SchedMlaV S2{{}, Wl, big + B_ZMLA, G, cblk};
      gemm256<true>(lds, S2, E, wv_);
    }
    xcd_barrier(ws, lds, wv_);
    build_rope_tables((float2*)smem, wv_);
    norm_rows<96, 16, 32, false>(big + B_QM, 96, NTOK * 4, kp()->g_mla_q + l * 96, 0.10206207261596575f * LOG2E, nullptr, (const float2*)smem, wv_);
    norm_rows<96, 16, 32, true>(big + B_KM, 96, NTOK * 4, kp()->g_mla_k + l * 96, 1.f, big + B_ZMLA, (const float2*)smem, wv_);
    xcd_barrier(ws, lds, wv_);
    phase_attn(l, big, need_ctx, smem, wv_);
    xcd_barrier(ws, lds, wv_);
    {
      const int nsp = need_ctx ? 3 : 2;
      for (int j = 0; j < nsp; ++j) {
        const int mode = (j < 2) ? 1 : 2, pm0 = (j < 2) ? j * 64 : 0, cnt = (j < 2) ? 64 : 16;
        {
          SchedGate S{{}, hbuf, Wl, pm0, cnt, G, cblk, mode};
          EpiGate E{big + B_G0, pm0};
          gemm256<false>(lds, S, E, wv_);
        }
        xcd_barrier(ws, lds, wv_);
        {
          SchedProj S{{}, big + B_O, Wl, pm0, cnt, G, cblk, mode};
          EpiProj E{big + B_G0, big + B_M, pm0, mode};
          gemm256<true>(lds, S, E, wv_);
        }
        xcd_barrier(ws, lds, wv_);
      }
    }
    {
      SchedResid S{{}, big + B_M, Wl + W_OUT, 1024, 4, need_ctx ? 16 : 0, G, cblk, 2048u, 2048u};
      EpiResid E{xl_src, kp()->out, part, mods_l, 2048};
      gemm256<false>(lds, S, E, wv_);
    }
    xcd_barrier(ws, lds, wv_);
    phase_norm(kp()->out, xc_src, kp()->g_norm2 + l * 1024, mods_l, 3072, 4096, hbuf, skip_ctx, need_ctx ? part : nullptr, need_ctx ? xc : nullptr, wv_);
    xcd_barrier(ws, lds, wv_);
    {
      SchedRows S{{}, hbuf, Wl + W_UP, 1024, nrt, 16, G, cblk, skip_ctx ? 1 : 0, 2048u, 2048u};
      EpiUp E{big + B_U, skip_ctx ? 1 : 0};
      gemm256<true>(lds, S, E, wv_);
    }
    xcd_barrier(ws, lds, wv_);
    {
      SchedResid S{{}, big + B_U, Wl + W_DOWN, 4096, 4, need_ctx ? 16 : 0, G, cblk, 8192u, 8192u};
      EpiResid E{kp()->out, kp()->out, part, mods_l, 5120};
      gemm256<false>(lds, S, E, wv_);
    }
    if (l == 0) xcd_barrier(ws, lds, wv_);
  }
}

extern "C" void kernel_launch(void* const* d_in, const int* in_sizes, int n_in, void* d_out, int out_size, void* d_ws,
                              size_t ws_size, hipStream_t stream) {
  static int grid_blocks = 0;
  if (!grid_blocks) {
    int dev = 0, cus = 0, per_cu = 0;
    (void)hipGetDevice(&dev);
    (void)hipDeviceGetAttribute(&cus, hipDeviceAttributeMultiprocessorCount, dev);
    (void)hipOccupancyMaxActiveBlocksPerMultiprocessor(&per_cu, hybrid_block_megakernel, NTHR, 0);
    if (per_cu < 1) fprintf(stderr, "occupancy query returned %d\n", per_cu);
    grid_blocks = cus;
  }
  if (ws_size < WS_NEED) fprintf(stderr, "workspace too small: %zu < %zu\n", ws_size, (size_t)WS_NEED);
  (void)hipMemsetAsync((char*)d_ws + OFF_BAR, 0, XCD_BAR_WORDS * 4, stream);
  Params p{};
  const float** pf = (const float**)&p;
  for (int i = 0; i < 31; ++i) pf[i] = (const float*)d_in[i];
  p.out = (float*)d_out;
  p.ws = (char*)d_ws;
  void* args[] = {&p};
  hipError_t e = hipLaunchCooperativeKernel((void*)hybrid_block_megakernel, dim3(grid_blocks), dim3(NTHR), args, 0, stream);
  if (e != hipSuccess) fprintf(stderr, "cooperative launch failed: %s (grid %d)\n", hipGetErrorString(e), grid_blocks);
}
```

```cpp
#include <hip/hip_runtime.h>
#include <hip/hip_cooperative_groups.h>
#include <cstdio>
namespace cg = cooperative_groups;

typedef _Float16 half_t;
typedef __attribute__((ext_vector_type(8))) _Float16 h8;
typedef __attribute__((ext_vector_type(4))) _Float16 h4;
typedef __attribute__((ext_vector_type(4))) float f4;
typedef __attribute__((ext_vector_type(2))) float f2;
typedef __attribute__((ext_vector_type(16))) float f16v;

#define DI __device__ __forceinline__
#define LAS __attribute__((address_space(3)))

constexpr int NB = 16, SEQ = 2048, CTX = 256, TOK = 2304, NTOK = NB * TOK;
constexpr float LOG2E = 1.4426950408889634f;
constexpr float EPS = 1e-6f;

constexpr int NQK = 1792;
constexpr int NVT = 768;
constexpr int ZS = 352;
constexpr size_t W_QK = 0;
constexpr size_t W_V = W_QK + (size_t)NQK * 1024;
constexpr size_t W_GATE = W_V + (size_t)NVT * 1024;
constexpr size_t W_BR = W_GATE + (size_t)4096 * 1024;
constexpr size_t W_OUT = W_BR + (size_t)4 * 1024 * 256;
constexpr size_t W_UP = W_OUT + (size_t)1024 * 1024;
constexpr size_t W_DOWN = W_UP + (size_t)4096 * 1024;
constexpr size_t W_UQ = W_DOWN + (size_t)1024 * 4096;
constexpr size_t W_UK = W_UQ + (size_t)512 * 256;
constexpr size_t W_UV = W_UK + (size_t)256 * 256;
constexpr size_t W_LAYER = W_UV + (size_t)256 * 256;

constexpr size_t al256(size_t x) { return (x + 255) & ~(size_t)255; }
constexpr size_t OFF_BAR = 0;
constexpr size_t OFF_W = 16384;
constexpr size_t OFF_MOD = al256(OFF_W + 2 * W_LAYER * 2);
constexpr size_t OFF_XC = al256(OFF_MOD + (size_t)2 * 17 * 6144 * 4);
constexpr size_t OFF_H = al256(OFF_XC + (size_t)NB * CTX * 1024 * 4);
constexpr size_t OFF_BIG = al256(OFF_H + (size_t)NTOK * 1024 * 2);
constexpr size_t B_O = 0;
constexpr size_t B_QM = B_O + (size_t)NTOK * 1024;
constexpr size_t B_KM = B_QM + (size_t)NTOK * 384;
constexpr size_t B_VTM = B_KM + (size_t)NTOK * 384;
constexpr size_t B_QNA = B_VTM + (size_t)NTOK * 256;
constexpr size_t B_KNA = B_QNA + (size_t)NTOK * 256;
constexpr size_t B_VTNA = B_KNA + (size_t)NTOK * 256;
constexpr size_t B_QDF = B_VTNA + (size_t)NTOK * 256;
constexpr size_t B_KDF = B_QDF + (size_t)NTOK * 256;
constexpr size_t B_VTDF = B_KDF + (size_t)NTOK * 256;
constexpr size_t B_QG = B_VTDF + (size_t)NTOK * 256;
constexpr size_t B_KG = B_QG + (size_t)NTOK * 256;
constexpr size_t B_VTG = B_KG + (size_t)NTOK * 128;
constexpr size_t B_ZMLA = B_VTG + (size_t)NTOK * 128;
constexpr size_t B_END = B_ZMLA + (size_t)NTOK * ZS;
constexpr size_t B_M = B_O + (size_t)NTOK * 1024;
constexpr size_t GSLAB = (size_t)64 * 256 * 4096;
constexpr size_t B_G0 = B_M + (size_t)NTOK * 1024;
constexpr size_t B_P5END = B_G0 + GSLAB;
constexpr size_t B_U = 0;
constexpr size_t B_MAX = B_END > B_P5END ? B_END : B_P5END;
constexpr size_t OFF_PART = OFF_BIG + (size_t)NTOK * 4096 * 2;
constexpr size_t WS_NEED = (OFF_BIG + B_MAX * 2) > (OFF_PART + (size_t)4 * NB * CTX * 1024 * 4) ? (OFF_BIG + B_MAX * 2) : (OFF_PART + (size_t)4 * NB * CTX * 1024 * 4);
static_assert(B_P5END * 2 <= (size_t)NTOK * 4096 * 2, "merge buffers must end before the partial buffer");
static_assert(B_MAX >= (size_t)NTOK * 4096, "u must fit");
static_assert(WS_NEED <= (size_t)536870912, "workspace budget");

constexpr int NTHR = 512, NWAVE = 8;
constexpr int GEMM_LDS = 131072;
constexpr int SMEM_BYTES = GEMM_LDS + 16;

struct Params {
  const float *x, *c, *ctx, *c_ctx, *w_ada, *b_ada, *g_norm1, *g_norm2, *w_in;
  const float *g_mla_qa, *w_mla_uq, *g_mla_kva, *w_mla_ukv, *g_mla_q, *g_mla_k;
  const float *g_na_q, *g_na_k, *na_rpb;
  const float *g_diff_q, *g_diff_k, *lq1, *lk1, *lq2, *lk2, *g_diff_sub;
  const float *g_gqa_q, *g_gqa_k, *w_branch, *w_out, *w_up, *w_down;
  float* out;
  char* ws;
};


typedef const Params __attribute__((address_space(4))) * KPtr;
DI KPtr kp() {
  KPtr q = (KPtr)__builtin_amdgcn_kernarg_segment_ptr();
  asm volatile("" : "+s"(q));
  return q;
}

DI int tid_opaque(int wv_) {
  unsigned z = 0u;
  asm volatile("" : "+v"(z));
  int t = (wv_ << 6) | (int)__builtin_amdgcn_mbcnt_hi(~0u, __builtin_amdgcn_mbcnt_lo(~0u, z));
  asm volatile("" : "+v"(t));
  return t;
}

DI float wave_sum(float v) {
#pragma unroll
  for (int o = 32; o > 0; o >>= 1) v += __shfl_xor(v, o);
  return v;
}

#define XB_TMO      128
#define XB_XCNT(j)  (256  + 64 * (j))
#define XB_XSUB(j)  (1280 + 64 * (j))
#define XB_XGEN(j)  (2304 + 64 * (j))
#define XB_TOP      3328
#define XB_TOPGEN   3392
#define XCD_BAR_WORDS 3456
#define XB_SPIN_CAP (1u << 22)
DI unsigned xb_ld(unsigned* p) { return __hip_atomic_load(p, __ATOMIC_RELAXED, __HIP_MEMORY_SCOPE_AGENT); }
DI unsigned xb_add(unsigned* p, unsigned v) { return __hip_atomic_fetch_add(p, v, __ATOMIC_RELAXED, __HIP_MEMORY_SCOPE_AGENT); }
DI unsigned xb_xcc_id() { return (unsigned)__builtin_amdgcn_s_getreg((3 << 11) | 20) & 0xFu; }
#define XB_SPIN(cond, bar) do { unsigned _sp = 0; while (cond) { __builtin_amdgcn_s_sleep(1); \
    if ((++_sp & 255u) == 0u) { if (xb_ld(&(bar)[XB_TMO])) break; if (_sp > XB_SPIN_CAP) { atomicAdd(&(bar)[XB_TMO], 1u); break; } } } } while (0)
DI void xcd_barrier_post(unsigned* bar, int wv_) {
  if (tid_opaque(wv_) == 0) (void)xb_add(&bar[XB_XCNT(xb_xcc_id())], 1u);
}
DI void xcd_barrier_complete(unsigned* bar, unsigned x, unsigned& nloc, unsigned& nx) {
  const unsigned G = gridDim.x * gridDim.y * gridDim.z;
  unsigned sum, cnt, mine, sp = 0u;
  for (;;) {
    sum = 0u; cnt = 0u; mine = 0u;
#pragma unroll
    for (unsigned j = 0; j < 16; ++j) { const unsigned c = xb_ld(&bar[XB_XCNT(j)]); sum += c; cnt += (c > 0u) ? 1u : 0u; mine = (j == x) ? c : mine; }
    if (sum == G) break;
    __builtin_amdgcn_s_sleep(1);
    if ((++sp & 255u) == 0u) { if (xb_ld(&bar[XB_TMO])) break; if (sp > XB_SPIN_CAP) { atomicAdd(&bar[XB_TMO], 1u); break; } }
  }
  nloc = mine > 0u ? mine : 1u; nx = cnt > 0u ? cnt : 1u;
}
DI void xcd_barrier(char* ws_, LAS unsigned char* lds_, int wv_) {
  asm volatile("s_waitcnt vmcnt(0)" ::: "memory");
  __syncthreads();
  if (tid_opaque(wv_) == 0) {
    char* wsl = ws_;
    asm volatile("" : "+s"(wsl));
    unsigned* bar = (unsigned*)(wsl + OFF_BAR);
    volatile LAS unsigned* st = (volatile LAS unsigned*)(lds_ + GEMM_LDS);
    const unsigned x = xb_xcc_id();
    __builtin_amdgcn_s_waitcnt(0);
    unsigned nloc = st[0], nx = st[1];
    if (nloc == 0u) { xcd_barrier_complete(bar, x, nloc, nx); st[0] = nloc; st[1] = nx; }
    const unsigned old = xb_add(&bar[XB_XSUB(x)], 1u);
    const unsigned gen = old / nloc;
    if (old + 1u == (gen + 1u) * nloc) {
      __builtin_amdgcn_fence(__ATOMIC_RELEASE, "agent");
      asm volatile("s_waitcnt vmcnt(0)" ::: "memory");
      const unsigned og = xb_add(&bar[XB_TOP], 1u);
      const unsigned tg = og / nx;
      if (og + 1u == (tg + 1u) * nx) xb_add(&bar[XB_TOPGEN], 1u);
      else XB_SPIN(xb_ld(&bar[XB_TOPGEN]) == tg, bar);
      __builtin_amdgcn_fence(__ATOMIC_ACQUIRE, "agent");
      xb_add(&bar[XB_XGEN(x)], 1u);
      asm volatile("s_waitcnt vmcnt(0)" ::: "memory");
    } else {
      XB_SPIN(xb_ld(&bar[XB_XGEN(x)]) == gen, bar);
      __builtin_amdgcn_fence(__ATOMIC_ACQUIRE, "agent");
      asm volatile("s_waitcnt vmcnt(0)" ::: "memory");
    }
  }
  __syncthreads();
}

DI void phase_mods(float* mods, char* smem, int wv_) {
  const KPtr p = kp();
  float* sil = (float*)smem;
  const int tid = tid_opaque(wv_);
  for (int w = blockIdx.x; w < 192; w += gridDim.x) {
    const int l = w / 96, n0 = (w % 96) * 64;
    __syncthreads();
    for (int idx = tid; idx < 17 * 1024; idx += NTHR) {
      const int b = idx >> 10, k = idx & 1023;
      const float v = (b < 16) ? p->c[b * 1024 + k] : p->c_ctx[k];
      sil[idx] = v / (1.f + expf(-v));
    }
    __syncthreads();
    const int kq = tid >> 6, nn = tid & 63;
    float acc[17];
#pragma unroll
    for (int b = 0; b < 17; ++b) acc[b] = 0.f;
    const float* wp = p->w_ada + (size_t)l * 1024 * 6144 + (size_t)(kq * 128) * 6144 + n0 + nn;
    const float* sp = sil + kq * 128;
#pragma unroll 4
    for (int k = 0; k < 128; ++k) {
      const float wv = wp[(size_t)k * 6144];
#pragma unroll
      for (int b = 0; b < 17; ++b) acc[b] += sp[b * 1024 + k] * wv;
    }
    __syncthreads();
    float* red = (float*)smem;
#pragma unroll
    for (int b = 0; b < 17; ++b) red[(kq * 17 + b) * 64 + nn] = acc[b];
    __syncthreads();
    for (int idx = tid; idx < 17 * 64; idx += NTHR) {
      float s = p->b_ada[l * 6144 + n0 + (idx & 63)];
#pragma unroll
      for (int q = 0; q < 8; ++q) s += red[q * 17 * 64 + idx];
      mods[((size_t)l * 17 + (idx >> 6)) * 6144 + n0 + (idx & 63)] = s;
    }
  }
  __syncthreads();
}

DI void tconv_job(const float* src, int ld, int c0, int K, int Kvalid, int Nvalid, int Npad, half_t* dst, int& base,
                  float* tile, int wv_, int Nwrite = -1, int kshift = 0) {
  if (Nwrite < 0) Nwrite = Npad;
  const int nnt = Npad / 64, tot = (K / 64) * nnt;
  const int G = gridDim.x;
  const int start = (int)((blockIdx.x + G - (base % G)) % G);
  const int tid_ = tid_opaque(wv_);
  const int tx = tid_ & 63, ty = tid_ >> 6;
  for (int t = start; t < tot; t += 2 * G) {
    const int t2 = t + G;
    const bool has2 = t2 < tot;
    const int kt = t / nnt, nt = t % nnt, kt2 = has2 ? t2 / nnt : kt, nt2 = has2 ? t2 % nnt : nt;
    float r0[8], r1[8];
#pragma unroll
    for (int i = 0; i < 8; ++i) {
      const int k = i * 8 + ty, n = nt * 64 + tx, n2 = nt2 * 64 + tx;
      const int ks0 = kt * 64 + k - kshift, ks1 = kt2 * 64 + k - kshift;
      r0[i] = (n < Nvalid && ks0 >= 0 && ks0 < Kvalid) ? src[(size_t)ks0 * ld + c0 + n] : 0.f;
      r1[i] = (has2 && n2 < Nvalid && ks1 >= 0 && ks1 < Kvalid) ? src[(size_t)ks1 * ld + c0 + n2] : 0.f;
    }
    __syncthreads();
#pragma unroll
    for (int i = 0; i < 8; ++i) {
      tile[(i * 8 + ty) * 65 + tx] = r0[i];
      tile[64 * 65 + (i * 8 + ty) * 65 + tx] = r1[i];
    }
    __syncthreads();
#pragma unroll
    for (int i = 0; i < 8; ++i) {
      const int n = i * 8 + ty;
      if (nt * 64 + n < Nwrite) dst[(size_t)(nt * 64 + n) * K + kt * 64 + tx] = (half_t)tile[tx * 65 + n];
      if (has2 && nt2 * 64 + n < Nwrite) dst[(size_t)(nt2 * 64 + n) * K + kt2 * 64 + tx] = (half_t)tile[64 * 65 + tx * 65 + n];
    }
  }
  base += tot;
}

struct NormRow { const float* mod; int g, b, t; bool valid, isctx; };
DI void norm_load(int g, const float* xl, const float* xc, const float* mods_l, bool skip_ctx, int lane, float4 (&v)[4], NormRow& r) {
  r.g = g; r.valid = g < NTOK;
  const int gg = r.valid ? g : 0;
  r.b = gg / TOK; r.t = gg - r.b * TOK;
  r.isctx = r.t >= SEQ;
  if (r.isctx && skip_ctx) r.valid = false;
  const float* src = r.isctx ? xc + ((size_t)r.b * CTX + (r.t - SEQ)) * 1024 : xl + ((size_t)r.b * SEQ + r.t) * 1024;
  r.mod = mods_l + (size_t)(r.isctx ? 16 : r.b) * 6144;
  if (r.valid) {
#pragma unroll
    for (int i = 0; i < 4; ++i) v[i] = *(const float4*)(src + i * 256 + lane * 4);
  } else {
#pragma unroll
    for (int i = 0; i < 4; ++i) v[i] = float4{0.f, 0.f, 0.f, 0.f};
  }
}
DI void norm_finish(float4 (&v)[4], const NormRow& r, const float* gam, int sh_off, int sc_off, half_t* h, const float* part, float* xc_store, int lane) {
  if (r.valid && r.isctx && part != nullptr) {
    const size_t ro = ((size_t)r.b * CTX + (r.t - SEQ)) * 1024;
#pragma unroll
    for (int i = 0; i < 4; ++i) {
#pragma unroll
      for (int ks = 0; ks < 4; ++ks) {
        const float4 pv = *(const float4*)(part + (size_t)ks * NB * CTX * 1024 + ro + i * 256 + lane * 4);
        v[i].x += pv.x; v[i].y += pv.y; v[i].z += pv.z; v[i].w += pv.w;
      }
      if (xc_store != nullptr) *(float4*)(xc_store + ro + i * 256 + lane * 4) = v[i];
    }
  }
  float ss = 0.f;
#pragma unroll
  for (int i = 0; i < 4; ++i) ss += v[i].x * v[i].x + v[i].y * v[i].y + v[i].z * v[i].z + v[i].w * v[i].w;
  ss = wave_sum(ss);
  if (!r.valid) return;
  const float rstd = rsqrtf(ss * (1.f / 1024.f) + EPS);
#pragma unroll
  for (int i = 0; i < 4; ++i) {
    const int col = i * 256 + lane * 4;
    const float4 gg = *(const float4*)(gam + col);
    const float4 sc = *(const float4*)(r.mod + sc_off + col);
    const float4 sh = *(const float4*)(r.mod + sh_off + col);
    h4 o;
    o[0] = (half_t)(v[i].x * rstd * gg.x * (1.f + sc.x) + sh.x);
    o[1] = (half_t)(v[i].y * rstd * gg.y * (1.f + sc.y) + sh.y);
    o[2] = (half_t)(v[i].z * rstd * gg.z * (1.f + sc.z) + sh.z);
    o[3] = (half_t)(v[i].w * rstd * gg.w * (1.f + sc.w) + sh.w);
    *(h4*)(h + (size_t)r.g * 1024 + col) = o;
  }
}
DI void phase_norm(const float* xl, const float* xc, const float* gam, const float* mods_l, int sh_off,
                   int sc_off, half_t* h, bool skip_ctx, const float* part, float* xc_store, int wv_) {
  const int tid_ = tid_opaque(wv_);
  const int wave = tid_ >> 6, lane = tid_ & 63;
  const int stride = gridDim.x * NWAVE;
  for (int g = blockIdx.x * NWAVE + wave; g < NTOK; g += 2 * stride) {
    float4 v0[4], v1[4];
    NormRow r0, r1;
    norm_load(g, xl, xc, mods_l, skip_ctx, lane, v0, r0);
    norm_load(g + stride, xl, xc, mods_l, skip_ctx, lane, v1, r1);
    norm_finish(v0, r0, gam, sh_off, sc_off, h, part, xc_store, lane);
    norm_finish(v1, r1, gam, sh_off, sc_off, h, part, xc_store, lane);
  }
}

constexpr int BK = 64, HALF = 128, HTB = HALF * BK * 2;
DI int lds_byte(int r, int c) { const int st = (r >> 4) * 2 + (c >> 5), rr = r & 15, cc = c & 31, ob = rr * 64 + cc * 2; return st * 1024 + (ob ^ (((ob >> 9) & 1) << 5)); }
DI void stage_rc(int b, int& R, int& C) { const int st = b / 1024, sb = b % 1024, swz = sb ^ (((sb >> 9) & 1) << 5); R = (st >> 1) * 16 + swz / 64; C = (st & 1) * 32 + (swz % 64) / 2; }
DI int perm32(int rho) { const int n = rho >> 4, i = rho & 15; return 8 * (i >> 2) + 4 * n + (i & 3); }

struct SchedBase {
  static DI int bmap(bool perm, int R) { return perm ? ((R & ~31) + perm32(R & 31)) : R; }
  static constexpr int BHALF = 128;
  static constexpr bool CHAIN = false;
};
struct GUnit { const char* A; const char* B; int nt, pm, pn, aux, ks; };

DI bool tile_map(int L, int nM, int nN, int& pm, int& pn) {
  const int nwg = nM * nN;
  if (L >= nwg) return false;
  int wgid = L;
  { const int q = nwg / 8, r = nwg % 8, xcd = wgid % 8, off = wgid / 8; wgid = (xcd < r ? xcd * (q + 1) : r * (q + 1) + (xcd - r) * q) + off; }
  const int nig = 8 * nN, gid = wgid / nig, fm = gid * 8, gsz = (nM - fm) < 8 ? (nM - fm) : 8;
  pm = fm + ((wgid % nig) % gsz); pn = (wgid % nig) / gsz;
  return true;
}

template <bool PERM, class Sched, class Epi>
DI void gemm256(LAS unsigned char* lds, const Sched& S, const Epi& E, int wv_) {
  const int tid = tid_opaque(wv_), wid = __builtin_amdgcn_readfirstlane(tid >> 6), lane = tid & 63, wr = wid >> 2, wc = wid & 3, fr = lane & 15, fq = lane >> 4;
  unsigned cvA0, cvA1, cvB0, cvB1;
  { int R, C;
    stage_rc(tid * 16, R, C); cvA0 = (unsigned)R * S.lda2 + C * 2; cvB0 = (unsigned)Sched::bmap(PERM, R) * S.ldb2 + C * 2;
    stage_rc(tid * 16 + 8192, R, C); cvA1 = (unsigned)R * S.lda2 + C * 2; cvB1 = (unsigned)Sched::bmap(PERM, R) * S.ldb2 + C * 2; }
  const size_t chA = (size_t)HALF * S.lda2, chB = (size_t)Sched::BHALF * S.ldb2;
  const size_t kstep = (size_t)(BK * 2);
  const unsigned ldsw = (unsigned)wid * 1024u;
  const int aoff = lds_byte(wr * 64 + fr, fq * 8), boff = lds_byte(wc * 32 + fr, fq * 8);
#define G_SA(b, h) (((b) * 2 + (h)) * HTB)
#define G_SB(b, h) ((4 + (b) * 2 + (h)) * HTB)
#define G_STAGE(bufoff, gbase, v0, v1) do { \
    __builtin_amdgcn_global_load_lds((const unsigned*)((const char*)(gbase) + (v0)), (LAS unsigned*)(lds + (bufoff) + ldsw), 16, 0, 0); \
    __builtin_amdgcn_global_load_lds((const unsigned*)((const char*)(gbase) + (v1)), (LAS unsigned*)(lds + (bufoff) + ldsw + 8192), 16, 0, 0); } while (0)
#define G_LDA(dst, b, h) do { _Pragma("unroll") for (int m = 0; m < 4; ++m) _Pragma("unroll") for (int k = 0; k < 2; ++k) dst[m][k] = *(const LAS h8*)(lds + G_SA(b, h) + aoff + m * 2048 + k * 1024); } while (0)
#define G_LDB(dst, b, h) do { _Pragma("unroll") for (int n = 0; n < 2; ++n) _Pragma("unroll") for (int k = 0; k < 2; ++k) dst[n][k] = *(const LAS h8*)(lds + G_SB(b, h) + boff + n * 2048 + k * 1024); } while (0)
#define G_MMA(ai, bj, At, Bt) do { __builtin_amdgcn_s_setprio(1); _Pragma("unroll") for (int m = 0; m < 4; ++m) _Pragma("unroll") for (int n = 0; n < 2; ++n) _Pragma("unroll") for (int k = 0; k < 2; ++k) \
    acc[ai][bj][m][n] = __builtin_amdgcn_mfma_f32_16x16x32_f16(Bt[n][k], At[m][k], acc[ai][bj][m][n], 0, 0, 0); __builtin_amdgcn_s_setprio(0); } while (0)
#define G_WAIT_V(n) asm volatile("s_waitcnt vmcnt(" #n ")" ::: "memory")
#define G_WAIT_L(n) asm volatile("s_waitcnt lgkmcnt(" #n ")" ::: "memory")
#define G_BAR __builtin_amdgcn_s_barrier()
#define G_SCHED __builtin_amdgcn_sched_barrier(0)
  GUnit cur, nxt;
  int ui = 0;
  if (!S.next(0, cur)) return;
  f4 acc[2][2][4][2];
#pragma unroll
  for (int a = 0; a < 2; ++a)
#pragma unroll
    for (int b = 0; b < 2; ++b)
#pragma unroll
      for (int m = 0; m < 4; ++m)
#pragma unroll
        for (int n = 0; n < 2; ++n) acc[a][b][m][n] = f4{0.f, 0.f, 0.f, 0.f};
  h8 At[4][2], B0[2][2], B1[2][2];
  const char* cA = cur.A;
  const char* cB = cur.B;
  G_STAGE(G_SB(0, 0), cB, cvB0, cvB1); G_STAGE(G_SA(0, 0), cA, cvA0, cvA1); G_STAGE(G_SB(0, 1), cB + chB, cvB0, cvB1); G_STAGE(G_SA(0, 1), cA + chA, cvA0, cvA1);
  if (wr == 1) G_BAR;
  G_WAIT_V(4); G_BAR;
  G_STAGE(G_SB(1, 0), cB + kstep, cvB0, cvB1); G_STAGE(G_SA(1, 0), cA + kstep, cvA0, cvA1); G_STAGE(G_SB(1, 1), cB + chB + kstep, cvB0, cvB1);
  G_WAIT_V(6); G_BAR;
  for (;;) {
    const bool has_next = S.next(ui + 1, nxt);
    const char* nA = has_next ? nxt.A : cA;
    const char* nB = has_next ? nxt.B : cB;
    int nt = cur.nt;
    asm volatile("" : "+s"(nt));
    for (int t = 0; t < nt; t += 2) {
      const bool last = (t == nt - 2);
      const char* a1 = cA + (size_t)(t + 1) * kstep;
      const char* a2 = last ? nA : cA + (size_t)(t + 2) * kstep;
      const char* b2 = last ? nB : cB + (size_t)(t + 2) * kstep;
      const char* a3 = a2 + kstep;
      const char* b3 = b2 + kstep;
      G_LDB(B0, 0, 0); G_SCHED; G_LDA(At, 0, 0); G_STAGE(G_SA(1, 1), a1 + chA, cvA0, cvA1);
      G_WAIT_L(8); G_BAR; G_WAIT_L(0); G_MMA(0, 0, At, B0); G_BAR; G_SCHED;
      G_LDB(B1, 0, 1); G_STAGE(G_SB(0, 0), b2, cvB0, cvB1);
      G_BAR; G_WAIT_L(0); G_MMA(0, 1, At, B1); G_BAR;
      G_LDA(At, 0, 1); G_STAGE(G_SA(0, 0), a2, cvA0, cvA1);
      G_BAR; G_WAIT_L(0); G_MMA(1, 0, At, B0); G_BAR; G_SCHED;
      G_STAGE(G_SB(0, 1), b2 + chB, cvB0, cvB1);
      G_WAIT_V(6); G_BAR; G_MMA(1, 1, At, B1); G_BAR;
      G_LDB(B0, 1, 0); G_SCHED; G_LDA(At, 1, 0); G_STAGE(G_SA(0, 1), a2 + chA, cvA0, cvA1);
      G_WAIT_L(8); G_BAR; G_WAIT_L(0); G_MMA(0, 0, At, B0); G_BAR; G_SCHED;
      G_LDB(B1, 1, 1); G_STAGE(G_SB(1, 0), b3, cvB0, cvB1);
      G_BAR; G_WAIT_L(0); G_MMA(0, 1, At, B1); G_BAR;
      G_LDA(At, 1, 1); G_STAGE(G_SA(1, 0), a3, cvA0, cvA1);
      G_BAR; G_WAIT_L(0); G_MMA(1, 0, At, B0); G_BAR; G_SCHED;
      G_STAGE(G_SB(1, 1), b3 + chB, cvB0, cvB1);
      G_WAIT_V(6); G_BAR; G_MMA(1, 1, At, B1); G_BAR;
    }
    bool keep = false;
    if constexpr (Sched::CHAIN) keep = E(acc, cur, wr, wc, fr, fq); else E(acc, cur, wr, wc, fr, fq);
    if (!has_next) break;
    if (!keep) {
#pragma unroll
      for (int a = 0; a < 2; ++a)
#pragma unroll
        for (int b = 0; b < 2; ++b)
#pragma unroll
          for (int m = 0; m < 4; ++m)
#pragma unroll
            for (int n = 0; n < 2; ++n) acc[a][b][m][n] = f4{0.f, 0.f, 0.f, 0.f};
    }
    cur = nxt; cA = nA; cB = nB; ++ui;
  }
  G_WAIT_V(0);
  if (wr == 0) G_BAR;
  G_BAR;
#undef G_SA
#undef G_SB
#undef G_STAGE
#undef G_LDA
#undef G_LDB
#undef G_MMA
#undef G_WAIT_V
#undef G_WAIT_L
#undef G_BAR
#undef G_SCHED
}

DI h8 pack8(const f4& a, const f4& b) {
  h8 o;
  o[0] = (half_t)a[0]; o[1] = (half_t)a[1]; o[2] = (half_t)a[2]; o[3] = (half_t)a[3];
  o[4] = (half_t)b[0]; o[5] = (half_t)b[1]; o[6] = (half_t)b[2]; o[7] = (half_t)b[3];
  return o;
}
DI int row0_of(int pm, int mode) { return mode == 0 ? pm * 256 : (mode == 1 ? (pm >> 3) * TOK + (pm & 7) * 256 : pm * TOK + SEQ); }

struct SchedInproj : SchedBase {
  const half_t* hbuf; const half_t* Wl; int G, c;
  static constexpr unsigned lda2 = 2048, ldb2 = 2048;
  DI bool next(int i, GUnit& u) const {
    const int L = i * G + c;
    u.nt = 16;
    if (L < 144 * 7) {
      tile_map(L, 144, 7, u.pm, u.pn);
      u.A = (const char*)(hbuf + (size_t)u.pm * 256 * 1024); u.B = (const char*)(Wl + W_QK + (size_t)u.pn * 256 * 1024); u.aux = 0;
      return true;
    }
    if (!tile_map(L - 144 * 7, 3, 144, u.pm, u.pn)) return false;
    u.A = (const char*)(Wl + W_V + (size_t)u.pm * 256 * 1024); u.B = (const char*)(hbuf + (size_t)u.pn * 256 * 1024); u.aux = 1;
    return true;
  }
};
struct EpiInproj {
  half_t* big;
  DI void operator()(const f4 (&acc)[2][2][4][2], const GUnit& u, int wr, int wc, int fr, int fq) const {
    if (u.aux == 0) {
      const int g0 = u.pm * 256, b = g0 / TOK, t0 = g0 - b * TOK + wr * 64;
#pragma unroll
      for (int bj = 0; bj < 2; ++bj) {
        const int cb = u.pn * 256 + bj * 128 + wc * 32;
        half_t* ptr; int ts;
        if (cb < 352) { ptr = big + B_ZMLA + (size_t)b * TOK * ZS + cb; ts = ZS; }
        else if (cb < 864) { const int c = cb - 352, part = c >> 8, hh = (c >> 6) & 3; ptr = big + (part ? B_KNA : B_QNA) + (size_t)(b * 4 + hh) * TOK * 64 + (c & 63); ts = 64; }
        else if (cb < 1376) { const int c = cb - 864, part = c >> 8, hm = (c >> 5) & 7; ptr = big + (part ? B_KDF : B_QDF) + (size_t)(b * 8 + hm) * TOK * 32; ts = 32; }
        else if (cb < 1632) { const int c = cb - 1376; ptr = big + B_QG + (size_t)(b * 4 + (c >> 6)) * TOK * 64 + (c & 63); ts = 64; }
        else if (cb < 1760) { const int c = cb - 1632; ptr = big + B_KG + (size_t)(b * 2 + (c >> 6)) * TOK * 64 + (c & 63); ts = 64; }
        else continue;
        const unsigned lo = (unsigned)(fr * ts + 8 * fq) * 2u;
        char* rb = (char*)(ptr + (size_t)t0 * ts);
#pragma unroll
        for (int ai = 0; ai < 2; ++ai)
#pragma unroll
          for (int m = 0; m < 4; ++m)
            *(h8*)(rb + (size_t)((ai * 128 + m * 16) * ts) * 2 + lo) = pack8(acc[ai][bj][m][0], acc[ai][bj][m][1]);
      }
    } else {
      const int g0 = u.pn * 256, b = g0 / TOK, t0 = g0 - b * TOK;
      const int nh = (u.pm == 2) ? 2 : 4;
      char* vt = (char*)(big + (u.pm == 0 ? B_VTNA : (u.pm == 1 ? B_VTDF : B_VTG)) + (size_t)b * nh * 64 * TOK + (size_t)(wr * 64) * TOK + t0 + wc * 32);
      const unsigned lo = (unsigned)(fr * TOK + 8 * fq) * 2u;
#pragma unroll
      for (int ai = 0; ai < 2; ++ai) {
        if (u.pm == 2 && ai == 1) continue;
#pragma unroll
        for (int m = 0; m < 4; ++m)
#pragma unroll
          for (int bj = 0; bj < 2; ++bj)
            *(h8*)(vt + ((size_t)(ai * 128 + m * 16) * TOK + bj * 128) * 2 + lo) = pack8(acc[ai][bj][m][0], acc[ai][bj][m][1]);
      }
    }
  }
};

struct SchedMlaQK : SchedBase {
  const half_t* Wl; const half_t* zmla; int G, c;
  static constexpr unsigned lda2 = ZS * 2, ldb2 = 512;
  DI bool next(int i, GUnit& u) const {
    const int L = i * G + c;
    u.nt = 4;
    if (L < 288) {
      tile_map(L, 144, 2, u.pm, u.pn);
      u.A = (const char*)(zmla + 96 + (size_t)u.pm * 256 * ZS);
      u.B = (const char*)(Wl + W_UQ + (size_t)u.pn * 256 * 256); u.aux = 0;
      return true;
    }
    if (L < 432) {
      u.pm = L - 288; u.pn = 0;
      u.A = (const char*)(zmla + (size_t)u.pm * 256 * ZS);
      u.B = (const char*)(Wl + W_UK); u.aux = 1;
      return true;
    }
    return false;
  }
};
struct SchedMlaV : SchedBase {
  const half_t* Wl; const half_t* zmla; int G, c;
  static constexpr unsigned lda2 = 512, ldb2 = ZS * 2;
  DI bool next(int i, GUnit& u) const {
    const int L = i * G + c;
    if (L >= 144) return false;
    u.nt = 4; u.pm = 0; u.pn = L;
    u.A = (const char*)(Wl + W_UV);
    u.B = (const char*)(zmla + (size_t)u.pn * 256 * ZS); u.aux = 2;
    return true;
  }
};
struct EpiMla {
  half_t* big;
  DI void operator()(const f4 (&acc)[2][2][4][2], const GUnit& u, int wr, int wc, int fr, int fq) const {
    if (u.aux < 2) {
      const int g0 = u.pm * 256, b = g0 / TOK, t0 = g0 - b * TOK + wr * 64;
      const unsigned lo = (unsigned)(fr * 96 + 8 * fq) * 2u;
#pragma unroll
      for (int bj = 0; bj < 2; ++bj) {
        const int cb = u.pn * 256 + bj * 128 + wc * 32;
        half_t* ptr;
        if (u.aux == 0) {
          if (cb >= 384) continue;
          const int hh = cb / 96, dd = cb - hh * 96;
          ptr = big + B_QM + (size_t)(b * 4 + hh) * TOK * 96 + dd;
        } else {
          ptr = big + B_KM + (size_t)(b * 4 + (cb >> 6)) * TOK * 96 + (cb & 63);
        }
        char* rb = (char*)(ptr + (size_t)t0 * 96);
#pragma unroll
        for (int ai = 0; ai < 2; ++ai)
#pragma unroll
          for (int m = 0; m < 4; ++m)
            *(h8*)(rb + (size_t)((ai * 128 + m * 16) * 96) * 2 + lo) = pack8(acc[ai][bj][m][0], acc[ai][bj][m][1]);
      }
    } else {
      const int g0 = u.pn * 256, b = g0 / TOK, t0 = g0 - b * TOK;
      char* vt = (char*)(big + B_VTM + (size_t)b * 4 * 64 * TOK + (size_t)(wr * 64) * TOK + t0 + wc * 32);
      const unsigned lo = (unsigned)(fr * TOK + 8 * fq) * 2u;
#pragma unroll
      for (int ai = 0; ai < 2; ++ai)
#pragma unroll
        for (int m = 0; m < 4; ++m)
#pragma unroll
          for (int bj = 0; bj < 2; ++bj)
            *(h8*)(vt + ((size_t)(ai * 128 + m * 16) * TOK + bj * 128) * 2 + lo) = pack8(acc[ai][bj][m][0], acc[ai][bj][m][1]);
    }
  }
};

struct SchedRows : SchedBase {
  const half_t* A; const half_t* B; int K, nM, nN, G, c; int mode; unsigned lda2, ldb2;
  DI bool next(int i, GUnit& u) const {
    if (!tile_map(i * G + c, nM, nN, u.pm, u.pn)) return false;
    u.A = (const char*)(A + (size_t)row0_of(u.pm, mode) * K); u.B = (const char*)(B + (size_t)u.pn * 256 * K);
    u.nt = K >> 6; u.aux = 0;
    return true;
  }
};
struct SchedResid : SchedBase {
  const half_t* A; const half_t* B; int K, nN, nctx, G, c; unsigned lda2, ldb2;
  DI bool next(int i, GUnit& u) const {
    const int L = i * G + c, nfull = 128 * nN;
    if (L < nfull) {
      tile_map(L, 128, nN, u.pm, u.pn);
      u.A = (const char*)(A + (size_t)row0_of(u.pm, 1) * K); u.B = (const char*)(B + (size_t)u.pn * 256 * K);
      u.nt = K >> 6; u.aux = 0;
      return true;
    }
    const int L2 = L - nfull;
    if (L2 >= nctx * nN * 4) return false;
    const int ks = L2 & 3, t = L2 >> 2;
    u.pm = t / nN; u.pn = t - u.pm * nN;
    const int kq = K >> 2;
    u.A = (const char*)(A + (size_t)row0_of(u.pm, 2) * K + ks * kq); u.B = (const char*)(B + (size_t)u.pn * 256 * K + ks * kq);
    u.nt = kq >> 6; u.aux = 1; u.ks = ks;
    return true;
  }
};
struct EpiResid {
  const float* xl_src; float* xl_dst; float* part; const float* mods_l; int gt_off;
  DI void operator()(const f4 (&acc)[2][2][4][2], const GUnit& u, int wr, int wc, int fr, int fq) const {
    const bool isctx = u.aux == 1;
    const int g0 = row0_of(u.pm, isctx ? 2 : 1), b = g0 / TOK, t0 = g0 - b * TOK;
    const int col0 = u.pn * 256 + wc * 32;
    const size_t rowoff = (size_t)(wr * 64) * 1024 + col0;
    const char* src = (const char*)(xl_src + ((size_t)b * SEQ + (isctx ? 0 : t0)) * 1024 + rowoff);
    char* dst = (char*)(xl_dst + ((size_t)b * SEQ + (isctx ? 0 : t0)) * 1024 + rowoff);
    const char* gt = (const char*)(mods_l + (size_t)(isctx ? 16 : b) * 6144 + gt_off + col0);
    const unsigned lo = (unsigned)(fr * 1024 + 4 * fq) * 4u, glo = (unsigned)(4 * fq) * 4u;
    f4 gv[2][2];
#pragma unroll
    for (int bj = 0; bj < 2; ++bj)
#pragma unroll
      for (int n = 0; n < 2; ++n) gv[bj][n] = *(const f4*)(gt + (bj * 128 + n * 16) * 4 + glo);
    if (!isctx) {
#pragma unroll
      for (int ai = 0; ai < 2; ++ai)
#pragma unroll
        for (int mh = 0; mh < 2; ++mh) {
          f4 xv[2][2][2];
#pragma unroll
          for (int mm = 0; mm < 2; ++mm)
#pragma unroll
            for (int bj = 0; bj < 2; ++bj)
#pragma unroll
              for (int n = 0; n < 2; ++n)
                xv[mm][bj][n] = *(const f4*)(src + ((size_t)(ai * 128 + (mh * 2 + mm) * 16) * 1024 + bj * 128 + n * 16) * 4 + lo);
#pragma unroll
          for (int mm = 0; mm < 2; ++mm)
#pragma unroll
            for (int bj = 0; bj < 2; ++bj)
#pragma unroll
              for (int n = 0; n < 2; ++n)
                *(f4*)(dst + ((size_t)(ai * 128 + (mh * 2 + mm) * 16) * 1024 + bj * 128 + n * 16) * 4 + lo) =
                    xv[mm][bj][n] + gv[bj][n] * acc[ai][bj][mh * 2 + mm][n];
        }
    } else {
      char* pp = (char*)(part + ((size_t)u.ks * NB * CTX + (size_t)b * CTX + (t0 - SEQ) + wr * 64) * 1024 + col0);
#pragma unroll
      for (int ai = 0; ai < 2; ++ai)
#pragma unroll
        for (int m = 0; m < 4; ++m)
#pragma unroll
          for (int bj = 0; bj < 2; ++bj)
#pragma unroll
            for (int n = 0; n < 2; ++n)
              *(f4*)(pp + ((size_t)(ai * 128 + m * 16) * 1024 + bj * 128 + n * 16) * 4 + lo) = gv[bj][n] * acc[ai][bj][m][n];
    }
  }
};
struct EpiUp {
  half_t* ubuf; int skip_ctx;
  DI void operator()(const f4 (&acc)[2][2][4][2], const GUnit& u, int wr, int wc, int fr, int fq) const {
    const int g0 = row0_of(u.pm, skip_ctx);
    char* rb = (char*)(ubuf + (size_t)(g0 + wr * 64) * 4096 + u.pn * 256 + wc * 32);
    const unsigned lo = (unsigned)(fr * 4096 + 8 * fq) * 2u;
#pragma unroll
    for (int ai = 0; ai < 2; ++ai)
#pragma unroll
      for (int m = 0; m < 4; ++m)
#pragma unroll
        for (int bj = 0; bj < 2; ++bj) {
          f4 a = acc[ai][bj][m][0], c = acc[ai][bj][m][1];
#pragma unroll
          for (int j = 0; j < 4; ++j) { a[j] = fmaxf(a[j], 0.f); a[j] *= a[j]; c[j] = fmaxf(c[j], 0.f); c[j] *= c[j]; }
          *(h8*)(rb + ((size_t)(ai * 128 + m * 16) * 4096 + bj * 128) * 2 + lo) = pack8(a, c);
        }
  }
};

DI void build_rope_tables(float2* tab, int wv_) {
  const int tid_ = tid_opaque(wv_);
  __syncthreads();
  for (int idx = tid_; idx < 512 + 1024; idx += NTHR) {
    const bool big = idx >= 512;
    const int j = big ? idx - 512 : idx;
    const int pos = big ? (j >> 4) : (j >> 3), i = big ? (j & 15) : (j & 7);
    const float invf = exp2f(-(float)i * (13.287712379549449f / (big ? 16.f : 8.f)));
    const float ang = (float)pos * invf;
    float sn, cs;
    sincosf(ang, &sn, &cs);
    tab[idx] = float2{cs, sn};
  }
  __syncthreads();
}
template <int DLEN, int LPR, int ROPE, bool KR>
DI void norm_rows(half_t* base, int stride, int nrows, const float* gain, float oscale, const half_t* zmla, const float2* rtab, int wv_) {
  const int tid_ = tid_opaque(wv_);
  const int lane = tid_ & 63, wave = tid_ >> 6;
  constexpr int RPW = 64 / LPR;
  const int s = lane % LPR, sub = lane / LPR;
  const bool active = s * 8 < DLEN;
  float gn[8];
#pragma unroll
  for (int i = 0; i < 8; ++i) gn[i] = active ? gain[s * 8 + i] : 0.f;
  for (int r0 = (blockIdx.x * NWAVE + wave) * RPW; r0 < nrows; r0 += gridDim.x * NWAVE * RPW) {
    const int rho = r0 + sub;
    const int t = rho % TOK;
    half_t* ptr = base + (size_t)rho * stride + s * 8;
    const half_t* src = ptr;
    if (KR && s >= 8) {
      const int b = rho / (4 * TOK);
      src = zmla + ((size_t)b * TOK + t) * ZS + 128 + (s - 8) * 8;
    }
    float f[8];
    float ss = 0.f;
    if (active) {
      const h8 v = *(const h8*)src;
#pragma unroll
      for (int i = 0; i < 8; ++i) { f[i] = (float)v[i]; ss += f[i] * f[i]; }
    } else {
#pragma unroll
      for (int i = 0; i < 8; ++i) f[i] = 0.f;
    }
#pragma unroll
    for (int o = LPR / 2; o > 0; o >>= 1) ss += __shfl_xor(ss, o);
    const float rstd = rsqrtf(ss * (1.f / DLEN) + EPS);
#pragma unroll
    for (int i = 0; i < 8; ++i) f[i] = f[i] * rstd * gn[i];
    if (ROPE != 0) {
      constexpr int PX = (ROPE == 64) ? 2 : 1;
      float pf[8];
#pragma unroll
      for (int i = 0; i < 8; ++i) pf[i] = __shfl_xor(f[i], PX);
      constexpr int RB = (DLEN - ROPE) / 8;
      if (t < SEQ && s >= RB && active) {
        const int sr = s - RB;
        const int q = (ROPE == 64) ? (sr >> 1) : sr;
        const int pos = (q < 2) ? (t >> 6) : (t & 63);
        const float sgn = (q & 1) ? 1.f : -1.f;
        constexpr int NFI = (ROPE == 64) ? 16 : 8;
        const float2* tb = rtab + ((ROPE == 64) ? 512 : 0) + pos * NFI + ((ROPE == 64) ? (sr & 1) * 8 : 0);
#pragma unroll
        for (int i = 0; i < 8; ++i) {
          const float2 cssn = tb[i];
          f[i] = f[i] * cssn.x + sgn * pf[i] * cssn.y;
        }
      }
    }
    if (active) {
      h8 o;
#pragma unroll
      for (int i = 0; i < 8; ++i) o[i] = (half_t)(f[i] * oscale);
      *(h8*)ptr = o;
    }
  }
}

constexpr int ATT_STAGE = 22528, ATT_VOFF = 13312, ATT_STASH = 49152;
template <int DQ, bool NA, int NQG>
DI void attn_wg(const half_t* Qp, const half_t* Kp, const half_t* Vp, int q0, bool active, int seg0_start, int seg0_tiles,
                int seg1_start, int seg1_tiles, const float* rpb_h, int rq, char* smem, int tid, f16v (&O)[2][NQG]) {
  constexpr int NKS = DQ / 16, KSTR = DQ + 8, VSTR = 72, CPK = DQ / 8, KCH = 64 * CPK;
  const int lane = tid & 63, r = lane & 31, h = lane >> 5;
  h8 qf[NQG][NKS];
#pragma unroll
  for (int qg = 0; qg < NQG; ++qg)
#pragma unroll
    for (int ks = 0; ks < NKS; ++ks) qf[qg][ks] = *(const h8*)(Qp + (size_t)(q0 + qg * 32 + r) * DQ + ks * 16 + h * 8);
  float mrun[NQG], lrun[NQG];
#pragma unroll
  for (int qg = 0; qg < NQG; ++qg) { mrun[qg] = -1e30f; lrun[qg] = 0.f; }
#pragma unroll
  for (int a = 0; a < 2; ++a)
#pragma unroll
    for (int c = 0; c < NQG; ++c)
#pragma unroll
      for (int i = 0; i < 16; ++i) O[a][c][i] = 0.f;
  const int ntiles = seg0_tiles + seg1_tiles;
  const int kc0 = tid, kc1 = tid + 512;
  const half_t* kg0 = Kp + kc0 * 8;
  const half_t* kg1 = Kp + kc1 * 8;
  const half_t* vg = Vp + (size_t)(tid >> 3) * TOK + (tid & 7) * 8;
  const int ks0 = (kc0 / CPK) * KSTR + (kc0 % CPK) * 8, ks1 = (kc1 / CPK) * KSTR + (kc1 % CPK) * 8, vs0 = (tid >> 3) * VSTR + (tid & 7) * 8;
  uint4 kreg0 = {0, 0, 0, 0}, kreg1 = {0, 0, 0, 0}, vreg;
  const int r0w = min(max(rq - 4, 0), 24);
  {
    const int k0 = (0 < seg0_tiles) ? seg0_start : seg1_start;
    if (kc0 < KCH) kreg0 = *(const uint4*)(kg0 + (size_t)k0 * DQ);
    if (DQ == 96 && kc1 < KCH) kreg1 = *(const uint4*)(kg1 + (size_t)k0 * DQ);
    vreg = *(const uint4*)(vg + k0);
    if (kc0 < KCH) *(uint4*)((half_t*)smem + ks0) = kreg0;
    if (DQ == 96 && kc1 < KCH) *(uint4*)((half_t*)smem + ks1) = kreg1;
    *(uint4*)((half_t*)(smem + ATT_VOFF) + vs0) = vreg;
  }
  __syncthreads();
  for (int it = 0; it < ntiles; ++it) {
    const int k0 = (it < seg0_tiles) ? seg0_start + it * 64 : seg1_start + (it - seg0_tiles) * 64;
    const bool more = it + 1 < ntiles;
    if (more) {
      const int itn = it + 1;
      const int k1 = (itn < seg0_tiles) ? seg0_start + itn * 64 : seg1_start + (itn - seg0_tiles) * 64;
      if (kc0 < KCH) kreg0 = *(const uint4*)(kg0 + (size_t)k1 * DQ);
      if (DQ == 96 && kc1 < KCH) kreg1 = *(const uint4*)(kg1 + (size_t)k1 * DQ);
      vreg = *(const uint4*)(vg + k1);
    }
    const half_t* ksm = (const half_t*)(smem + (it & 1) * ATT_STAGE) + r * KSTR + h * 8;
    const half_t* vsm = (const half_t*)(smem + (it & 1) * ATT_STAGE + ATT_VOFF) + r * VSTR + h * 4;
    const bool masked = NA && it < seg0_tiles;
    const int krow = k0 >> 6;
    const bool need = active && (!masked || (krow >= r0w && krow < r0w + 8));
    if (need) {
#pragma unroll 1
      for (int st = 0; st < 2; ++st) {
        f16v S[NQG];
#pragma unroll
        for (int qg = 0; qg < NQG; ++qg)
#pragma unroll
          for (int i = 0; i < 16; ++i) S[qg][i] = 0.f;
#pragma unroll
        for (int ks = 0; ks < NKS; ++ks) {
          const h8 kf = *(const h8*)(ksm + (st * 32) * KSTR + ks * 16);
#pragma unroll
          for (int qg = 0; qg < NQG; ++qg) S[qg] = __builtin_amdgcn_mfma_f32_32x32x16_f16(kf, qf[qg][ks], S[qg], 0, 0, 0);
        }
        if (masked) {
          const int cb = st * 32;
          const int dr = krow - rq + 7;
#pragma unroll
          for (int qg = 0; qg < NQG; ++qg) {
            const int qc = qg * 32 + r;
            const int cs = min(max(qc - 8, 0), 48);
#pragma unroll
            for (int i = 0; i < 16; ++i) {
              const int c = cb + (i & 3) + 8 * (i >> 2) + 4 * h;
              const bool valid = (c >= cs) && (c < cs + 16);
              float bias = 0.f;
              if (valid) bias = rpb_h[dr * 31 + (c - qc + 15)] * LOG2E;
              S[qg][i] = valid ? S[qg][i] + bias : -1e30f;
            }
          }
        }
        h4 vf[2][2][2];
#pragma unroll
        for (int dvt = 0; dvt < 2; ++dvt)
#pragma unroll
          for (int sx = 0; sx < 2; ++sx)
#pragma unroll
            for (int hf = 0; hf < 2; ++hf) vf[dvt][sx][hf] = *(const h4*)(vsm + (dvt * 32) * VSTR + st * 32 + sx * 16 + hf * 8);
#pragma unroll
        for (int qg = 0; qg < NQG; ++qg) {
          h8 P[2];
          float mx = S[qg][0];
#pragma unroll
          for (int i = 1; i < 16; ++i) mx = fmaxf(mx, S[qg][i]);
          mx = fmaxf(mx, __shfl_xor(mx, 32));
          const float mn = fmaxf(mrun[qg], mx);
          if (__builtin_amdgcn_ballot_w64(mn > mrun[qg]) != 0ull) {
            const float alpha = __builtin_amdgcn_exp2f(mrun[qg] - mn);
            lrun[qg] *= alpha;
#pragma unroll
            for (int dvt = 0; dvt < 2; ++dvt)
#pragma unroll
              for (int i = 0; i < 16; ++i) O[dvt][qg][i] *= alpha;
            mrun[qg] = mn;
          }
          f2 rs2 = {0.f, 0.f};
          const f2 mn2 = {mn, mn};
#pragma unroll
          for (int i = 0; i < 16; i += 2) {
            const f2 s2 = {S[qg][i], S[qg][i + 1]};
            const f2 d2 = s2 - mn2;
            f2 p2;
            p2.x = __builtin_amdgcn_exp2f(d2.x);
            p2.y = __builtin_amdgcn_exp2f(d2.y);
            if (NA) { p2.x = (s2.x <= -1e29f) ? 0.f : p2.x; p2.y = (s2.y <= -1e29f) ? 0.f : p2.y; }
            rs2 += p2;
            P[i >> 3][i & 7] = (half_t)p2.x;
            P[i >> 3][(i & 7) + 1] = (half_t)p2.y;
          }
          lrun[qg] += rs2.x + rs2.y;
#pragma unroll
          for (int dvt = 0; dvt < 2; ++dvt) {
#pragma unroll
            for (int sx = 0; sx < 2; ++sx) {
              const h8 va = __builtin_shufflevector(vf[dvt][sx][0], vf[dvt][sx][1], 0, 1, 2, 3, 4, 5, 6, 7);
              O[dvt][qg] = __builtin_amdgcn_mfma_f32_32x32x16_f16(va, P[sx], O[dvt][qg], 0, 0, 0);
            }
          }
        }
      }
    }
    if (more) {
      char* nb = smem + ((it + 1) & 1) * ATT_STAGE;
      if (kc0 < KCH) *(uint4*)((half_t*)nb + ks0) = kreg0;
      if (DQ == 96 && kc1 < KCH) *(uint4*)((half_t*)nb + ks1) = kreg1;
      *(uint4*)((half_t*)(nb + ATT_VOFF) + vs0) = vreg;
    }
    __syncthreads();
  }
#pragma unroll
  for (int qg = 0; qg < NQG; ++qg) {
    const float lt = lrun[qg] + __shfl_xor(lrun[qg], 32);
    const float inv = 1.f / lt;
#pragma unroll
    for (int dvt = 0; dvt < 2; ++dvt)
#pragma unroll
      for (int i = 0; i < 16; ++i) O[dvt][qg][i] *= inv;
  }
}

template <int NQG>
DI void store_o(const f16v (&O)[2][NQG], half_t* orow0  , int lane) {
  const int r = lane & 31, h = lane >> 5;
#pragma unroll
  for (int qg = 0; qg < NQG; ++qg)
#pragma unroll
    for (int dvt = 0; dvt < 2; ++dvt)
#pragma unroll
      for (int c = 0; c < 4; ++c) {
        h4 o;
#pragma unroll
        for (int j = 0; j < 4; ++j) o[j] = (half_t)O[dvt][qg][4 * c + j];
        *(h4*)(orow0 + (size_t)(qg * 32 + r) * 1024 + dvt * 32 + 8 * c + 4 * h) = o;
      }
}

DI void phase_attn(int l, half_t* big, bool need_ctx, char* smem, int wv_) {
  const KPtr p = kp();
  const int wave = wv_;
  const int NQB = need_ctx ? 5 : 4;
  half_t* obuf = big + B_O;
  const float lam_init = 0.8f - 0.6f * expf(-0.3f * (float)l);
  float lam;
  {
    float d1 = 0.f, d2 = 0.f;
#pragma unroll 1
    for (int i = 0; i < 32; ++i) {
      d1 += p->lq1[l * 32 + i] * p->lk1[l * 32 + i];
      d2 += p->lq2[l * 32 + i] * p->lk2[l * 32 + i];
    }
    lam = expf(d1) - expf(d2) + lam_init;
    lam = __builtin_bit_cast(float, __builtin_amdgcn_readfirstlane(__builtin_bit_cast(int, lam)));
  }
  const float one_m_li = __builtin_bit_cast(float, __builtin_amdgcn_readfirstlane(__builtin_bit_cast(int, 1.f - lam_init)));
  const int per = 4 * 16 * NQB;
#pragma unroll
  for (int mixer = 0; mixer < 4; ++mixer) {
    const int lo = mixer * per;
    const int first = lo + (int)((blockIdx.x + gridDim.x - (lo % gridDim.x)) % gridDim.x);
    const int tid_m = tid_opaque(wv_);
    const int lane = tid_m & 63, h = lane >> 5;
#pragma unroll 1
    for (int item = first; item < lo + per; item += gridDim.x) {
      const int j = item - lo;
      const bool qctx = j >= 256;
      const int xq = j & 7, yq = j >> 3, pr = xq * 8 + (yq >> 2);
      const int hh = qctx ? (j - 256) >> 4 : pr >> 4;
      const int b = qctx ? (j - 256) & 15 : pr & 15;
      const int qb = qctx ? 4 : (yq & 3);
      const bool active = !qctx || wave < 4;
      const int q0 = active ? qb * 512 + wave * 64 : SEQ;
      const int s0 = qctx ? SEQ : 0, n0t = qctx ? 4 : 36;
      f16v O[2][2];
      half_t* orow = obuf + (size_t)(b * TOK + q0) * 1024 + hh * 64;
      if (mixer == 0) {
        half_t* stash = (half_t*)(smem + ATT_STASH) + wave * 4096;
        attn_wg<32, false, 2>(big + B_QDF + (size_t)(b * 8 + hh * 2) * TOK * 32, big + B_KDF + (size_t)(b * 8 + hh * 2) * TOK * 32,
                              big + B_VTDF + (size_t)(b * 4 + hh) * 64 * TOK, q0, active, s0, n0t, 0, 0, nullptr, 0, smem, tid_m, O);
#pragma unroll
        for (int dvt = 0; dvt < 2; ++dvt)
#pragma unroll
          for (int qg = 0; qg < 2; ++qg)
#pragma unroll
            for (int i = 0; i < 16; ++i) stash[((dvt * 2 + qg) * 16 + i) * 64 + lane] = (half_t)O[dvt][qg][i];
        attn_wg<32, false, 2>(big + B_QDF + (size_t)(b * 8 + hh * 2 + 1) * TOK * 32, big + B_KDF + (size_t)(b * 8 + hh * 2 + 1) * TOK * 32,
                              big + B_VTDF + (size_t)(b * 4 + hh) * 64 * TOK, q0, active, s0, n0t, 0, 0, nullptr, 0, smem, tid_m, O);
#pragma unroll
        for (int qg = 0; qg < 2; ++qg) {
          float ss = 0.f;
#pragma unroll
          for (int dvt = 0; dvt < 2; ++dvt)
#pragma unroll
            for (int i = 0; i < 16; ++i) {
              const float v = (float)stash[((dvt * 2 + qg) * 16 + i) * 64 + lane] - lam * O[dvt][qg][i];
              O[dvt][qg][i] = v;
              ss += v * v;
            }
          ss += __shfl_xor(ss, 32);
          const float rstd = rsqrtf(ss * (1.f / 64.f) + EPS) * one_m_li;
#pragma unroll
          for (int dvt = 0; dvt < 2; ++dvt)
#pragma unroll
            for (int i = 0; i < 16; ++i) {
              const int dv = dvt * 32 + (i & 3) + 8 * (i >> 2) + 4 * h;
              O[dvt][qg][i] *= rstd * p->g_diff_sub[l * 64 + dv];
            }
        }
        if (active) store_o<2>(O, orow + 2 * 256, lane);
      } else if (mixer == 1) {
        attn_wg<96, false, 2>(big + B_QM + (size_t)(b * 4 + hh) * TOK * 96, big + B_KM + (size_t)(b * 4 + hh) * TOK * 96,
                              big + B_VTM + (size_t)(b * 4 + hh) * 64 * TOK, q0, active, s0, n0t, 0, 0, nullptr, 0, smem, tid_m, O);
        if (active) store_o<2>(O, orow + 0 * 256, lane);
      } else if (mixer == 2) {
        const int kv = hh >> 1;
        attn_wg<64, false, 2>(big + B_QG + (size_t)(b * 4 + hh) * TOK * 64, big + B_KG + (size_t)(b * 2 + kv) * TOK * 64,
                              big + B_VTG + (size_t)(b * 2 + kv) * 64 * TOK, q0, active, s0, n0t, 0, 0, nullptr, 0, smem, tid_m, O);
        if (active) store_o<2>(O, orow + 3 * 256, lane);
      } else {
        const int rq = q0 >> 6;
        const int rq0 = qb * 8;
        const int rlo = min(max(rq0 - 4, 0), 24), rhi = min(max(rq0 + 7 - 4, 0), 24) + 8;
        const int seg0s = rlo * 64, seg0n = qctx ? 0 : (rhi - rlo);
        attn_wg<64, true, 2>(big + B_QNA + (size_t)(b * 4 + hh) * TOK * 64, big + B_KNA + (size_t)(b * 4 + hh) * TOK * 64,
                             big + B_VTNA + (size_t)(b * 4 + hh) * 64 * TOK, q0, active, seg0s, seg0n, SEQ, 4,
                             p->na_rpb + (size_t)(l * 4 + hh) * 15 * 31, rq, smem, tid_m, O);
        if (active) store_o<2>(O, orow + 1 * 256, lane);
      }
    }
  }
}

struct SchedGate : SchedBase {
  const half_t* hbuf; const half_t* Wl; int pm0, cnt, G, c, mode;
  static constexpr unsigned lda2 = 2048, ldb2 = 2048;
  static DI int bmap(bool, int R) { return ((R >> 4) & 1) * 1024 + (R >> 5) * 16 + (R & 15); }
  static constexpr int BHALF = 2048;
  DI bool next(int i, GUnit& u) const {
    int pm, pn;
    if (!tile_map(i * G + c, cnt, 16, pm, pn)) return false;
    u.pm = pm0 + pm; u.pn = pn; u.nt = 16; u.aux = 0;
    u.A = (const char*)(hbuf + (size_t)row0_of(u.pm, mode) * 1024); u.B = (const char*)(Wl + W_GATE + (size_t)pn * 64 * 1024);
    return true;
  }
};
DI float gate_clamped(float x) { return fmaxf(__builtin_amdgcn_rcpf(1.f + __expf(-x)), 6.103515625e-05f); }
struct EpiGate {
  half_t* gb; int pm0;
  DI void operator()(const f4 (&acc)[2][2][4][2], const GUnit& u, int wr, int wc, int fr, int fq) const {
    char* rb = (char*)(gb + (size_t)((u.pm - pm0) * 256 + wr * 64) * 4096 + u.pn * 64 + wc * 16);
    const unsigned lo = (unsigned)(fr * 4096 + 4 * fq) * 2u;
#pragma unroll
    for (int ai = 0; ai < 2; ++ai)
#pragma unroll
      for (int m = 0; m < 4; ++m) {
        f4 gq[4];
#pragma unroll
        for (int br = 0; br < 4; ++br)
#pragma unroll
          for (int j = 0; j < 4; ++j) gq[br][j] = gate_clamped(acc[ai][br >> 1][m][br & 1][j]);
#pragma unroll
        for (int br = 0; br < 4; ++br) {
          h4 o;
#pragma unroll
          for (int j = 0; j < 4; ++j) o[j] = (half_t)(br < 3 ? gq[br][j] * __builtin_amdgcn_rcpf(gq[br + 1][j]) : gq[3][j]);
          *(h4*)(rb + ((size_t)(ai * 128 + m * 16) * 4096 + br * 1024) * 2 + lo) = o;
        }
      }
  }
};
struct SchedProj : SchedBase {
  const half_t* obuf; const half_t* Wl; int pm0, cnt, G, c, mode;
  static constexpr unsigned lda2 = 2048, ldb2 = 512;
  static constexpr bool CHAIN = true;
  DI bool next(int i, GUnit& u) const {
    int pm, pn;
    if (!tile_map((i >> 2) * G + c, cnt, 4, pm, pn)) return false;
    const int br = i & 3;
    u.pm = pm0 + pm; u.pn = pn; u.nt = 4; u.aux = br;
    u.A = (const char*)(obuf + (size_t)row0_of(u.pm, mode) * 1024 + br * 256);
    u.B = (const char*)(Wl + W_BR + (size_t)(br * 1024 + pn * 256) * 256);
    return true;
  }
};
struct EpiProj {
  const half_t* gb; half_t* mbuf; int pm0, mode;
  DI bool operator()(f4 (&acc)[2][2][4][2], const GUnit& u, int wr, int wc, int fr, int fq) const {
    const int br = u.aux;
    const char* gp = (const char*)(gb + (size_t)((u.pm - pm0) * 256 + wr * 64) * 4096 + br * 1024 + u.pn * 256 + wc * 32);
    const unsigned glo = (unsigned)(fr * 4096 + 8 * fq) * 2u;
    h8 gq[2][4][2];
#pragma unroll
    for (int ai = 0; ai < 2; ++ai)
#pragma unroll
      for (int m = 0; m < 4; ++m)
#pragma unroll
        for (int bj = 0; bj < 2; ++bj) gq[ai][m][bj] = *(const h8*)(gp + ((size_t)(ai * 128 + m * 16) * 4096 + bj * 128) * 2 + glo);
#pragma unroll
    for (int ai = 0; ai < 2; ++ai)
#pragma unroll
      for (int m = 0; m < 4; ++m)
#pragma unroll
        for (int bj = 0; bj < 2; ++bj)
#pragma unroll
          for (int j = 0; j < 4; ++j) { acc[ai][bj][m][0][j] *= (float)gq[ai][m][bj][j]; acc[ai][bj][m][1][j] *= (float)gq[ai][m][bj][4 + j]; }
    if (br < 3) return true;
    char* mp = (char*)(mbuf + (size_t)(row0_of(u.pm, mode) + wr * 64) * 1024 + u.pn * 256 + wc * 32);
    const unsigned mlo = (unsigned)(fr * 1024 + 8 * fq) * 2u;
#pragma unroll
    for (int ai = 0; ai < 2; ++ai)
#pragma unroll
      for (int m = 0; m < 4; ++m)
#pragma unroll
        for (int bj = 0; bj < 2; ++bj)
          *(h8*)(mp + ((size_t)(ai * 128 + m * 16) * 1024 + bj * 128) * 2 + mlo) = pack8(acc[ai][bj][m][0], acc[ai][bj][m][1]);
    return false;
  }
};

__global__ void __launch_bounds__(NTHR) hybrid_block_megakernel(Params p) {
  __shared__ __attribute__((aligned(16))) char smem[SMEM_BYTES];
  char* ws = kp()->ws;
  if (ws == nullptr) cg::this_grid().sync();
  half_t* W = (half_t*)(ws + OFF_W);
  float* mods = (float*)(ws + OFF_MOD);
  float* xc = (float*)(ws + OFF_XC);
  half_t* hbuf = (half_t*)(ws + OFF_H);
  half_t* big = (half_t*)(ws + OFF_BIG);
  float* part = (float*)(ws + OFF_PART);
  LAS unsigned char* lds = (LAS unsigned char*)smem;
  const int G = gridDim.x, cblk = blockIdx.x;

  const int wv_ = __builtin_amdgcn_readfirstlane((int)threadIdx.x >> 6);
  volatile LAS unsigned* st = (volatile LAS unsigned*)(lds + GEMM_LDS);
  if (threadIdx.x < 4) st[threadIdx.x] = 0u;
  __syncthreads();
  xcd_barrier_post((unsigned*)(ws + OFF_BAR), wv_);

  phase_mods(mods, smem, wv_);
  {
    int base = 0;
    float* tile = (float*)smem;
    for (int l = 0; l < 2; ++l) {
      half_t* Wl = W + (size_t)l * W_LAYER;
      const float* win = kp()->w_in + (size_t)l * 1024 * 6496;
      tconv_job(win, 6496, 192, 1024, 1024, 160, 192, Wl + W_QK, base, tile, wv_, 160);
      tconv_job(win, 6496, 0, 1024, 1024, 192, 192, Wl + W_QK + (size_t)160 * 1024, base, tile, wv_);
      tconv_job(win, 6496, 352, 1024, 1024, 512, 512, Wl + W_QK + (size_t)352 * 1024, base, tile, wv_);
      tconv_job(win, 6496, 1120, 1024, 1024, 512, 512, Wl + W_QK + (size_t)864 * 1024, base, tile, wv_);
      tconv_job(win, 6496, 1888, 1024, 1024, 384, 384, Wl + W_QK + (size_t)1376 * 1024, base, tile, wv_);
      tconv_job(win, 6496, 0, 1024, 1024, 0, 64, Wl + W_QK + (size_t)1760 * 1024, base, tile, wv_, 32);
      tconv_job(win, 6496, 864, 1024, 1024, 256, 256, Wl + W_V, base, tile, wv_);
      tconv_job(win, 6496, 1632, 1024, 1024, 256, 256, Wl + W_V + (size_t)256 * 1024, base, tile, wv_);
      tconv_job(win, 6496, 2272, 1024, 1024, 128, 256, Wl + W_V + (size_t)512 * 1024, base, tile, wv_);
      tconv_job(win, 6496, 2400, 1024, 1024, 4096, 4096, Wl + W_GATE, base, tile, wv_);
      for (int br = 0; br < 4; ++br)
        tconv_job(kp()->w_branch + ((size_t)l * 4 + br) * 256 * 1024, 1024, 0, 256, 256, 1024, 1024, Wl + W_BR + (size_t)br * 1024 * 256, base, tile, wv_);
      tconv_job(kp()->w_out + (size_t)l * 1024 * 1024, 1024, 0, 1024, 1024, 1024, 1024, Wl + W_OUT, base, tile, wv_);
      tconv_job(kp()->w_up + (size_t)l * 1024 * 4096, 4096, 0, 1024, 1024, 4096, 4096, Wl + W_UP, base, tile, wv_);
      tconv_job(kp()->w_down + (size_t)l * 4096 * 1024, 1024, 0, 4096, 4096, 1024, 1024, Wl + W_DOWN, base, tile, wv_);
      tconv_job(kp()->w_mla_uq + (size_t)l * 192 * 384, 384, 0, 256, 192, 384, 512, Wl + W_UQ, base, tile, wv_, -1, 64);
      for (int hh = 0; hh < 4; ++hh) {
        tconv_job(kp()->w_mla_ukv + (size_t)l * 128 * 512, 512, hh * 128, 256, 128, 64, 64, Wl + W_UK + (size_t)hh * 64 * 256, base, tile, wv_);
        tconv_job(kp()->w_mla_ukv + (size_t)l * 128 * 512, 512, hh * 128 + 64, 256, 128, 64, 64, Wl + W_UV + (size_t)hh * 64 * 256, base, tile, wv_);
      }
    }
  }
  xcd_barrier(ws, lds, wv_);

  for (int l = 0; l < 2; ++l) {
    const bool need_ctx = (l == 0);
    const bool skip_ctx = !need_ctx;
    const half_t* Wl = W + (size_t)l * W_LAYER;
    const float* mods_l = mods + (size_t)l * 17 * 6144;
    const float* xl_src = (l == 0) ? kp()->x : kp()->out;
    const float* xc_src = (l == 0) ? kp()->ctx : xc;
    const int nrt = skip_ctx ? 128 : 144;

    phase_norm(xl_src, xc_src, kp()->g_norm1 + l * 1024, mods_l, 0, 1024, hbuf, false, (l == 1) ? part : nullptr, nullptr, wv_);
    xcd_barrier(ws, lds, wv_);
    {
      SchedInproj S{{}, hbuf, Wl, G, cblk};
      EpiInproj E{big};
      gemm256<true>(lds, S, E, wv_);
    }
    xcd_barrier(ws, lds, wv_);
    {
      build_rope_tables((float2*)smem, wv_);
      half_t* zmla = big + B_ZMLA;
      norm_rows<192, 32, 0, false>(zmla + 160, ZS, NTOK, kp()->g_mla_qa + l * 192, 1.f, nullptr, (const float2*)smem, wv_);
      norm_rows<128, 16, 0, false>(zmla, ZS, NTOK, kp()->g_mla_kva + l * 128, 1.f, nullptr, (const float2*)smem, wv_);
      norm_rows<64, 8, 0, false>(big + B_QNA, 64, NTOK * 4, kp()->g_na_q + l * 64, 0.125f * LOG2E, nullptr, (const float2*)smem, wv_);
      norm_rows<64, 8, 0, false>(big + B_KNA, 64, NTOK * 4, kp()->g_na_k + l * 64, 1.f, nullptr, (const float2*)smem, wv_);
      norm_rows<32, 4, 32, false>(big + B_QDF, 32, NTOK * 8, kp()->g_diff_q + l * 32, 0.17677669529663687f * LOG2E, nullptr, (const float2*)smem, wv_);
      norm_rows<32, 4, 32, false>(big + B_KDF, 32, NTOK * 8, kp()->g_diff_k + l * 32, 1.f, nullptr, (const float2*)smem, wv_);
      norm_rows<64, 8, 64, false>(big + B_QG, 64, NTOK * 4, kp()->g_gqa_q + l * 64, 0.125f * LOG2E, nullptr, (const float2*)smem, wv_);
      norm_rows<64, 8, 64, false>(big + B_KG, 64, NTOK * 2, kp()->g_gqa_k + l * 64, 1.f, nullptr, (const float2*)smem, wv_);
    }
    xcd_barrier(ws, lds, wv_);
    {
      SchedMlaQK S{{}, Wl, big + B_ZMLA, G, cblk};
      EpiMla E{big};
      gemm256<true>(lds, S, E, wv_);
      SchedMlaV S2{{}, Wl, big + B_ZMLA, G, cblk};
      gemm256<true>(lds, S2, E, wv_);
    }
    xcd_barrier(ws, lds, wv_);
    build_rope_tables((float2*)smem, wv_);
    norm_rows<96, 16, 32, false>(big + B_QM, 96, NTOK * 4, kp()->g_mla_q + l * 96, 0.10206207261596575f * LOG2E, nullptr, (const float2*)smem, wv_);
    norm_rows<96, 16, 32, true>(big + B_KM, 96, NTOK * 4, kp()->g_mla_k + l * 96, 1.f, big + B_ZMLA, (const float2*)smem, wv_);
    xcd_barrier(ws, lds, wv_);
    phase_attn(l, big, need_ctx, smem, wv_);
    xcd_barrier(ws, lds, wv_);
    {
      const int nsp = need_ctx ? 3 : 2;
      for (int j = 0; j < nsp; ++j) {
        const int mode = (j < 2) ? 1 : 2, pm0 = (j < 2) ? j * 64 : 0, cnt = (j < 2) ? 64 : 16;
        {
          SchedGate S{{}, hbuf, Wl, pm0, cnt, G, cblk, mode};
          EpiGate E{big + B_G0, pm0};
          gemm256<false>(lds, S, E, wv_);
        }
        xcd_barrier(ws, lds, wv_);
        {
          SchedProj S{{}, big + B_O, Wl, pm0, cnt, G, cblk, mode};
          EpiProj E{big + B_G0, big + B_M, pm0, mode};
          gemm256<true>(lds, S, E, wv_);
        }
        xcd_barrier(ws, lds, wv_);
      }
    }
    {
      SchedResid S{{}, big + B_M, Wl + W_OUT, 1024, 4, need_ctx ? 16 : 0, G, cblk, 2048u, 2048u};
      EpiResid E{xl_src, kp()->out, part, mods_l, 2048};
      gemm256<false>(lds, S, E, wv_);
    }
    xcd_barrier(ws, lds, wv_);
    phase_norm(kp()->out, xc_src, kp()->g_norm2 + l * 1024, mods_l, 3072, 4096, hbuf, skip_ctx, need_ctx ? part : nullptr, need_ctx ? xc : nullptr, wv_);
    xcd_barrier(ws, lds, wv_);
    {
      SchedRows S{{}, hbuf, Wl + W_UP, 1024, nrt, 16, G, cblk, skip_ctx ? 1 : 0, 2048u, 2048u};
      EpiUp E{big + B_U, skip_ctx ? 1 : 0};
      gemm256<true>(lds, S, E, wv_);
    }
    xcd_barrier(ws, lds, wv_);
    {
      SchedResid S{{}, big + B_U, Wl + W_DOWN, 4096, 4, need_ctx ? 16 : 0, G, cblk, 8192u, 8192u};
      EpiResid E{kp()->out, kp()->out, part, mods_l, 5120};
      gemm256<false>(lds, S, E, wv_);
    }
    if (l == 0) xcd_barrier(ws, lds, wv_);
  }
}

extern "C" void kernel_launch(void* const* d_in, const int* in_sizes, int n_in, void* d_out, int out_size, void* d_ws,
                              size_t ws_size, hipStream_t stream) {
  static int grid_blocks = 0;
  if (!grid_blocks) {
    int dev = 0, cus = 0, per_cu = 0;
    (void)hipGetDevice(&dev);
    (void)hipDeviceGetAttribute(&cus, hipDeviceAttributeMultiprocessorCount, dev);
    (void)hipOccupancyMaxActiveBlocksPerMultiprocessor(&per_cu, hybrid_block_megakernel, NTHR, 0);
    if (per_cu < 1) fprintf(stderr, "occupancy query returned %d\n", per_cu);
    grid_blocks = cus;
  }
  if (ws_size < WS_NEED) fprintf(stderr, "workspace too small: %zu < %zu\n", ws_size, (size_t)WS_NEED);
  (void)hipMemsetAsync((char*)d_ws + OFF_BAR, 0, XCD_BAR_WORDS * 4, stream);
  Params p{};
  const float** pf = (const float**)&p;
  for (int i = 0; i < 31; ++i) pf[i] = (const float*)d_in[i];
  p.out = (float*)d_out;
  p.ws = (char*)d_ws;
  void* args[] = {&p};
  hipError_t e = hipLaunchCooperativeKernel((void*)hybrid_block_megakernel, dim3(grid_blocks), dim3(NTHR), args, 0, stream);
  if (e != hipSuccess) fprintf(stderr, "cooperative launch failed: %s (grid %d)\n", hipGetErrorString(e), grid_blocks);
}
```

```cpp
#include <hip/hip_runtime.h>
#include <hip/hip_cooperative_groups.h>
#include <cstdio>
namespace cg = cooperative_groups;

typedef _Float16 half_t;
typedef __attribute__((ext_vector_type(8))) _Float16 h8;
typedef __attribute__((ext_vector_type(4))) _Float16 h4;
typedef __attribute__((ext_vector_type(4))) float f4;
typedef __attribute__((ext_vector_type(2))) float f2;
typedef __attribute__((ext_vector_type(16))) float f16v;

#define DI __device__ __forceinline__
#define LAS __attribute__((address_space(3)))

constexpr int NB = 16, SEQ = 2048, CTX = 256, TOK = 2304, NTOK = NB * TOK;
constexpr float LOG2E = 1.4426950408889634f;
constexpr float EPS = 1e-6f;

constexpr int NQK = 1792;
constexpr int NVT = 768;
constexpr int ZS = 352;
constexpr size_t W_QK = 0;
constexpr size_t W_V = W_QK + (size_t)NQK * 1024;
constexpr size_t W_GATE = W_V + (size_t)NVT * 1024;
constexpr size_t W_BR = W_GATE + (size_t)4096 * 1024;
constexpr size_t W_OUT = W_BR + (size_t)4 * 1024 * 256;
constexpr size_t W_UP = W_OUT + (size_t)1024 * 1024;
constexpr size_t W_DOWN = W_UP + (size_t)4096 * 1024;
constexpr size_t W_UQ = W_DOWN + (size_t)1024 * 4096;
constexpr size_t W_UK = W_UQ + (size_t)512 * 256;
constexpr size_t W_UV = W_UK + (size_t)256 * 256;
constexpr size_t W_LAYER = W_UV + (size_t)256 * 256;

constexpr size_t al256(size_t x) { return (x + 255) & ~(size_t)255; }
constexpr size_t OFF_BAR = 0;
constexpr size_t OFF_W = 16384;
constexpr size_t OFF_MOD = al256(OFF_W + 2 * W_LAYER * 2);
constexpr size_t OFF_XC = al256(OFF_MOD + (size_t)2 * 17 * 6144 * 4);
constexpr size_t OFF_H = al256(OFF_XC + (size_t)NB * CTX * 1024 * 4);
constexpr size_t OFF_BIG = al256(OFF_H + (size_t)NTOK * 1024 * 2);
constexpr size_t B_O = 0;
constexpr size_t B_QM = B_O + (size_t)NTOK * 1024;
constexpr size_t B_KM = B_QM + (size_t)NTOK * 384;
constexpr size_t B_VTM = B_KM + (size_t)NTOK * 384;
constexpr size_t B_QNA = B_VTM + (size_t)NTOK * 256;
constexpr size_t B_KNA = B_QNA + (size_t)NTOK * 256;
constexpr size_t B_VTNA = B_KNA + (size_t)NTOK * 256;
constexpr size_t B_QDF = B_VTNA + (size_t)NTOK * 256;
constexpr size_t B_KDF = B_QDF + (size_t)NTOK * 256;
constexpr size_t B_VTDF = B_KDF + (size_t)NTOK * 256;
constexpr size_t B_QG = B_VTDF + (size_t)NTOK * 256;
constexpr size_t B_KG = B_QG + (size_t)NTOK * 256;
constexpr size_t B_VTG = B_KG + (size_t)NTOK * 128;
constexpr size_t B_ZMLA = B_VTG + (size_t)NTOK * 128;
constexpr size_t B_END = B_ZMLA + (size_t)NTOK * ZS;
constexpr size_t B_M = B_O + (size_t)NTOK * 1024;
constexpr size_t GSLAB = (size_t)64 * 256 * 4096;
constexpr size_t B_G0 = B_M + (size_t)NTOK * 1024;
constexpr size_t B_P5END = B_G0 + GSLAB;
constexpr size_t B_U = 0;
constexpr size_t B_MAX = B_END > B_P5END ? B_END : B_P5END;
constexpr size_t OFF_PART = OFF_BIG + (size_t)NTOK * 4096 * 2;
constexpr size_t WS_NEED = (OFF_BIG + B_MAX * 2) > (OFF_PART + (size_t)4 * NB * CTX * 1024 * 4) ? (OFF_BIG + B_MAX * 2) : (OFF_PART + (size_t)4 * NB * CTX * 1024 * 4);
static_assert(B_P5END * 2 <= (size_t)NTOK * 4096 * 2, "merge buffers must end before the partial buffer");
static_assert(B_MAX >= (size_t)NTOK * 4096, "u must fit");
static_assert(WS_NEED <= (size_t)536870912, "workspace budget");

constexpr int NTHR = 512, NWAVE = 8;
constexpr int GEMM_LDS = 131072;
constexpr int SMEM_BYTES = GEMM_LDS + 16;

struct Params {
  const float *x, *c, *ctx, *c_ctx, *w_ada, *b_ada, *g_norm1, *g_norm2, *w_in;
  const float *g_mla_qa, *w_mla_uq, *g_mla_kva, *w_mla_ukv, *g_mla_q, *g_mla_k;
  const float *g_na_q, *g_na_k, *na_rpb;
  const float *g_diff_q, *g_diff_k, *lq1, *lk1, *lq2, *lk2, *g_diff_sub;
  const float *g_gqa_q, *g_gqa_k, *w_branch, *w_out, *w_up, *w_down;
  float* out;
  char* ws;
};


typedef const Params __attribute__((address_space(4))) * KPtr;
DI KPtr kp() {
  KPtr q = (KPtr)__builtin_amdgcn_kernarg_segment_ptr();
  asm volatile("" : "+s"(q));
  return q;
}

DI int tid_opaque(int wv_) {
  unsigned z = 0u;
  asm volatile("" : "+v"(z));
  int t = (wv_ << 6) | (int)__builtin_amdgcn_mbcnt_hi(~0u, __builtin_amdgcn_mbcnt_lo(~0u, z));
  asm volatile("" : "+v"(t));
  return t;
}


typedef unsigned u4v __attribute__((ext_vector_type(4)));
typedef unsigned u2v __attribute__((ext_vector_type(2)));
DI void wt16(const void* ubase, unsigned voff, u4v v) {
  asm volatile("global_store_dwordx4 %0, %1, %2 sc1\n\ts_nop 1" :: "v"(voff), "v"(v), "s"(ubase) : "memory");
}
DI void wt8(const void* ubase, unsigned voff, u2v v) {
  asm volatile("global_store_dwordx2 %0, %1, %2 sc1\n\ts_nop 1" :: "v"(voff), "v"(v), "s"(ubase) : "memory");
}
DI void wt16p(void* p, u4v v) {
  asm volatile("global_store_dwordx4 %0, %1, off sc1\n\ts_nop 1" :: "v"(p), "v"(v) : "memory");
}
DI void wt8p(void* p, u2v v) {
  asm volatile("global_store_dwordx2 %0, %1, off sc1\n\ts_nop 1" :: "v"(p), "v"(v) : "memory");
}
DI void wt2p(void* p, half_t v) {
  const unsigned u = (unsigned)__builtin_bit_cast(unsigned short, v);
  asm volatile("global_store_short %0, %1, off sc1\n\ts_nop 1" :: "v"(p), "v"(u) : "memory");
}
DI u4v as_u4(h8 v) { return __builtin_bit_cast(u4v, v); }
DI u4v as_u4(f4 v) { return __builtin_bit_cast(u4v, v); }
DI u2v as_u2(h4 v) { return __builtin_bit_cast(u2v, v); }

DI float wave_sum(float v) {
#pragma unroll
  for (int o = 32; o > 0; o >>= 1) v += __shfl_xor(v, o);
  return v;
}

#define XB_TMO      128
#define XB_XCNT(j)  (256  + 64 * (j))
#define XB_XSUB(j)  (1280 + 64 * (j))
#define XB_XGEN(j)  (2304 + 64 * (j))
#define XB_TOP      3328
#define XB_TOPGEN   3392
#define XCD_BAR_WORDS 3456
#define XB_SPIN_CAP (1u << 22)
DI unsigned xb_ld(unsigned* p) { return __hip_atomic_load(p, __ATOMIC_RELAXED, __HIP_MEMORY_SCOPE_AGENT); }
DI unsigned xb_add(unsigned* p, unsigned v) { return __hip_atomic_fetch_add(p, v, __ATOMIC_RELAXED, __HIP_MEMORY_SCOPE_AGENT); }
DI unsigned xb_xcc_id() { return (unsigned)__builtin_amdgcn_s_getreg((3 << 11) | 20) & 0xFu; }
#define XB_SPIN(cond, bar) do { unsigned _sp = 0; while (cond) { __builtin_amdgcn_s_sleep(1); \
    if ((++_sp & 255u) == 0u) { if (xb_ld(&(bar)[XB_TMO])) break; if (_sp > XB_SPIN_CAP) { atomicAdd(&(bar)[XB_TMO], 1u); break; } } } } while (0)
DI void xcd_barrier_post(unsigned* bar, int wv_) {
  if (tid_opaque(wv_) == 0) (void)xb_add(&bar[XB_XCNT(xb_xcc_id())], 1u);
}
DI void xcd_barrier_complete(unsigned* bar, unsigned x, unsigned& nloc, unsigned& nx) {
  const unsigned G = gridDim.x * gridDim.y * gridDim.z;
  unsigned sum, cnt, mine, sp = 0u;
  for (;;) {
    sum = 0u; cnt = 0u; mine = 0u;
#pragma unroll
    for (unsigned j = 0; j < 16; ++j) { const unsigned c = xb_ld(&bar[XB_XCNT(j)]); sum += c; cnt += (c > 0u) ? 1u : 0u; mine = (j == x) ? c : mine; }
    if (sum == G) break;
    __builtin_amdgcn_s_sleep(1);
    if ((++sp & 255u) == 0u) { if (xb_ld(&bar[XB_TMO])) break; if (sp > XB_SPIN_CAP) { atomicAdd(&bar[XB_TMO], 1u); break; } }
  }
  nloc = mine > 0u ? mine : 1u; nx = cnt > 0u ? cnt : 1u;
}
DI void xcd_barrier(char* ws_, LAS unsigned char* lds_, int wv_) {
  asm volatile("s_waitcnt vmcnt(0)" ::: "memory");
  __syncthreads();
  if (tid_opaque(wv_) == 0) {
    char* wsl = ws_;
    asm volatile("" : "+s"(wsl));
    unsigned* bar = (unsigned*)(wsl + OFF_BAR);
    volatile LAS unsigned* st = (volatile LAS unsigned*)(lds_ + GEMM_LDS);
    const unsigned x = xb_xcc_id();
    __builtin_amdgcn_s_waitcnt(0);
    unsigned nloc = st[0], nx = st[1];
    if (nloc == 0u) { xcd_barrier_complete(bar, x, nloc, nx); st[0] = nloc; st[1] = nx; }
    const unsigned old = xb_add(&bar[XB_XSUB(x)], 1u);
    const unsigned gen = old / nloc;
    if (old + 1u == (gen + 1u) * nloc) {
      __builtin_amdgcn_fence(__ATOMIC_RELEASE, "agent");
      asm volatile("s_waitcnt vmcnt(0)" ::: "memory");
      const unsigned og = xb_add(&bar[XB_TOP], 1u);
      const unsigned tg = og / nx;
      if (og + 1u == (tg + 1u) * nx) xb_add(&bar[XB_TOPGEN], 1u);
      else XB_SPIN(xb_ld(&bar[XB_TOPGEN]) == tg, bar);
      __builtin_amdgcn_fence(__ATOMIC_ACQUIRE, "agent");
      xb_add(&bar[XB_XGEN(x)], 1u);
      asm volatile("s_waitcnt vmcnt(0)" ::: "memory");
    } else {
      XB_SPIN(xb_ld(&bar[XB_XGEN(x)]) == gen, bar);
      __builtin_amdgcn_fence(__ATOMIC_ACQUIRE, "agent");
      asm volatile("s_waitcnt vmcnt(0)" ::: "memory");
    }
  }
  __syncthreads();
}

DI void phase_mods(float* mods, char* smem, int wv_) {
  const KPtr p = kp();
  float* sil = (float*)smem;
  const int tid = tid_opaque(wv_);
  for (int w = blockIdx.x; w < 192; w += gridDim.x) {
    const int l = w / 96, n0 = (w % 96) * 64;
    __syncthreads();
    for (int idx = tid; idx < 17 * 1024; idx += NTHR) {
      const int b = idx >> 10, k = idx & 1023;
      const float v = (b < 16) ? p->c[b * 1024 + k] : p->c_ctx[k];
      sil[idx] = v / (1.f + expf(-v));
    }
    __syncthreads();
    const int kq = tid >> 6, nn = tid & 63;
    float acc[17];
#pragma unroll
    for (int b = 0; b < 17; ++b) acc[b] = 0.f;
    const float* wp = p->w_ada + (size_t)l * 1024 * 6144 + (size_t)(kq * 128) * 6144 + n0 + nn;
    const float* sp = sil + kq * 128;
#pragma unroll 4
    for (int k = 0; k < 128; ++k) {
      const float wv = wp[(size_t)k * 6144];
#pragma unroll
      for (int b = 0; b < 17; ++b) acc[b] += sp[b * 1024 + k] * wv;
    }
    __syncthreads();
    float* red = (float*)smem;
#pragma unroll
    for (int b = 0; b < 17; ++b) red[(kq * 17 + b) * 64 + nn] = acc[b];
    __syncthreads();
    for (int idx = tid; idx < 17 * 64; idx += NTHR) {
      float s = p->b_ada[l * 6144 + n0 + (idx & 63)];
#pragma unroll
      for (int q = 0; q < 8; ++q) s += red[q * 17 * 64 + idx];
      mods[((size_t)l * 17 + (idx >> 6)) * 6144 + n0 + (idx & 63)] = s;
    }
  }
  __syncthreads();
}

DI void tconv_job(const float* src, int ld, int c0, int K, int Kvalid, int Nvalid, int Npad, half_t* dst, int& base,
                  float* tile, int wv_, int Nwrite = -1, int kshift = 0) {
  if (Nwrite < 0) Nwrite = Npad;
  const int nnt = Npad / 64, tot = (K / 64) * nnt;
  const int G = gridDim.x;
  const int start = (int)((blockIdx.x + G - (base % G)) % G);
  const int tid_ = tid_opaque(wv_);
  const int tx = tid_ & 63, ty = tid_ >> 6;
  for (int t = start; t < tot; t += 2 * G) {
    const int t2 = t + G;
    const bool has2 = t2 < tot;
    const int kt = t / nnt, nt = t % nnt, kt2 = has2 ? t2 / nnt : kt, nt2 = has2 ? t2 % nnt : nt;
    float r0[8], r1[8];
#pragma unroll
    for (int i = 0; i < 8; ++i) {
      const int k = i * 8 + ty, n = nt * 64 + tx, n2 = nt2 * 64 + tx;
      const int ks0 = kt * 64 + k - kshift, ks1 = kt2 * 64 + k - kshift;
      r0[i] = (n < Nvalid && ks0 >= 0 && ks0 < Kvalid) ? src[(size_t)ks0 * ld + c0 + n] : 0.f;
      r1[i] = (has2 && n2 < Nvalid && ks1 >= 0 && ks1 < Kvalid) ? src[(size_t)ks1 * ld + c0 + n2] : 0.f;
    }
    __syncthreads();
#pragma unroll
    for (int i = 0; i < 8; ++i) {
      tile[(i * 8 + ty) * 65 + tx] = r0[i];
      tile[64 * 65 + (i * 8 + ty) * 65 + tx] = r1[i];
    }
    __syncthreads();
#pragma unroll
    for (int i = 0; i < 8; ++i) {
      const int n = i * 8 + ty;
      if (nt * 64 + n < Nwrite) dst[(size_t)(nt * 64 + n) * K + kt * 64 + tx] = (half_t)tile[tx * 65 + n];
      if (has2 && nt2 * 64 + n < Nwrite) dst[(size_t)(nt2 * 64 + n) * K + kt2 * 64 + tx] = (half_t)tile[64 * 65 + tx * 65 + n];
    }
  }
  base += tot;
}

struct NormRow { const float* mod; int g, b, t; bool valid, isctx; };
DI void norm_load(int g, const float* xl, const float* xc, const float* mods_l, bool skip_ctx, int lane, float4 (&v)[4], NormRow& r) {
  r.g = g; r.valid = g < NTOK;
  const int gg = r.valid ? g : 0;
  r.b = gg / TOK; r.t = gg - r.b * TOK;
  r.isctx = r.t >= SEQ;
  if (r.isctx && skip_ctx) r.valid = false;
  const float* src = r.isctx ? xc + ((size_t)r.b * CTX + (r.t - SEQ)) * 1024 : xl + ((size_t)r.b * SEQ + r.t) * 1024;
  r.mod = mods_l + (size_t)(r.isctx ? 16 : r.b) * 6144;
  if (r.valid) {
#pragma unroll
    for (int i = 0; i < 4; ++i) v[i] = *(const float4*)(src + i * 256 + lane * 4);
  } else {
#pragma unroll
    for (int i = 0; i < 4; ++i) v[i] = float4{0.f, 0.f, 0.f, 0.f};
  }
}
DI void norm_finish(float4 (&v)[4], const NormRow& r, const float* gam, int sh_off, int sc_off, half_t* h, const float* part, float* xc_store, int lane) {
  if (r.valid && r.isctx && part != nullptr) {
    const size_t ro = ((size_t)r.b * CTX + (r.t - SEQ)) * 1024;
#pragma unroll
    for (int i = 0; i < 4; ++i) {
#pragma unroll
      for (int ks = 0; ks < 4; ++ks) {
        const float4 pv = *(const float4*)(part + (size_t)ks * NB * CTX * 1024 + ro + i * 256 + lane * 4);
        v[i].x += pv.x; v[i].y += pv.y; v[i].z += pv.z; v[i].w += pv.w;
      }
      if (xc_store != nullptr) *(float4*)(xc_store + ro + i * 256 + lane * 4) = v[i];
    }
  }
  float ss = 0.f;
#pragma unroll
  for (int i = 0; i < 4; ++i) ss += v[i].x * v[i].x + v[i].y * v[i].y + v[i].z * v[i].z + v[i].w * v[i].w;
  ss = wave_sum(ss);
  if (!r.valid) return;
  const float rstd = rsqrtf(ss * (1.f / 1024.f) + EPS);
#pragma unroll
  for (int i = 0; i < 4; ++i) {
    const int col = i * 256 + lane * 4;
    const float4 gg = *(const float4*)(gam + col);
    const float4 sc = *(const float4*)(r.mod + sc_off + col);
    const float4 sh = *(const float4*)(r.mod + sh_off + col);
    h4 o;
    o[0] = (half_t)(v[i].x * rstd * gg.x * (1.f + sc.x) + sh.x);
    o[1] = (half_t)(v[i].y * rstd * gg.y * (1.f + sc.y) + sh.y);
    o[2] = (half_t)(v[i].z * rstd * gg.z * (1.f + sc.z) + sh.z);
    o[3] = (half_t)(v[i].w * rstd * gg.w * (1.f + sc.w) + sh.w);
    *(h4*)(h + (size_t)r.g * 1024 + col) = o;
  }
}
DI void phase_norm(const float* xl, const float* xc, const float* gam, const float* mods_l, int sh_off,
                   int sc_off, half_t* h, bool skip_ctx, const float* part, float* xc_store, int wv_) {
  const int tid_ = tid_opaque(wv_);
  const int wave = tid_ >> 6, lane = tid_ & 63;
  const int stride = gridDim.x * NWAVE;
  for (int g = blockIdx.x * NWAVE + wave; g < NTOK; g += 2 * stride) {
    float4 v0[4], v1[4];
    NormRow r0, r1;
    norm_load(g, xl, xc, mods_l, skip_ctx, lane, v0, r0);
    norm_load(g + stride, xl, xc, mods_l, skip_ctx, lane, v1, r1);
    norm_finish(v0, r0, gam, sh_off, sc_off, h, part, xc_store, lane);
    norm_finish(v1, r1, gam, sh_off, sc_off, h, part, xc_store, lane);
  }
}

constexpr int BK = 64, HALF = 128, HTB = HALF * BK * 2;
DI int lds_byte(int r, int c) { const int st = (r >> 4) * 2 + (c >> 5), rr = r & 15, cc = c & 31, ob = rr * 64 + cc * 2; return st * 1024 + (ob ^ (((ob >> 9) & 1) << 5)); }
DI void stage_rc(int b, int& R, int& C) { const int st = b / 1024, sb = b % 1024, swz = sb ^ (((sb >> 9) & 1) << 5); R = (st >> 1) * 16 + swz / 64; C = (st & 1) * 32 + (swz % 64) / 2; }
DI int perm32(int rho) { const int n = rho >> 4, i = rho & 15; return 8 * (i >> 2) + 4 * n + (i & 3); }

struct SchedBase {
  static DI int bmap(bool perm, int R) { return perm ? ((R & ~31) + perm32(R & 31)) : R; }
  static constexpr int BHALF = 128;
  static constexpr bool CHAIN = false;
};
struct GUnit { const char* A; const char* B; int nt, pm, pn, aux, ks; };

DI bool tile_map(int L, int nM, int nN, int& pm, int& pn) {
  const int nwg = nM * nN;
  if (L >= nwg) return false;
  int wgid = L;
  { const int q = nwg / 8, r = nwg % 8, xcd = wgid % 8, off = wgid / 8; wgid = (xcd < r ? xcd * (q + 1) : r * (q + 1) + (xcd - r) * q) + off; }
  const int nig = 8 * nN, gid = wgid / nig, fm = gid * 8, gsz = (nM - fm) < 8 ? (nM - fm) : 8;
  pm = fm + ((wgid % nig) % gsz); pn = (wgid % nig) / gsz;
  return true;
}

template <bool PERM, class Sched, class Epi>
DI void gemm256(LAS unsigned char* lds, const Sched& S, const Epi& E, int wv_) {
  const int tid = tid_opaque(wv_), wid = __builtin_amdgcn_readfirstlane(tid >> 6), lane = tid & 63, wr = wid >> 2, wc = wid & 3, fr = lane & 15, fq = lane >> 4;
  unsigned cvA0, cvA1, cvB0, cvB1;
  { int R, C;
    stage_rc(tid * 16, R, C); cvA0 = (unsigned)R * S.lda2 + C * 2; cvB0 = (unsigned)Sched::bmap(PERM, R) * S.ldb2 + C * 2;
    stage_rc(tid * 16 + 8192, R, C); cvA1 = (unsigned)R * S.lda2 + C * 2; cvB1 = (unsigned)Sched::bmap(PERM, R) * S.ldb2 + C * 2; }
  const size_t chA = (size_t)HALF * S.lda2, chB = (size_t)Sched::BHALF * S.ldb2;
  const size_t kstep = (size_t)(BK * 2);
  const unsigned ldsw = (unsigned)wid * 1024u;
  const int aoff = lds_byte(wr * 64 + fr, fq * 8), boff = lds_byte(wc * 32 + fr, fq * 8);
#define G_SA(b, h) (((b) * 2 + (h)) * HTB)
#define G_SB(b, h) ((4 + (b) * 2 + (h)) * HTB)
#define G_STAGE(bufoff, gbase, v0, v1) do { \
    __builtin_amdgcn_global_load_lds((const unsigned*)((const char*)(gbase) + (v0)), (LAS unsigned*)(lds + (bufoff) + ldsw), 16, 0, 0); \
    __builtin_amdgcn_global_load_lds((const unsigned*)((const char*)(gbase) + (v1)), (LAS unsigned*)(lds + (bufoff) + ldsw + 8192), 16, 0, 0); } while (0)
#define G_LDA(dst, b, h) do { _Pragma("unroll") for (int m = 0; m < 4; ++m) _Pragma("unroll") for (int k = 0; k < 2; ++k) dst[m][k] = *(const LAS h8*)(lds + G_SA(b, h) + aoff + m * 2048 + k * 1024); } while (0)
#define G_LDB(dst, b, h) do { _Pragma("unroll") for (int n = 0; n < 2; ++n) _Pragma("unroll") for (int k = 0; k < 2; ++k) dst[n][k] = *(const LAS h8*)(lds + G_SB(b, h) + boff + n * 2048 + k * 1024); } while (0)
#define G_MMA(ai, bj, At, Bt) do { __builtin_amdgcn_s_setprio(1); _Pragma("unroll") for (int m = 0; m < 4; ++m) _Pragma("unroll") for (int n = 0; n < 2; ++n) _Pragma("unroll") for (int k = 0; k < 2; ++k) \
    acc[ai][bj][m][n] = __builtin_amdgcn_mfma_f32_16x16x32_f16(Bt[n][k], At[m][k], acc[ai][bj][m][n], 0, 0, 0); __builtin_amdgcn_s_setprio(0); } while (0)
#define G_WAIT_V(n) asm volatile("s_waitcnt vmcnt(" #n ")" ::: "memory")
#define G_WAIT_L(n) asm volatile("s_waitcnt lgkmcnt(" #n ")" ::: "memory")
#define G_BAR __builtin_amdgcn_s_barrier()
#define G_SCHED __builtin_amdgcn_sched_barrier(0)
  GUnit cur, nxt;
  int ui = 0;
  if (!S.next(0, cur)) return;
  f4 acc[2][2][4][2];
#pragma unroll
  for (int a = 0; a < 2; ++a)
#pragma unroll
    for (int b = 0; b < 2; ++b)
#pragma unroll
      for (int m = 0; m < 4; ++m)
#pragma unroll
        for (int n = 0; n < 2; ++n) acc[a][b][m][n] = f4{0.f, 0.f, 0.f, 0.f};
  h8 At[4][2], B0[2][2], B1[2][2];
  const char* cA = cur.A;
  const char* cB = cur.B;
  G_STAGE(G_SB(0, 0), cB, cvB0, cvB1); G_STAGE(G_SA(0, 0), cA, cvA0, cvA1); G_STAGE(G_SB(0, 1), cB + chB, cvB0, cvB1); G_STAGE(G_SA(0, 1), cA + chA, cvA0, cvA1);
  if (wr == 1) G_BAR;
  G_WAIT_V(4); G_BAR;
  G_STAGE(G_SB(1, 0), cB + kstep, cvB0, cvB1); G_STAGE(G_SA(1, 0), cA + kstep, cvA0, cvA1); G_STAGE(G_SB(1, 1), cB + chB + kstep, cvB0, cvB1);
  G_WAIT_V(6); G_BAR;
  for (;;) {
    const bool has_next = S.next(ui + 1, nxt);
    const char* nA = has_next ? nxt.A : cA;
    const char* nB = has_next ? nxt.B : cB;
    int nt = cur.nt;
    asm volatile("" : "+s"(nt));
    for (int t = 0; t < nt; t += 2) {
      const bool last = (t == nt - 2);
      const char* a1 = cA + (size_t)(t + 1) * kstep;
      const char* a2 = last ? nA : cA + (size_t)(t + 2) * kstep;
      const char* b2 = last ? nB : cB + (size_t)(t + 2) * kstep;
      const char* a3 = a2 + kstep;
      const char* b3 = b2 + kstep;
      G_LDB(B0, 0, 0); G_SCHED; G_LDA(At, 0, 0); G_STAGE(G_SA(1, 1), a1 + chA, cvA0, cvA1);
      G_WAIT_L(8); G_BAR; G_WAIT_L(0); G_MMA(0, 0, At, B0); G_BAR; G_SCHED;
      G_LDB(B1, 0, 1); G_STAGE(G_SB(0, 0), b2, cvB0, cvB1);
      G_BAR; G_WAIT_L(0); G_MMA(0, 1, At, B1); G_BAR;
      G_LDA(At, 0, 1); G_STAGE(G_SA(0, 0), a2, cvA0, cvA1);
      G_BAR; G_WAIT_L(0); G_MMA(1, 0, At, B0); G_BAR; G_SCHED;
      G_STAGE(G_SB(0, 1), b2 + chB, cvB0, cvB1);
      G_WAIT_V(6); G_BAR; G_MMA(1, 1, At, B1); G_BAR;
      G_LDB(B0, 1, 0); G_SCHED; G_LDA(At, 1, 0); G_STAGE(G_SA(0, 1), a2 + chA, cvA0, cvA1);
      G_WAIT_L(8); G_BAR; G_WAIT_L(0); G_MMA(0, 0, At, B0); G_BAR; G_SCHED;
      G_LDB(B1, 1, 1); G_STAGE(G_SB(1, 0), b3, cvB0, cvB1);
      G_BAR; G_WAIT_L(0); G_MMA(0, 1, At, B1); G_BAR;
      G_LDA(At, 1, 1); G_STAGE(G_SA(1, 0), a3, cvA0, cvA1);
      G_BAR; G_WAIT_L(0); G_MMA(1, 0, At, B0); G_BAR; G_SCHED;
      G_STAGE(G_SB(1, 1), b3 + chB, cvB0, cvB1);
      G_WAIT_V(6); G_BAR; G_MMA(1, 1, At, B1); G_BAR;
    }
    bool keep = false;
    if constexpr (Sched::CHAIN) keep = E(acc, cur, wr, wc, fr, fq); else E(acc, cur, wr, wc, fr, fq);
    if (!has_next) break;
    if (!keep) {
#pragma unroll
      for (int a = 0; a < 2; ++a)
#pragma unroll
        for (int b = 0; b < 2; ++b)
#pragma unroll
          for (int m = 0; m < 4; ++m)
#pragma unroll
            for (int n = 0; n < 2; ++n) acc[a][b][m][n] = f4{0.f, 0.f, 0.f, 0.f};
    }
    cur = nxt; cA = nA; cB = nB; ++ui;
  }
  G_WAIT_V(0);
  if (wr == 0) G_BAR;
  G_BAR;
#undef G_SA
#undef G_SB
#undef G_STAGE
#undef G_LDA
#undef G_LDB
#undef G_MMA
#undef G_WAIT_V
#undef G_WAIT_L
#undef G_BAR
#undef G_SCHED
}

DI h8 pack8(const f4& a, const f4& b) {
  h8 o;
  o[0] = (half_t)a[0]; o[1] = (half_t)a[1]; o[2] = (half_t)a[2]; o[3] = (half_t)a[3];
  o[4] = (half_t)b[0]; o[5] = (half_t)b[1]; o[6] = (half_t)b[2]; o[7] = (half_t)b[3];
  return o;
}
DI int row0_of(int pm, int mode) { return mode == 0 ? pm * 256 : (mode == 1 ? (pm >> 3) * TOK + (pm & 7) * 256 : pm * TOK + SEQ); }

struct SchedInproj : SchedBase {
  const half_t* hbuf; const half_t* Wl; int G, c;
  static constexpr unsigned lda2 = 2048, ldb2 = 2048;
  DI bool next(int i, GUnit& u) const {
    const int L = i * G + c;
    u.nt = 16;
    if (L < 144 * 7) {
      tile_map(L, 144, 7, u.pm, u.pn);
      u.A = (const char*)(hbuf + (size_t)u.pm * 256 * 1024); u.B = (const char*)(Wl + W_QK + (size_t)u.pn * 256 * 1024); u.aux = 0;
      return true;
    }
    if (!tile_map(L - 144 * 7, 3, 144, u.pm, u.pn)) return false;
    u.A = (const char*)(Wl + W_V + (size_t)u.pm * 256 * 1024); u.B = (const char*)(hbuf + (size_t)u.pn * 256 * 1024); u.aux = 1;
    return true;
  }
};
struct EpiInproj {
  half_t* big;
  DI void operator()(const f4 (&acc)[2][2][4][2], const GUnit& u, int wr, int wc, int fr, int fq) const {
    if (u.aux == 0) {
      const int g0 = u.pm * 256, b = g0 / TOK, t0 = g0 - b * TOK + wr * 64;
#pragma unroll
      for (int bj = 0; bj < 2; ++bj) {
        const int cb = u.pn * 256 + bj * 128 + wc * 32;
        half_t* ptr; int ts;
        if (cb < 352) { ptr = big + B_ZMLA + (size_t)b * TOK * ZS + cb; ts = ZS; }
        else if (cb < 864) { const int c = cb - 352, part = c >> 8, hh = (c >> 6) & 3; ptr = big + (part ? B_KNA : B_QNA) + (size_t)(b * 4 + hh) * TOK * 64 + (c & 63); ts = 64; }
        else if (cb < 1376) { const int c = cb - 864, part = c >> 8, hm = (c >> 5) & 7; ptr = big + (part ? B_KDF : B_QDF) + (size_t)(b * 8 + hm) * TOK * 32; ts = 32; }
        else if (cb < 1632) { const int c = cb - 1376; ptr = big + B_QG + (size_t)(b * 4 + (c >> 6)) * TOK * 64 + (c & 63); ts = 64; }
        else if (cb < 1760) { const int c = cb - 1632; ptr = big + B_KG + (size_t)(b * 2 + (c >> 6)) * TOK * 64 + (c & 63); ts = 64; }
        else continue;
        const unsigned lo = (unsigned)(fr * ts + 8 * fq) * 2u;
        char* rb = (char*)(ptr + (size_t)t0 * ts);
#pragma unroll
        for (int ai = 0; ai < 2; ++ai)
#pragma unroll
          for (int m = 0; m < 4; ++m)
            wt16(rb + (size_t)((ai * 128 + m * 16) * ts) * 2, lo, as_u4(pack8(acc[ai][bj][m][0], acc[ai][bj][m][1])));
      }
    } else {
      const int g0 = u.pn * 256, b = g0 / TOK, t0 = g0 - b * TOK;
      const int nh = (u.pm == 2) ? 2 : 4;
      char* vt = (char*)(big + (u.pm == 0 ? B_VTNA : (u.pm == 1 ? B_VTDF : B_VTG)) + (size_t)b * nh * 64 * TOK + (size_t)(wr * 64) * TOK + t0 + wc * 32);
      const unsigned lo = (unsigned)(fr * TOK + 8 * fq) * 2u;
#pragma unroll
      for (int ai = 0; ai < 2; ++ai) {
        if (u.pm == 2 && ai == 1) continue;
#pragma unroll
        for (int m = 0; m < 4; ++m)
#pragma unroll
          for (int bj = 0; bj < 2; ++bj)
            wt16(vt + ((size_t)(ai * 128 + m * 16) * TOK + bj * 128) * 2, lo, as_u4(pack8(acc[ai][bj][m][0], acc[ai][bj][m][1])));
      }
    }
  }
};

struct SchedMlaQK : SchedBase {
  const half_t* Wl; const half_t* zmla; int G, c;
  static constexpr unsigned lda2 = ZS * 2, ldb2 = 512;
  DI bool next(int i, GUnit& u) const {
    const int L = i * G + c;
    u.nt = 4;
    if (L < 288) {
      tile_map(L, 144, 2, u.pm, u.pn);
      u.A = (const char*)(zmla + 96 + (size_t)u.pm * 256 * ZS);
      u.B = (const char*)(Wl + W_UQ + (size_t)u.pn * 256 * 256); u.aux = 0;
      return true;
    }
    if (L < 432) {
      u.pm = L - 288; u.pn = 0;
      u.A = (const char*)(zmla + (size_t)u.pm * 256 * ZS);
      u.B = (const char*)(Wl + W_UK); u.aux = 1;
      return true;
    }
    return false;
  }
};
struct SchedMlaV : SchedBase {
  const half_t* Wl; const half_t* zmla; int G, c;
  static constexpr unsigned lda2 = 512, ldb2 = ZS * 2;
  DI bool next(int i, GUnit& u) const {
    const int L = i * G + c;
    if (L >= 144) return false;
    u.nt = 4; u.pm = 0; u.pn = L;
    u.A = (const char*)(Wl + W_UV);
    u.B = (const char*)(zmla + (size_t)u.pn * 256 * ZS); u.aux = 2;
    return true;
  }
};
struct EpiMla {
  half_t* big;
  DI void operator()(const f4 (&acc)[2][2][4][2], const GUnit& u, int wr, int wc, int fr, int fq) const {
    if (u.aux < 2) {
      const int g0 = u.pm * 256, b = g0 / TOK, t0 = g0 - b * TOK + wr * 64;
      const unsigned lo = (unsigned)(fr * 96 + 8 * fq) * 2u;
#pragma unroll
      for (int bj = 0; bj < 2; ++bj) {
        const int cb = u.pn * 256 + bj * 128 + wc * 32;
        half_t* ptr;
        if (u.aux == 0) {
          if (cb >= 384) continue;
          const int hh = cb / 96, dd = cb - hh * 96;
          ptr = big + B_QM + (size_t)(b * 4 + hh) * TOK * 96 + dd;
        } else {
          ptr = big + B_KM + (size_t)(b * 4 + (cb >> 6)) * TOK * 96 + (cb & 63);
        }
        char* rb = (char*)(ptr + (size_t)t0 * 96);
#pragma unroll
        for (int ai = 0; ai < 2; ++ai)
#pragma unroll
          for (int m = 0; m < 4; ++m)
            wt16(rb + (size_t)((ai * 128 + m * 16) * 96) * 2, lo, as_u4(pack8(acc[ai][bj][m][0], acc[ai][bj][m][1])));
      }
    } else {
      const int g0 = u.pn * 256, b = g0 / TOK, t0 = g0 - b * TOK;
      char* vt = (char*)(big + B_VTM + (size_t)b * 4 * 64 * TOK + (size_t)(wr * 64) * TOK + t0 + wc * 32);
      const unsigned lo = (unsigned)(fr * TOK + 8 * fq) * 2u;
#pragma unroll
      for (int ai = 0; ai < 2; ++ai)
#pragma unroll
        for (int m = 0; m < 4; ++m)
#pragma unroll
          for (int bj = 0; bj < 2; ++bj)
            wt16(vt + ((size_t)(ai * 128 + m * 16) * TOK + bj * 128) * 2, lo, as_u4(pack8(acc[ai][bj][m][0], acc[ai][bj][m][1])));
    }
  }
};

struct SchedRows : SchedBase {
  const half_t* A; const half_t* B; int K, nM, nN, G, c; int mode; unsigned lda2, ldb2;
  DI bool next(int i, GUnit& u) const {
    if (!tile_map(i * G + c, nM, nN, u.pm, u.pn)) return false;
    u.A = (const char*)(A + (size_t)row0_of(u.pm, mode) * K); u.B = (const char*)(B + (size_t)u.pn * 256 * K);
    u.nt = K >> 6; u.aux = 0;
    return true;
  }
};
struct SchedResid : SchedBase {
  const half_t* A; const half_t* B; int K, nN, nctx, G, c; unsigned lda2, ldb2;
  DI bool next(int i, GUnit& u) const {
    const int L = i * G + c, nfull = 128 * nN;
    if (L < nfull) {
      tile_map(L, 128, nN, u.pm, u.pn);
      u.A = (const char*)(A + (size_t)row0_of(u.pm, 1) * K); u.B = (const char*)(B + (size_t)u.pn * 256 * K);
      u.nt = K >> 6; u.aux = 0;
      return true;
    }
    const int L2 = L - nfull;
    if (L2 >= nctx * nN * 4) return false;
    const int ks = L2 & 3, t = L2 >> 2;
    u.pm = t / nN; u.pn = t - u.pm * nN;
    const int kq = K >> 2;
    u.A = (const char*)(A + (size_t)row0_of(u.pm, 2) * K + ks * kq); u.B = (const char*)(B + (size_t)u.pn * 256 * K + ks * kq);
    u.nt = kq >> 6; u.aux = 1; u.ks = ks;
    return true;
  }
};
struct EpiResid {
  const float* xl_src; float* xl_dst; float* part; const float* mods_l; int gt_off;
  DI void operator()(const f4 (&acc)[2][2][4][2], const GUnit& u, int wr, int wc, int fr, int fq) const {
    const bool isctx = u.aux == 1;
    const int g0 = row0_of(u.pm, isctx ? 2 : 1), b = g0 / TOK, t0 = g0 - b * TOK;
    const int col0 = u.pn * 256 + wc * 32;
    const size_t rowoff = (size_t)(wr * 64) * 1024 + col0;
    const char* src = (const char*)(xl_src + ((size_t)b * SEQ + (isctx ? 0 : t0)) * 1024 + rowoff);
    char* dst = (char*)(xl_dst + ((size_t)b * SEQ + (isctx ? 0 : t0)) * 1024 + rowoff);
    const char* gt = (const char*)(mods_l + (size_t)(isctx ? 16 : b) * 6144 + gt_off + col0);
    const unsigned lo = (unsigned)(fr * 1024 + 4 * fq) * 4u, glo = (unsigned)(4 * fq) * 4u;
    f4 gv[2][2];
#pragma unroll
    for (int bj = 0; bj < 2; ++bj)
#pragma unroll
      for (int n = 0; n < 2; ++n) gv[bj][n] = *(const f4*)(gt + (bj * 128 + n * 16) * 4 + glo);
    if (!isctx) {
#pragma unroll
      for (int ai = 0; ai < 2; ++ai)
#pragma unroll
        for (int mh = 0; mh < 2; ++mh) {
          f4 xv[2][2][2];
#pragma unroll
          for (int mm = 0; mm < 2; ++mm)
#pragma unroll
            for (int bj = 0; bj < 2; ++bj)
#pragma unroll
              for (int n = 0; n < 2; ++n)
                xv[mm][bj][n] = *(const f4*)(src + ((size_t)(ai * 128 + (mh * 2 + mm) * 16) * 1024 + bj * 128 + n * 16) * 4 + lo);
#pragma unroll
          for (int mm = 0; mm < 2; ++mm)
#pragma unroll
            for (int bj = 0; bj < 2; ++bj)
#pragma unroll
              for (int n = 0; n < 2; ++n)
                wt16(dst + ((size_t)(ai * 128 + (mh * 2 + mm) * 16) * 1024 + bj * 128 + n * 16) * 4, lo, as_u4(xv[mm][bj][n] + gv[bj][n] * acc[ai][bj][mh * 2 + mm][n]));
        }
    } else {
      char* pp = (char*)(part + ((size_t)u.ks * NB * CTX + (size_t)b * CTX + (t0 - SEQ) + wr * 64) * 1024 + col0);
#pragma unroll
      for (int ai = 0; ai < 2; ++ai)
#pragma unroll
        for (int m = 0; m < 4; ++m)
#pragma unroll
          for (int bj = 0; bj < 2; ++bj)
#pragma unroll
            for (int n = 0; n < 2; ++n)
              wt16(pp + ((size_t)(ai * 128 + m * 16) * 1024 + bj * 128 + n * 16) * 4, lo, as_u4(gv[bj][n] * acc[ai][bj][m][n]));
    }
  }
};
struct EpiUp {
  half_t* ubuf; int skip_ctx;
  DI void operator()(const f4 (&acc)[2][2][4][2], const GUnit& u, int wr, int wc, int fr, int fq) const {
    const int g0 = row0_of(u.pm, skip_ctx);
    char* rb = (char*)(ubuf + (size_t)(g0 + wr * 64) * 4096 + u.pn * 256 + wc * 32);
    const unsigned lo = (unsigned)(fr * 4096 + 8 * fq) * 2u;
#pragma unroll
    for (int ai = 0; ai < 2; ++ai)
#pragma unroll
      for (int m = 0; m < 4; ++m)
#pragma unroll
        for (int bj = 0; bj < 2; ++bj) {
          f4 a = acc[ai][bj][m][0], c = acc[ai][bj][m][1];
#pragma unroll
          for (int j = 0; j < 4; ++j) { a[j] = fmaxf(a[j], 0.f); a[j] *= a[j]; c[j] = fmaxf(c[j], 0.f); c[j] *= c[j]; }
          wt16(rb + ((size_t)(ai * 128 + m * 16) * 4096 + bj * 128) * 2, lo, as_u4(pack8(a, c)));
        }
  }
};

DI void build_rope_tables(float2* tab, int wv_) {
  const int tid_ = tid_opaque(wv_);
  __syncthreads();
  for (int idx = tid_; idx < 512 + 1024; idx += NTHR) {
    const bool big = idx >= 512;
    const int j = big ? idx - 512 : idx;
    const int pos = big ? (j >> 4) : (j >> 3), i = big ? (j & 15) : (j & 7);
    const float invf = exp2f(-(float)i * (13.287712379549449f / (big ? 16.f : 8.f)));
    const float ang = (float)pos * invf;
    float sn, cs;
    sincosf(ang, &sn, &cs);
    tab[idx] = float2{cs, sn};
  }
  __syncthreads();
}
template <int DLEN, int LPR, int ROPE, bool KR>
DI void norm_rows(half_t* base, int stride, int nrows, const float* gain, float oscale, const half_t* zmla, const float2* rtab, int wv_) {
  const int tid_ = tid_opaque(wv_);
  const int lane = tid_ & 63, wave = tid_ >> 6;
  constexpr int RPW = 64 / LPR;
  const int s = lane % LPR, sub = lane / LPR;
  const bool active = s * 8 < DLEN;
  float gn[8];
#pragma unroll
  for (int i = 0; i < 8; ++i) gn[i] = active ? gain[s * 8 + i] : 0.f;
  for (int r0 = (blockIdx.x * NWAVE + wave) * RPW; r0 < nrows; r0 += gridDim.x * NWAVE * RPW) {
    const int rho = r0 + sub;
    const int t = rho % TOK;
    half_t* ptr = base + (size_t)rho * stride + s * 8;
    const half_t* src = ptr;
    if (KR && s >= 8) {
      const int b = rho / (4 * TOK);
      src = zmla + ((size_t)b * TOK + t) * ZS + 128 + (s - 8) * 8;
    }
    float f[8];
    float ss = 0.f;
    if (active) {
      const h8 v = *(const h8*)src;
#pragma unroll
      for (int i = 0; i < 8; ++i) { f[i] = (float)v[i]; ss += f[i] * f[i]; }
    } else {
#pragma unroll
      for (int i = 0; i < 8; ++i) f[i] = 0.f;
    }
#pragma unroll
    for (int o = LPR / 2; o > 0; o >>= 1) ss += __shfl_xor(ss, o);
    const float rstd = rsqrtf(ss * (1.f / DLEN) + EPS);
#pragma unroll
    for (int i = 0; i < 8; ++i) f[i] = f[i] * rstd * gn[i];
    if (ROPE != 0) {
      constexpr int PX = (ROPE == 64) ? 2 : 1;
      float pf[8];
#pragma unroll
      for (int i = 0; i < 8; ++i) pf[i] = __shfl_xor(f[i], PX);
      constexpr int RB = (DLEN - ROPE) / 8;
      if (t < SEQ && s >= RB && active) {
        const int sr = s - RB;
        const int q = (ROPE == 64) ? (sr >> 1) : sr;
        const int pos = (q < 2) ? (t >> 6) : (t & 63);
        const float sgn = (q & 1) ? 1.f : -1.f;
        constexpr int NFI = (ROPE == 64) ? 16 : 8;
        const float2* tb = rtab + ((ROPE == 64) ? 512 : 0) + pos * NFI + ((ROPE == 64) ? (sr & 1) * 8 : 0);
#pragma unroll
        for (int i = 0; i < 8; ++i) {
          const float2 cssn = tb[i];
          f[i] = f[i] * cssn.x + sgn * pf[i] * cssn.y;
        }
      }
    }
    if (active) {
      h8 o;
#pragma unroll
      for (int i = 0; i < 8; ++i) o[i] = (half_t)(f[i] * oscale);
      wt16p(ptr, as_u4(o));
    }
  }
}

constexpr int ATT_STAGE = 22528, ATT_VOFF = 13312, ATT_STASH = 49152;
template <int DQ, bool NA, int NQG>
DI void attn_wg(const half_t* Qp, const half_t* Kp, const half_t* Vp, int q0, bool active, int seg0_start, int seg0_tiles,
                int seg1_start, int seg1_tiles, const float* rpb_h, int rq, char* smem, int tid, f16v (&O)[2][NQG]) {
  constexpr int NKS = DQ / 16, KSTR = DQ + 8, VSTR = 72, CPK = DQ / 8, KCH = 64 * CPK;
  const int lane = tid & 63, r = lane & 31, h = lane >> 5;
  h8 qf[NQG][NKS];
#pragma unroll
  for (int qg = 0; qg < NQG; ++qg)
#pragma unroll
    for (int ks = 0; ks < NKS; ++ks) qf[qg][ks] = *(const h8*)(Qp + (size_t)(q0 + qg * 32 + r) * DQ + ks * 16 + h * 8);
  float mrun[NQG], lrun[NQG];
#pragma unroll
  for (int qg = 0; qg < NQG; ++qg) { mrun[qg] = -1e30f; lrun[qg] = 0.f; }
#pragma unroll
  for (int a = 0; a < 2; ++a)
#pragma unroll
    for (int c = 0; c < NQG; ++c)
#pragma unroll
      for (int i = 0; i < 16; ++i) O[a][c][i] = 0.f;
  const int ntiles = seg0_tiles + seg1_tiles;
  const int kc0 = tid, kc1 = tid + 512;
  const half_t* kg0 = Kp + kc0 * 8;
  const half_t* kg1 = Kp + kc1 * 8;
  const half_t* vg = Vp + (size_t)(tid >> 3) * TOK + (tid & 7) * 8;
  const int ks0 = (kc0 / CPK) * KSTR + (kc0 % CPK) * 8, ks1 = (kc1 / CPK) * KSTR + (kc1 % CPK) * 8, vs0 = (tid >> 3) * VSTR + (tid & 7) * 8;
  uint4 kreg0 = {0, 0, 0, 0}, kreg1 = {0, 0, 0, 0}, vreg;
  const int r0w = min(max(rq - 4, 0), 24);
  {
    const int k0 = (0 < seg0_tiles) ? seg0_start : seg1_start;
    if (kc0 < KCH) kreg0 = *(const uint4*)(kg0 + (size_t)k0 * DQ);
    if (DQ == 96 && kc1 < KCH) kreg1 = *(const uint4*)(kg1 + (size_t)k0 * DQ);
    vreg = *(const uint4*)(vg + k0);
    if (kc0 < KCH) *(uint4*)((half_t*)smem + ks0) = kreg0;
    if (DQ == 96 && kc1 < KCH) *(uint4*)((half_t*)smem + ks1) = kreg1;
    *(uint4*)((half_t*)(smem + ATT_VOFF) + vs0) = vreg;
  }
  __syncthreads();
  for (int it = 0; it < ntiles; ++it) {
    const int k0 = (it < seg0_tiles) ? seg0_start + it * 64 : seg1_start + (it - seg0_tiles) * 64;
    const bool more = it + 1 < ntiles;
    if (more) {
      const int itn = it + 1;
      const int k1 = (itn < seg0_tiles) ? seg0_start + itn * 64 : seg1_start + (itn - seg0_tiles) * 64;
      if (kc0 < KCH) kreg0 = *(const uint4*)(kg0 + (size_t)k1 * DQ);
      if (DQ == 96 && kc1 < KCH) kreg1 = *(const uint4*)(kg1 + (size_t)k1 * DQ);
      vreg = *(const uint4*)(vg + k1);
    }
    const half_t* ksm = (const half_t*)(smem + (it & 1) * ATT_STAGE) + r * KSTR + h * 8;
    const half_t* vsm = (const half_t*)(smem + (it & 1) * ATT_STAGE + ATT_VOFF) + r * VSTR + h * 4;
    const bool masked = NA && it < seg0_tiles;
    const int krow = k0 >> 6;
    const bool need = active && (!masked || (krow >= r0w && krow < r0w + 8));
    if (need) {
#pragma unroll 1
      for (int st = 0; st < 2; ++st) {
        f16v S[NQG];
#pragma unroll
        for (int qg = 0; qg < NQG; ++qg)
#pragma unroll
          for (int i = 0; i < 16; ++i) S[qg][i] = 0.f;
#pragma unroll
        for (int ks = 0; ks < NKS; ++ks) {
          const h8 kf = *(const h8*)(ksm + (st * 32) * KSTR + ks * 16);
#pragma unroll
          for (int qg = 0; qg < NQG; ++qg) S[qg] = __builtin_amdgcn_mfma_f32_32x32x16_f16(kf, qf[qg][ks], S[qg], 0, 0, 0);
        }
        if (masked) {
          const int cb = st * 32;
          const int dr = krow - rq + 7;
#pragma unroll
          for (int qg = 0; qg < NQG; ++qg) {
            const int qc = qg * 32 + r;
            const int cs = min(max(qc - 8, 0), 48);
#pragma unroll
            for (int i = 0; i < 16; ++i) {
              const int c = cb + (i & 3) + 8 * (i >> 2) + 4 * h;
              const bool valid = (c >= cs) && (c < cs + 16);
              float bias = 0.f;
              if (valid) bias = rpb_h[dr * 31 + (c - qc + 15)] * LOG2E;
              S[qg][i] = valid ? S[qg][i] + bias : -1e30f;
            }
          }
        }
        h4 vf[2][2][2];
#pragma unroll
        for (int dvt = 0; dvt < 2; ++dvt)
#pragma unroll
          for (int sx = 0; sx < 2; ++sx)
#pragma unroll
            for (int hf = 0; hf < 2; ++hf) vf[dvt][sx][hf] = *(const h4*)(vsm + (dvt * 32) * VSTR + st * 32 + sx * 16 + hf * 8);
#pragma unroll
        for (int qg = 0; qg < NQG; ++qg) {
          h8 P[2];
          float mx = S[qg][0];
#pragma unroll
          for (int i = 1; i < 16; ++i) mx = fmaxf(mx, S[qg][i]);
          mx = fmaxf(mx, __shfl_xor(mx, 32));
          const float mn = fmaxf(mrun[qg], mx);
          if (__builtin_amdgcn_ballot_w64(mn > mrun[qg]) != 0ull) {
            const float alpha = __builtin_amdgcn_exp2f(mrun[qg] - mn);
            lrun[qg] *= alpha;
#pragma unroll
            for (int dvt = 0; dvt < 2; ++dvt)
#pragma unroll
              for (int i = 0; i < 16; ++i) O[dvt][qg][i] *= alpha;
            mrun[qg] = mn;
          }
          f2 rs2 = {0.f, 0.f};
          const f2 mn2 = {mn, mn};
#pragma unroll
          for (int i = 0; i < 16; i += 2) {
            const f2 s2 = {S[qg][i], S[qg][i + 1]};
            const f2 d2 = s2 - mn2;
            f2 p2;
            p2.x = __builtin_amdgcn_exp2f(d2.x);
            p2.y = __builtin_amdgcn_exp2f(d2.y);
            if (NA) { p2.x = (s2.x <= -1e29f) ? 0.f : p2.x; p2.y = (s2.y <= -1e29f) ? 0.f : p2.y; }
            rs2 += p2;
            P[i >> 3][i & 7] = (half_t)p2.x;
            P[i >> 3][(i & 7) + 1] = (half_t)p2.y;
          }
          lrun[qg] += rs2.x + rs2.y;
#pragma unroll
          for (int dvt = 0; dvt < 2; ++dvt) {
#pragma unroll
            for (int sx = 0; sx < 2; ++sx) {
              const h8 va = __builtin_shufflevector(vf[dvt][sx][0], vf[dvt][sx][1], 0, 1, 2, 3, 4, 5, 6, 7);
              O[dvt][qg] = __builtin_amdgcn_mfma_f32_32x32x16_f16(va, P[sx], O[dvt][qg], 0, 0, 0);
            }
          }
        }
      }
    }
    if (more) {
      char* nb = smem + ((it + 1) & 1) * ATT_STAGE;
      if (kc0 < KCH) *(uint4*)((half_t*)nb + ks0) = kreg0;
      if (DQ == 96 && kc1 < KCH) *(uint4*)((half_t*)nb + ks1) = kreg1;
      *(uint4*)((half_t*)(nb + ATT_VOFF) + vs0) = vreg;
    }
    __syncthreads();
  }
#pragma unroll
  for (int qg = 0; qg < NQG; ++qg) {
    const float lt = lrun[qg] + __shfl_xor(lrun[qg], 32);
    const float inv = 1.f / lt;
#pragma unroll
    for (int dvt = 0; dvt < 2; ++dvt)
#pragma unroll
      for (int i = 0; i < 16; ++i) O[dvt][qg][i] *= inv;
  }
}

template <int NQG>
DI void store_o(const f16v (&O)[2][NQG], half_t* orow0  , int lane) {
  const int r = lane & 31, h = lane >> 5;
#pragma unroll
  for (int qg = 0; qg < NQG; ++qg)
#pragma unroll
    for (int dvt = 0; dvt < 2; ++dvt)
#pragma unroll
      for (int c = 0; c < 4; ++c) {
        h4 o;
#pragma unroll
        for (int j = 0; j < 4; ++j) o[j] = (half_t)O[dvt][qg][4 * c + j];
        *(h4*)(orow0 + (size_t)(qg * 32 + r) * 1024 + dvt * 32 + 8 * c + 4 * h) = o;
      }
}

DI void phase_attn(int l, half_t* big, bool need_ctx, char* smem, int wv_) {
  const KPtr p = kp();
  const int wave = wv_;
  const int NQB = need_ctx ? 5 : 4;
  half_t* obuf = big + B_O;
  const float lam_init = 0.8f - 0.6f * expf(-0.3f * (float)l);
  float lam;
  {
    float d1 = 0.f, d2 = 0.f;
#pragma unroll 1
    for (int i = 0; i < 32; ++i) {
      d1 += p->lq1[l * 32 + i] * p->lk1[l * 32 + i];
      d2 += p->lq2[l * 32 + i] * p->lk2[l * 32 + i];
    }
    lam = expf(d1) - expf(d2) + lam_init;
    lam = __builtin_bit_cast(float, __builtin_amdgcn_readfirstlane(__builtin_bit_cast(int, lam)));
  }
  const float one_m_li = __builtin_bit_cast(float, __builtin_amdgcn_readfirstlane(__builtin_bit_cast(int, 1.f - lam_init)));
  const int per = 4 * 16 * NQB;
#pragma unroll
  for (int mixer = 0; mixer < 4; ++mixer) {
    const int lo = mixer * per;
    const int first = lo + (int)((blockIdx.x + gridDim.x - (lo % gridDim.x)) % gridDim.x);
    const int tid_m = tid_opaque(wv_);
    const int lane = tid_m & 63, h = lane >> 5;
#pragma unroll 1
    for (int item = first; item < lo + per; item += gridDim.x) {
      const int j = item - lo;
      const bool qctx = j >= 256;
      const int xq = j & 7, yq = j >> 3, pr = xq * 8 + (yq >> 2);
      const int hh = qctx ? (j - 256) >> 4 : pr >> 4;
      const int b = qctx ? (j - 256) & 15 : pr & 15;
      const int qb = qctx ? 4 : (yq & 3);
      const bool active = !qctx || wave < 4;
      const int q0 = active ? qb * 512 + wave * 64 : SEQ;
      const int s0 = qctx ? SEQ : 0, n0t = qctx ? 4 : 36;
      f16v O[2][2];
      half_t* orow = obuf + (size_t)(b * TOK + q0) * 1024 + hh * 64;
      if (mixer == 0) {
        half_t* stash = (half_t*)(smem + ATT_STASH) + wave * 4096;
        attn_wg<32, false, 2>(big + B_QDF + (size_t)(b * 8 + hh * 2) * TOK * 32, big + B_KDF + (size_t)(b * 8 + hh * 2) * TOK * 32,
                              big + B_VTDF + (size_t)(b * 4 + hh) * 64 * TOK, q0, active, s0, n0t, 0, 0, nullptr, 0, smem, tid_m, O);
#pragma unroll
        for (int dvt = 0; dvt < 2; ++dvt)
#pragma unroll
          for (int qg = 0; qg < 2; ++qg)
#pragma unroll
            for (int i = 0; i < 16; ++i) stash[((dvt * 2 + qg) * 16 + i) * 64 + lane] = (half_t)O[dvt][qg][i];
        attn_wg<32, false, 2>(big + B_QDF + (size_t)(b * 8 + hh * 2 + 1) * TOK * 32, big + B_KDF + (size_t)(b * 8 + hh * 2 + 1) * TOK * 32,
                              big + B_VTDF + (size_t)(b * 4 + hh) * 64 * TOK, q0, active, s0, n0t, 0, 0, nullptr, 0, smem, tid_m, O);
#pragma unroll
        for (int qg = 0; qg < 2; ++qg) {
          float ss = 0.f;
#pragma unroll
          for (int dvt = 0; dvt < 2; ++dvt)
#pragma unroll
            for (int i = 0; i < 16; ++i) {
              const float v = (float)stash[((dvt * 2 + qg) * 16 + i) * 64 + lane] - lam * O[dvt][qg][i];
              O[dvt][qg][i] = v;
              ss += v * v;
            }
          ss += __shfl_xor(ss, 32);
          const float rstd = rsqrtf(ss * (1.f / 64.f) + EPS) * one_m_li;
#pragma unroll
          for (int dvt = 0; dvt < 2; ++dvt)
#pragma unroll
            for (int i = 0; i < 16; ++i) {
              const int dv = dvt * 32 + (i & 3) + 8 * (i >> 2) + 4 * h;
              O[dvt][qg][i] *= rstd * p->g_diff_sub[l * 64 + dv];
            }
        }
        if (active) store_o<2>(O, orow + 2 * 256, lane);
      } else if (mixer == 1) {
        attn_wg<96, false, 2>(big + B_QM + (size_t)(b * 4 + hh) * TOK * 96, big + B_KM + (size_t)(b * 4 + hh) * TOK * 96,
                              big + B_VTM + (size_t)(b * 4 + hh) * 64 * TOK, q0, active, s0, n0t, 0, 0, nullptr, 0, smem, tid_m, O);
        if (active) store_o<2>(O, orow + 0 * 256, lane);
      } else if (mixer == 2) {
        const int kv = hh >> 1;
        attn_wg<64, false, 2>(big + B_QG + (size_t)(b * 4 + hh) * TOK * 64, big + B_KG + (size_t)(b * 2 + kv) * TOK * 64,
                              big + B_VTG + (size_t)(b * 2 + kv) * 64 * TOK, q0, active, s0, n0t, 0, 0, nullptr, 0, smem, tid_m, O);
        if (active) store_o<2>(O, orow + 3 * 256, lane);
      } else {
        const int rq = q0 >> 6;
        const int rq0 = qb * 8;
        const int rlo = min(max(rq0 - 4, 0), 24), rhi = min(max(rq0 + 7 - 4, 0), 24) + 8;
        const int seg0s = rlo * 64, seg0n = qctx ? 0 : (rhi - rlo);
        attn_wg<64, true, 2>(big + B_QNA + (size_t)(b * 4 + hh) * TOK * 64, big + B_KNA + (size_t)(b * 4 + hh) * TOK * 64,
                             big + B_VTNA + (size_t)(b * 4 + hh) * 64 * TOK, q0, active, seg0s, seg0n, SEQ, 4,
                             p->na_rpb + (size_t)(l * 4 + hh) * 15 * 31, rq, smem, tid_m, O);
        if (active) store_o<2>(O, orow + 1 * 256, lane);
      }
    }
  }
}

struct SchedGate : SchedBase {
  const half_t* hbuf; const half_t* Wl; int pm0, cnt, G, c, mode;
  static constexpr unsigned lda2 = 2048, ldb2 = 2048;
  static DI int bmap(bool, int R) { return ((R >> 4) & 1) * 1024 + (R >> 5) * 16 + (R & 15); }
  static constexpr int BHALF = 2048;
  DI bool next(int i, GUnit& u) const {
    int pm, pn;
    if (!tile_map(i * G + c, cnt, 16, pm, pn)) return false;
    u.pm = pm0 + pm; u.pn = pn; u.nt = 16; u.aux = 0;
    u.A = (const char*)(hbuf + (size_t)row0_of(u.pm, mode) * 1024); u.B = (const char*)(Wl + W_GATE + (size_t)pn * 64 * 1024);
    return true;
  }
};
DI float gate_clamped(float x) { return fmaxf(__builtin_amdgcn_rcpf(1.f + __expf(-x)), 6.103515625e-05f); }
struct EpiGate {
  half_t* gb; int pm0;
  DI void operator()(const f4 (&acc)[2][2][4][2], const GUnit& u, int wr, int wc, int fr, int fq) const {
    char* rb = (char*)(gb + (size_t)((u.pm - pm0) * 256 + wr * 64) * 4096 + u.pn * 64 + wc * 16);
    const unsigned lo = (unsigned)(fr * 4096 + 4 * fq) * 2u;
#pragma unroll
    for (int ai = 0; ai < 2; ++ai)
#pragma unroll
      for (int m = 0; m < 4; ++m) {
        f4 gq[4];
#pragma unroll
        for (int br = 0; br < 4; ++br)
#pragma unroll
          for (int j = 0; j < 4; ++j) gq[br][j] = gate_clamped(acc[ai][br >> 1][m][br & 1][j]);
#pragma unroll
        for (int br = 0; br < 4; ++br) {
          h4 o;
#pragma unroll
          for (int j = 0; j < 4; ++j) o[j] = (half_t)(br < 3 ? gq[br][j] * __builtin_amdgcn_rcpf(gq[br + 1][j]) : gq[3][j]);
          *(h4*)(rb + ((size_t)(ai * 128 + m * 16) * 4096 + br * 1024) * 2 + lo) = o;
        }
      }
  }
};
struct SchedProj : SchedBase {
  const half_t* obuf; const half_t* Wl; int pm0, cnt, G, c, mode;
  static constexpr unsigned lda2 = 2048, ldb2 = 512;
  static constexpr bool CHAIN = true;
  DI bool next(int i, GUnit& u) const {
    int pm, pn;
    if (!tile_map((i >> 2) * G + c, cnt, 4, pm, pn)) return false;
    const int br = i & 3;
    u.pm = pm0 + pm; u.pn = pn; u.nt = 4; u.aux = br;
    u.A = (const char*)(obuf + (size_t)row0_of(u.pm, mode) * 1024 + br * 256);
    u.B = (const char*)(Wl + W_BR + (size_t)(br * 1024 + pn * 256) * 256);
    return true;
  }
};
struct EpiProj {
  const half_t* gb; half_t* mbuf; int pm0, mode;
  DI bool operator()(f4 (&acc)[2][2][4][2], const GUnit& u, int wr, int wc, int fr, int fq) const {
    const int br = u.aux;
    const char* gp = (const char*)(gb + (size_t)((u.pm - pm0) * 256 + wr * 64) * 4096 + br * 1024 + u.pn * 256 + wc * 32);
    const unsigned glo = (unsigned)(fr * 4096 + 8 * fq) * 2u;
    h8 gq[2][4][2];
#pragma unroll
    for (int ai = 0; ai < 2; ++ai)
#pragma unroll
      for (int m = 0; m < 4; ++m)
#pragma unroll
        for (int bj = 0; bj < 2; ++bj) gq[ai][m][bj] = *(const h8*)(gp + ((size_t)(ai * 128 + m * 16) * 4096 + bj * 128) * 2 + glo);
#pragma unroll
    for (int ai = 0; ai < 2; ++ai)
#pragma unroll
      for (int m = 0; m < 4; ++m)
#pragma unroll
        for (int bj = 0; bj < 2; ++bj)
#pragma unroll
          for (int j = 0; j < 4; ++j) { acc[ai][bj][m][0][j] *= (float)gq[ai][m][bj][j]; acc[ai][bj][m][1][j] *= (float)gq[ai][m][bj][4 + j]; }
    if (br < 3) return true;
    char* mp = (char*)(mbuf + (size_t)(row0_of(u.pm, mode) + wr * 64) * 1024 + u.pn * 256 + wc * 32);
    const unsigned mlo = (unsigned)(fr * 1024 + 8 * fq) * 2u;
#pragma unroll
    for (int ai = 0; ai < 2; ++ai)
#pragma unroll
      for (int m = 0; m < 4; ++m)
#pragma unroll
        for (int bj = 0; bj < 2; ++bj)
          wt16(mp + ((size_t)(ai * 128 + m * 16) * 1024 + bj * 128) * 2, mlo, as_u4(pack8(acc[ai][bj][m][0], acc[ai][bj][m][1])));
    return false;
  }
};

__global__ void __launch_bounds__(NTHR) hybrid_block_megakernel(Params p) {
  __shared__ __attribute__((aligned(16))) char smem[SMEM_BYTES];
  char* ws = kp()->ws;
  if (ws == nullptr) cg::this_grid().sync();
  half_t* W = (half_t*)(ws + OFF_W);
  float* mods = (float*)(ws + OFF_MOD);
  float* xc = (float*)(ws + OFF_XC);
  half_t* hbuf = (half_t*)(ws + OFF_H);
  half_t* big = (half_t*)(ws + OFF_BIG);
  float* part = (float*)(ws + OFF_PART);
  LAS unsigned char* lds = (LAS unsigned char*)smem;
  const int G = gridDim.x, cblk = blockIdx.x;

  const int wv_ = __builtin_amdgcn_readfirstlane((int)threadIdx.x >> 6);
  volatile LAS unsigned* st = (volatile LAS unsigned*)(lds + GEMM_LDS);
  if (threadIdx.x < 4) st[threadIdx.x] = 0u;
  __syncthreads();
  xcd_barrier_post((unsigned*)(ws + OFF_BAR), wv_);

  phase_mods(mods, smem, wv_);
  {
    int base = 0;
    float* tile = (float*)smem;
    for (int l = 0; l < 2; ++l) {
      half_t* Wl = W + (size_t)l * W_LAYER;
      const float* win = kp()->w_in + (size_t)l * 1024 * 6496;
      tconv_job(win, 6496, 192, 1024, 1024, 160, 192, Wl + W_QK, base, tile, wv_, 160);
      tconv_job(win, 6496, 0, 1024, 1024, 192, 192, Wl + W_QK + (size_t)160 * 1024, base, tile, wv_);
      tconv_job(win, 6496, 352, 1024, 1024, 512, 512, Wl + W_QK + (size_t)352 * 1024, base, tile, wv_);
      tconv_job(win, 6496, 1120, 1024, 1024, 512, 512, Wl + W_QK + (size_t)864 * 1024, base, tile, wv_);
      tconv_job(win, 6496, 1888, 1024, 1024, 384, 384, Wl + W_QK + (size_t)1376 * 1024, base, tile, wv_);
      tconv_job(win, 6496, 0, 1024, 1024, 0, 64, Wl + W_QK + (size_t)1760 * 1024, base, tile, wv_, 32);
      tconv_job(win, 6496, 864, 1024, 1024, 256, 256, Wl + W_V, base, tile, wv_);
      tconv_job(win, 6496, 1632, 1024, 1024, 256, 256, Wl + W_V + (size_t)256 * 1024, base, tile, wv_);
      tconv_job(win, 6496, 2272, 1024, 1024, 128, 256, Wl + W_V + (size_t)512 * 1024, base, tile, wv_);
      tconv_job(win, 6496, 2400, 1024, 1024, 4096, 4096, Wl + W_GATE, base, tile, wv_);
      for (int br = 0; br < 4; ++br)
        tconv_job(kp()->w_branch + ((size_t)l * 4 + br) * 256 * 1024, 1024, 0, 256, 256, 1024, 1024, Wl + W_BR + (size_t)br * 1024 * 256, base, tile, wv_);
      tconv_job(kp()->w_out + (size_t)l * 1024 * 1024, 1024, 0, 1024, 1024, 1024, 1024, Wl + W_OUT, base, tile, wv_);
      tconv_job(kp()->w_up + (size_t)l * 1024 * 4096, 4096, 0, 1024, 1024, 4096, 4096, Wl + W_UP, base, tile, wv_);
      tconv_job(kp()->w_down + (size_t)l * 4096 * 1024, 1024, 0, 4096, 4096, 1024, 1024, Wl + W_DOWN, base, tile, wv_);
      tconv_job(kp()->w_mla_uq + (size_t)l * 192 * 384, 384, 0, 256, 192, 384, 512, Wl + W_UQ, base, tile, wv_, -1, 64);
      for (int hh = 0; hh < 4; ++hh) {
        tconv_job(kp()->w_mla_ukv + (size_t)l * 128 * 512, 512, hh * 128, 256, 128, 64, 64, Wl + W_UK + (size_t)hh * 64 * 256, base, tile, wv_);
        tconv_job(kp()->w_mla_ukv + (size_t)l * 128 * 512, 512, hh * 128 + 64, 256, 128, 64, 64, Wl + W_UV + (size_t)hh * 64 * 256, base, tile, wv_);
      }
    }
  }
  xcd_barrier(ws, lds, wv_);

  for (int l = 0; l < 2; ++l) {
    const bool need_ctx = (l == 0);
    const bool skip_ctx = !need_ctx;
    const half_t* Wl = W + (size_t)l * W_LAYER;
    const float* mods_l = mods + (size_t)l * 17 * 6144;
    const float* xl_src = (l == 0) ? kp()->x : kp()->out;
    const float* xc_src = (l == 0) ? kp()->ctx : xc;
    const int nrt = skip_ctx ? 128 : 144;

    phase_norm(xl_src, xc_src, kp()->g_norm1 + l * 1024, mods_l, 0, 1024, hbuf, false, (l == 1) ? part : nullptr, nullptr, wv_);
    xcd_barrier(ws, lds, wv_);
    {
      SchedInproj S{{}, hbuf, Wl, G, cblk};
      EpiInproj E{big};
      gemm256<true>(lds, S, E, wv_);
    }
    xcd_barrier(ws, lds, wv_);
    {
      build_rope_tables((float2*)smem, wv_);
      half_t* zmla = big + B_ZMLA;
      norm_rows<192, 32, 0, false>(zmla + 160, ZS, NTOK, kp()->g_mla_qa + l * 192, 1.f, nullptr, (const float2*)smem, wv_);
      norm_rows<128, 16, 0, false>(zmla, ZS, NTOK, kp()->g_mla_kva + l * 128, 1.f, nullptr, (const float2*)smem, wv_);
      norm_rows<64, 8, 0, false>(big + B_QNA, 64, NTOK * 4, kp()->g_na_q + l * 64, 0.125f * LOG2E, nullptr, (const float2*)smem, wv_);
      norm_rows<64, 8, 0, false>(big + B_KNA, 64, NTOK * 4, kp()->g_na_k + l * 64, 1.f, nullptr, (const float2*)smem, wv_);
      norm_rows<32, 4, 32, false>(big + B_QDF, 32, NTOK * 8, kp()->g_diff_q + l * 32, 0.17677669529663687f * LOG2E, nullptr, (const float2*)smem, wv_);
      norm_rows<32, 4, 32, false>(big + B_KDF, 32, NTOK * 8, kp()->g_diff_k + l * 32, 1.f, nullptr, (const float2*)smem, wv_);
      norm_rows<64, 8, 64, false>(big + B_QG, 64, NTOK * 4, kp()->g_gqa_q + l * 64, 0.125f * LOG2E, nullptr, (const float2*)smem, wv_);
      norm_rows<64, 8, 64, false>(big + B_KG, 64, NTOK * 2, kp()->g_gqa_k + l * 64, 1.f, nullptr, (const float2*)smem, wv_);
    }
    xcd_barrier(ws, lds, wv_);
    {
      SchedMlaQK S{{}, Wl, big + B_ZMLA, G, cblk};
      EpiMla E{big};
      gemm256<true>(lds, S, E, wv_);
      SchedMlaV S2{{}, Wl, big + B_ZMLA, G, cblk};
      gemm256<true>(lds, S2, E, wv_);
    }
    xcd_barrier(ws, lds, wv_);
    build_rope_tables((float2*)smem, wv_);
    norm_rows<96, 16, 32, false>(big + B_QM, 96, NTOK * 4, kp()->g_mla_q + l * 96, 0.10206207261596575f * LOG2E, nullptr, (const float2*)smem, wv_);
    norm_rows<96, 16, 32, true>(big + B_KM, 96, NTOK * 4, kp()->g_mla_k + l * 96, 1.f, big + B_ZMLA, (const float2*)smem, wv_);
    xcd_barrier(ws, lds, wv_);
    phase_attn(l, big, need_ctx, smem, wv_);
    xcd_barrier(ws, lds, wv_);
    {
      const int nsp = need_ctx ? 3 : 2;
      for (int j = 0; j < nsp; ++j) {
        const int mode = (j < 2) ? 1 : 2, pm0 = (j < 2) ? j * 64 : 0, cnt = (j < 2) ? 64 : 16;
        {
          SchedGate S{{}, hbuf, Wl, pm0, cnt, G, cblk, mode};
          EpiGate E{big + B_G0, pm0};
          gemm256<false>(lds, S, E, wv_);
        }
        xcd_barrier(ws, lds, wv_);
        {
          SchedProj S{{}, big + B_O, Wl, pm0, cnt, G, cblk, mode};
          EpiProj E{big + B_G0, big + B_M, pm0, mode};
          gemm256<true>(lds, S, E, wv_);
        }
        xcd_barrier(ws, lds, wv_);
      }
    }
    {
      SchedResid S{{}, big + B_M, Wl + W_OUT, 1024, 4, need_ctx ? 16 : 0, G, cblk, 2048u, 2048u};
      EpiResid E{xl_src, kp()->out, part, mods_l, 2048};
      gemm256<false>(lds, S, E, wv_);
    }
    xcd_barrier(ws, lds, wv_);
    phase_norm(kp()->out, xc_src, kp()->g_norm2 + l * 1024, mods_l, 3072, 4096, hbuf, skip_ctx, need_ctx ? part : nullptr, need_ctx ? xc : nullptr, wv_);
    xcd_barrier(ws, lds, wv_);
    {
      SchedRows S{{}, hbuf, Wl + W_UP, 1024, nrt, 16, G, cblk, skip_ctx ? 1 : 0, 2048u, 2048u};
      EpiUp E{big + B_U, skip_ctx ? 1 : 0};
      gemm256<true>(lds, S, E, wv_);
    }
    xcd_barrier(ws, lds, wv_);
    {
      SchedResid S{{}, big + B_U, Wl + W_DOWN, 4096, 4, need_ctx ? 16 : 0, G, cblk, 8192u, 8192u};
      EpiResid E{kp()->out, kp()->out, part, mods_l, 5120};
      gemm256<false>(lds, S, E, wv_);
    }
    if (l == 0) xcd_barrier(ws, lds, wv_);
  }
}

extern "C" void kernel_launch(void* const* d_in, const int* in_sizes, int n_in, void* d_out, int out_size, void* d_ws,
                              size_t ws_size, hipStream_t stream) {
  static int grid_blocks = 0;
  if (!grid_blocks) {
    int dev = 0, cus = 0, per_cu = 0;
    (void)hipGetDevice(&dev);
    (void)hipDeviceGetAttribute(&cus, hipDeviceAttributeMultiprocessorCount, dev);
    (void)hipOccupancyMaxActiveBlocksPerMultiprocessor(&per_cu, hybrid_block_megakernel, NTHR, 0);
    if (per_cu < 1) fprintf(stderr, "occupancy query returned %d\n", per_cu);
    grid_blocks = cus;
  }
  if (ws_size < WS_NEED) fprintf(stderr, "workspace too small: %zu < %zu\n", ws_size, (size_t)WS_NEED);
  (void)hipMemsetAsync((char*)d_ws + OFF_BAR, 0, XCD_BAR_WORDS * 4, stream);
  Params p{};
  const float** pf = (const float**)&p;
  for (int i = 0; i < 31; ++i) pf[i] = (const float*)d_in[i];
  p.out = (float*)d_out;
  p.ws = (char*)d_ws;
  void* args[] = {&p};
  hipError_t e = hipLaunchCooperativeKernel((void*)hybrid_block_megakernel, dim3(grid_blocks), dim3(NTHR), args, 0, stream);
  if (e != hipSuccess) fprintf(stderr, "cooperative launch failed: %s (grid %d)\n", hipGetErrorString(e), grid_blocks);
}
```
